# Optimizing an MI355X kernel written in HIP

```python
import jax, jax.numpy as jnp
from jax import lax
import numpy as np

D_MODEL = 1024
BATCH = 16
SEQ = 2048
DEPTH = 4

CTX_LEN = 256
GRID_W = 64
N_MOD = 6

RW_HEADS = 8
RW_HEAD_DIM = 64
RW_DIM = RW_HEADS * RW_HEAD_DIM
RW_DECAY_LORA = 64
RW_ICLR_LORA = 64
RW_GATE_LORA = 128
RW_GN_EPS = 64e-5
RW_IN = 3 * RW_DIM + 2 * RW_DECAY_LORA + 2 * RW_ICLR_LORA + RW_GATE_LORA

HG_HEADS = 4
HG_KEY_DIM = 128
HG_VAL_DIM = 128
HG_DIM = HG_HEADS * HG_KEY_DIM
HG_VDIM = HG_HEADS * HG_VAL_DIM
HG_CHUNK = 64
HG_IN = 3 * HG_DIM + 2 * HG_VDIM
HG_F_FLOOR = 1e-30

EVEN_IN = RW_IN + HG_IN
EVEN_OUT = RW_DIM + HG_VDIM

MLA_HEADS = 16
MLA_NOPE = 64
MLA_ROPE = 32
MLA_V = 64
MLA_Q_RANK = 256
MLA_KV_RANK = 128
MLA_IN = MLA_Q_RANK + MLA_KV_RANK + MLA_ROPE
MLA_QK = MLA_NOPE + MLA_ROPE
MLA_SCALE = MLA_QK ** -0.5
ATTN_BLOCK = 128
ROPE_BASE = 10000.0

N_EXPERTS = 32
TOP_K = 4
EXPERT_DIM = 1024
SWIGLU_LIMIT = 7.0
SWIGLU_ALPHA = 1.702

N_EVEN = (DEPTH + 1) // 2
N_ODD = DEPTH // 2
DEEPNORM_ALPHA = (2 * DEPTH) ** 0.25
DEEPNORM_BETA = (8 * DEPTH) ** -0.25
LN_EPS = 1e-5
RMS_EPS = 1e-6

kernel_name = 'hybrid_rwkv7_hgrn2_mla_moe_dit'


def split_sizes(z, sizes):
    idx, acc = [], 0
    for s in sizes[:-1]:
        acc += s
        idx.append(acc)
    return jnp.split(z, idx, axis=-1)


def layer_norm(x, g, b):
    xf = x.astype(jnp.float32)
    mu = jnp.mean(xf, -1, keepdims=True)
    var = jnp.mean(jnp.square(xf - mu), -1, keepdims=True)
    return ((xf - mu) * lax.rsqrt(var + LN_EPS)).astype(x.dtype) * g + b


def rms_normalize(x):
    xf = x.astype(jnp.float32)
    return xf * lax.rsqrt(jnp.mean(jnp.square(xf), -1, keepdims=True) + RMS_EPS)


def rms_norm(x, g):
    return rms_normalize(x).astype(x.dtype) * g


def modulate(h, shift, scale):
    return h * (1 + scale) + shift


def centred_shift(z):
    prev = jnp.pad(z[:, :-1], ((0, 0), (1, 0), (0, 0)))
    nxt = jnp.pad(z[:, 1:], ((0, 0), (0, 1), (0, 0)))
    return 0.5 * (prev + nxt) - z


def reverse_segments(z, n_ctx):
    return jnp.concatenate([jnp.flip(z[:, :n_ctx], 1), jnp.flip(z[:, n_ctx:], 1)], axis=1)


def scan_order(z_fwd, z_bwd, n_ctx):
    return jnp.stack([z_fwd, reverse_segments(z_bwd, n_ctx)])


def merge_dirs(y, n_ctx):
    return y[0] + reverse_segments(y[1], n_ctx)


def rwkv7_scan(r, w, k, v, aa, bb):
    d2, b, _, h, n = r.shape
    xs = tuple(jnp.moveaxis(z.astype(jnp.float32), 2, 0) for z in (r, w, k, v, aa, bb))

    def step(state, inp):
        r_t, w_t, k_t, v_t, a_t, b_t = inp
        sa = jnp.einsum('dbhvk,dbhk->dbhv', state, a_t)
        state = (state * w_t[..., None, :] + sa[..., :, None] * b_t[..., None, :]
                 + v_t[..., :, None] * k_t[..., None, :])
        return state, jnp.einsum('dbhvk,dbhk->dbhv', state, r_t)

    _, y = lax.scan(step, jnp.zeros((d2, b, h, n, n), jnp.float32), xs)
    return jnp.moveaxis(y, 0, 2)


def rwkv7_group(za, n_ctx, w0, w2, a0, a2, g2, k_k, k_a, r_k, gn_g, gn_b):
    b, t, _ = za.shape
    to_heads = lambda z: z.reshape(*z.shape[:-1], RW_HEADS, RW_HEAD_DIM)
    r, k, v, wd, ad, gd = split_sizes(
        za, [RW_DIM, RW_DIM, RW_DIM, 2 * RW_DECAY_LORA, 2 * RW_ICLR_LORA, RW_GATE_LORA])
    wd = wd.reshape(b, t, 2, RW_DECAY_LORA)
    ad = ad.reshape(b, t, 2, RW_ICLR_LORA)
    w_pre = (w0 + jnp.einsum('btdr,drc->btdc', jnp.tanh(wd), w2)).astype(jnp.float32)
    decay = jnp.exp(-jnp.exp(-jax.nn.softplus(-w_pre) - 0.5))
    a = jax.nn.sigmoid(a0 + jnp.einsum('btdr,drc->btdc', ad, a2))
    g = jax.nn.sigmoid(gd) @ g2
    kk = to_heads((k * k_k).astype(jnp.float32))
    kk = (kk * lax.rsqrt(jnp.maximum(jnp.sum(jnp.square(kk), -1, keepdims=True), 1e-24)))
    kk = kk.reshape(b, t, RW_DIM)
    k_dir = k[:, :, None] * (1 + (a - 1) * k_a)
    bb = kk[:, :, None] * a
    shared = lambda z: to_heads(scan_order(z, z, n_ctx))
    per_dir = lambda z: to_heads(scan_order(z[:, :, 0], z[:, :, 1], n_ctx))
    y = rwkv7_scan(shared(r), per_dir(decay), per_dir(k_dir), shared(v), shared(-kk), per_dir(bb))
    y = merge_dirs(y, n_ctx)
    mu = jnp.mean(y, -1, keepdims=True)
    var = jnp.mean(jnp.square(y - mu), -1, keepdims=True)
    y = ((y - mu) * lax.rsqrt(var + RW_GN_EPS)).reshape(b, t, RW_DIM).astype(za.dtype)
    y = y * gn_g + gn_b
    bonus = jnp.einsum('bthn,btdhn,hn->bth', to_heads(r), to_heads(k_dir), r_k)[..., None] * to_heads(v)
    return (y + bonus.reshape(b, t, RW_DIM)) * g


def hgrn2_chunk_scan(q, k, log_f, v):
    d2, b, t, h, _ = q.shape
    nc = t // HG_CHUNK

    def chunks(z):
        z = z.astype(jnp.float32).reshape(d2, b, nc, HG_CHUNK, h, z.shape[-1])
        return jnp.transpose(z, (2, 0, 1, 4, 3, 5))

    lower_tri = jnp.tril(jnp.ones((HG_CHUNK, HG_CHUNK), bool))[:, :, None]

    def step(state, inp):
        q_c, k_c, g_c, v_c = inp
        cum = jnp.cumsum(g_c, axis=-2)
        diff = cum[..., :, None, :] - cum[..., None, :, :]
        decay = jnp.where(lower_tri, jnp.exp(jnp.minimum(diff, 0.0)), 0.0)
        scores = jnp.einsum('dbhtk,dbhsk,dbhtsk->dbhts', q_c, k_c, decay)
        out = (jnp.einsum('dbhts,dbhsv->dbhtv', scores, v_c)
               + jnp.einsum('dbhtk,dbhkv->dbhtv', q_c * jnp.exp(cum), state))
        last = cum[..., -1:, :]
        state = (state * jnp.exp(last)[..., 0, :, None]
                 + jnp.einsum('dbhsk,dbhsv->dbhkv', k_c * jnp.exp(last - cum), v_c))
        return state, out

    s0 = jnp.zeros((d2, b, h, q.shape[-1], v.shape[-1]), jnp.float32)
    _, o = lax.scan(step, s0, tuple(chunks(z) for z in (q, k, log_f, v)))
    return jnp.transpose(o, (1, 2, 0, 4, 3, 5)).reshape(d2, b, t, h, v.shape[-1])


def hgrn2_group(zb, n_ctx, lower, norm_g):
    b, t, _ = zb.shape
    kh = lambda z: z.reshape(*z.shape[:-1], HG_HEADS, HG_KEY_DIM)
    vh = lambda z: z.reshape(*z.shape[:-1], HG_HEADS, HG_VAL_DIM)
    q, f_logit, i, g = split_sizes(zb, [HG_DIM, 2 * HG_DIM, HG_VDIM, HG_VDIM])
    f_logit = f_logit.reshape(b, t, 2, HG_DIM).astype(jnp.float32)
    sig = jax.nn.sigmoid(f_logit)
    f = lower + (1 - lower) * sig
    log_f = jnp.log(jnp.maximum(f, HG_F_FLOOR))
    k_in = (1 - lower) * (1 - sig)
    q = jax.nn.silu(q)
    o = hgrn2_chunk_scan(kh(scan_order(q, q, n_ctx)),
                         kh(scan_order(k_in[:, :, 0], k_in[:, :, 1], n_ctx)),
                         kh(scan_order(log_f[:, :, 0], log_f[:, :, 1], n_ctx)),
                         vh(scan_order(i, i, n_ctx)))
    o = rms_normalize(merge_dirs(o, n_ctx)).reshape(b, t, HG_VDIM).astype(zb.dtype) * norm_g
    return o * jax.nn.silu(g)


def rwkv7_hgrn2_mixer(u_ctx, u_lat, w_in, mu, w0, w2, a0, a2, g2, k_k, k_a, r_k, gn_g, gn_b,
                      lower, hg_norm_g, w_out, need_ctx):
    n_ctx = u_ctx.shape[1]

    def project(u):
        z = u @ w_in
        za, zb = z[..., :RW_IN], z[..., RW_IN:]
        return za + mu * centred_shift(za), zb

    za_c, zb_c = project(u_ctx)
    za_l, zb_l = project(u_lat)
    za = jnp.concatenate([za_c, za_l], axis=1)
    zb = jnp.concatenate([zb_c, zb_l], axis=1)
    y = jnp.concatenate([rwkv7_group(za, n_ctx, w0, w2, a0, a2, g2, k_k, k_a, r_k, gn_g, gn_b),
                         hgrn2_group(zb, n_ctx, lower, hg_norm_g)], axis=-1)
    if need_ctx:
        y = y @ w_out
        return y[:, :n_ctx], y[:, n_ctx:]
    return None, y[:, n_ctx:] @ w_out


def axial_rope_tables(rows):
    t = jnp.arange(rows * GRID_W)
    row = (t // GRID_W).astype(jnp.float32)
    col = (t % GRID_W).astype(jnp.float32)
    half = MLA_ROPE // 2
    inv_freq = ROPE_BASE ** (-jnp.arange(0, half, 2, dtype=jnp.float32) / half)
    ang_r = row[:, None] * inv_freq
    ang_c = col[:, None] * inv_freq
    ang = jnp.concatenate([ang_r, ang_r, ang_c, ang_c], axis=-1)
    return jnp.cos(ang), jnp.sin(ang)


def rope(x, cos, sin):
    r1, r2, c1, c2 = jnp.split(x, 4, axis=-1)
    rot = jnp.concatenate([-r2, r1, -c2, c1], axis=-1)
    return x * cos.astype(x.dtype) + rot * sin.astype(x.dtype)


def mla_queries(zq, q_norm_g, w_qb, cos, sin):
    b, l, _ = zq.shape
    q = (rms_norm(zq, q_norm_g) @ w_qb).reshape(b, l, MLA_HEADS, MLA_QK)
    if cos is None:
        return q
    return jnp.concatenate([q[..., :MLA_NOPE], rope(q[..., MLA_NOPE:], cos[:, None], sin[:, None])], -1)


def mla_keys_values(zkv, kv_norm_g, w_kvb, cos, sin):
    b, l, _ = zkv.shape
    kva, kpe = zkv[..., :MLA_KV_RANK], zkv[..., MLA_KV_RANK:]
    kv = (rms_norm(kva, kv_norm_g) @ w_kvb).reshape(b, l, MLA_HEADS, MLA_NOPE + MLA_V)
    if cos is not None:
        kpe = rope(kpe, cos, sin)
    k = jnp.concatenate([kv[..., :MLA_NOPE],
                         jnp.broadcast_to(kpe[:, :, None], (b, l, MLA_HEADS, MLA_ROPE))], axis=-1)
    return k, kv[..., MLA_NOPE:]


def attend(q, k, v):
    s = jnp.einsum('bqhd,bkhd->bhqk', q, k).astype(jnp.float32) * MLA_SCALE
    p = jax.nn.softmax(s, axis=-1).astype(v.dtype)
    return jnp.einsum('bhqk,bkhd->bqhd', p, v)


def mla_mixer(u_ctx, u_lat, w_in, q_norm_g, w_qb, kv_norm_g, w_kvb, w_out, cos, sin, need_ctx):
    b, n_lat, _ = u_lat.shape
    z_lat = u_lat @ w_in
    q_lat = mla_queries(z_lat[..., :MLA_Q_RANK], q_norm_g, w_qb, cos, sin)
    k_lat, v_lat = mla_keys_values(z_lat[..., MLA_Q_RANK:], kv_norm_g, w_kvb, cos, sin)
    k_ctx, v_ctx = mla_keys_values(u_ctx @ w_in[:, MLA_Q_RANK:], kv_norm_g, w_kvb, None, None)
    k_all = jnp.concatenate([k_ctx, k_lat], axis=1)
    v_all = jnp.concatenate([v_ctx, v_lat], axis=1)
    n_blk = n_lat // ATTN_BLOCK
    q_blocks = jnp.moveaxis(q_lat.reshape(b, n_blk, ATTN_BLOCK, MLA_HEADS, MLA_QK), 1, 0)
    o = lax.map(lambda q_b: attend(q_b, k_all, v_all), q_blocks)
    y_lat = jnp.moveaxis(o, 0, 1).reshape(b, n_lat, MLA_HEADS * MLA_V) @ w_out
    if not need_ctx:
        return None, y_lat
    q_ctx = mla_queries(u_ctx @ w_in[:, :MLA_Q_RANK], q_norm_g, w_qb, None, None)
    y_ctx = attend(q_ctx, k_ctx, v_ctx).reshape(b, -1, MLA_HEADS * MLA_V) @ w_out
    return y_ctx, y_lat


def moe_clamped_swiglu(u, w_router, b_router, w_gu, b_gu, w_down, b_down):
    logits = (u @ w_router + b_router).astype(jnp.float32)
    top_logit, top_idx = lax.top_k(logits, TOP_K)
    gates = jnp.einsum('nk,nke->ne', jax.nn.softmax(top_logit, axis=-1),
                       jax.nn.one_hot(top_idx, N_EXPERTS, dtype=jnp.float32)).astype(u.dtype)
    out = jnp.zeros_like(u)
    for e in range(N_EXPERTS):
        glu, lin = jnp.split(u @ w_gu[e] + b_gu[e], 2, axis=-1)
        glu = jnp.minimum(glu, SWIGLU_LIMIT)
        lin = jnp.clip(lin, -SWIGLU_LIMIT, SWIGLU_LIMIT)
        act = glu * jax.nn.sigmoid(SWIGLU_ALPHA * glu) * (lin + 1)
        out = out + gates[:, e:e + 1] * (act @ w_down[e] + b_down[e])
    return out


def setup_inputs(seed: int = 0) -> dict:
    key = jax.random.key(seed)
    keys = jax.random.split(key, 48)
    count = [0]

    def nk():
        k = keys[count[0]]
        count[0] += 1
        return k

    def nrm(shape, scale):
        return scale * jax.random.normal(nk(), shape, jnp.float32)

    def unif(shape, lo, hi):
        return jax.random.uniform(nk(), shape, jnp.float32, lo, hi)

    D, F, E = D_MODEL, EXPERT_DIM, N_EXPERTS
    return {
        'x': nrm((BATCH, SEQ, D), 1.0),
        'c': nrm((BATCH, D), 1.0),
        'ctx': nrm((BATCH, CTX_LEN, D), 1.0),
        'c_ctx': nrm((D,), 1.0),
        'mod_w': nrm((DEPTH, D, N_MOD * D), 0.5 * D ** -0.5),
        'mod_b': nrm((DEPTH, N_MOD * D), 0.02),
        'ln_g': 1.0 + nrm((DEPTH, 2, D), 0.02),
        'ln_b': nrm((DEPTH, 2, D), 0.02),
        'ev_w_in': nrm((N_EVEN, D, EVEN_IN), D ** -0.5),
        'rw_mu': unif((N_EVEN, RW_IN), 0.2, 0.8),
        'rw_w0': unif((N_EVEN, 2, RW_DIM), -6.5, -1.5),
        'rw_w2': nrm((N_EVEN, 2, RW_DECAY_LORA, RW_DIM), 0.1 * RW_DECAY_LORA ** -0.5),
        'rw_a0': nrm((N_EVEN, 2, RW_DIM), 0.1),
        'rw_a2': nrm((N_EVEN, 2, RW_ICLR_LORA, RW_DIM), 0.1 * RW_ICLR_LORA ** -0.5),
        'rw_g2': nrm((N_EVEN, RW_GATE_LORA, RW_DIM), RW_GATE_LORA ** -0.5),
        'rw_k_k': 0.85 + nrm((N_EVEN, RW_DIM), 0.02),
        'rw_k_a': 1.0 + nrm((N_EVEN, RW_DIM), 0.02),
        'rw_r_k': nrm((N_EVEN, RW_HEADS, RW_HEAD_DIM), 0.1),
        'rw_gn_g': 1.0 + nrm((N_EVEN, RW_DIM), 0.02),
        'rw_gn_b': nrm((N_EVEN, RW_DIM), 0.02),
        'hg_lb': nrm((N_EVEN, 2, HG_DIM), 0.5),
        'hg_norm_g': 1.0 + nrm((N_EVEN, HG_VDIM), 0.02),
        'ev_w_out': nrm((N_EVEN, EVEN_OUT, D), DEEPNORM_BETA * EVEN_OUT ** -0.5),
        'od_w_in': nrm((N_ODD, D, MLA_IN), D ** -0.5),
        'mla_q_norm_g': 1.0 + nrm((N_ODD, MLA_Q_RANK), 0.02),
        'mla_w_qb': nrm((N_ODD, MLA_Q_RANK, MLA_HEADS * MLA_QK), MLA_Q_RANK ** -0.5),
        'mla_kv_norm_g': 1.0 + nrm((N_ODD, MLA_KV_RANK), 0.02),
        'mla_w_kvb': nrm((N_ODD, MLA_KV_RANK, MLA_HEADS * (MLA_NOPE + MLA_V)), MLA_KV_RANK ** -0.5),
        'od_w_out': nrm((N_ODD, MLA_HEADS * MLA_V, D), DEEPNORM_BETA * (MLA_HEADS * MLA_V) ** -0.5),
        'moe_w_router': nrm((DEPTH, D, E), D ** -0.5),
        'moe_b_router': nrm((DEPTH, E), 0.01),
        'moe_w_gu': nrm((DEPTH, E, D, 2 * F), D ** -0.5),
        'moe_b_gu': nrm((DEPTH, E, 2 * F), 0.02),
        'moe_w_down': nrm((DEPTH, E, F, D), DEEPNORM_BETA * F ** -0.5),
        'moe_b_down': nrm((DEPTH, E, D), 0.02),
    }


def reference(x, c, ctx, c_ctx, mod_w, mod_b, ln_g, ln_b, ev_w_in, rw_mu, rw_w0, rw_w2, rw_a0,
              rw_a2, rw_g2, rw_k_k, rw_k_a, rw_r_k, rw_gn_g, rw_gn_b, hg_lb, hg_norm_g, ev_w_out,
              od_w_in, mla_q_norm_g, mla_w_qb, mla_kv_norm_g, mla_w_kvb, od_w_out, moe_w_router,
              moe_b_router, moe_w_gu, moe_b_gu, moe_w_down, moe_b_down):
    b, n_lat, d = x.shape
    n_ctx = ctx.shape[1]
    rows = n_lat // GRID_W
    cos, sin = axial_rope_tables(rows)
    lb = jax.nn.softmax(hg_lb.astype(jnp.float32), axis=0)
    hg_lower = jnp.cumsum(lb, axis=0) - lb[0]
    c_act = jax.nn.silu(c)
    cc_act = jax.nn.silu(c_ctx)
    h_lat, h_ctx = x, ctx
    for layer in range(DEPTH):
        need_ctx = layer < DEPTH - 1
        j = layer // 2
        m_lat = jnp.split((c_act @ mod_w[layer] + mod_b[layer])[:, None, :], N_MOD, axis=-1)
        m_ctx = jnp.split(cc_act @ mod_w[layer] + mod_b[layer], N_MOD, axis=-1)
        u_lat = modulate(h_lat, m_lat[0], m_lat[1])
        u_ctx = modulate(h_ctx, m_ctx[0], m_ctx[1])
        if layer % 2 == 0:
            y_ctx, y_lat = rwkv7_hgrn2_mixer(
                u_ctx, u_lat, ev_w_in[j], rw_mu[j], rw_w0[j], rw_w2[j], rw_a0[j], rw_a2[j],
                rw_g2[j], rw_k_k[j], rw_k_a[j], rw_r_k[j], rw_gn_g[j], rw_gn_b[j],
                hg_lower[j], hg_norm_g[j], ev_w_out[j], need_ctx)
        else:
            y_ctx, y_lat = mla_mixer(
                u_ctx, u_lat, od_w_in[j], mla_q_norm_g[j], mla_w_qb[j], mla_kv_norm_g[j],
                mla_w_kvb[j], od_w_out[j], cos, sin, need_ctx)
        h_lat = layer_norm(DEEPNORM_ALPHA * h_lat + m_lat[2] * y_lat, ln_g[layer, 0], ln_b[layer, 0])
        u_lat = modulate(h_lat, m_lat[3], m_lat[4])
        moe_args = (moe_w_router[layer], moe_b_router[layer], moe_w_gu[layer], moe_b_gu[layer],
                    moe_w_down[layer], moe_b_down[layer])
        if need_ctx:
            h_ctx = layer_norm(DEEPNORM_ALPHA * h_ctx + m_ctx[2] * y_ctx, ln_g[layer, 0], ln_b[layer, 0])
            u_ctx = modulate(h_ctx, m_ctx[3], m_ctx[4])
            tokens = jnp.concatenate([u_ctx.reshape(-1, d), u_lat.reshape(-1, d)], axis=0)
            f = moe_clamped_swiglu(tokens, *moe_args)
            f_ctx = f[:b * n_ctx].reshape(h_ctx.shape)
            f_lat = f[b * n_ctx:].reshape(h_lat.shape)
            h_ctx = layer_norm(DEEPNORM_ALPHA * h_ctx + m_ctx[5] * f_ctx, ln_g[layer, 1], ln_b[layer, 1])
        else:
            f_lat = moe_clamped_swiglu(u_lat.reshape(-1, d), *moe_args).reshape(h_lat.shape)
        h_lat = layer_norm(DEEPNORM_ALPHA * h_lat + m_lat[5] * f_lat, ln_g[layer, 1], ln_b[layer, 1])
    return h_lat
```

```cpp
#include <hip/hip_runtime.h>
#include <cstdio>
#include <cstring>
#include <cmath>
#ifdef HOST_TEST
static int D_MODEL = 128, BATCH = 2, SEQ = 128, CTX_LEN = 64, N_EXPERTS = 8, EXPERT_DIM = 64;
#define HD
#else
constexpr int D_MODEL = 1024, BATCH = 16, SEQ = 2048, CTX_LEN = 256, N_EXPERTS = 32, EXPERT_DIM = 1024;
#define HD __host__ __device__
#endif
constexpr int DEPTH = 4, GRID_W = 64, N_MOD = 6;
constexpr int RW_HEADS = 8, RW_HD = 64, RW_DIM = 512, RW_DL = 64, RW_IL = 64, RW_GL = 128, RW_IN = 1920;
constexpr int HG_HEADS = 4, HG_KD = 128, HG_VD = 128, HG_DIM = 512, HG_VDIM = 512, HG_IN = 2560;
constexpr int EVEN_IN = 4480, EVEN_OUT = 1024;
constexpr int MLA_HEADS = 16, MLA_NOPE = 64, MLA_ROPE = 32, MLA_V = 64, MLA_QR = 256, MLA_KVR = 128, MLA_IN = 416, MLA_QK = 96;
constexpr int TOP_K = 4, N_EVEN = 2, N_ODD = 2;
constexpr int MOE_PAD = 256;
#define ALPHA 1.681792830507429f
#define NC_ (BATCH * CTX_LEN)
#define NL_ (BATCH * SEQ)
#define NT_ (NC_ + NL_)
#define TT_ (CTX_LEN + SEQ)
#define NSLOT_ (NT_ * TOP_K + N_EXPERTS * MOE_PAD)

HD inline float sigmoidf_(float x) { return 1.f / (1.f + expf(-x)); }
HD inline float siluf_(float x) { return x / (1.f + expf(-x)); }
HD inline float softplusf_(float x) { return x > 20.f ? x : log1pf(expf(x)); }
HD inline int tokrow(int b, int t) { return t < CTX_LEN ? b * CTX_LEN + t : NC_ + b * SEQ + (t - CTX_LEN); }
HD inline int scan_pos(int d, int i) { return d == 0 ? i : (i < CTX_LEN ? CTX_LEN - 1 - i : CTX_LEN + (SEQ - 1 - (i - CTX_LEN))); }
HD inline int modrow(int row) { return row < NC_ ? BATCH : (row - NC_) / SEQ; }

struct NaiveCtx {
    const float *x, *c, *ctx, *c_ctx, *mod_w, *mod_b, *ln_g, *ln_b, *ev_w_in, *rw_mu, *rw_w0, *rw_w2, *rw_a0, *rw_a2, *rw_g2, *rw_k_k, *rw_k_a, *rw_r_k,
        *rw_gn_g, *rw_gn_b, *hg_lb, *hg_norm_g, *ev_w_out, *od_w_in, *mla_q_norm_g, *mla_w_qb, *mla_kv_norm_g, *mla_w_kvb, *od_w_out, *moe_w_router,
        *moe_b_router, *moe_w_gu, *moe_b_gu, *moe_w_down, *moe_b_down;
    float* out;
    float *H, *MOD, *U, *Z, *ZS, *R, *V, *KKR, *NKK, *G, *DEC, *AG, *KD, *BB, *Y, *HQ, *HF, *HK, *O, *YCAT, *YO;
    float *QN, *KVN, *KPE, *Q, *KV, *AO, *LOGIT, *TOPG, *H1, *ACT, *OUT2;
    int *TOPI, *CNT, *OFF, *CUR, *SLOT, *TOKOF, *TILE_E;
};

struct NaiveWs { size_t total; };
static size_t naive_carve(NaiveCtx& C, char* base) {
    size_t off = 0;
    auto take = [&](size_t nfl) { size_t o = off; off += ((nfl * 4 + 255) / 256) * 256; return base ? (float*)(base + o) : (float*)nullptr; };
    const size_t NT = NT_, NS = NSLOT_;
    C.H = take(NT * D_MODEL); C.MOD = take((size_t)DEPTH * (BATCH + 1) * N_MOD * D_MODEL); C.U = take(NT * D_MODEL); C.YO = take(NT * D_MODEL);
    C.LOGIT = take(NT * N_EXPERTS); C.TOPG = take(NT * TOP_K);
    C.TOPI = (int*)take(NT * TOP_K); C.CNT = (int*)take(64); C.OFF = (int*)take(64); C.CUR = (int*)take(64); C.SLOT = (int*)take(NT * TOP_K); C.TOKOF = (int*)take(NS);
    C.TILE_E = (int*)take(NS / 64 + 64);
    const size_t ubase = off; size_t umax = off;
    C.Z = take(NT * EVEN_IN); C.ZS = take(NT * RW_IN);
    C.R = take(NT * 512); C.V = take(NT * 512); C.KKR = take(NT * 512); C.NKK = take(NT * 512); C.G = take(NT * 512);
    C.DEC = take(2 * NT * 512); C.AG = take(2 * NT * 512); C.KD = take(2 * NT * 512); C.BB = take(2 * NT * 512); C.Y = take(2 * NT * 512);
    C.HQ = take(NT * 512); C.HF = take(2 * NT * 512); C.HK = take(2 * NT * 512); C.O = take(2 * NT * 512);
    C.YCAT = take(NT * 1024);
    umax = off > umax ? off : umax; off = ubase;
    (void)take(NT * EVEN_IN);
    C.QN = take(NT * MLA_QR); C.KVN = take(NT * MLA_KVR); C.KPE = take(NT * MLA_ROPE); C.Q = take(NT * MLA_HEADS * MLA_QK); C.KV = take(NT * MLA_HEADS * 128);
    C.AO = take(NT * 1024);
    umax = off > umax ? off : umax; off = ubase;
    C.H1 = take(NS * 2 * EXPERT_DIM); C.ACT = take(NS * EXPERT_DIM); C.OUT2 = take(NS * D_MODEL);
    umax = off > umax ? off : umax; off = umax;
    return off;
}

#ifdef HOST_TEST
#define NLAUNCH(n, ...) do { auto f_ = __VA_ARGS__; for (long i_ = 0; i_ < (long)(n); ++i_) f_(i_); } while (0)
#else
template <class F> __global__ void __launch_bounds__(256) k_run(long n, F f) { for (long i = (long)blockIdx.x * 256 + threadIdx.x; i < n; i += (long)gridDim.x * 256) f(i); }
template <class F> static void nlaunch_(long n, F f, hipStream_t st) { long nb = (n + 255) / 256; if (nb > 65536) nb = 65536; if (nb < 1) nb = 1; hipLaunchKernelGGL(k_run<F>, dim3((unsigned)nb), dim3(256), 0, st, n, f); }
#define NLAUNCH(n, ...) nlaunch_((long)(n), __VA_ARGS__, g_stream)
static hipStream_t g_stream;
#endif

#ifdef HOST_TEST
static void ngemm(const float* A, int lda, const int* arow, const float* B, long bstride, int ldb, const float* bias, long biasstride, float* Cm, int ldc, int M, int N, int K, const int* tile_e) {
    for (int m = 0; m < M; ++m) {
        int e = 0; if (tile_e) { e = tile_e[m / 64]; if (e < 0) continue; }
        int ar = arow ? arow[m] : m; if (ar < 0) continue;
        const float* Bp = B + (size_t)e * bstride;
        for (int n = 0; n < N; ++n) { double s = bias ? bias[(size_t)e * biasstride + n] : 0.0; for (int k = 0; k < K; ++k) s += (double)A[(size_t)ar * lda + k] * Bp[(size_t)k * ldb + n]; Cm[(size_t)m * ldc + n] = (float)s; }
    }
}
#else
__global__ void __launch_bounds__(256) k_ngemm(const float* A, const int* arow, const float* B, const float* bias, float* Cm, const int* tile_e, long bstride, long biasstride, int lda, int ldb, int ldc, int M, int N, int K) {
    __shared__ float As[16][68], Bs[16][68];
    const int rt = blockIdx.y, ct = blockIdx.x, tid = threadIdx.x, tx = tid & 15, ty = tid >> 4;
    int e = 0; if (tile_e) { e = tile_e[rt]; if (e < 0) return; }
    const float* Bp = B + (size_t)e * bstride;
    const int m0 = rt * 64, n0 = ct * 64;
    float acc[4][4] = {};
    const int ar_l = tid >> 2, ak = (tid & 3) * 4; int am = m0 + ar_l; int arr = -1; if (am < M) arr = arow ? arow[am] : am;
    const int bk = tid >> 4, bn = (tid & 15) * 4;
    for (int k0 = 0; k0 < K; k0 += 16) {
        float4 av = make_float4(0, 0, 0, 0); if (arr >= 0) av = *(const float4*)(A + (size_t)arr * lda + k0 + ak);
        As[ak + 0][ar_l] = av.x; As[ak + 1][ar_l] = av.y; As[ak + 2][ar_l] = av.z; As[ak + 3][ar_l] = av.w;
        float bv[4]; for (int j = 0; j < 4; ++j) { int n = n0 + bn + j; bv[j] = n < N ? Bp[(size_t)(k0 + bk) * ldb + n] : 0.f; }
        Bs[bk][bn + 0] = bv[0]; Bs[bk][bn + 1] = bv[1]; Bs[bk][bn + 2] = bv[2]; Bs[bk][bn + 3] = bv[3];
        __syncthreads();
_Pragma("unroll")
        for (int k = 0; k < 16; ++k) {
            float a[4], b[4];
_Pragma("unroll")
            for (int i = 0; i < 4; ++i) { a[i] = As[k][ty * 4 + i]; b[i] = Bs[k][tx * 4 + i]; }
_Pragma("unroll")
            for (int i = 0; i < 4; ++i)
_Pragma("unroll")
                for (int j = 0; j < 4; ++j) acc[i][j] += a[i] * b[j];
        }
        __syncthreads();
    }
_Pragma("unroll")
    for (int i = 0; i < 4; ++i) { int m = m0 + ty * 4 + i; if (m >= M) continue;
_Pragma("unroll")
        for (int j = 0; j < 4; ++j) { int n = n0 + tx * 4 + j; if (n < N) Cm[(size_t)m * ldc + n] = acc[i][j] + (bias ? bias[(size_t)e * biasstride + n] : 0.f); } }
}
static void ngemm(const float* A, int lda, const int* arow, const float* B, long bstride, int ldb, const float* bias, long biasstride, float* Cm, int ldc, int M, int N, int K, const int* tile_e) {
    dim3 grid((N + 63) / 64, (M + 63) / 64);
    hipLaunchKernelGGL(k_ngemm, grid, dim3(256), 0, g_stream, A, arow, B, bias, Cm, tile_e, bstride, biasstride, lda, ldb, ldc, M, N, K);
}
#endif

static void naive_forward(NaiveCtx C) {
    const int D = D_MODEL, NT = NT_, NC = NC_;
    NLAUNCH((long)NT * D, [=] HD(long i) { long row = i / D_MODEL; int d = (int)(i % D_MODEL); C.H[i] = row < NC_ ? C.ctx[row * D_MODEL + d] : C.x[(row - NC_) * D_MODEL + d]; });
    NLAUNCH((long)DEPTH * (BATCH + 1) * N_MOD * D, [=] HD(long i) {
        const int W = N_MOD * D_MODEL; int j = (int)(i % W); long t = i / W; int r = (int)(t % (BATCH + 1)); int l = (int)(t / (BATCH + 1));
        const float* cv = r < BATCH ? C.c + (size_t)r * D_MODEL : C.c_ctx; const float* w = C.mod_w + (size_t)l * D_MODEL * W;
        float s = 0.f; for (int k = 0; k < D_MODEL; ++k) s += siluf_(cv[k]) * w[(size_t)k * W + j];
        C.MOD[i] = s + C.mod_b[(size_t)l * W + j]; });
    for (int layer = 0; layer < DEPTH; ++layer) {
        const bool need_ctx = layer < DEPTH - 1; const long j2 = layer / 2;
        const float* MODL = C.MOD + (size_t)layer * (BATCH + 1) * N_MOD * D;
        NLAUNCH((long)NT * D, [=] HD(long i) { long row = i / D_MODEL; int d = (int)(i % D_MODEL); const float* m = MODL + (size_t)modrow((int)row) * N_MOD * D_MODEL; C.U[i] = C.H[i] * (1.f + m[D_MODEL + d]) + m[d]; });
        if (layer % 2 == 0) {
            ngemm(C.U, D, nullptr, C.ev_w_in + (size_t)j2 * D * EVEN_IN, 0, EVEN_IN, nullptr, 0, C.Z, EVEN_IN, NT, EVEN_IN, D, nullptr);
            const float* mu = C.rw_mu + (size_t)j2 * RW_IN;
            NLAUNCH((long)NT * RW_IN, [=] HD(long i) { int row = (int)(i / RW_IN), c = (int)(i % RW_IN);
                int t, len; if (row < NC_) { t = row % CTX_LEN; len = CTX_LEN; } else { t = (row - NC_) % SEQ; len = SEQ; }
                float z = C.Z[(size_t)row * EVEN_IN + c]; float p = t > 0 ? C.Z[(size_t)(row - 1) * EVEN_IN + c] : 0.f; float n = t < len - 1 ? C.Z[(size_t)(row + 1) * EVEN_IN + c] : 0.f;
                C.ZS[i] = z + mu[c] * (0.5f * (p + n) - z); });
            const float *w0 = C.rw_w0 + (size_t)j2 * 2 * 512, *w2 = C.rw_w2 + (size_t)j2 * 2 * 64 * 512, *a0 = C.rw_a0 + (size_t)j2 * 2 * 512, *a2 = C.rw_a2 + (size_t)j2 * 2 * 64 * 512,
                        *g2 = C.rw_g2 + (size_t)j2 * 128 * 512, *k_k = C.rw_k_k + (size_t)j2 * 512, *k_a = C.rw_k_a + (size_t)j2 * 512, *r_k = C.rw_r_k + (size_t)j2 * 512,
                        *gn_g = C.rw_gn_g + (size_t)j2 * 512, *gn_b = C.rw_gn_b + (size_t)j2 * 512;
            NLAUNCH((long)NT * 512, [=] HD(long i) { int row = (int)(i / 512), c = (int)(i % 512); const float* zs = C.ZS + (size_t)row * RW_IN;
                float r = zs[c], k = zs[512 + c], v = zs[1024 + c];
                C.R[i] = r; C.V[i] = v; C.KKR[i] = k * k_k[c];
                float g = 0.f; for (int q = 0; q < 128; ++q) g += sigmoidf_(zs[1792 + q]) * g2[(size_t)q * 512 + c];
                C.G[i] = g;
                for (int d = 0; d < 2; ++d) {
                    float wl = 0.f, al = 0.f;
                    for (int q = 0; q < 64; ++q) { wl += tanhf(zs[1536 + d * 64 + q]) * w2[((size_t)d * 64 + q) * 512 + c]; al += zs[1664 + d * 64 + q] * a2[((size_t)d * 64 + q) * 512 + c]; }
                    float wpre = w0[d * 512 + c] + wl; float dec = expf(-expf(-softplusf_(-wpre) - 0.5f)); float a = sigmoidf_(a0[d * 512 + c] + al);
                    size_t o = ((size_t)d * NT_ + row) * 512 + c;
                    C.DEC[o] = dec; C.AG[o] = a; C.KD[o] = k * (1.f + (a - 1.f) * k_a[c]);
                } });
            NLAUNCH((long)NT * RW_HEADS, [=] HD(long i) { int row = (int)(i / RW_HEADS), h = (int)(i % RW_HEADS); size_t b0 = (size_t)row * 512 + h * 64;
                float ss = 0.f; for (int n = 0; n < 64; ++n) ss += C.KKR[b0 + n] * C.KKR[b0 + n];
                float inv = 1.f / sqrtf(fmaxf(ss, 1e-24f));
                for (int n = 0; n < 64; ++n) { float kk = C.KKR[b0 + n] * inv; C.NKK[b0 + n] = -kk; for (int d = 0; d < 2; ++d) { size_t o = ((size_t)d * NT_ + row) * 512 + h * 64 + n; C.BB[o] = kk * C.AG[o]; } } });
            NLAUNCH((long)2 * BATCH * RW_HEADS * 64, [=] HD(long i) { int v = (int)(i % 64); long t = i / 64; int h = (int)(t % RW_HEADS); t /= RW_HEADS; int b = (int)(t % BATCH); int d = (int)(t / BATCH);
                float S[64];
_Pragma("unroll")
                for (int k = 0; k < 64; ++k) S[k] = 0.f;
                for (int st = 0; st < TT_; ++st) { int row = tokrow(b, scan_pos(d, st)); size_t s0 = (size_t)row * 512 + h * 64, s1 = ((size_t)d * NT_ + row) * 512 + h * 64;
                    float sa = 0.f;
_Pragma("unroll")
                    for (int k = 0; k < 64; ++k) sa += S[k] * C.NKK[s0 + k];
                    float vv = C.V[s0 + v], y = 0.f;
_Pragma("unroll")
                    for (int k = 0; k < 64; ++k) { S[k] = S[k] * C.DEC[s1 + k] + sa * C.BB[s1 + k] + vv * C.KD[s1 + k]; y += S[k] * C.R[s0 + k]; }
                    C.Y[s1 + v] = y; } });
            const float* lbp = C.hg_lb; const float* hgn = C.hg_norm_g + (size_t)j2 * 512;
            NLAUNCH((long)NT * 512, [=] HD(long i) { int row = (int)(i / 512), c = (int)(i % 512); const float* zb = C.Z + (size_t)row * EVEN_IN + RW_IN;
                C.HQ[i] = siluf_(zb[c]);
                for (int d = 0; d < 2; ++d) {
                    float mx = -1e30f; for (int q = 0; q < N_EVEN; ++q) mx = fmaxf(mx, lbp[((size_t)q * 2 + d) * 512 + c]);
                    float den = 0.f, num = 0.f; for (int q = 0; q < N_EVEN; ++q) { float e = expf(lbp[((size_t)q * 2 + d) * 512 + c] - mx); den += e; if (q >= 1 && q <= j2) num += e; }
                    float lower = num / den;
                    float sig = sigmoidf_(zb[512 + d * 512 + c]); float f = lower + (1.f - lower) * sig; f = fmaxf(f, 1e-30f);
                    size_t o = ((size_t)d * NT_ + row) * 512 + c; C.HF[o] = f; C.HK[o] = (1.f - lower) * (1.f - sig);
                } });
            NLAUNCH((long)2 * BATCH * HG_HEADS * 128, [=] HD(long i) { int v = (int)(i % 128); long t = i / 128; int h = (int)(t % HG_HEADS); t /= HG_HEADS; int b = (int)(t % BATCH); int d = (int)(t / BATCH);
                float S[128];
_Pragma("unroll")
                for (int k = 0; k < 128; ++k) S[k] = 0.f;
                for (int st = 0; st < TT_; ++st) { int row = tokrow(b, scan_pos(d, st)); size_t s0 = (size_t)row * 512 + h * 128, s1 = ((size_t)d * NT_ + row) * 512 + h * 128;
                    float val = C.Z[(size_t)row * EVEN_IN + RW_IN + 1536 + h * 128 + v], o = 0.f;
_Pragma("unroll")
                    for (int k = 0; k < 128; ++k) { S[k] = C.HF[s1 + k] * S[k] + C.HK[s1 + k] * val; o += S[k] * C.HQ[s0 + k]; }
                    C.O[s1 + v] = o; } });
            NLAUNCH((long)NT * RW_HEADS, [=] HD(long i) { int row = (int)(i / RW_HEADS), h = (int)(i % RW_HEADS); size_t b0 = (size_t)row * 512 + h * 64, b1 = ((size_t)NT_ + row) * 512 + h * 64;
                float mu_ = 0.f; for (int n = 0; n < 64; ++n) mu_ += C.Y[b0 + n] + C.Y[b1 + n]; mu_ /= 64.f;
                float var = 0.f; for (int n = 0; n < 64; ++n) { float y = C.Y[b0 + n] + C.Y[b1 + n] - mu_; var += y * y; } var /= 64.f;
                float rs = 1.f / sqrtf(var + 64e-5f);
                float bon = 0.f; for (int n = 0; n < 64; ++n) bon += C.R[b0 + n] * (C.KD[b0 + n] + C.KD[b1 + n]) * r_k[h * 64 + n];
                for (int n = 0; n < 64; ++n) { int c = h * 64 + n; float y = (C.Y[b0 + n] + C.Y[b1 + n] - mu_) * rs * gn_g[c] + gn_b[c]; C.YCAT[(size_t)row * 1024 + c] = (y + bon * C.V[b0 + n]) * C.G[b0 + n]; } });
            NLAUNCH((long)NT * HG_HEADS, [=] HD(long i) { int row = (int)(i / HG_HEADS), h = (int)(i % HG_HEADS); size_t b0 = (size_t)row * 512 + h * 128, b1 = ((size_t)NT_ + row) * 512 + h * 128;
                float ss = 0.f; for (int n = 0; n < 128; ++n) { float o = C.O[b0 + n] + C.O[b1 + n]; ss += o * o; }
                float rs = 1.f / sqrtf(ss / 128.f + 1e-6f);
                for (int n = 0; n < 128; ++n) { int c = h * 128 + n; float o = (C.O[b0 + n] + C.O[b1 + n]) * rs * hgn[c]; C.YCAT[(size_t)row * 1024 + 512 + c] = o * siluf_(C.Z[(size_t)row * EVEN_IN + RW_IN + 2048 + c]); } });
            ngemm(C.YCAT, 1024, nullptr, C.ev_w_out + (size_t)j2 * 1024 * D, 0, D, nullptr, 0, C.YO, D, NT, D, 1024, nullptr);
        } else {
            ngemm(C.U, D, nullptr, C.od_w_in + (size_t)j2 * D * MLA_IN, 0, MLA_IN, nullptr, 0, C.Z, EVEN_IN, NT, MLA_IN, D, nullptr);
            const float *qng = C.mla_q_norm_g + (size_t)j2 * MLA_QR, *kvng = C.mla_kv_norm_g + (size_t)j2 * MLA_KVR;
            NLAUNCH((long)NT, [=] HD(long i) { int row = (int)i; const float* z = C.Z + (size_t)row * EVEN_IN;
                float ss = 0.f; for (int k = 0; k < MLA_QR; ++k) ss += z[k] * z[k]; float rs = 1.f / sqrtf(ss / MLA_QR + 1e-6f);
                for (int k = 0; k < MLA_QR; ++k) C.QN[(size_t)row * MLA_QR + k] = z[k] * rs * qng[k];
                ss = 0.f; for (int k = 0; k < MLA_KVR; ++k) ss += z[MLA_QR + k] * z[MLA_QR + k]; rs = 1.f / sqrtf(ss / MLA_KVR + 1e-6f);
                for (int k = 0; k < MLA_KVR; ++k) C.KVN[(size_t)row * MLA_KVR + k] = z[MLA_QR + k] * rs * kvng[k];
                const float* kp = z + MLA_QR + MLA_KVR; float* o = C.KPE + (size_t)row * 32;
                if (row < NC_) { for (int k = 0; k < 32; ++k) o[k] = kp[k]; }
                else { int s = (row - NC_) % SEQ; float fr = (float)(s / GRID_W), fc = (float)(s % GRID_W);
                    for (int q = 0; q < 8; ++q) { float inv = powf(10000.f, -(float)(2 * q) / 16.f); float ar = fr * inv, ac = fc * inv; float cr = cosf(ar), sr = sinf(ar), cc = cosf(ac), sc = sinf(ac);
                        o[q] = kp[q] * cr - kp[8 + q] * sr; o[8 + q] = kp[8 + q] * cr + kp[q] * sr; o[16 + q] = kp[16 + q] * cc - kp[24 + q] * sc; o[24 + q] = kp[24 + q] * cc + kp[16 + q] * sc; } } });
            ngemm(C.QN, MLA_QR, nullptr, C.mla_w_qb + (size_t)j2 * MLA_QR * 1536, 0, 1536, nullptr, 0, C.Q, 1536, NT, 1536, MLA_QR, nullptr);
            ngemm(C.KVN, MLA_KVR, nullptr, C.mla_w_kvb + (size_t)j2 * MLA_KVR * 2048, 0, 2048, nullptr, 0, C.KV, 2048, NT, 2048, MLA_KVR, nullptr);
            NLAUNCH((long)NL_ * MLA_HEADS * 8, [=] HD(long i) { int q = (int)(i % 8); long t = i / 8; int h = (int)(t % MLA_HEADS); int lr = (int)(t / MLA_HEADS); int s = lr % SEQ;
                float* p = C.Q + (size_t)(NC_ + lr) * 1536 + h * 96 + 64; float fr = (float)(s / GRID_W), fc = (float)(s % GRID_W);
                float inv = powf(10000.f, -(float)(2 * q) / 16.f); float ar = fr * inv, ac = fc * inv; float cr = cosf(ar), sr = sinf(ar), cc = cosf(ac), sc = sinf(ac);
                float r1 = p[q], r2 = p[8 + q], c1 = p[16 + q], c2 = p[24 + q];
                p[q] = r1 * cr - r2 * sr; p[8 + q] = r2 * cr + r1 * sr; p[16 + q] = c1 * cc - c2 * sc; p[24 + q] = c2 * cc + c1 * sc; });
            const long row_lo = need_ctx ? 0 : NC;
            NLAUNCH((long)(NT - row_lo) * MLA_HEADS, [=] HD(long i) { const int nrows_ = NT_ - (int)row_lo; int h = (int)(i / nrows_); int row = (int)row_lo + (int)(i % nrows_);
                int b, nkeys; if (row < NC_) { b = row / CTX_LEN; nkeys = CTX_LEN; } else { b = (row - NC_) / SEQ; nkeys = TT_; }
                float q[96];
_Pragma("unroll")
                for (int k = 0; k < 96; ++k) q[k] = C.Q[(size_t)row * 1536 + h * 96 + k];
                float o[64];
_Pragma("unroll")
                for (int k = 0; k < 64; ++k) o[k] = 0.f;
                float m = -1e30f, l = 0.f; const float scale = 0.10206207261596577f;
                for (int t = 0; t < nkeys; ++t) { int kr = tokrow(b, t); const float* kn = C.KV + (size_t)kr * 2048 + h * 128; const float* kp = C.KPE + (size_t)kr * 32;
                    float s = 0.f;
_Pragma("unroll")
                    for (int k = 0; k < 64; ++k) s += q[k] * kn[k];
_Pragma("unroll")
                    for (int k = 0; k < 32; ++k) s += q[64 + k] * kp[k];
                    s *= scale; float mn = fmaxf(m, s); float corr = expf(m - mn), p = expf(s - mn); l = l * corr + p;
_Pragma("unroll")
                    for (int k = 0; k < 64; ++k) o[k] = o[k] * corr + p * kn[64 + k];
                    m = mn; }
                float il = 1.f / l;
_Pragma("unroll")
                for (int k = 0; k < 64; ++k) C.AO[(size_t)row * 1024 + h * 64 + k] = o[k] * il; });
            ngemm(C.AO, 1024, nullptr, C.od_w_out + (size_t)j2 * 1024 * D, 0, D, nullptr, 0, C.YO, D, NT, D, 1024, nullptr);
        }
        const float *lng0 = C.ln_g + ((size_t)layer * 2 + 0) * D, *lnb0 = C.ln_b + ((size_t)layer * 2 + 0) * D, *lng1 = C.ln_g + ((size_t)layer * 2 + 1) * D, *lnb1 = C.ln_b + ((size_t)layer * 2 + 1) * D;
        const long row_lo = need_ctx ? 0 : NC;
        NLAUNCH((long)(NT - row_lo), [=] HD(long i) { int row = (int)row_lo + (int)i; const float* m = MODL + (size_t)modrow(row) * N_MOD * D_MODEL; float* h = C.H + (size_t)row * D_MODEL; const float* yo = C.YO + (size_t)row * D_MODEL;
            float mu_ = 0.f; for (int d = 0; d < D_MODEL; ++d) mu_ += ALPHA * h[d] + m[2 * D_MODEL + d] * yo[d]; mu_ /= D_MODEL;
            float var = 0.f; for (int d = 0; d < D_MODEL; ++d) { float t = ALPHA * h[d] + m[2 * D_MODEL + d] * yo[d] - mu_; var += t * t; } var /= D_MODEL;
            float rs = 1.f / sqrtf(var + 1e-5f);
            for (int d = 0; d < D_MODEL; ++d) { float t = (ALPHA * h[d] + m[2 * D_MODEL + d] * yo[d] - mu_) * rs * lng0[d] + lnb0[d]; h[d] = t; C.U[(size_t)row * D_MODEL + d] = t * (1.f + m[4 * D_MODEL + d]) + m[3 * D_MODEL + d]; } });
        const float *wr = C.moe_w_router + (size_t)layer * D * N_EXPERTS, *br = C.moe_b_router + (size_t)layer * N_EXPERTS;
        NLAUNCH((long)(NT - row_lo) * N_EXPERTS, [=] HD(long i) { int e = (int)(i % N_EXPERTS); int row = (int)row_lo + (int)(i / N_EXPERTS); const float* u = C.U + (size_t)row * D_MODEL;
            float s = 0.f; for (int k = 0; k < D_MODEL; ++k) s += u[k] * wr[(size_t)k * N_EXPERTS + e]; C.LOGIT[(size_t)row * N_EXPERTS + e] = s + br[e]; });
        NLAUNCH(64, [=] HD(long i) { C.CNT[i] = 0; C.CUR[i] = 0; });
        NLAUNCH((long)(NT - row_lo), [=] HD(long i) { int row = (int)row_lo + (int)i; const float* lg = C.LOGIT + (size_t)row * N_EXPERTS; int idx[TOP_K]; float val[TOP_K];
            for (int k = 0; k < TOP_K; ++k) { int best = -1; float bv = -3.4e38f; for (int e = 0; e < N_EXPERTS; ++e) { bool used = false; for (int q = 0; q < k; ++q) used |= (idx[q] == e); if (!used && lg[e] > bv) { bv = lg[e]; best = e; } } idx[k] = best; val[k] = bv; }
            float den = 0.f; for (int k = 0; k < TOP_K; ++k) den += expf(val[k] - val[0]);
            for (int k = 0; k < TOP_K; ++k) { C.TOPI[(size_t)row * TOP_K + k] = idx[k]; C.TOPG[(size_t)row * TOP_K + k] = expf(val[k] - val[0]) / den;
#ifdef HOST_TEST
                C.CNT[idx[k]]++;
#else
                atomicAdd(&C.CNT[idx[k]], 1);
#endif
            } });
        NLAUNCH(1, [=] HD(long) { int off = 0; for (int e = 0; e < N_EXPERTS; ++e) { C.OFF[e] = off; int nt = (C.CNT[e] + MOE_PAD - 1) / MOE_PAD * MOE_PAD; for (int t = 0; t < nt / 64; ++t) C.TILE_E[off / 64 + t] = (t * 64 < C.CNT[e]) ? e : -1; off += nt; }
            for (int t = off / 64; t < NSLOT_ / 64; ++t) C.TILE_E[t] = -1; });
        NLAUNCH((long)NSLOT_, [=] HD(long i) { C.TOKOF[i] = -1; });
        NLAUNCH((long)(NT - row_lo) * TOP_K, [=] HD(long i) { int row = (int)row_lo + (int)(i / TOP_K); int k = (int)(i % TOP_K); int e = C.TOPI[(size_t)row * TOP_K + k];
#ifdef HOST_TEST
            int r = C.CUR[e]++;
#else
            int r = atomicAdd(&C.CUR[e], 1);
#endif
            int s = C.OFF[e] + r; C.SLOT[(size_t)row * TOP_K + k] = s; C.TOKOF[s] = row; });
        const int F = EXPERT_DIM;
        ngemm(C.U, D, C.TOKOF, C.moe_w_gu + (size_t)layer * N_EXPERTS * D * 2 * F, (long)D * 2 * F, 2 * F, C.moe_b_gu + (size_t)layer * N_EXPERTS * 2 * F, 2 * F, C.H1, 2 * F, NSLOT_, 2 * F, D, C.TILE_E);
        NLAUNCH((long)NSLOT_ * F, [=] HD(long i) { long s = i / EXPERT_DIM; int j = (int)(i % EXPERT_DIM); if (C.TOKOF[s] < 0) { C.ACT[i] = 0.f; return; }
            float glu = fminf(C.H1[s * 2 * EXPERT_DIM + j], 7.f), lin = fminf(fmaxf(C.H1[s * 2 * EXPERT_DIM + EXPERT_DIM + j], -7.f), 7.f);
            C.ACT[i] = glu * sigmoidf_(1.702f * glu) * (lin + 1.f); });
        ngemm(C.ACT, F, nullptr, C.moe_w_down + (size_t)layer * N_EXPERTS * F * D, (long)F * D, D, C.moe_b_down + (size_t)layer * N_EXPERTS * D, D, C.OUT2, D, NSLOT_, D, F, C.TILE_E);
        float* outp = C.out; const long last = (layer == DEPTH - 1);
        NLAUNCH((long)(NT - row_lo), [=] HD(long i) { int row = (int)row_lo + (int)i; const float* m = MODL + (size_t)modrow(row) * N_MOD * D_MODEL; float* h = C.H + (size_t)row * D_MODEL;
            const int* sl = C.SLOT + (size_t)row * TOP_K; const float* tg = C.TOPG + (size_t)row * TOP_K;
            float mu_ = 0.f; for (int d = 0; d < D_MODEL; ++d) { float f = 0.f; for (int k = 0; k < TOP_K; ++k) f += tg[k] * C.OUT2[(size_t)sl[k] * D_MODEL + d]; mu_ += ALPHA * h[d] + m[5 * D_MODEL + d] * f; } mu_ /= D_MODEL;
            float var = 0.f; for (int d = 0; d < D_MODEL; ++d) { float f = 0.f; for (int k = 0; k < TOP_K; ++k) f += tg[k] * C.OUT2[(size_t)sl[k] * D_MODEL + d]; float t = ALPHA * h[d] + m[5 * D_MODEL + d] * f - mu_; var += t * t; } var /= D_MODEL;
            float rs = 1.f / sqrtf(var + 1e-5f);
            for (int d = 0; d < D_MODEL; ++d) { float f = 0.f; for (int k = 0; k < TOP_K; ++k) f += tg[k] * C.OUT2[(size_t)sl[k] * D_MODEL + d]; float t = (ALPHA * h[d] + m[5 * D_MODEL + d] * f - mu_) * rs * lng1[d] + lnb1[d]; h[d] = t; if (last) outp[(size_t)(row - NC_) * D_MODEL + d] = t; } });
    }
}
extern "C" void kernel_launch(void* const* d_in, const int* in_sizes, int n_in, void* d_out, int out_size, void* d_ws, size_t ws_size, hipStream_t stream) {
    NaiveCtx C; memset(&C, 0, sizeof(C));
    const float** ip = (const float**)&C.x; for (int i = 0; i < 35; ++i) ip[i] = (const float*)d_in[i];
    C.out = (float*)d_out;
    size_t need = naive_carve(C, (char*)d_ws);
    if (n_in != 35 || need > ws_size) { fprintf(stderr, "kernel_launch: n_in %d ws need %zu have %zu\n", n_in, need, ws_size); return; }
    g_stream = stream;
    naive_forward(C);
}
```

```cpp
#include <hip/hip_runtime.h>
#include <cstdio>
#include <cstring>
#include <cmath>
#define PERSISTENT 1

#define PB_THREADS 512
#define XB_TMO      128
#define XB_XCNT(j)  (256  + 64 * (j))
#define XB_XSUB(j)  (1280 + 64 * (j))
#define XB_XGEN(j)  (2304 + 64 * (j))
#define XB_TOP      3328
#define XB_TOPGEN   3392
#define XCD_BAR_WORDS 3456
#define XB_SPIN_CAP (1u << 22)
#define LAS __attribute__((address_space(3)))

__device__ __forceinline__ unsigned xb_ld(unsigned* p)              { return __hip_atomic_load(p, __ATOMIC_RELAXED, __HIP_MEMORY_SCOPE_AGENT); }
__device__ __forceinline__ unsigned xb_add(unsigned* p, unsigned v) { return __hip_atomic_fetch_add(p, v, __ATOMIC_RELAXED, __HIP_MEMORY_SCOPE_AGENT); }
__device__ __forceinline__ unsigned xb_xcc_id() { return (unsigned)__builtin_amdgcn_s_getreg((3 << 11) | 20) & 0xFu; }
#define XB_SPIN(cond, bar) do { unsigned _sp = 0; while (cond) { __builtin_amdgcn_s_sleep(1); \
    if ((++_sp & 255u) == 0u) { if (xb_ld(&(bar)[XB_TMO])) break; if (_sp > XB_SPIN_CAP) { atomicAdd(&(bar)[XB_TMO], 1u); break; } } } } while (0)

struct XcdBarrier {
    unsigned* bar; unsigned x;
    volatile LAS unsigned* st;
};

__device__ __forceinline__ XcdBarrier xcd_barrier_post(unsigned* bar, volatile LAS unsigned* st) {
    XcdBarrier b; b.bar = bar; b.x = xb_xcc_id(); b.st = st;
    if (threadIdx.x == 0) (void)xb_add(&bar[XB_XCNT(b.x)], 1u);
    return b;
}
__device__ __forceinline__ void xcd_barrier_complete(unsigned* bar, unsigned x, unsigned& nloc, unsigned& nx) {
    const unsigned G = gridDim.x * gridDim.y * gridDim.z;
    unsigned sum, cnt, mine, sp = 0u;
    for (;;) {
        sum = 0u; cnt = 0u; mine = 0u;
#pragma unroll
        for (unsigned j = 0; j < 16; ++j) { const unsigned c = xb_ld(&bar[XB_XCNT(j)]); sum += c; cnt += (c > 0u) ? 1u : 0u; mine = (j == x) ? c : mine; }
        if (sum == G) break;
        __builtin_amdgcn_s_sleep(1);
        if ((++sp & 255u) == 0u) { if (xb_ld(&bar[XB_TMO])) break; if (sp > XB_SPIN_CAP) { atomicAdd(&bar[XB_TMO], 1u); break; } }
    }
    nloc = mine > 0u ? mine : 1u; nx = cnt > 0u ? cnt : 1u;
}

__device__ __forceinline__ void xcd_barrier(const XcdBarrier& b) {
    asm volatile("s_waitcnt vmcnt(0)" ::: "memory");
    __syncthreads();
    if (threadIdx.x == 0) {
        unsigned* bar = b.bar;
        __builtin_amdgcn_s_waitcnt(0);
        unsigned nloc = b.st[0], nx = b.st[1];
        if (nloc == 0u) { xcd_barrier_complete(bar, b.x, nloc, nx); b.st[0] = nloc; b.st[1] = nx; }
        const unsigned old = xb_add(&bar[XB_XSUB(b.x)], 1u);
        const unsigned gen = old / nloc;
        if (old + 1u == (gen + 1u) * nloc) {
            __builtin_amdgcn_fence(__ATOMIC_RELEASE, "agent");
            asm volatile("s_waitcnt vmcnt(0)" ::: "memory");
            const unsigned og = xb_add(&bar[XB_TOP], 1u);
            const unsigned tg = og / nx;
            if (og + 1u == (tg + 1u) * nx) xb_add(&bar[XB_TOPGEN], 1u);
            else XB_SPIN(xb_ld(&bar[XB_TOPGEN]) == tg, bar);
            __builtin_amdgcn_fence(__ATOMIC_ACQUIRE, "agent");
            xb_add(&bar[XB_XGEN(b.x)], 1u);
            asm volatile("s_waitcnt vmcnt(0)" ::: "memory");
        } else {
            XB_SPIN(xb_ld(&bar[XB_XGEN(b.x)]) == gen, bar);
            __builtin_amdgcn_fence(__ATOMIC_ACQUIRE, "agent");
            asm volatile("s_waitcnt vmcnt(0)" ::: "memory");
        }
    }
    __syncthreads();
}
typedef unsigned short bf16_t;
typedef short bf16x8 __attribute__((ext_vector_type(8)));
typedef float f32x4 __attribute__((ext_vector_type(4)));
typedef unsigned u32x4 __attribute__((ext_vector_type(4)));
typedef unsigned u32x2 __attribute__((ext_vector_type(2)));
#define DI __device__ __forceinline__
#define GAS __attribute__((address_space(1)))
DI int opaque_bid() { int b = blockIdx.x; asm volatile("" : "+s"(b)); return b; }
DI int otid(int wv) { int l; asm volatile("v_mbcnt_lo_u32_b32 %0, -1, 0\n\tv_mbcnt_hi_u32_b32 %0, -1, %0" : "=v"(l) : "s"(wv)); return (wv << 6) | l; }
DI void grid_sync(const XcdBarrier& b) { XcdBarrier t = b; asm volatile("" : "+s"(t.bar), "+s"(t.x)); xcd_barrier(t); }
DI void lds_barrier() { asm volatile("s_waitcnt lgkmcnt(0)\n\ts_barrier" ::: "memory"); }
DI float fexp2(float x) { return __builtin_amdgcn_exp2f(x); }
DI float fexp(float x) { return __builtin_amdgcn_exp2f(x * 1.4426950408889634f); }
DI float flog2(float x) { return __builtin_amdgcn_logf(x); }
DI float flog(float x) { return __builtin_amdgcn_logf(x) * 0.6931471805599453f; }
DI float fsigmoid(float x) { return __builtin_amdgcn_rcpf(1.f + fexp(-x)); }
DI float fsilu(float x) { return x * fsigmoid(x); }
DI float ftanh(float x) { return 2.f * fsigmoid(2.f * x) - 1.f; }
DI float fsoftplus(float x) { return x > 20.f ? x : flog(1.f + fexp(x)); }
DI unsigned cvt_pk_bf16(float lo, float hi) { unsigned r; asm volatile("v_cvt_pk_bf16_f32 %0, %1, %2" : "=v"(r) : "v"(lo), "v"(hi)); return r; }
DI float bf_lo(unsigned w) { return __uint_as_float(w << 16); }
DI float bf_hi(unsigned w) { return __uint_as_float(w & 0xffff0000u); }
#ifndef REP_EPI
#define REP_EPI 1
#endif
struct NaiveCtx;
DI LAS int* cv_counter(const LAS NaiveCtx* Cp_);
DI bool cv_addr(const LAS NaiveCtx* Cp_, int T, int tid, const float*& sp, bf16_t*& dp, int& ld);
#ifndef CV_CARRY
#define CV_CARRY 1
#endif
#ifndef CV_NH
#define CV_NH 1
#endif
#define CV_LOADS(V, sp, ld) do { _Pragma("unroll") for (int i_ = 0; i_ < 4; ++i_) _Pragma("unroll") for (int h_ = 0; h_ < CV_NH; ++h_) V[i_][h_] = __builtin_nontemporal_load((const GAS f32x4*)((sp) + (size_t)i_ * (ld) + 4 * h_)); } while (0)
#define CV_STORES(V, dp) do { _Pragma("unroll") for (int j_ = 0; j_ < 4 * CV_NH; ++j_) { u32x2 w_; w_.x = cvt_pk_bf16(V[0][j_ >> 2][j_ & 3], V[1][j_ >> 2][j_ & 3]); w_.y = cvt_pk_bf16(V[2][j_ >> 2][j_ & 3], V[3][j_ >> 2][j_ & 3]); \
        *(GAS u32x2*)((dp) + (size_t)j_ * 1024) = w_; } } while (0)
namespace g8 {
constexpr int BM = 256, BK = 64, HALF = 128, HTB = HALF * BK * 2, STAGE_BYTES = 8 * HTB, NXCD = 8, WGM = 8;
__host__ __device__ __forceinline__ int lds_byte(int r, int c) { const int st = (r >> 4) * 2 + (c >> 5), rr = r & 15, cc = c & 31, ob = rr * 64 + cc * 2; return st * 1024 + (ob ^ (((ob >> 9) & 1) << 5)); }
__host__ __device__ __forceinline__ void stage_rc(int b, int& R, int& C) { const int st = b / 1024, sb = b % 1024, swz = sb ^ (((sb >> 9) & 1) << 5); R = (st >> 1) * 16 + swz / 64; C = (st & 1) * 32 + (swz % 64) / 2; }
__host__ __device__ __forceinline__ int perm32(int rho) { const int n = rho >> 4, i = rho & 15; return 8 * (i >> 2) + 4 * n + (i & 3); }
struct Unit { int pm, pn, e; };

struct DenseSched {
    const char* A; const char* Bt; size_t tstep; int nM, nN, nwg, G, c;
    DI void init(const bf16_t* A_, const bf16_t* Bt_, int M, int N, int K, int G_, int c_) { A = (const char*)A_; Bt = (const char*)Bt_; tstep = (size_t)BM * K * 2; nM = M / BM; nN = N / BM; nwg = nM * nN; G = G_; c = c_; }
    DI bool next(int i, Unit& u) const {
        const long L = (long)i * G + c; if (L >= nwg) return false;
        int wgid = (int)L; { const int q = nwg / NXCD, r = nwg % NXCD, xcd = wgid % NXCD, off = wgid / NXCD; wgid = (xcd < r ? xcd * (q + 1) : r * (q + 1) + (xcd - r) * q) + off; }
        const int nig = WGM * nN, gid = wgid / nig, fm = gid * WGM, gsz = (nM - fm) < WGM ? (nM - fm) : WGM;
        u.pm = fm + ((wgid % nig) % gsz); u.pn = (wgid % nig) / gsz; u.e = 0; return true;
    }
    DI const char* a(const Unit& u) const { return A + (size_t)u.pm * tstep; }
    DI const char* b(const Unit& u) const { return Bt + (size_t)u.pn * tstep; }
};

struct LoraSched : DenseSched {
    DI const char* a(const Unit& u) const { return A + (size_t)u.pm * tstep + (u.pn < 8 ? 0 : 256); }
    DI const char* b(const Unit& u) const { return Bt + (size_t)u.pn * tstep + (u.pn < 8 ? 0 : 256); }
};

struct EpiF32 {
    static constexpr bool PERM = false;
    float* C; int ldc; int ncols;
    DI void operator()(const f32x4 (&acc)[2][2][4][2], const Unit& u, int wr, int wc, int fr, int fq) const {
        const int row0 = u.pm * BM + wr * 64 + fr, col0 = u.pn * BM + wc * 32 + 4 * fq;
#pragma unroll
        for (int ai = 0; ai < 2; ++ai)
#pragma unroll
            for (int m = 0; m < 4; ++m) { float* rowp = C + (size_t)(row0 + ai * HALF + m * 16) * ldc + col0;
#pragma unroll
                for (int bj = 0; bj < 2; ++bj)
#pragma unroll
                    for (int n = 0; n < 2; ++n) if (col0 + bj * HALF + n * 16 < ncols) *(GAS f32x4*)(rowp + bj * HALF + n * 16) = acc[ai][bj][m][n]; }
    }
};


struct MoeSched {
    const char* A; const char* Bt; size_t tstep, bstride; const LAS int* tstart; int NCT, nE, nunits, G, c;
    DI void init(const bf16_t* A_, const bf16_t* Bt_, int K, int N, int nE_, const LAS int* tstart_, int G_, int c_) { A = (const char*)A_; Bt = (const char*)Bt_; tstep = (size_t)BM * K * 2; bstride = (size_t)N * K * 2; tstart = tstart_; NCT = N / BM; nE = nE_; nunits = tstart_[nE_] * NCT; G = G_; c = c_; }
    int cs = 0, cl = 0, jj = 0; bool chunk = false;
    DI void set_chunk(int craw) { if (G != 256) return; const int x = craw & 7, q = nunits / NXCD, r = nunits % NXCD; jj = craw >> 3; cs = x * q + (x < r ? x : r); cl = q + (x < r ? 1 : 0); chunk = true; }
    DI long unit(int i) const { if (chunk) { const int k = i * 32 + jj; return k < cl ? (long)cs + k : -1L; } const long L = (long)i * G + c; return L < nunits ? L : -1L; }
    DI bool next(int i, Unit& u) const {
        const long L = unit(i); if (L < 0) return false;
        const int rt = (int)(L / NCT); u.pm = rt; u.pn = (int)(L % NCT);
        const int ln_ = (int)__builtin_amdgcn_mbcnt_hi(~0u, __builtin_amdgcn_mbcnt_lo(~0u, 0u));
        const bool hit_ = (ln_ >= 1 && ln_ < nE) ? (tstart[ln_] <= rt) : false;
        u.e = (int)__builtin_popcountll(__ballot(hit_)); return true;
    }
    bool gather = false;
    DI const char* a(const Unit& u) const { return gather ? A : A + (size_t)u.pm * tstep; }
    DI const char* b(const Unit& u) const { return Bt + (size_t)u.e * bstride + (size_t)u.pn * tstep; }
};
struct EpiSwiGLU {
    static constexpr bool PERM = true;
    bf16_t* ACT; const float* bgu; int F;
    DI void operator()(const f32x4 (&acc)[2][2][4][2], const Unit& u, int wr, int wc, int fr, int fq) const {
        const int row0 = u.pm * BM + wr * 64 + fr, j0 = u.pn * HALF + wc * 32 + 8 * fq;
        const float* bp = bgu + (size_t)u.e * 2 * F + j0;
        f32x4 bg[2], bl[2];
#pragma unroll
        for (int n = 0; n < 2; ++n) { bg[n] = *(const GAS f32x4*)(bp + 4 * n); bl[n] = *(const GAS f32x4*)(bp + F + 4 * n); }
#pragma unroll
        for (int ai = 0; ai < 2; ++ai)
#pragma unroll
            for (int m = 0; m < 4; ++m) { float o[8];
#pragma unroll
                for (int n = 0; n < 2; ++n)
#pragma unroll
                    for (int j = 0; j < 4; j += 2) {
                        typedef float f32x2_ __attribute__((ext_vector_type(2)));
                        f32x2_ gl = (f32x2_){acc[ai][0][m][n][j], acc[ai][0][m][n][j + 1]} + (f32x2_){bg[n][j], bg[n][j + 1]};
                        f32x2_ li = (f32x2_){acc[ai][1][m][n][j], acc[ai][1][m][n][j + 1]} + (f32x2_){bl[n][j], bl[n][j + 1]};
                        gl = __builtin_elementwise_min(gl, (f32x2_){7.f, 7.f}); li = __builtin_elementwise_min(__builtin_elementwise_max(li, (f32x2_){-7.f, -7.f}), (f32x2_){7.f, 7.f});
                        const f32x2_ ex = gl * (f32x2_){-2.4554669595930156f, -2.4554669595930156f};
                        f32x2_ den; den.x = __builtin_amdgcn_exp2f(ex.x); den.y = __builtin_amdgcn_exp2f(ex.y); den = den + (f32x2_){1.f, 1.f};
                        f32x2_ sg; sg.x = __builtin_amdgcn_rcpf(den.x); sg.y = __builtin_amdgcn_rcpf(den.y);
                        const f32x2_ r2 = (gl * sg) * (li + (f32x2_){1.f, 1.f});
                        o[4 * n + j] = r2.x; o[4 * n + j + 1] = r2.y; }
                u32x4 w; w.x = cvt_pk_bf16(o[0], o[1]); w.y = cvt_pk_bf16(o[2], o[3]); w.z = cvt_pk_bf16(o[4], o[5]); w.w = cvt_pk_bf16(o[6], o[7]);
                *(GAS u32x4*)(ACT + (size_t)(row0 + ai * HALF + m * 16) * F + j0) = w; }
    }
};
struct EpiDownF32 {
    static constexpr bool PERM = false;
    float* C; int ldc; const float* bd;
    DI void operator()(const f32x4 (&acc)[2][2][4][2], const Unit& u, int wr, int wc, int fr, int fq) const {
        const int row0 = u.pm * BM + wr * 64 + fr, col0 = u.pn * BM + wc * 32 + 4 * fq;
        const float* bp = bd + (size_t)u.e * ldc + col0;
        f32x4 bv[2][2];
#pragma unroll
        for (int bj = 0; bj < 2; ++bj)
#pragma unroll
            for (int n = 0; n < 2; ++n) bv[bj][n] = *(const GAS f32x4*)(bp + bj * HALF + n * 16);
#pragma unroll
        for (int ai = 0; ai < 2; ++ai)
#pragma unroll
            for (int m = 0; m < 4; ++m) { float* rowp = C + (size_t)(row0 + ai * HALF + m * 16) * ldc + col0;
#pragma unroll
                for (int bj = 0; bj < 2; ++bj)
#pragma unroll
                    for (int n = 0; n < 2; ++n) *(GAS f32x4*)(rowp + bj * HALF + n * 16) = acc[ai][bj][m][n] + bv[bj][n]; }
    }
};
struct EpiDownBf16 {
    static constexpr bool PERM = true;
    bf16_t* O; int ldc; const float* bd;
    DI void operator()(const f32x4 (&acc)[2][2][4][2], const Unit& u, int wr, int wc, int fr, int fq) const {
        const int row0 = u.pm * BM + wr * 64 + fr, col0 = u.pn * BM + wc * 32 + 8 * fq;
        const float* bp = bd + (size_t)u.e * ldc + col0;
        f32x4 bv[2][2];
#pragma unroll
        for (int bj = 0; bj < 2; ++bj)
#pragma unroll
            for (int n = 0; n < 2; ++n) bv[bj][n] = *(const GAS f32x4*)(bp + bj * HALF + 4 * n);
#pragma unroll
        for (int ai = 0; ai < 2; ++ai)
#pragma unroll
            for (int m = 0; m < 4; ++m) { bf16_t* rowp = O + (size_t)(row0 + ai * HALF + m * 16) * ldc + col0;
#pragma unroll
                for (int bj = 0; bj < 2; ++bj) { const f32x4 v0 = acc[ai][bj][m][0] + bv[bj][0], v1 = acc[ai][bj][m][1] + bv[bj][1];
                    u32x4 w; w.x = cvt_pk_bf16(v0[0], v0[1]); w.y = cvt_pk_bf16(v0[2], v0[3]); w.z = cvt_pk_bf16(v1[0], v1[1]); w.w = cvt_pk_bf16(v1[2], v1[3]);
                    *(GAS u32x4*)(rowp + bj * HALF) = w; } }
    }
};
struct EpiBf16 {
    static constexpr bool PERM = true;
    bf16_t* O; int ldc; float scale;
    DI void operator()(const f32x4 (&acc)[2][2][4][2], const Unit& u, int wr, int wc, int fr, int fq) const {
        const int row0 = u.pm * BM + wr * 64 + fr, col0 = u.pn * BM + wc * 32 + 8 * fq;
#pragma unroll
        for (int ai = 0; ai < 2; ++ai)
#pragma unroll
            for (int m = 0; m < 4; ++m) { bf16_t* rowp = O + (size_t)(row0 + ai * HALF + m * 16) * ldc + col0;
#pragma unroll
                for (int bj = 0; bj < 2; ++bj) { const f32x4 v0 = acc[ai][bj][m][0] * scale, v1 = acc[ai][bj][m][1] * scale;
                    u32x4 w; w.x = cvt_pk_bf16(v0[0], v0[1]); w.y = cvt_pk_bf16(v0[2], v0[3]); w.z = cvt_pk_bf16(v1[0], v1[1]); w.w = cvt_pk_bf16(v1[2], v1[3]);
                    *(GAS u32x4*)(rowp + bj * HALF) = w; } }
    }
};

template <int K, class Epi, class Sched, bool GATHER = false, int LD = K>
DI void gemm_phase(LAS unsigned char* lds, const Sched& S, const Epi& E, int wv_, const LAS int* gtab = nullptr, const LAS NaiveCtx* cvC = nullptr) {
    const int tid = otid(wv_);
    int cvbase = 0;
    if (cvC) cvbase = __builtin_amdgcn_readfirstlane(*cv_counter(cvC));
    const int wid = __builtin_amdgcn_readfirstlane(tid >> 6), lane = tid & 63, wr = wid >> 2, wc = wid & 3, fr = lane & 15, fq = lane >> 4;
    constexpr int nt = K / BK;
    static_assert(K % 128 == 0 && K >= 256, "K");
    unsigned voffB[2], cvo[2][2], nvo[2][2];
#pragma unroll
    for (int i = 0; i < 2; ++i) { int R, C; stage_rc(tid * 16 + i * 8192, R, C); const int Rb = Epi::PERM ? ((R & ~31) + perm32(R & 31)) : R; voffB[i] = (unsigned)(Rb * LD + C) * 2u; }
#define PG8_CALC_VO(VO, UI) do { _Pragma("unroll") for (int h_ = 0; h_ < 2; ++h_) _Pragma("unroll") for (int i_ = 0; i_ < 2; ++i_) { int R_, C_; stage_rc(tid * 16 + i_ * 8192, R_, C_); \
        const int row_ = GATHER ? gtab[(UI) * 256 + h_ * HALF + R_] : h_ * HALF + R_; VO[h_][i_] = (unsigned)(row_ * LD + C_) * 2u; } } while (0)
    constexpr size_t kstep = (size_t)(BK * 2);
    constexpr size_t hstep = (size_t)HALF * LD * 2;
    const unsigned ldsw = (unsigned)wid * 1024u;
    const int aoff = lds_byte(wr * 64 + fr, fq * 8), boff = lds_byte(wc * 32 + fr, fq * 8);
#define PG8_SA(b, h) (((b) * 2 + (h)) * HTB)
#define PG8_SB(b, h) ((4 + (b) * 2 + (h)) * HTB)
#define PG8_STAGE(bufoff, gbase, voff) do { _Pragma("unroll") for (int _i = 0; _i < 2; ++_i) \
        __builtin_amdgcn_global_load_lds((const unsigned*)((const char*)(gbase) + (voff)[_i]), (LAS unsigned*)(lds + (bufoff) + ldsw + _i * 8192), 16, 0, 0); } while (0)
#define PG8_LDA(dst, b, h) do { _Pragma("unroll") for (int m = 0; m < 4; ++m) _Pragma("unroll") for (int k = 0; k < 2; ++k) dst[m][k] = *(const LAS bf16x8*)(lds + PG8_SA(b, h) + aoff + m * 2048 + k * 1024); } while (0)
#define PG8_LDB(dst, b, h) do { _Pragma("unroll") for (int n = 0; n < 2; ++n) _Pragma("unroll") for (int k = 0; k < 2; ++k) dst[n][k] = *(const LAS bf16x8*)(lds + PG8_SB(b, h) + boff + n * 2048 + k * 1024); } while (0)
#define PG8_MMA(ai, bj, At, Bt) do { __builtin_amdgcn_s_setprio(1); _Pragma("unroll") for (int m = 0; m < 4; ++m) _Pragma("unroll") for (int n = 0; n < 2; ++n) _Pragma("unroll") for (int k = 0; k < 2; ++k) \
        acc[ai][bj][m][n] = __builtin_amdgcn_mfma_f32_16x16x32_bf16(Bt[n][k], At[m][k], acc[ai][bj][m][n], 0, 0, 0); __builtin_amdgcn_s_setprio(0); } while (0)
#define PG8_WAIT_V(n) asm volatile("s_waitcnt vmcnt(" #n ")" ::: "memory")
#define PG8_WAIT_L(n) asm volatile("s_waitcnt lgkmcnt(" #n ")" ::: "memory")
#define PG8_BAR __builtin_amdgcn_s_barrier()
#define PG8_SCHED __builtin_amdgcn_sched_barrier(0)
    Unit cur, nxt; int ui = 0;
#if CV_CARRY
    f32x4 cvv[4][CV_NH]; bool cvon = false;
#endif
    if (!S.next(0, cur)) return;
    f32x4 acc[2][2][4][2];
#pragma unroll
    for (int a = 0; a < 2; ++a)
#pragma unroll
        for (int b = 0; b < 2; ++b)
#pragma unroll
            for (int m = 0; m < 4; ++m)
#pragma unroll
                for (int n = 0; n < 2; ++n) acc[a][b][m][n] = (f32x4){0.f, 0.f, 0.f, 0.f};
    bf16x8 At[4][2], B0[2][2], B1[2][2];
    const char* cA = S.a(cur); const char* cB = S.b(cur);
    PG8_CALC_VO(cvo, 0);
    PG8_STAGE(PG8_SB(0, 0), cB, voffB); PG8_STAGE(PG8_SB(0, 1), cB + hstep, voffB); PG8_STAGE(PG8_SA(0, 0), cA, cvo[0]); PG8_STAGE(PG8_SA(0, 1), cA, cvo[1]);
    if (wr == 1) PG8_BAR;
    PG8_WAIT_V(2); PG8_BAR;
    PG8_STAGE(PG8_SB(1, 0), cB + kstep, voffB); PG8_STAGE(PG8_SA(1, 0), cA + kstep, cvo[0]); PG8_STAGE(PG8_SB(1, 1), cB + hstep + kstep, voffB);
    PG8_WAIT_V(6); PG8_BAR;
    for (;;) {
        const bool has_next = S.next(ui + 1, nxt);
        const char* nA = has_next ? S.a(nxt) : cA; const char* nB = has_next ? S.b(nxt) : cB;
        if (has_next) PG8_CALC_VO(nvo, ui + 1); else { nvo[0][0] = cvo[0][0]; nvo[0][1] = cvo[0][1]; nvo[1][0] = cvo[1][0]; nvo[1][1] = cvo[1][1]; }
#pragma unroll 1
        for (int t = 0; t < nt; t += 2) {
            const bool last = (t == nt - 2);
            const char* a1 = cA + (size_t)(t + 1) * kstep;
            const char* a2 = last ? nA : cA + (size_t)(t + 2) * kstep; const char* b2 = last ? nB : cB + (size_t)(t + 2) * kstep;
            const char* a3 = a2 + kstep; const char* b3 = b2 + kstep;
            unsigned s0[2], s1[2]; s0[0] = last ? nvo[0][0] : cvo[0][0]; s0[1] = last ? nvo[0][1] : cvo[0][1]; s1[0] = last ? nvo[1][0] : cvo[1][0]; s1[1] = last ? nvo[1][1] : cvo[1][1];
            PG8_LDB(B0, 0, 0); PG8_LDB(B1, 0, 1); PG8_SCHED; PG8_LDA(At, 0, 0); PG8_STAGE(PG8_SA(1, 1), a1, cvo[1]);
            PG8_WAIT_V(8); PG8_WAIT_L(0); PG8_BAR; PG8_MMA(0, 0, At, B0); PG8_MMA(0, 1, At, B1); PG8_BAR; PG8_SCHED;
            PG8_LDA(At, 0, 1); PG8_STAGE(PG8_SB(0, 0), b2, voffB); PG8_STAGE(PG8_SB(0, 1), b2 + hstep, voffB); PG8_STAGE(PG8_SA(0, 0), a2, s0);
            PG8_WAIT_V(8); PG8_WAIT_L(0); PG8_BAR; PG8_MMA(1, 0, At, B0); PG8_MMA(1, 1, At, B1); PG8_BAR; PG8_SCHED;
            PG8_LDB(B0, 1, 0); PG8_LDB(B1, 1, 1); PG8_SCHED; PG8_LDA(At, 1, 0); PG8_STAGE(PG8_SA(0, 1), a2, s1);
            PG8_WAIT_V(8); PG8_WAIT_L(0); PG8_BAR; PG8_MMA(0, 0, At, B0); PG8_MMA(0, 1, At, B1); PG8_BAR; PG8_SCHED;
            PG8_LDA(At, 1, 1); PG8_STAGE(PG8_SB(1, 0), b3, voffB); PG8_STAGE(PG8_SB(1, 1), b3 + hstep, voffB); PG8_STAGE(PG8_SA(1, 0), a3, s0);
            PG8_WAIT_V(8); PG8_WAIT_L(0); PG8_BAR; PG8_MMA(1, 0, At, B0); PG8_MMA(1, 1, At, B1); PG8_BAR; PG8_SCHED;
        }
        if (wr == 0) PG8_BAR;
#if CV_CARRY
        if (cvC) { const float* cvs = nullptr; bf16_t* cvd = nullptr; int cvl = 0;
            if (cvon) { cv_addr(cvC, (cvbase + ui - 1) * S.G + S.c, otid(wv_), cvs, cvd, cvl); CV_STORES(cvv, cvd); }
            cvon = cv_addr(cvC, (cvbase + ui) * S.G + S.c, otid(wv_), cvs, cvd, cvl); if (cvon) CV_LOADS(cvv, cvs, cvl); }
#else
        f32x4 cvv[4][CV_NH]; const float* cvs = nullptr; bf16_t* cvd = nullptr; int cvl = 0; bool cvon = false;
        if (cvC) { cvon = cv_addr(cvC, (cvbase + ui) * S.G + S.c, otid(wv_), cvs, cvd, cvl); if (cvon) CV_LOADS(cvv, cvs, cvl); }
#endif
        { const int t2_ = otid(wv_), fr_ = t2_ & 15, fq_ = (t2_ & 63) >> 4;
          _Pragma("unroll") for (int re_ = 0; re_ < REP_EPI; ++re_) E(acc, cur, wr, wc, fr_, fq_); }
#if !CV_CARRY
        if (cvC) { if (cvon) CV_STORES(cvv, cvd); }
#endif
        if (!has_next) break;
#pragma unroll
        for (int a = 0; a < 2; ++a)
#pragma unroll
            for (int b = 0; b < 2; ++b)
#pragma unroll
                for (int m = 0; m < 4; ++m)
#pragma unroll
                    for (int n = 0; n < 2; ++n) acc[a][b][m][n] = (f32x4){0.f, 0.f, 0.f, 0.f};
        cur = nxt; cA = nA; cB = nB; ++ui; cvo[0][0] = nvo[0][0]; cvo[0][1] = nvo[0][1]; cvo[1][0] = nvo[1][0]; cvo[1][1] = nvo[1][1];
        if (wr == 1) PG8_BAR;
    }
#if CV_CARRY
    if (cvC) { if (cvon) { const float* cvs = nullptr; bf16_t* cvd = nullptr; int cvl = 0; cv_addr(cvC, (cvbase + ui) * S.G + S.c, otid(wv_), cvs, cvd, cvl); CV_STORES(cvv, cvd); } }
#endif
    PG8_WAIT_V(0);
    PG8_BAR;
    if (cvC) { if (otid(wv_) == 0) *cv_counter(cvC) = cvbase + ui + 1; }
#undef PG8_CALC_VO
#undef PG8_SA
#undef PG8_SB
#undef PG8_STAGE
#undef PG8_LDA
#undef PG8_LDB
#undef PG8_MMA
#undef PG8_WAIT_V
#undef PG8_WAIT_L
#undef PG8_BAR
#undef PG8_SCHED
}
}
#define GRID_STRIDE_WAVES(i_, n_) for (long tz_ = otid(wv_), i_ = ((long)(tz_ >> 6) * gridDim.x + opaque_bid()) * 64 + (tz_ & 63); i_ < (long)(n_); i_ += (long)gridDim.x * PB_THREADS)
DI bf16_t f2bf(float x) { return (bf16_t)(cvt_pk_bf16(x, 0.f) & 0xffffu); }

DI void conv_weight_r(LAS unsigned char* lds, const float* __restrict__ src, size_t sstride, bf16_t* __restrict__ dst, size_t dstride, int K, int N, int ldsrc, int Kpad, int Npad, int mode, int ti0, int G, int total, int wv_) {
    const int t = otid(wv_), nkt = Kpad / 64, nnt = Npad / 256, tpm = nkt * nnt;
    const int kk = t >> 6, c4 = (t & 63) * 4;
    float4 v[8];
#define CW_LOAD(TI) do { const int mat_ = (TI) / tpm, tile_ = (TI) % tpm, n0_ = (tile_ / nkt) * 256, k0_ = (tile_ % nkt) * 64; \
        const int sc_ = mode == 1 ? (c4 < 128 ? 0 : N / 2) + (n0_ / 256) * 128 + (c4 & 127) : n0_ + c4; const float* sp_ = src + (size_t)mat_ * sstride; \
        _Pragma("unroll") for (int i = 0; i < 8; ++i) { const int k_ = k0_ + 8 * kk + i; v[i] = make_float4(0.f, 0.f, 0.f, 0.f); \
            if (k_ < K && sc_ < N) { const f32x4 g_ = *(const GAS f32x4*)(sp_ + (size_t)k_ * ldsrc + sc_); v[i] = make_float4(g_[0], g_[1], g_[2], g_[3]); } } } while (0)
    int ti = ti0, par = 0;
    if (ti < total) CW_LOAD(ti);
    while (ti < total) {
        LAS bf16_t* Ts = (LAS bf16_t*)(lds + par * (256 * 72 * 2));
        const int mat = ti / tpm, tile = ti % tpm, n0 = (tile / nkt) * 256, k0 = (tile % nkt) * 64;
#define CW_COL(J, F) { u32x4 w_; w_.x = cvt_pk_bf16(v[0].F, v[1].F); w_.y = cvt_pk_bf16(v[2].F, v[3].F); w_.z = cvt_pk_bf16(v[4].F, v[5].F); w_.w = cvt_pk_bf16(v[6].F, v[7].F); *(LAS u32x4*)(Ts + (c4 + J) * 72 + 8 * kk) = w_; }
        CW_COL(0, x) CW_COL(1, y) CW_COL(2, z) CW_COL(3, w)
#undef CW_COL
        const int tn = ti + G;
        if (tn < total) CW_LOAD(tn);
        lds_barrier();
        bf16_t* dp = dst + (size_t)mat * dstride;
#pragma unroll
        for (int q0 = 0; q0 < 4; ++q0) { const int q = t + 512 * q0, n = q >> 3, k8 = (q & 7) * 8;
            const u32x4 w = *(const LAS u32x4*)(Ts + n * 72 + k8);
            *(GAS u32x4*)(dp + (size_t)(n0 + n) * Kpad + k0 + k8) = w; }
        ti = tn; par ^= 1;
    }
    __syncthreads();
#undef CW_LOAD
}
DI void conv_weight_b(LAS unsigned char* lds, const float* __restrict__ src, size_t sstride, bf16_t* __restrict__ dst, size_t dstride, int nmat, int K, int N, int ldsrc, int Kpad, int Npad, int mode, int wv_) {
    conv_weight_r(lds, src, sstride, dst, dstride, K, N, ldsrc, Kpad, Npad, mode, opaque_bid(), gridDim.x, (Kpad / 64) * (Npad / 256) * nmat, wv_);
}
DI void conv_act(const float* __restrict__ src, int lda, int K, bf16_t* __restrict__ dst, int Kpad, long M, int wv_) {
    const int cpr = Kpad / 8;
    GRID_STRIDE_WAVES(i, M * cpr) { const long row = i / cpr; const int c = (int)(i % cpr) * 8; u32x4 w = (u32x4){0u, 0u, 0u, 0u};
        if (c < K) { const f32x4 a_ = *(const GAS f32x4*)(src + row * lda + c), b_ = *(const GAS f32x4*)(src + row * lda + c + 4); const float4 a = make_float4(a_[0], a_[1], a_[2], a_[3]), b = make_float4(b_[0], b_[1], b_[2], b_[3]);
            w.x = cvt_pk_bf16(a.x, a.y); w.y = cvt_pk_bf16(a.z, a.w); w.z = cvt_pk_bf16(b.x, b.y); w.w = cvt_pk_bf16(b.z, b.w); }
        *(GAS u32x4*)(dst + row * Kpad + c) = w; }
}
#ifdef HOST_TEST
static int D_MODEL = 128, BATCH = 2, SEQ = 128, CTX_LEN = 64, N_EXPERTS = 8, EXPERT_DIM = 64;
#define HD
#else
constexpr int D_MODEL = 1024, BATCH = 16, SEQ = 2048, CTX_LEN = 256, N_EXPERTS = 32, EXPERT_DIM = 1024;
#ifdef PERSISTENT
#define HD __device__
#else
#define HD __host__ __device__
#endif
#endif
constexpr int DEPTH = 4, GRID_W = 64, N_MOD = 6;
constexpr int RW_HEADS = 8, RW_HD = 64, RW_DIM = 512, RW_DL = 64, RW_IL = 64, RW_GL = 128, RW_IN = 1920;
constexpr int HG_HEADS = 4, HG_KD = 128, HG_VD = 128, HG_DIM = 512, HG_VDIM = 512, HG_IN = 2560;
constexpr int EVEN_IN = 4480, EVEN_OUT = 1024;
constexpr int MLA_HEADS = 16, MLA_NOPE = 64, MLA_ROPE = 32, MLA_V = 64, MLA_QR = 256, MLA_KVR = 128, MLA_IN = 416, MLA_QK = 96;
constexpr int TOP_K = 4, N_EVEN = 2, N_ODD = 2;
constexpr int MOE_PAD = 256;
#define ALPHA 1.681792830507429f

#ifndef REP_MOE
#define REP_MOE 1
#endif
#ifndef REP_ATT
#define REP_ATT 1
#endif
#ifndef REP_RWS
#define REP_RWS 1
#endif
#ifndef REP_HGS
#define REP_HGS 1
#endif
#ifndef REP_DEN
#define REP_DEN 1
#endif
#ifndef REP_TLE
#define REP_TLE 1
#endif
#ifndef REP_PRO
#define REP_PRO 1
#endif
#ifndef CV_BACKGROUND
#define CV_BACKGROUND 0
#endif
#ifndef CV_TAIL
#define CV_TAIL 1
#endif
#ifndef CV_TAILN
#define CV_TAILN 10
#endif
#if CV_BACKGROUND
#define CV_PRO_LAYERS 1
#define CV_CTX Cp_
#elif CV_TAIL
#define CV_PRO_LAYERS 1
#define CV_CTX nullptr
#else
#define CV_PRO_LAYERS DEPTH
#define CV_CTX nullptr
#endif
#define RP(N, ...) _Pragma("unroll") for (int rep_ = 0; rep_ < (N); ++rep_) { __VA_ARGS__ }
#define NC_ (BATCH * CTX_LEN)
#define NL_ (BATCH * SEQ)
#define NT_ (NC_ + NL_)
#define TT_ (CTX_LEN + SEQ)
#define NSLOT_ (NT_ * TOP_K + N_EXPERTS * MOE_PAD)

#ifdef HOST_TEST
#define MEMFENCE_EVERY(k, n) do {} while (0)
#else
#define MEMFENCE_EVERY(k, n) do { if (((k) % (n)) == (n) - 1) asm volatile("" ::: "memory"); } while (0)
#endif
HD inline float sigmoidf_(float x) { return 1.f / (1.f + expf(-x)); }
HD inline float siluf_(float x) { return x / (1.f + expf(-x)); }
HD inline float softplusf_(float x) { return x > 20.f ? x : log1pf(expf(x)); }
HD inline int tokrow(int b, int t) { return t < CTX_LEN ? b * CTX_LEN + t : NC_ + b * SEQ + (t - CTX_LEN); }
HD inline int scan_pos(int d, int i) { return d == 0 ? i : (i < CTX_LEN ? CTX_LEN - 1 - i : CTX_LEN + (SEQ - 1 - (i - CTX_LEN))); }
#ifdef HOST_TEST
inline int ld_cnt(const int* p) { return *p; }
#else
__device__ inline int ld_cnt(const int* p) { return __hip_atomic_load(p, __ATOMIC_RELAXED, __HIP_MEMORY_SCOPE_AGENT); }
#endif
HD inline int modrow(int row) { return row < NC_ ? BATCH : (row - NC_) / SEQ; }

struct NaiveCtx {
    const float *x, *c, *ctx, *c_ctx, *mod_w, *mod_b, *ln_g, *ln_b, *ev_w_in, *rw_mu, *rw_w0, *rw_w2, *rw_a0, *rw_a2, *rw_g2, *rw_k_k, *rw_k_a, *rw_r_k,
        *rw_gn_g, *rw_gn_b, *hg_lb, *hg_norm_g, *ev_w_out, *od_w_in, *mla_q_norm_g, *mla_w_qb, *mla_kv_norm_g, *mla_w_kvb, *od_w_out, *moe_w_router,
        *moe_b_router, *moe_w_gu, *moe_b_gu, *moe_w_down, *moe_b_down;
    float* out;
    float *H, *MOD, *U, *Z, *ZS, *R, *V, *KKR, *NKK, *G, *DEC, *AG, *KD, *BB, *Y, *HQ, *HF, *HK, *OP, *YCAT, *YO;
    float *QN, *KVN, *KPE, *Q, *KV, *AO, *LOGIT, *TOPG, *H1, *ACT, *OUT2;
    int *TOPI, *CNT, *OFF, *CUR, *SLOT, *TOKOF, *TILE_E;
    unsigned short *WinE, *WoutE, *WinO, *Wqb, *Wkvb, *WoutO, *Wgu, *Wdn, *ABF, *XPB, *ACTB, *QB, *KB, *VB, *UB, *OUT2B, *TW, *LOB, *YCATB, *QNB, *KVNB, *AOB, *Wlora, *KVB, *KPEB, *ZB, *RBh, *VBh, *NKh, *GBh, *KDh, *BBh, *YOB, *HB, *YBh, *OBh;
    float *BON, *ROPE, *O;
    long cvn;
};
#if defined(PERSISTENT)
constexpr int CV_TN = 64 * CV_NH, CV_GU = (2 * EXPERT_DIM / CV_TN) * 8, CV_DN = (D_MODEL / CV_TN) * 8;
constexpr int CV_TPL = N_EXPERTS * (CV_GU + CV_DN);
DI LAS int* cv_counter(const LAS NaiveCtx* Cp_) { return (LAS int*)&Cp_->cvn; }
DI bool cv_addr(const LAS NaiveCtx* Cp_, int T, int tid, const float*& sp, bf16_t*& dp, int& ld) {
    if (T >= (DEPTH - 1) * CV_TPL) return false;
    const int layer = 1 + T / CV_TPL, r = T % CV_TPL;
    const int kb = (tid & 15) + 16 * ((tid >> 6) & 1), nb = ((tid >> 4) & 3) + 4 * (tid >> 7);
    if (r < N_EXPERTS * CV_GU) {
        const int mat = layer * N_EXPERTS + r / CV_GU, tile = r % CV_GU, n0 = (tile / 8) * CV_TN, k0 = (tile % 8) * 128;
        const int cb = ((n0 % 256) / 128) * EXPERT_DIM + (n0 / 256) * 128 + n0 % 128;
        sp = Cp_->moe_w_gu + (size_t)mat * ((size_t)D_MODEL * 2 * EXPERT_DIM) + (size_t)(k0 + kb * 4) * (2 * EXPERT_DIM) + cb + nb * (4 * CV_NH); ld = 2 * EXPERT_DIM;
        dp = Cp_->Wgu + (size_t)mat * ((size_t)2 * EXPERT_DIM * D_MODEL) + (size_t)(n0 + nb * (4 * CV_NH)) * D_MODEL + k0 + kb * 4;
    } else {
        const int r2 = r - N_EXPERTS * CV_GU, mat = layer * N_EXPERTS + r2 / CV_DN, tile = r2 % CV_DN, n0 = (tile / 8) * CV_TN, k0 = (tile % 8) * 128;
        sp = Cp_->moe_w_down + (size_t)mat * ((size_t)EXPERT_DIM * D_MODEL) + (size_t)(k0 + kb * 4) * D_MODEL + n0 + nb * (4 * CV_NH); ld = D_MODEL;
        dp = Cp_->Wdn + (size_t)mat * ((size_t)D_MODEL * EXPERT_DIM) + (size_t)(n0 + nb * (4 * CV_NH)) * EXPERT_DIM + k0 + kb * 4;
    }
    return true;
}
DI void cv_catchup(const LAS NaiveCtx* Cp_, long layer, int wv_) {
    const int G = gridDim.x, bid = opaque_bid();
    const int need = (int)((layer * CV_TPL + G - 1) / G);
    int j = __builtin_amdgcn_readfirstlane(*cv_counter(Cp_));
    if (j >= need) return;
    for (; j < need; ++j) { f32x4 v[4][CV_NH]; const float* sp = nullptr; bf16_t* dp = nullptr; int ld = 0;
        if (cv_addr(Cp_, j * G + bid, otid(wv_), sp, dp, ld)) { CV_LOADS(v, sp, ld); CV_STORES(v, dp); } }
    __syncthreads();
    if (otid(wv_) == 0) *cv_counter(Cp_) = j;
}
#endif
#if defined(PERSISTENT)
constexpr int CVT_GU = N_EXPERTS * 128, CVT_DN = N_EXPERTS * 64, CVT_L = CVT_GU + CVT_DN, CVT_TOT = (DEPTH - 1) * CVT_L;
DI void cv_range(const LAS NaiveCtx* Cp_, LAS unsigned char* lds, int a, int b, int step, int wv_) {
#pragma unroll 1
    for (int j = 0; j < 2 * (DEPTH - 1); ++j) { const int Lx = 1 + j / 2; const bool dn = (j & 1) != 0;
        const int base = CVT_L * (Lx - 1) + (dn ? CVT_GU : 0), lim = CVT_L * (Lx - 1) + (dn ? CVT_L : CVT_GU);
        const int v0 = a >= base ? a : a + ((base - a + step - 1) / step) * step, hi = b < lim ? b : lim;
        if (v0 < hi) { const int tb = (dn ? CVT_DN : CVT_GU) * Lx;
            conv_weight_r(lds, dn ? (*Cp_).moe_w_down : (*Cp_).moe_w_gu, (size_t)D_MODEL * (dn ? D_MODEL : 2 * EXPERT_DIM), dn ? (*Cp_).Wdn : (*Cp_).Wgu, (size_t)D_MODEL * (dn ? EXPERT_DIM : 2 * EXPERT_DIM),
                          1024, dn ? D_MODEL : 2 * EXPERT_DIM, dn ? D_MODEL : 2 * EXPERT_DIM, 1024, dn ? D_MODEL : 2 * EXPERT_DIM, dn ? 0 : 1, tb + (v0 - base), step, tb + (hi - base), wv_); } }
}
#ifndef MOE_REMAP
#define MOE_REMAP 2
#endif
#ifndef MOE_CHUNK
#define MOE_CHUNK 1
#endif
#if MOE_CHUNK
#define MOE_SET_CHUNK S_.set_chunk(opaque_bid());
#else
#define MOE_SET_CHUNK
#endif
DI int moe_remap(int c, int G, int nct) {
#if MOE_REMAP
    if (G == 256) { const int x = c & 7, j = c >> 3;
#if MOE_REMAP == 2
        if (nct == 8) return 8 * (4 * (j >> 2) + (x >> 1)) + 4 * (x & 1) + (j & 3);
        if (nct == 4) return 4 * (8 * (j >> 2) + x) + (j & 3); }
#elif MOE_REMAP == 3
        if (nct == 8) return 8 * (4 * (j >> 2) + (x >> 1)) + 4 * (x & 1) + (j & 3);
        if (nct == 4) return 4 * (4 * (j >> 1) + (x >> 1)) + 2 * (x & 1) + (j & 1); }
#else
        if (nct == 8) return 8 * (2 * (j >> 1) + (x >> 2)) + 2 * (x & 3) + (j & 1);
        if (nct == 4) return 4 * (4 * (j >> 1) + (x >> 1)) + 2 * (x & 1) + (j & 1); }
#endif
#endif
    return c;
}
DI void cv_tail(const LAS NaiveCtx* Cp_, LAS unsigned char* lds, const g8::MoeSched& S, int wv_) {
    int done = __builtin_amdgcn_readfirstlane(*cv_counter(Cp_));
    if (done >= CVT_TOT) return;
    int nidle = 0, mine = -1;
    if (S.chunk) { const int q = S.nunits / 8, r = S.nunits % 8, maxr = (q + (r ? 1 : 0) + 31) / 32, myx = opaque_bid() & 7;
#pragma unroll
        for (int x = 0; x < 8; ++x) { const int len = q + (x < r ? 1 : 0), rounds = (len + 31) / 32, busy = rounds < maxr ? 0 : len - 32 * (maxr - 1);
            if (x == myx && S.jj >= busy) mine = nidle + (S.jj - busy);
            nidle += 32 - busy; } }
    else { const int G = gridDim.x, r = S.nunits % G; if (r != 0) { nidle = G - r; if (S.c >= r) mine = S.c - r; } }
    if (nidle == 0) return;
    if (mine >= 0) { const int a = done + mine * CV_TAILN, b = a + CV_TAILN < CVT_TOT ? a + CV_TAILN : CVT_TOT; if (a < b) cv_range(Cp_, lds, a, b, 1, wv_); }
    done += nidle * CV_TAILN; if (done > CVT_TOT) done = CVT_TOT;
    __syncthreads();
    if (otid(wv_) == 0) *cv_counter(Cp_) = done;
}
DI void cv_catch(const LAS NaiveCtx* Cp_, LAS unsigned char* lds, long layer, int wv_) {
    const int G = gridDim.x, c = opaque_bid(), need = CVT_L * (int)layer;
    const int done = __builtin_amdgcn_readfirstlane(*cv_counter(Cp_));
    if (done >= need) return;
    cv_range(Cp_, lds, done + c, need, G, wv_);
    __syncthreads();
    if (otid(wv_) == 0) *cv_counter(Cp_) = need;
}
#endif


struct NaiveWs { size_t total; };
static size_t naive_carve(NaiveCtx& C, char* base) {
    size_t off = 0;
    auto take = [&](size_t nfl) { size_t o = off; off += ((nfl * 4 + 255) / 256) * 256; return base ? (float*)(base + o) : (float*)nullptr; };
    const size_t NT = NT_, NS = NSLOT_;
    C.H = take(NT * D_MODEL); C.MOD = take((size_t)DEPTH * (BATCH + 1) * N_MOD * D_MODEL); C.YO = take(NT * D_MODEL);
#if defined(PERSISTENT)
    C.U = nullptr;
#else
    C.U = take(NT * D_MODEL);
#endif
    C.LOGIT = take(NT * N_EXPERTS); C.TOPG = take(NT * TOP_K);
    C.TOPI = (int*)take(NT * TOP_K); C.CNT = (int*)take(64 * DEPTH); C.CUR = (int*)take(64 * DEPTH); C.OFF = (int*)take(64); C.SLOT = (int*)take(NT * TOP_K); C.TOKOF = (int*)take(NS);
    C.TILE_E = (int*)take(NS / 64 + 64);
    C.WinE = (unsigned short*)take((size_t)N_EVEN * 4608 * D_MODEL / 2); C.WoutE = (unsigned short*)take((size_t)N_EVEN * D_MODEL * 1024 / 2); C.WinO = (unsigned short*)take((size_t)N_ODD * 512 * D_MODEL / 2);
    C.Wqb = (unsigned short*)take((size_t)N_ODD * 1536 * 256 / 2); C.Wkvb = (unsigned short*)take((size_t)N_ODD * 2048 * 256 / 2); C.WoutO = (unsigned short*)take((size_t)N_ODD * D_MODEL * 1024 / 2);
    C.Wgu = (unsigned short*)take((size_t)DEPTH * N_EXPERTS * 2 * EXPERT_DIM * D_MODEL / 2); C.Wdn = (unsigned short*)take((size_t)DEPTH * N_EXPERTS * D_MODEL * EXPERT_DIM / 2);
    C.ABF = (unsigned short*)take((size_t)NT * 1024 / 2); C.UB = (unsigned short*)take((size_t)NT * 1024 / 2);
    const size_t ubase = off; size_t umax = off;
    C.Z = take(NT * EVEN_IN); C.ZS = take(NT * RW_IN);
    C.R = take(NT * 512); C.V = take(NT * 512); C.KKR = take(NT * 512); C.NKK = take(NT * 512); C.G = take(NT * 512);
    C.DEC = take(2 * NT * 512); C.AG = take(2 * NT * 512); C.KD = take(2 * NT * 512); C.BB = take(2 * NT * 512); C.Y = take(2 * NT * 512);
    C.HQ = take(NT * 512); C.HF = take(2 * NT * 512); C.HK = take(2 * NT * 512); C.OP = take(4 * NT * 512);
    C.YCAT = take(NT * 1024);
    umax = off > umax ? off : umax; off = ubase;
    (void)take(NT * EVEN_IN);
    C.QN = take(NT * MLA_QR); C.KVN = take(NT * MLA_KVR); C.KPE = take(NT * MLA_ROPE); C.Q = take(NT * MLA_HEADS * MLA_QK); C.KV = take(NT * MLA_HEADS * 128);
    C.AO = take(NT * 1024);
    C.QB = (unsigned short*)take(NT * MLA_HEADS * 96 / 2); C.KB = (unsigned short*)take((size_t)BATCH * MLA_HEADS * TT_ * 96 / 2); C.VB = (unsigned short*)take((size_t)BATCH * MLA_HEADS * TT_ * 64 / 2);
    umax = off > umax ? off : umax; off = ubase;
    C.H1 = take(NS * 2 * EXPERT_DIM); C.ACT = take(NS * EXPERT_DIM); C.OUT2 = take(NS * D_MODEL);
    C.OUT2B = (unsigned short*)C.OUT2; C.XPB = (unsigned short*)C.H1; C.ACTB = (unsigned short*)(C.H1 ? C.H1 + NS * EXPERT_DIM / 2 + 64 : C.H1);
    umax = off > umax ? off : umax; off = umax;
    return off;
}


#if defined(PERSISTENT)
static size_t mega_carve(NaiveCtx& C, char* base) {
    size_t off = 0;
    auto takeb = [&](size_t nbytes) { size_t o = off; off += ((nbytes + 255) / 256) * 256; return base ? (void*)(base + o) : (void*)nullptr; };
    const size_t NT = NT_, NS = NSLOT_;
    C.HB = (unsigned short*)takeb(NT * D_MODEL * 2); C.H = nullptr; C.MOD = (float*)takeb((size_t)DEPTH * (BATCH + 1) * N_MOD * D_MODEL * 4); C.YOB = (unsigned short*)takeb(NT * D_MODEL * 2); C.YO = nullptr; C.UB = (unsigned short*)takeb(NT * D_MODEL * 2);
    C.TOPG = (float*)takeb(NT * TOP_K * 4); C.TOPI = (int*)takeb(NT * TOP_K * 4); C.SLOT = (int*)takeb(NT * TOP_K * 4); C.CNT = (int*)takeb(64 * DEPTH * 4); C.CUR = (int*)takeb(64 * DEPTH * 4); C.TOKOF = (int*)takeb(NS * 4);
    C.ROPE = (float*)takeb((size_t)SEQ * 32 * 4);
    C.WinE = (unsigned short*)takeb((size_t)N_EVEN * 4608 * D_MODEL * 2); C.WoutE = (unsigned short*)takeb((size_t)N_EVEN * D_MODEL * 1024 * 2); C.WinO = (unsigned short*)takeb((size_t)N_ODD * 512 * D_MODEL * 2);
    C.Wqb = (unsigned short*)takeb((size_t)N_ODD * 1536 * 256 * 2); C.Wkvb = (unsigned short*)takeb((size_t)N_ODD * 2048 * 256 * 2); C.WoutO = (unsigned short*)takeb((size_t)N_ODD * D_MODEL * 1024 * 2);
    C.Wlora = (unsigned short*)takeb((size_t)N_EVEN * 2560 * 384 * 2);
    C.Wgu = (unsigned short*)takeb((size_t)DEPTH * N_EXPERTS * 2 * EXPERT_DIM * D_MODEL * 2); C.Wdn = (unsigned short*)takeb((size_t)DEPTH * N_EXPERTS * D_MODEL * EXPERT_DIM * 2);
    const size_t ubase = off; size_t umax = off;
    C.ZB = (unsigned short*)takeb(NT * 4608 * 2); C.Z = (float*)C.ZB; C.TW = (unsigned short*)takeb(NT * 384 * 2); C.LOB = (unsigned short*)takeb(NT * 2560 * 2);
    C.RBh = (unsigned short*)takeb(NT * 512 * 2); C.VBh = (unsigned short*)takeb(NT * 512 * 2); C.NKh = (unsigned short*)takeb(NT * 512 * 2); C.GBh = (unsigned short*)takeb(NT * 512 * 2);
    C.KDh = (unsigned short*)takeb(2 * NT * 512 * 2); C.BBh = (unsigned short*)takeb(2 * NT * 512 * 2); C.DEC = (float*)takeb(2 * NT * 512 * 4); C.YBh = (unsigned short*)takeb(2 * NT * 512 * 2); C.Y = nullptr;
    C.OBh = (unsigned short*)takeb(2 * NT * 512 * 2); C.O = nullptr; C.BON = (float*)takeb(NT * 8 * 4); C.YCATB = (unsigned short*)takeb(NT * 1024 * 2);
    umax = off > umax ? off : umax; off = ubase;
    (void)takeb(NT * 512 * 4); C.QNB = (unsigned short*)takeb(NT * 256 * 2); C.KVNB = (unsigned short*)takeb(NT * 256 * 2);
    C.QB = (unsigned short*)takeb(NT * MLA_HEADS * 96 * 2); C.KVB = (unsigned short*)takeb(NT * MLA_HEADS * 128 * 2); C.KPEB = (unsigned short*)takeb(NT * 32 * 2);
    C.AOB = (unsigned short*)takeb(NT * 1024 * 2);
    umax = off > umax ? off : umax; off = ubase;
    C.XPB = (unsigned short*)takeb(NS * D_MODEL * 2); C.ACTB = (unsigned short*)takeb(NS * EXPERT_DIM * 2); C.OUT2B = (unsigned short*)takeb(NS * D_MODEL * 2);
    umax = off > umax ? off : umax; off = umax;
    return off;
}
#endif
#if defined(HOST_TEST)
#define FWD_QUAL static
#define FWD_SIG NaiveCtx C
#define FWD_ARGS C
#define NLAUNCH(n, ...) do { auto f_ = __VA_ARGS__; for (long i_ = 0; i_ < (long)(n); ++i_) f_(i_); } while (0)
#elif defined(PERSISTENT)
#define FWD_QUAL __device__ __forceinline__
#define FWD_SIG const LAS NaiveCtx* Cp_, const XcdBarrier& bar, LAS unsigned char* lds, int wv_
#define FWD_ARGS Cp_, bar, lds, wv_
#define PERSIST_C_MACRO 1
#define NLAUNCH(n, ...) do { auto f_ = __VA_ARGS__; const long n_ = (long)(n); int tz_ = otid(wv_); \
    for (long i_ = ((long)(tz_ >> 6) * gridDim.x + opaque_bid()) * 64 + (tz_ & 63); i_ < n_; i_ += (long)gridDim.x * PB_THREADS) f_(i_); \
    grid_sync(bar); } while (0)
#else
#define FWD_QUAL static
#define FWD_SIG NaiveCtx C
#define FWD_ARGS C
template <class F> __global__ void __launch_bounds__(256) k_run(long n, F f) { for (long i = (long)blockIdx.x * 256 + threadIdx.x; i < n; i += (long)gridDim.x * 256) f(i); }
template <class F> static void nlaunch_(long n, F f, hipStream_t st) { long nb = (n + 255) / 256; if (nb > 65536) nb = 65536; if (nb < 1) nb = 1; hipLaunchKernelGGL(k_run<F>, dim3((unsigned)nb), dim3(256), 0, st, n, f); }
#define NLAUNCH(n, ...) nlaunch_((long)(n), __VA_ARGS__, g_stream)
static hipStream_t g_stream;
#endif

#ifdef HOST_TEST
static void ngemm(const float* A, int lda, const int* arow, const float* B, long bstride, int ldb, const float* bias, long biasstride, float* Cm, int ldc, int M, int N, int K, const int* tile_e) {
    for (int m = 0; m < M; ++m) {
        int e = 0; if (tile_e) { e = tile_e[m / 64]; if (e < 0) continue; }
        int ar = arow ? arow[m] : m; if (ar < 0) continue;
        const float* Bp = B + (size_t)e * bstride;
        for (int n = 0; n < N; ++n) { double s = bias ? bias[(size_t)e * biasstride + n] : 0.0; for (int k = 0; k < K; ++k) s += (double)A[(size_t)ar * lda + k] * Bp[(size_t)k * ldb + n]; Cm[(size_t)m * ldc + n] = (float)s; }
    }
}
#elif defined(PERSISTENT)
__device__ __forceinline__ void pgemm_(const float* A, int lda, const int* arow, const float* B, long bstride, int ldb, const float* bias, long biasstride, float* Cm, int ldc, int M, int N, int K, const int* tile_e, int wv_) {
    constexpr int NH = PB_THREADS / 256;
    __shared__ float As[NH][16][68], Bs[NH][16][68];
    const int tz_ = otid(wv_);
    const int half = tz_ >> 8, tid = tz_ & 255, tx = tid & 15, ty = tid >> 4;
    const int ntn = (N + 63) / 64, ntm = (M + 63) / 64, ntiles = ntn * ntm;
    const int ar_l = tid >> 2, ak = (tid & 3) * 4, bk = tid >> 4, bn = (tid & 15) * 4;
    for (int t0 = opaque_bid() * NH; t0 < ntiles; t0 += gridDim.x * NH) {
        const int tile = t0 + half; bool active = tile < ntiles; const int rt = active ? tile / ntn : 0, ct = active ? tile % ntn : 0;
        int e = 0; if (tile_e && active) { e = tile_e[rt]; if (e < 0) { active = false; e = 0; } }
        const float* Bp = B + (size_t)e * bstride;
        const int m0 = rt * 64, n0 = ct * 64;
        float acc[4][4];
_Pragma("unroll")
        for (int i = 0; i < 4; ++i)
_Pragma("unroll")
            for (int j = 0; j < 4; ++j) acc[i][j] = 0.f;
        int am = m0 + ar_l; int arr = -1; if (active && am < M) arr = arow ? arow[am] : am;
        for (int k0 = 0; k0 < K; k0 += 16) {
            float4 av = make_float4(0, 0, 0, 0); if (arr >= 0) av = *(const float4*)(A + (size_t)arr * lda + k0 + ak);
            As[half][ak + 0][ar_l] = av.x; As[half][ak + 1][ar_l] = av.y; As[half][ak + 2][ar_l] = av.z; As[half][ak + 3][ar_l] = av.w;
_Pragma("unroll")
            for (int j = 0; j < 4; ++j) { int n = n0 + bn + j; Bs[half][bk][bn + j] = (active && n < N) ? Bp[(size_t)(k0 + bk) * ldb + n] : 0.f; }
            __syncthreads();
_Pragma("unroll")
            for (int k = 0; k < 16; ++k) {
                float a[4], b[4];
_Pragma("unroll")
                for (int i = 0; i < 4; ++i) { a[i] = As[half][k][ty * 4 + i]; b[i] = Bs[half][k][tx * 4 + i]; }
_Pragma("unroll")
                for (int i = 0; i < 4; ++i)
_Pragma("unroll")
                    for (int j = 0; j < 4; ++j) acc[i][j] += a[i] * b[j];
            }
            __syncthreads();
        }
        if (active) {
_Pragma("unroll")
            for (int i = 0; i < 4; ++i) { int m = m0 + ty * 4 + i; if (m >= M) continue;
_Pragma("unroll")
                for (int j = 0; j < 4; ++j) { int n = n0 + tx * 4 + j; if (n < N) Cm[(size_t)m * ldc + n] = acc[i][j] + (bias ? bias[(size_t)e * biasstride + n] : 0.f); } }
        }
    }
}
#define ngemm(...) do { pgemm_(__VA_ARGS__, wv_); grid_sync(bar); } while (0)
#else
__global__ void __launch_bounds__(256) k_ngemm(const float* A, const int* arow, const float* B, const float* bias, float* Cm, const int* tile_e, long bstride, long biasstride, int lda, int ldb, int ldc, int M, int N, int K) {
    __shared__ float As[16][68], Bs[16][68];
    const int rt = blockIdx.y, ct = blockIdx.x, tid = threadIdx.x, tx = tid & 15, ty = tid >> 4;
    int e = 0; if (tile_e) { e = tile_e[rt]; if (e < 0) return; }
    const float* Bp = B + (size_t)e * bstride;
    const int m0 = rt * 64, n0 = ct * 64;
    float acc[4][4] = {};
    const int ar_l = tid >> 2, ak = (tid & 3) * 4; int am = m0 + ar_l; int arr = -1; if (am < M) arr = arow ? arow[am] : am;
    const int bk = tid >> 4, bn = (tid & 15) * 4;
    for (int k0 = 0; k0 < K; k0 += 16) {
        float4 av = make_float4(0, 0, 0, 0); if (arr >= 0) av = *(const float4*)(A + (size_t)arr * lda + k0 + ak);
        As[ak + 0][ar_l] = av.x; As[ak + 1][ar_l] = av.y; As[ak + 2][ar_l] = av.z; As[ak + 3][ar_l] = av.w;
        float bv[4]; for (int j = 0; j < 4; ++j) { int n = n0 + bn + j; bv[j] = n < N ? Bp[(size_t)(k0 + bk) * ldb + n] : 0.f; }
        Bs[bk][bn + 0] = bv[0]; Bs[bk][bn + 1] = bv[1]; Bs[bk][bn + 2] = bv[2]; Bs[bk][bn + 3] = bv[3];
        __syncthreads();
_Pragma("unroll")
        for (int k = 0; k < 16; ++k) {
            float a[4], b[4];
_Pragma("unroll")
            for (int i = 0; i < 4; ++i) { a[i] = As[k][ty * 4 + i]; b[i] = Bs[k][tx * 4 + i]; }
_Pragma("unroll")
            for (int i = 0; i < 4; ++i)
_Pragma("unroll")
                for (int j = 0; j < 4; ++j) acc[i][j] += a[i] * b[j];
        }
        __syncthreads();
    }
_Pragma("unroll")
    for (int i = 0; i < 4; ++i) { int m = m0 + ty * 4 + i; if (m >= M) continue;
_Pragma("unroll")
        for (int j = 0; j < 4; ++j) { int n = n0 + tx * 4 + j; if (n < N) Cm[(size_t)m * ldc + n] = acc[i][j] + (bias ? bias[(size_t)e * biasstride + n] : 0.f); } }
}
static void ngemm(const float* A, int lda, const int* arow, const float* B, long bstride, int ldb, const float* bias, long biasstride, float* Cm, int ldc, int M, int N, int K, const int* tile_e) {
    dim3 grid((N + 63) / 64, (M + 63) / 64);
    hipLaunchKernelGGL(k_ngemm, grid, dim3(256), 0, g_stream, A, arow, B, bias, Cm, tile_e, bstride, biasstride, lda, ldb, ldc, M, N, K);
}
#endif


#ifndef ATT_REMAP
#define ATT_REMAP 1
#endif
namespace att {
typedef float f32x16 __attribute__((ext_vector_type(16)));
typedef short s16x4 __attribute__((ext_vector_type(4)));
typedef __bf16 bf16x2_t __attribute__((ext_vector_type(2)));
typedef float f32x2_t __attribute__((ext_vector_type(2)));
constexpr int KROWB = 208, KT_BYTES = 64 * KROWB, VT_BYTES = 8192, BUF = KT_BYTES + VT_BYTES;
DI unsigned pk2(float a, float b) { f32x2_t f = {a, b}; return __builtin_bit_cast(unsigned, __builtin_convertvector(f, bf16x2_t)); }
template <int S> DI bf16x8 pack8(const f32x16& x) { u32x4 p; p.x = pk2(x[8 * S], x[8 * S + 1]); p.y = pk2(x[8 * S + 2], x[8 * S + 3]); p.z = pk2(x[8 * S + 4], x[8 * S + 5]); p.w = pk2(x[8 * S + 6], x[8 * S + 7]); return __builtin_bit_cast(bf16x8, p); }
#ifndef ATT_SETPRIO
#define ATT_SETPRIO 1
#endif
#if ATT_SETPRIO
#define ATT_PRIO(p) __builtin_amdgcn_s_setprio(p)
#else
#define ATT_PRIO(p)
#endif
#define ATT_MFMA(a, b, c) __builtin_amdgcn_mfma_f32_32x32x16_bf16((a), (b), (c), 0, 0, 0)

template <bool BF16OUT, int KVSRC> DI void attn_phase(LAS unsigned char* lds, const bf16_t* __restrict__ Qb, const bf16_t* __restrict__ Kb, const bf16_t* __restrict__ Vb, float* __restrict__ AO, bf16_t* __restrict__ AOB, int with_ctx, int wv_, const float* __restrict__ rope_tab = nullptr) {
    const int tid = otid(wv_), lane = tid & 63, wid = tid >> 6, r = lane & 31, h2 = lane >> 5, g1 = (lane >> 4) & 1, i16 = lane & 15;
    const int nlat = BATCH * MLA_HEADS * (SEQ / 256), nctx = with_ctx ? BATCH * MLA_HEADS * (CTX_LEN / 256) : 0;
    const int kq0 = tid, kq1 = 512 + tid; const bool has_k1 = tid < 256;
    const int kr0 = kq0 / 12, kc0 = kq0 % 12, kr1 = kq1 / 12, kc1 = kq1 % 12, vr = tid >> 3, vc = tid & 7;
    const unsigned kl0 = kr0 * KROWB + kc0 * 16, kl1 = kr1 * KROWB + kc1 * 16, vl = KT_BYTES + (vc >> 2) * 4096 + vr * 64 + (vc & 3) * 16;
    for (int u0 = opaque_bid(); u0 < nlat + nctx; u0 += gridDim.x) {
        int u = u0;
#if ATT_REMAP
        if (gridDim.x == 256 && u0 < nlat && (SEQ / 256) == 8) { const int c = u0 & 255, x = c & 7, j = c >> 3; u = (u0 & ~255) + 8 * (4 * x + (j >> 3)) + (j & 7); }
#endif
        int b, h, qrow0, nkeys;
        if (u < nlat) { const int qb = u % (SEQ / 256), bh = u / (SEQ / 256); b = bh / MLA_HEADS; h = bh % MLA_HEADS; qrow0 = NC_ + b * SEQ + qb * 256; nkeys = TT_; }
        else { const int v = u - nlat; const int qb = v % (CTX_LEN / 256), bh = v / (CTX_LEN / 256); b = bh / MLA_HEADS; h = bh % MLA_HEADS; qrow0 = b * CTX_LEN + qb * 256; nkeys = CTX_LEN; }
        const int nt = nkeys / 64;
        const bf16_t* qp = Qb + (size_t)(qrow0 + wid * 32 + r) * (MLA_HEADS * 96) + h * 96 + 8 * h2;
        bf16x8 qf[6];
#pragma unroll
        for (int s = 0; s < 6; ++s) qf[s] = *(const GAS bf16x8*)(qp + 16 * s);
        const bf16_t* kbase = Kb + (size_t)(b * MLA_HEADS + h) * TT_ * 96;
        const bf16_t* vbase = Vb + (size_t)(b * MLA_HEADS + h) * TT_ * 64;
#define ATT_LOAD_TO(TI, sk0, sk1, sv) do { if (KVSRC == 0) { const size_t ko = (size_t)(TI) * 64; \
            sk0 = *(const GAS u32x4*)(kbase + (ko + kr0) * 96 + kc0 * 8); if (has_k1) sk1 = *(const GAS u32x4*)(kbase + (ko + kr1) * 96 + kc1 * 8); sv = *(const GAS u32x4*)(vbase + (ko + vr) * 64 + vc * 8); } \
          else { const int t0_ = (TI) * 64; const size_t rb = t0_ < CTX_LEN ? (size_t)b * CTX_LEN + t0_ : (size_t)NC_ + (size_t)b * SEQ + (t0_ - CTX_LEN); \
            sk0 = kc0 < 8 ? *(const GAS u32x4*)(Kb + (rb + kr0) * (MLA_HEADS * 128) + h * 128 + kc0 * 8) : *(const GAS u32x4*)(Vb + (rb + kr0) * 32 + (kc0 - 8) * 8); \
            if (has_k1) sk1 = kc1 < 8 ? *(const GAS u32x4*)(Kb + (rb + kr1) * (MLA_HEADS * 128) + h * 128 + kc1 * 8) : *(const GAS u32x4*)(Vb + (rb + kr1) * 32 + (kc1 - 8) * 8); \
            sv = *(const GAS u32x4*)(Kb + (rb + vr) * (MLA_HEADS * 128) + h * 128 + 64 + vc * 8); } } while (0)
#define ATT_LOAD(TI) ATT_LOAD_TO(TI, sk0, sk1, sv)
        const bool do_rope = rope_tab != nullptr && u < nlat;
        f32x4 rt[2][4];
        if (do_rope) { const int spos = (qrow0 - NC_ + wid * 32 + r) % SEQ; const float* tb = rope_tab + (size_t)spos * 32;
#pragma unroll
            for (int f = 0; f < 2; ++f)
#pragma unroll
                for (int c = 0; c < 4; ++c) rt[f][c] = *(const GAS f32x4*)(tb + 16 * f + 4 * c); }
        u32x4 sk0, sk1 = (u32x4){0u, 0u, 0u, 0u}, sv, tk0, tk1 = (u32x4){0u, 0u, 0u, 0u}, tv;
        ATT_LOAD(0);
        if (nt > 1) { ATT_LOAD_TO(1, tk0, tk1, tv); }
        if (do_rope) {
#pragma unroll
            for (int f = 0; f < 2; ++f) { const u32x4 own = __builtin_bit_cast(u32x4, qf[4 + f]); u32x4 oth;
                oth.x = __shfl_xor(own.x, 32); oth.y = __shfl_xor(own.y, 32); oth.z = __shfl_xor(own.z, 32); oth.w = __shfl_xor(own.w, 32);
                const f32x4 c0 = rt[f][0], c1 = rt[f][1], s0 = rt[f][2], s1 = rt[f][3];
                const float sgn = h2 ? 1.f : -1.f;
                const float x[8] = {bf_lo(own.x), bf_hi(own.x), bf_lo(own.y), bf_hi(own.y), bf_lo(own.z), bf_hi(own.z), bf_lo(own.w), bf_hi(own.w)};
                const float y[8] = {bf_lo(oth.x), bf_hi(oth.x), bf_lo(oth.y), bf_hi(oth.y), bf_lo(oth.z), bf_hi(oth.z), bf_lo(oth.w), bf_hi(oth.w)};
                const float cs[8] = {c0[0], c0[1], c0[2], c0[3], c1[0], c1[1], c1[2], c1[3]}, sn[8] = {s0[0], s0[1], s0[2], s0[3], s1[0], s1[1], s1[2], s1[3]};
                u32x4 w; w.x = pk2(x[0] * cs[0] + sgn * y[0] * sn[0], x[1] * cs[1] + sgn * y[1] * sn[1]); w.y = pk2(x[2] * cs[2] + sgn * y[2] * sn[2], x[3] * cs[3] + sgn * y[3] * sn[3]);
                w.z = pk2(x[4] * cs[4] + sgn * y[4] * sn[4], x[5] * cs[5] + sgn * y[5] * sn[5]); w.w = pk2(x[6] * cs[6] + sgn * y[6] * sn[6], x[7] * cs[7] + sgn * y[7] * sn[7]);
                qf[4 + f] = __builtin_bit_cast(bf16x8, w); } }
#define ATT_QK(S0, S1, BUFP) do { _Pragma("unroll") for (int i = 0; i < 16; ++i) { S0[i] = 0.f; S1[i] = 0.f; } \
            _Pragma("unroll") for (int s = 0; s < 6; ++s) { const bf16x8 k0 = *(const LAS bf16x8*)((BUFP) + r * KROWB + 32 * s + 16 * h2); const bf16x8 k1 = *(const LAS bf16x8*)((BUFP) + (32 + r) * KROWB + 32 * s + 16 * h2); \
                S0 = ATT_MFMA(k0, qf[s], S0); S1 = ATT_MFMA(k1, qf[s], S1); } } while (0)
#define ATT_STORE_STAGE(NB) do { *(LAS u32x4*)((NB) + kl0) = sk0; if (has_k1) *(LAS u32x4*)((NB) + kl1) = sk1; *(LAS u32x4*)((NB) + vl) = sv; } while (0)
        ATT_STORE_STAGE(lds);
        if (nt > 1) { *(LAS u32x4*)(lds + BUF + kl0) = tk0; if (has_k1) *(LAS u32x4*)(lds + BUF + kl1) = tk1; *(LAS u32x4*)(lds + BUF + vl) = tv; }
        __syncthreads();
        f32x16 o0, o1, s0, s1;
#pragma unroll
        for (int i = 0; i < 16; ++i) { o0[i] = 0.f; o1[i] = 0.f; }
        ATT_QK(s0, s1, lds);
        float m = -1e30f, l = 0.f;
        int st_cur = 0;
        for (int t = 0; t < nt; ++t) {
            const int st_nxt = st_cur == 2 ? 0 : st_cur + 1, st_nn = st_nxt == 2 ? 0 : st_nxt + 1;
            LAS unsigned char* buf = lds + st_cur * BUF;
            if (t + 2 < nt) { ATT_LOAD(t + 2); }
            f32x16 n0, n1;
            ATT_QK(n0, n1, lds + st_nxt * BUF);
            float mt = __builtin_fmaxf(s0[0], s1[0]);
#pragma unroll
            for (int i = 1; i < 16; ++i) mt = __builtin_fmaxf(__builtin_fmaxf(mt, s0[i]), s1[i]);
            { float ma = mt, mb = mt; asm volatile("s_nop 1\n\tv_permlane32_swap_b32 %0, %1" : "+v"(ma), "+v"(mb)); mt = fmaxf(ma, mb); }
            if (__any(mt > m + 8.f)) { const float mnew = fmaxf(m, mt), alpha = __builtin_amdgcn_exp2f(m - mnew); m = mnew; l *= alpha;
#pragma unroll
                for (int i = 0; i < 16; ++i) { o0[i] *= alpha; o1[i] *= alpha; } }
            float ls = 0.f;
#pragma unroll
            for (int i = 0; i < 16; ++i) { s0[i] = __builtin_amdgcn_exp2f(s0[i] - m); s1[i] = __builtin_amdgcn_exp2f(s1[i] - m); ls += s0[i] + s1[i]; }
            l += ls;
            LAS unsigned char* vb = buf + KT_BYTES + (4 * h2 + (i16 >> 2)) * 64 + 32 * g1 + 8 * (i16 & 3);
#define ATT_PV(PS, SB, S2) do { const bf16x8 pb = pack8<S2>(PS); \
            { const s16x4 lo = __builtin_amdgcn_ds_read_tr16_b64_v4i16((LAS s16x4*)(vb + (32 * SB + 16 * S2) * 64)), hi = __builtin_amdgcn_ds_read_tr16_b64_v4i16((LAS s16x4*)(vb + (32 * SB + 16 * S2 + 8) * 64)); \
              o0 = ATT_MFMA(__builtin_shufflevector(lo, hi, 0, 1, 2, 3, 4, 5, 6, 7), pb, o0); } \
            { const s16x4 lo = __builtin_amdgcn_ds_read_tr16_b64_v4i16((LAS s16x4*)(vb + 4096 + (32 * SB + 16 * S2) * 64)), hi = __builtin_amdgcn_ds_read_tr16_b64_v4i16((LAS s16x4*)(vb + 4096 + (32 * SB + 16 * S2 + 8) * 64)); \
              o1 = ATT_MFMA(__builtin_shufflevector(lo, hi, 0, 1, 2, 3, 4, 5, 6, 7), pb, o1); } } while (0)
            ATT_PRIO(1); ATT_PV(s0, 0, 0); ATT_PV(s0, 0, 1); ATT_PV(s1, 1, 0); ATT_PV(s1, 1, 1); ATT_PRIO(0);
#undef ATT_PV
            if (t + 2 < nt) ATT_STORE_STAGE(lds + st_nn * BUF);
            __syncthreads();
            s0 = n0; s1 = n1;
            st_cur = st_nxt;
        }
#undef ATT_QK
#undef ATT_STORE_STAGE
        l += __shfl_xor(l, 32);
        const float il = 1.f / l;
        if (BF16OUT) { bf16_t* op = AOB + (size_t)(qrow0 + wid * 32 + r) * 1024 + h * 64 + 4 * h2;
#pragma unroll
            for (int g = 0; g < 4; ++g) {
                *(GAS u32x2*)(op + 8 * g) = (u32x2){pk2(o0[4 * g] * il, o0[4 * g + 1] * il), pk2(o0[4 * g + 2] * il, o0[4 * g + 3] * il)};
                *(GAS u32x2*)(op + 32 + 8 * g) = (u32x2){pk2(o1[4 * g] * il, o1[4 * g + 1] * il), pk2(o1[4 * g + 2] * il, o1[4 * g + 3] * il)}; }
        } else { float* op = AO + (size_t)(qrow0 + wid * 32 + r) * 1024 + h * 64 + 4 * h2;
#pragma unroll
            for (int g = 0; g < 4; ++g) {
                *(GAS f32x4*)(op + 8 * g) = (f32x4){o0[4 * g] * il, o0[4 * g + 1] * il, o0[4 * g + 2] * il, o0[4 * g + 3] * il};
                *(GAS f32x4*)(op + 32 + 8 * g) = (f32x4){o1[4 * g] * il, o1[4 * g + 1] * il, o1[4 * g + 2] * il, o1[4 * g + 3] * il}; } }
    }
}
#undef ATT_LOAD
#undef ATT_LOAD_TO
}

namespace tl {
DI float wsum(float v) { v += __shfl_xor(v, 32); v += __shfl_xor(v, 16); v += __shfl_xor(v, 8); v += __shfl_xor(v, 4); v += __shfl_xor(v, 2); v += __shfl_xor(v, 1); return v; }
DI void ld16f(const float* p, int lane, float (&v)[16]) {
#pragma unroll
    for (int i = 0; i < 2; ++i) { const f32x4 a = *(const GAS f32x4*)(p + 512 * i + 8 * lane), b = *(const GAS f32x4*)(p + 512 * i + 8 * lane + 4);
        v[8 * i] = a[0]; v[8 * i + 1] = a[1]; v[8 * i + 2] = a[2]; v[8 * i + 3] = a[3]; v[8 * i + 4] = b[0]; v[8 * i + 5] = b[1]; v[8 * i + 6] = b[2]; v[8 * i + 7] = b[3]; } }
DI void st16f(float* p, int lane, const float (&v)[16]) {
#pragma unroll
    for (int i = 0; i < 2; ++i) { *(GAS f32x4*)(p + 512 * i + 8 * lane) = (f32x4){v[8 * i], v[8 * i + 1], v[8 * i + 2], v[8 * i + 3]}; *(GAS f32x4*)(p + 512 * i + 8 * lane + 4) = (f32x4){v[8 * i + 4], v[8 * i + 5], v[8 * i + 6], v[8 * i + 7]}; } }
DI void ld16b(const bf16_t* p, int lane, float (&v)[16]) {
#pragma unroll
    for (int i = 0; i < 2; ++i) { const u32x4 w = *(const GAS u32x4*)(p + 512 * i + 8 * lane);
        v[8 * i] = bf_lo(w.x); v[8 * i + 1] = bf_hi(w.x); v[8 * i + 2] = bf_lo(w.y); v[8 * i + 3] = bf_hi(w.y); v[8 * i + 4] = bf_lo(w.z); v[8 * i + 5] = bf_hi(w.z); v[8 * i + 6] = bf_lo(w.w); v[8 * i + 7] = bf_hi(w.w); } }
DI void st16b(bf16_t* p, int lane, const float (&v)[16]) {
#pragma unroll
    for (int i = 0; i < 2; ++i) { u32x4 w; w.x = att::pk2(v[8 * i], v[8 * i + 1]); w.y = att::pk2(v[8 * i + 2], v[8 * i + 3]); w.z = att::pk2(v[8 * i + 4], v[8 * i + 5]); w.w = att::pk2(v[8 * i + 6], v[8 * i + 7]);
        *(GAS u32x4*)(p + 512 * i + 8 * lane) = w; } }
typedef _Float16 f16x8 __attribute__((ext_vector_type(8)));
typedef float f32x8 __attribute__((ext_vector_type(8)));
DI void ld16h(const unsigned short* p, int lane, float (&v)[16]) {
#pragma unroll
    for (int i = 0; i < 2; ++i) { const f16x8 hv = *(const GAS f16x8*)(p + 512 * i + 8 * lane); const f32x8 f = __builtin_convertvector(hv, f32x8);
#pragma unroll
        for (int j = 0; j < 8; ++j) v[8 * i + j] = f[j]; } }
DI void st16h(unsigned short* p, int lane, const float (&v)[16]) {
#pragma unroll
    for (int i = 0; i < 2; ++i) { f32x8 f;
#pragma unroll
        for (int j = 0; j < 8; ++j) f[j] = v[8 * i + j];
        *(GAS f16x8*)(p + 512 * i + 8 * lane) = __builtin_convertvector(f, f16x8); } }
#define TL_ROWS(row, row_lo, nrows) const int rpw_ = ((nrows) + (int)gridDim.x - 1) / (int)gridDim.x, wg_ = opaque_bid(), tid_ = otid(wv_), lane = tid_ & 63, wid_ = tid_ >> 6; (void)lane; \
    for (int rr_ = wid_, row = (row_lo) + wg_ * rpw_ + wid_; rr_ < rpw_ && row < (row_lo) + (nrows); rr_ += 8, row += 8)

DI void init_h(const LAS NaiveCtx* Cp_, int wv_) {
    TL_ROWS(row, 0, NT_) { float h[16], m0[16], m1[16], u[16];
        ld16f(row < NC_ ? (*Cp_).ctx + (size_t)row * D_MODEL : (*Cp_).x + (size_t)(row - NC_) * D_MODEL, lane, h);
        const float* m = (*Cp_).MOD + (size_t)modrow(row) * N_MOD * D_MODEL; ld16f(m, lane, m0); ld16f(m + D_MODEL, lane, m1);
#pragma unroll
        for (int k = 0; k < 16; ++k) u[k] = h[k] * (1.f + m1[k]) + m0[k];
        st16h((*Cp_).HB + (size_t)row * D_MODEL, lane, h); st16b((*Cp_).UB + (size_t)row * D_MODEL, lane, u); }
}


DI void mod_phase(const LAS NaiveCtx* Cp_, LAS unsigned char* lds, int wv_) {
    constexpr int W = N_MOD * D_MODEL, NR = BATCH + 1, NCOLS = DEPTH * W;
    const int t = otid(wv_), wg = opaque_bid(), cpw = (NCOLS + (int)gridDim.x - 1) / (int)gridDim.x;
    LAS float* sl = (LAS float*)(lds + 72 * 1024);
    { constexpr int NV = NR * D_MODEL / PB_THREADS; float cv[NV]; const GAS float* cp = (const GAS float*)(*Cp_).c; const GAS float* cc = (const GAS float*)(*Cp_).c_ctx;
      static_assert(NR * D_MODEL % PB_THREADS == 0, "silu table");
#pragma unroll
      for (int j = 0; j < NV; ++j) { const int i = t + PB_THREADS * j, r = i / D_MODEL, k = i % D_MODEL; cv[j] = r < BATCH ? cp[(size_t)r * D_MODEL + k] : cc[k]; }
#pragma unroll
      for (int j = 0; j < NV; ++j) sl[t + PB_THREADS * j] = siluf_(cv[j]); }
    __syncthreads();
    const int col = wg * cpw + t;
    if (t < cpw && col < NCOLS) { const int l = col / W, j = col % W; const float* w = (*Cp_).mod_w + (size_t)l * D_MODEL * W + j;
        float acc[NR];
#pragma unroll
        for (int r = 0; r < NR; ++r) acc[r] = 0.f;
        for (int k = 0; k < D_MODEL; k += 4) { const GAS float* wg_ = (const GAS float*)w; const float w0 = wg_[(size_t)k * W], w1 = wg_[(size_t)(k + 1) * W], w2 = wg_[(size_t)(k + 2) * W], w3 = wg_[(size_t)(k + 3) * W];
#pragma unroll
            for (int r = 0; r < NR; ++r) { const f32x4 s = *(const LAS f32x4*)(sl + r * D_MODEL + k); acc[r] += s[0] * w0 + s[1] * w1 + s[2] * w2 + s[3] * w3; } }
        const float bj = (*Cp_).mod_b[(size_t)l * W + j];
#pragma unroll
        for (int r = 0; r < NR; ++r) (*Cp_).MOD[((size_t)l * NR + r) * W + j] = acc[r] + bj; }
    __syncthreads();
}

constexpr int WRT_STRIDE = 1028;
__shared__ int tl_lcnt[32], tl_wgbase[32], tl_offs[33], tl_tstart[33], tl_cnt[32];

DI void ln1_row_pre(const LAS NaiveCtx* Cp_, const float* MODp, const float (&g0)[16], const float (&b0)[16], int row, int lane, bool wr, float (&t)[16]) {
    const float* m = MODp + (size_t)modrow(row) * N_MOD * D_MODEL;
    float a[16], b[16];
    ld16h((*Cp_).HB + (size_t)row * D_MODEL, lane, t); ld16b((*Cp_).YOB + (size_t)row * D_MODEL, lane, a); ld16f(m + 2 * D_MODEL, lane, b);
    float s = 0.f;
#pragma unroll
    for (int k = 0; k < 16; ++k) { t[k] = ALPHA * t[k] + b[k] * a[k]; s += t[k]; }
    const float mean = wsum(s) * (1.f / D_MODEL); s = 0.f;
#pragma unroll
    for (int k = 0; k < 16; ++k) { t[k] -= mean; s += t[k] * t[k]; }
    const float rs = 1.f / sqrtf(wsum(s) * (1.f / D_MODEL) + 1e-5f);
    ld16f(m + 3 * D_MODEL, lane, a); ld16f(m + 4 * D_MODEL, lane, b);
#pragma unroll
    for (int k = 0; k < 16; ++k) t[k] = t[k] * rs * g0[k] + b0[k];
    if (wr) st16h((*Cp_).HB + (size_t)row * D_MODEL, lane, t);
#pragma unroll
    for (int k = 0; k < 16; ++k) t[k] = t[k] * (1.f + b[k]) + a[k];
    if (wr) st16b((*Cp_).UB + (size_t)row * D_MODEL, lane, t);
}
DI void ln1_row_post(const LAS NaiveCtx* Cp_, const float* brp, int row, int lane, bool wr, float (&p)[16]) {
#define TL_STAGE(N, BIT) { const bool up_ = (lane & BIT) != 0; _Pragma("unroll") for (int k = 0; k < N / 2; ++k) { const float send_ = up_ ? p[k] : p[k + N / 2], keep_ = up_ ? p[k + N / 2] : p[k]; p[k] = keep_ + __shfl_xor(send_, BIT); } }
        TL_STAGE(16, 16) TL_STAGE(8, 8) TL_STAGE(4, 4) TL_STAGE(2, 2)
#undef TL_STAGE
        const int e_me = (lane >> 1) & 31;
        const float lg = p[0] + __shfl_xor(p[0], 1) + brp[e_me];
        int rank = 0;
#pragma unroll
        for (int e2 = 0; e2 < 32; ++e2) { const float v = __builtin_bit_cast(float, __builtin_amdgcn_readlane(__builtin_bit_cast(int, lg), 2 * e2)); rank += (v > lg || (v == lg && e2 < e_me)) ? 1 : 0; }
        float vk[4]; int ek[4];
#pragma unroll
        for (int k = 0; k < 4; ++k) { const unsigned long long mk = __ballot(rank == k && (lane & 1) == 0); const int src = __builtin_amdgcn_readfirstlane((int)__builtin_ctzll(mk | (1ull << 63)));
            vk[k] = __builtin_bit_cast(float, __builtin_amdgcn_readlane(__builtin_bit_cast(int, lg), src)); ek[k] = src >> 1; }
        float wk[4], den = 0.f;
#pragma unroll
        for (int k = 0; k < 4; ++k) { wk[k] = expf(vk[k] - vk[0]); den += wk[k]; }
        if (wr && lane < 4) { const int e = lane == 0 ? ek[0] : lane == 1 ? ek[1] : lane == 2 ? ek[2] : ek[3]; const float g = (lane == 0 ? wk[0] : lane == 1 ? wk[1] : lane == 2 ? wk[2] : wk[3]) / den;
            const int r = atomicAdd(&tl_lcnt[e], 1);
            (*Cp_).TOPI[(size_t)row * TOP_K + lane] = e; (*Cp_).TOPG[(size_t)row * TOP_K + lane] = g; (*Cp_).SLOT[(size_t)row * TOP_K + lane] = r; }
}
DI void ln1_router(const LAS NaiveCtx* Cp_, LAS unsigned char* lds, long layer, int row_lo, int nrows, int wv_) {
    LAS float* wrt = (LAS float*)lds;
    { const int t = otid(wv_); const float* wrp = (*Cp_).moe_w_router + (size_t)layer * D_MODEL * N_EXPERTS;
      { const GAS f32x4* wrp4 = (const GAS f32x4*)wrp; constexpr int NV = D_MODEL * N_EXPERTS / 4 / PB_THREADS; f32x4 wv[NV];
#pragma unroll
        for (int j = 0; j < NV; ++j) wv[j] = wrp4[t + PB_THREADS * j];
#pragma unroll
        for (int j = 0; j < NV; ++j) { const int idx = 4 * (t + PB_THREADS * j);
#pragma unroll
            for (int c = 0; c < 4; ++c) wrt[((idx + c) & 31) * WRT_STRIDE + ((idx + c) >> 5)] = wv[j][c]; } }
      if (t < 32) tl_lcnt[t] = 0; }
    __syncthreads();
    const float* MODp = (*Cp_).MOD + (size_t)layer * (BATCH + 1) * N_MOD * D_MODEL;
    const float* lg0 = (*Cp_).ln_g + ((size_t)layer * 2) * D_MODEL; const float* lb0 = (*Cp_).ln_b + ((size_t)layer * 2) * D_MODEL;
    const float* brp = (*Cp_).moe_b_router + (size_t)layer * N_EXPERTS;
    { const int rpw_ = (nrows + (int)gridDim.x - 1) / (int)gridDim.x, wg_ = opaque_bid(), tid_ = otid(wv_), lane = tid_ & 63, wid_ = tid_ >> 6;
      float g0[16], b0[16]; ld16f(lg0, lane, g0); ld16f(lb0, lane, b0);
      for (int rr_ = wid_, row = row_lo + wg_ * rpw_ + wid_; rr_ < rpw_ && row < row_lo + nrows; rr_ += 16, row += 16) {
        const bool hasB = (rr_ + 8 < rpw_) && (row + 8 < row_lo + nrows); const int rowB = hasB ? row + 8 : row;
        float tA[16], tB[16];
        ln1_row_pre(Cp_, MODp, g0, b0, row, lane, true, tA); ln1_row_pre(Cp_, MODp, g0, b0, rowB, lane, hasB, tB);
        float pA[16], pB[16];
        const bool up5 = (lane & 32) != 0;
#pragma unroll
        for (int k = 0; k < 16; ++k) { float aA[2], aB[2];
#pragma unroll
            for (int hh = 0; hh < 2; ++hh) { const int e = k + 16 * hh; float accA = 0.f, accB = 0.f;
#pragma unroll
                for (int i = 0; i < 2; ++i) { const f32x4 w0 = *(const LAS f32x4*)(wrt + e * WRT_STRIDE + 512 * i + 8 * lane), w1 = *(const LAS f32x4*)(wrt + e * WRT_STRIDE + 512 * i + 8 * lane + 4);
                    accA += tA[8 * i] * w0[0] + tA[8 * i + 1] * w0[1] + tA[8 * i + 2] * w0[2] + tA[8 * i + 3] * w0[3] + tA[8 * i + 4] * w1[0] + tA[8 * i + 5] * w1[1] + tA[8 * i + 6] * w1[2] + tA[8 * i + 7] * w1[3];
                    accB += tB[8 * i] * w0[0] + tB[8 * i + 1] * w0[1] + tB[8 * i + 2] * w0[2] + tB[8 * i + 3] * w0[3] + tB[8 * i + 4] * w1[0] + tB[8 * i + 5] * w1[1] + tB[8 * i + 6] * w1[2] + tB[8 * i + 7] * w1[3]; }
                aA[hh] = accA; aB[hh] = accB; }
            { const float sendA = up5 ? aA[0] : aA[1], keepA = up5 ? aA[1] : aA[0]; pA[k] = keepA + __shfl_xor(sendA, 32);
              const float sendB = up5 ? aB[0] : aB[1], keepB = up5 ? aB[1] : aB[0]; pB[k] = keepB + __shfl_xor(sendB, 32); }
            __builtin_amdgcn_sched_barrier(0); }
        ln1_row_post(Cp_, brp, row, lane, true, pA); ln1_row_post(Cp_, brp, rowB, lane, hasB, pB);
      } }
    __syncthreads();
    { const int t = otid(wv_); if (t < 32) tl_wgbase[t] = atomicAdd((*Cp_).CNT + layer * 64 + t, tl_lcnt[t]); }
}

DI void slots_gather(const LAS NaiveCtx* Cp_, long layer, int row_lo, int nrows, int wv_) {
    { const int t = otid(wv_); if (t < N_EXPERTS) tl_cnt[t] = ld_cnt((*Cp_).CNT + layer * 64 + t); }
    __syncthreads();
    { const int t = otid(wv_); if (t == 0) { int off = 0; for (int e = 0; e < N_EXPERTS; ++e) { tl_offs[e] = off; tl_tstart[e] = off / MOE_PAD; off += (tl_cnt[e] + MOE_PAD - 1) / MOE_PAD * MOE_PAD; } tl_offs[N_EXPERTS] = off; tl_tstart[N_EXPERTS] = off / MOE_PAD; } }
    __syncthreads();
    { const int rpw_ = (nrows + (int)gridDim.x - 1) / (int)gridDim.x, base = row_lo + opaque_bid() * rpw_, hi = (base + rpw_ < row_lo + nrows) ? base + rpw_ : row_lo + nrows;
      const GAS int* topi = (const GAS int*)(*Cp_).TOPI; GAS int* slotp = (GAS int*)(*Cp_).SLOT; GAS int* tokof = (GAS int*)(*Cp_).TOKOF;
      for (int i = otid(wv_); i < (hi - base) * TOP_K; i += PB_THREADS) { const int row = base + i / TOP_K; const size_t idx = (size_t)base * TOP_K + i;
          const int e = topi[idx]; const int slot = tl_offs[e] + tl_wgbase[e] + slotp[idx]; slotp[idx] = slot;
          tokof[slot] = row; } }
    { const int wg = opaque_bid(), t = otid(wv_);
      if (wg < N_EXPERTS) { const int cnt = tl_cnt[wg], lo = tl_offs[wg] + cnt, hi = tl_offs[wg + 1]; for (int s = lo + t; s < hi; s += PB_THREADS) (*Cp_).TOKOF[s] = 0; } }
}

DI void cmb_issue(const LAS NaiveCtx* Cp_, int row, int lane, u32x4 (&o)[4][2], float (&g)[4], f16x8 (&h)[2]) {
    const GAS int* sp = (const GAS int*)((*Cp_).SLOT + (size_t)row * TOP_K); const GAS float* gp = (const GAS float*)((*Cp_).TOPG + (size_t)row * TOP_K);
    int sl[4];
#pragma unroll
    for (int q = 0; q < 4; ++q) { sl[q] = sp[q]; g[q] = gp[q]; }
#pragma unroll
    for (int q = 0; q < 4; ++q) { const GAS u32x4* p = (const GAS u32x4*)((*Cp_).OUT2B + (size_t)sl[q] * D_MODEL + 8 * lane); o[q][0] = p[0]; o[q][1] = p[64]; }
#pragma unroll
    for (int i = 0; i < 2; ++i) h[i] = *(const GAS f16x8*)((*Cp_).HB + (size_t)row * D_MODEL + 512 * i + 8 * lane);
}
DI void cmb_finish(const LAS NaiveCtx* Cp_, const float* MODp, const float (&g1)[16], const float (&b1)[16], bool last, int row, int lane, bool wr, const u32x4 (&o)[4][2], const float (&g)[4], const f16x8 (&h)[2]) {
    const float* m = MODp + (size_t)modrow(row) * N_MOD * D_MODEL;
    float f[16], t[16], a[16], b[16];
#pragma unroll
    for (int k = 0; k < 16; ++k) f[k] = 0.f;
#pragma unroll
    for (int q = 0; q < 4; ++q)
#pragma unroll
        for (int i = 0; i < 2; ++i) { const u32x4 w = o[q][i];
            f[8 * i] += g[q] * bf_lo(w.x); f[8 * i + 1] += g[q] * bf_hi(w.x); f[8 * i + 2] += g[q] * bf_lo(w.y); f[8 * i + 3] += g[q] * bf_hi(w.y);
            f[8 * i + 4] += g[q] * bf_lo(w.z); f[8 * i + 5] += g[q] * bf_hi(w.z); f[8 * i + 6] += g[q] * bf_lo(w.w); f[8 * i + 7] += g[q] * bf_hi(w.w); }
#pragma unroll
    for (int i = 0; i < 2; ++i) { const f32x8 hf = __builtin_convertvector(h[i], f32x8);
#pragma unroll
        for (int j = 0; j < 8; ++j) t[8 * i + j] = hf[j]; }
    ld16f(m + 5 * D_MODEL, lane, b);
    float s = 0.f;
#pragma unroll
    for (int k = 0; k < 16; ++k) { t[k] = ALPHA * t[k] + b[k] * f[k]; s += t[k]; }
    const float mean = wsum(s) * (1.f / D_MODEL); s = 0.f;
#pragma unroll
    for (int k = 0; k < 16; ++k) { t[k] -= mean; s += t[k] * t[k]; }
    const float rs = 1.f / sqrtf(wsum(s) * (1.f / D_MODEL) + 1e-5f);
#pragma unroll
    for (int k = 0; k < 16; ++k) t[k] = t[k] * rs * g1[k] + b1[k];
    if (!wr) return;
    if (last) { st16f((*Cp_).out + (size_t)(row - NC_) * D_MODEL, lane, t); }
    else { const float* mn = MODp + (size_t)(BATCH + 1) * N_MOD * D_MODEL + (size_t)modrow(row) * N_MOD * D_MODEL; ld16f(mn, lane, a); ld16f(mn + D_MODEL, lane, b);
        st16h((*Cp_).HB + (size_t)row * D_MODEL, lane, t);
#pragma unroll
        for (int k = 0; k < 16; ++k) t[k] = t[k] * (1.f + b[k]) + a[k];
        st16b((*Cp_).UB + (size_t)row * D_MODEL, lane, t); }
}
DI void combine_ln2(const LAS NaiveCtx* Cp_, long layer, int row_lo, int nrows, int wv_) {
    const float* MODp = (*Cp_).MOD + (size_t)layer * (BATCH + 1) * N_MOD * D_MODEL;
    const float* lg1 = (*Cp_).ln_g + ((size_t)layer * 2 + 1) * D_MODEL; const float* lb1 = (*Cp_).ln_b + ((size_t)layer * 2 + 1) * D_MODEL;
    const bool last = layer == DEPTH - 1;
    const int rpw_ = (nrows + (int)gridDim.x - 1) / (int)gridDim.x, wg_ = opaque_bid(), tid_ = otid(wv_), lane = tid_ & 63, wid_ = tid_ >> 6;
    float g1[16], b1[16]; ld16f(lg1, lane, g1); ld16f(lb1, lane, b1);
    for (int rr_ = wid_, row = row_lo + wg_ * rpw_ + wid_; rr_ < rpw_ && row < row_lo + nrows; rr_ += 16, row += 16) {
        const bool hasB = (rr_ + 8 < rpw_) && (row + 8 < row_lo + nrows); const int rowB = hasB ? row + 8 : row;
        u32x4 oA[4][2], oB[4][2]; float gA[4], gB[4]; f16x8 hA[2], hB[2];
        cmb_issue(Cp_, row, lane, oA, gA, hA); cmb_issue(Cp_, rowB, lane, oB, gB, hB);
        cmb_finish(Cp_, MODp, g1, b1, last, row, lane, true, oA, gA, hA); cmb_finish(Cp_, MODp, g1, b1, last, rowB, lane, hasB, oB, gB, hB);
    }
}
}

namespace tl {
DI u32x4 pack8f(const float (&v)[8]) { u32x4 w; w.x = att::pk2(v[0], v[1]); w.y = att::pk2(v[2], v[3]); w.z = att::pk2(v[4], v[5]); w.w = att::pk2(v[6], v[7]); return w; }
DI void ld8f(const float* p, float (&v)[8]) { const f32x4 a = *(const GAS f32x4*)p, b = *(const GAS f32x4*)(p + 4); v[0] = a[0]; v[1] = a[1]; v[2] = a[2]; v[3] = a[3]; v[4] = b[0]; v[5] = b[1]; v[6] = b[2]; v[7] = b[3]; }
DI void st8f(float* p, const float (&v)[8]) { *(GAS f32x4*)p = (f32x4){v[0], v[1], v[2], v[3]}; *(GAS f32x4*)(p + 4) = (f32x4){v[4], v[5], v[6], v[7]}; }
DI void up8b(const u32x4 w, float (&v)[8]) { v[0] = bf_lo(w.x); v[1] = bf_hi(w.x); v[2] = bf_lo(w.y); v[3] = bf_hi(w.y); v[4] = bf_lo(w.z); v[5] = bf_hi(w.z); v[6] = bf_lo(w.w); v[7] = bf_hi(w.w); }
DI void ld8b(const bf16_t* p, float (&v)[8]) { const u32x4 w = *(const GAS u32x4*)p; v[0] = bf_lo(w.x); v[1] = bf_hi(w.x); v[2] = bf_lo(w.y); v[3] = bf_hi(w.y); v[4] = bf_lo(w.z); v[5] = bf_hi(w.z); v[6] = bf_lo(w.w); v[7] = bf_hi(w.w); }
DI void shifted8(const float* Z, int ldz, int row, int c, bool has_p, bool has_n, const float* mu, float (&o)[8]) {
    float z[8], p[8], n[8], m[8]; ld8f(Z + (size_t)row * ldz + c, z); ld8f(mu + c, m);
    if (has_p) ld8f(Z + (size_t)(row - 1) * ldz + c, p); else {
#pragma unroll
        for (int j = 0; j < 8; ++j) p[j] = 0.f; }
    if (has_n) ld8f(Z + (size_t)(row + 1) * ldz + c, n); else {
#pragma unroll
        for (int j = 0; j < 8; ++j) n[j] = 0.f; }
#pragma unroll
    for (int j = 0; j < 8; ++j) o[j] = z[j] + m[j] * (0.5f * (p[j] + n[j]) - z[j]);
}
DI void shifted8b(const bf16_t* Z, int row, int c, bool has_p, bool has_n, const float* mu, float (&o)[8]) {
    float z[8], p[8], n[8], m[8]; ld8b(Z + (size_t)row * 4608 + c, z); ld8f(mu + c, m);
    if (has_p) ld8b(Z + (size_t)(row - 1) * 4608 + c, p); else {
#pragma unroll
        for (int j = 0; j < 8; ++j) p[j] = 0.f; }
    if (has_n) ld8b(Z + (size_t)(row + 1) * 4608 + c, n); else {
#pragma unroll
        for (int j = 0; j < 8; ++j) n[j] = 0.f; }
#pragma unroll
    for (int j = 0; j < 8; ++j) o[j] = z[j] + m[j] * (0.5f * (p[j] + n[j]) - z[j]);
}
#define TL_SEG(row, t, len) int t, len; if ((row) < NC_) { t = (row) % CTX_LEN; len = CTX_LEN; } else { t = ((row) - NC_) % SEQ; len = SEQ; }

DI void rw_tw(const LAS NaiveCtx* Cp_, long layer, int wv_) {
    const float* mu = (*Cp_).rw_mu + (size_t)(layer / 2) * RW_IN;
    TL_ROWS(row, 0, NT_) { if (lane < 48) { TL_SEG(row, t, len); float zs[8]; shifted8b((*Cp_).ZB, row, 1536 + 8 * lane, t > 0, t < len - 1, mu, zs);
#pragma unroll
            for (int j = 0; j < 8; ++j) zs[j] = lane < 16 ? ftanh(zs[j]) : (lane < 32 ? zs[j] : fsigmoid(zs[j]));
            *(GAS u32x4*)((*Cp_).TW + (size_t)row * 384 + 8 * lane) = pack8f(zs); } }
}

DI void rw_prep(const LAS NaiveCtx* Cp_, long layer, int wv_) {
    const long j2 = layer / 2;
    const float* mu = (*Cp_).rw_mu + (size_t)j2 * RW_IN;
    const float *w0 = (*Cp_).rw_w0 + (size_t)j2 * 1024, *a0 = (*Cp_).rw_a0 + (size_t)j2 * 1024, *kkp = (*Cp_).rw_k_k + (size_t)j2 * 512, *kap = (*Cp_).rw_k_a + (size_t)j2 * 512, *rkp = (*Cp_).rw_r_k + (size_t)j2 * 512;
    TL_ROWS(row, 0, NT_) { TL_SEG(row, t, len); const bool hp = t > 0, hn = t < len - 1; const int c0 = 8 * lane;
        float r[8], k[8], v[8], tmp[8], kk[8], g[8];
        const bf16_t* lo = (*Cp_).LOB + (size_t)row * 2560;
        const u32x4 lwl0 = *(const GAS u32x4*)(lo + c0), lwl1 = *(const GAS u32x4*)(lo + 512 + c0), lal0 = *(const GAS u32x4*)(lo + 1024 + c0), lal1 = *(const GAS u32x4*)(lo + 1536 + c0), lg = *(const GAS u32x4*)(lo + 2048 + c0);
        shifted8b((*Cp_).ZB, row, c0, hp, hn, mu, r); shifted8b((*Cp_).ZB, row, 512 + c0, hp, hn, mu, k); shifted8b((*Cp_).ZB, row, 1024 + c0, hp, hn, mu, v);
        ld8f(kkp + c0, tmp); float ss = 0.f;
#pragma unroll
        for (int j = 0; j < 8; ++j) { kk[j] = k[j] * tmp[j]; ss += kk[j] * kk[j]; }
        ss += __shfl_xor(ss, 1); ss += __shfl_xor(ss, 2); ss += __shfl_xor(ss, 4);
        const float inv = 1.f / sqrtf(fmaxf(ss, 1e-24f));
#pragma unroll
        for (int j = 0; j < 8; ++j) { kk[j] *= inv; tmp[j] = -kk[j]; }
        *(GAS u32x4*)((*Cp_).RBh + (size_t)row * 512 + c0) = pack8f(r); *(GAS u32x4*)((*Cp_).VBh + (size_t)row * 512 + c0) = pack8f(v); *(GAS u32x4*)((*Cp_).NKh + (size_t)row * 512 + c0) = pack8f(tmp);
        *(GAS u32x4*)((*Cp_).GBh + (size_t)row * 512 + c0) = lg; (void)g;
        float ka[8], rk[8], bon = 0.f; ld8f(kap + c0, ka); ld8f(rkp + c0, rk);
#pragma unroll
        for (int d = 0; d < 2; ++d) { float wl[8], al[8], wb[8], ab[8], dec[8], kd[8], bb[8];
            up8b(d ? lwl1 : lwl0, wl); up8b(d ? lal1 : lal0, al); ld8f(w0 + d * 512 + c0, wb); ld8f(a0 + d * 512 + c0, ab);
#pragma unroll
            for (int j = 0; j < 8; ++j) { const float wpre = wb[j] + wl[j]; dec[j] = -1.4426950408889634f * fexp(-fsoftplus(-wpre) - 0.5f);     const float a = fsigmoid(ab[j] + al[j]);
                kd[j] = k[j] * (1.f + (a - 1.f) * ka[j]); bb[j] = kk[j] * a; bon += r[j] * kd[j] * rk[j]; }
            const size_t o = ((size_t)d * NT_ + row) * 512 + c0; st8f((*Cp_).DEC + o, dec); *(GAS u32x4*)((*Cp_).KDh + o) = pack8f(kd); *(GAS u32x4*)((*Cp_).BBh + o) = pack8f(bb); }
        bon += __shfl_xor(bon, 1); bon += __shfl_xor(bon, 2); bon += __shfl_xor(bon, 4);
        if ((lane & 7) == 0) (*Cp_).BON[(size_t)row * 8 + (lane >> 3)] = bon;
    }
}

DI void even_post(const LAS NaiveCtx* Cp_, long layer, int wv_) {
    const long j2 = layer / 2;
    const float *gng = (*Cp_).rw_gn_g + (size_t)j2 * 512, *gnb = (*Cp_).rw_gn_b + (size_t)j2 * 512, *hgn = (*Cp_).hg_norm_g + (size_t)j2 * 512;
    TL_ROWS(row, 0, NT_) { const int c0 = 8 * lane;
        const u32x4 eo0 = *(const GAS u32x4*)((*Cp_).OBh + (size_t)row * 512 + c0), eo1 = *(const GAS u32x4*)((*Cp_).OBh + ((size_t)NT_ + row) * 512 + c0), egz = *(const GAS u32x4*)((*Cp_).ZB + (size_t)row * 4608 + RW_IN + 2048 + c0);
        { float y[8], y1[8], a[8], b[8], v[8], g[8], o[8];
          const u32x4 ry = *(const GAS u32x4*)((*Cp_).YBh + (size_t)row * 512 + c0), ry1 = *(const GAS u32x4*)((*Cp_).YBh + ((size_t)NT_ + row) * 512 + c0), rv = *(const GAS u32x4*)((*Cp_).VBh + (size_t)row * 512 + c0), rg = *(const GAS u32x4*)((*Cp_).GBh + (size_t)row * 512 + c0);
          const float bon = ((const GAS float*)(*Cp_).BON)[(size_t)row * 8 + (lane >> 3)]; ld8f(gng + c0, a); ld8f(gnb + c0, b);
          up8b(ry, y); up8b(ry1, y1);
          float s = 0.f;
#pragma unroll
          for (int j = 0; j < 8; ++j) { y[j] += y1[j]; s += y[j]; }
          s += __shfl_xor(s, 1); s += __shfl_xor(s, 2); s += __shfl_xor(s, 4); const float mean = s * (1.f / 64.f); s = 0.f;
#pragma unroll
          for (int j = 0; j < 8; ++j) { y[j] -= mean; s += y[j] * y[j]; }
          s += __shfl_xor(s, 1); s += __shfl_xor(s, 2); s += __shfl_xor(s, 4); const float rs = 1.f / sqrtf(s * (1.f / 64.f) + 64e-5f);
          up8b(rv, v); up8b(rg, g);
#pragma unroll
          for (int j = 0; j < 8; ++j) o[j] = (y[j] * rs * a[j] + b[j] + bon * v[j]) * g[j];
          *(GAS u32x4*)((*Cp_).YCATB + (size_t)row * 1024 + c0) = pack8f(o); }
        { float o[8], t0[8], a[8], gz[8]; up8b(eo0, o); up8b(eo1, t0);
#pragma unroll
          for (int j = 0; j < 8; ++j) o[j] += t0[j];
          float s = 0.f;
#pragma unroll
          for (int j = 0; j < 8; ++j) s += o[j] * o[j];
          s += __shfl_xor(s, 1); s += __shfl_xor(s, 2); s += __shfl_xor(s, 4); s += __shfl_xor(s, 8); const float rs = 1.f / sqrtf(s * (1.f / 128.f) + 1e-6f);
          ld8f(hgn + c0, a); up8b(egz, gz);
#pragma unroll
          for (int j = 0; j < 8; ++j) o[j] = o[j] * rs * a[j] * fsilu(gz[j]);
          *(GAS u32x4*)((*Cp_).YCATB + (size_t)row * 1024 + 512 + c0) = pack8f(o); }
    }
}

DI void mla_prep(const LAS NaiveCtx* Cp_, long layer, int wv_) {
    const long j2 = layer / 2; const float* qng = (*Cp_).mla_q_norm_g + (size_t)j2 * MLA_QR; const float* kvng = (*Cp_).mla_kv_norm_g + (size_t)j2 * MLA_KVR;
    TL_ROWS(row, 0, NT_) { const float* z = (*Cp_).Z + (size_t)row * 512;
        const f32x4 q = *(const GAS f32x4*)(z + 4 * lane); const float kv0 = z[256 + 2 * lane], kv1 = z[256 + 2 * lane + 1]; const float x = lane < 32 ? z[384 + lane] : 0.f;
        const float rsq = 1.f / sqrtf(wsum(q[0] * q[0] + q[1] * q[1] + q[2] * q[2] + q[3] * q[3]) * (1.f / MLA_QR) + 1e-6f);
        const f32x4 gq = *(const GAS f32x4*)(qng + 4 * lane);
        *(GAS u32x2*)((*Cp_).QNB + (size_t)row * 256 + 4 * lane) = (u32x2){att::pk2(q[0] * rsq * gq[0], q[1] * rsq * gq[1]), att::pk2(q[2] * rsq * gq[2], q[3] * rsq * gq[3])};
        const float rskv = 1.f / sqrtf(wsum(kv0 * kv0 + kv1 * kv1) * (1.f / MLA_KVR) + 1e-6f);
        *(GAS unsigned*)((*Cp_).KVNB + (size_t)row * 256 + 2 * lane) = att::pk2(kv0 * rskv * kvng[2 * lane], kv1 * rskv * kvng[2 * lane + 1]);
        *(GAS unsigned*)((*Cp_).KVNB + (size_t)row * 256 + 128 + 2 * lane) = 0u;
        const float partner = __shfl_xor(x, 8); float outv = x; int b, t;
        if (row >= NC_) { const int s = (row - NC_) % SEQ; b = (row - NC_) / SEQ; t = CTX_LEN + s; const float pos = (float)((lane & 16) ? (s % GRID_W) : (s / GRID_W));
            const float ang = pos * exp2f(-(float)(lane & 7) * 1.6609640474436812f); const float cs = cosf(ang), sn = sinf(ang); outv = (lane & 8) ? x * cs + partner * sn : x * cs - partner * sn; }
        else { b = row / CTX_LEN; t = row % CTX_LEN; }
        (void)b; (void)t; if (lane < 32) (*Cp_).KPEB[(size_t)row * 32 + lane] = f2bf(outv);
    }
}
DI void rope_table(const LAS NaiveCtx* Cp_, int wv_) {
    GRID_STRIDE_WAVES(i, (long)SEQ * 16) { const int s = (int)(i >> 4), q = (int)(i & 15); const float pos = (float)((q & 8) ? (s % GRID_W) : (s / GRID_W)); const float ang = pos * exp2f(-(float)(q & 7) * 1.6609640474436812f);
        (*Cp_).ROPE[(size_t)s * 32 + (q & 8) * 2 + (q & 7)] = cosf(ang); (*Cp_).ROPE[(size_t)s * 32 + (q & 8) * 2 + 8 + (q & 7)] = sinf(ang); }
}
DI void rope_q(const LAS NaiveCtx* Cp_, int wv_) {
    GRID_STRIDE_WAVES(i, (long)NL_ * MLA_HEADS) { const int h = (int)(i % MLA_HEADS); const long lr = i / MLA_HEADS; const int s = (int)(lr % SEQ);
        bf16_t* p = (*Cp_).QB + (size_t)(NC_ + lr) * (MLA_HEADS * 96) + h * 96 + 64; const float* tab = (*Cp_).ROPE + (size_t)s * 32;
        float r1[8], r2[8], c1[8], c2[8], cr[8], sr[8], cc[8], sc[8], o[8];
        ld8b(p, r1); ld8b(p + 8, r2); ld8b(p + 16, c1); ld8b(p + 24, c2); ld8f(tab, cr); ld8f(tab + 8, sr); ld8f(tab + 16, cc); ld8f(tab + 24, sc);
#pragma unroll
        for (int j = 0; j < 8; ++j) o[j] = r1[j] * cr[j] - r2[j] * sr[j];
        *(GAS u32x4*)p = pack8f(o);
#pragma unroll
        for (int j = 0; j < 8; ++j) o[j] = r2[j] * cr[j] + r1[j] * sr[j];
        *(GAS u32x4*)(p + 8) = pack8f(o);
#pragma unroll
        for (int j = 0; j < 8; ++j) o[j] = c1[j] * cc[j] - c2[j] * sc[j];
        *(GAS u32x4*)(p + 16) = pack8f(o);
#pragma unroll
        for (int j = 0; j < 8; ++j) o[j] = c2[j] * cc[j] + c1[j] * sc[j];
        *(GAS u32x4*)(p + 24) = pack8f(o); }
}
DI void lora_weights(const LAS NaiveCtx* Cp_, int wv_) {
    GRID_STRIDE_WAVES(i, (long)N_EVEN * 2560 * 384) { const int k = (int)(i % 384); const long t = i / 384; const int n = (int)(t % 2560), j = (int)(t / 2560); const int blk = n >> 9, c = n & 511; float v = 0.f;
        if (blk < 2) { if (k >= blk * 64 && k < blk * 64 + 64) v = (*Cp_).rw_w2[(((size_t)j * 2 + blk) * 64 + (k - blk * 64)) * 512 + c]; }
        else if (blk < 4) { const int d = blk - 2; if (k >= 128 + d * 64 && k < 128 + d * 64 + 64) v = (*Cp_).rw_a2[(((size_t)j * 2 + d) * 64 + (k - 128 - d * 64)) * 512 + c]; }
        else { if (k >= 256) v = (*Cp_).rw_g2[((size_t)j * 128 + (k - 256)) * 512 + c]; }
        (*Cp_).Wlora[i] = f2bf(v); }
}
}

namespace scan {
#ifndef SC_L32_PERM
#define SC_L32_PERM 1
#endif
#ifndef SC_L16_PERM
#define SC_L16_PERM 1
#endif
#ifndef SC_L8_DPP
#define SC_L8_DPP 1
#endif
#define SC_DPP(x, CTRL) __builtin_bit_cast(float, __builtin_amdgcn_update_dpp(0, __builtin_bit_cast(int, (x)), (CTRL), 0xF, 0xF, true))
DI float swap32_sum(float a, float b) { asm volatile("s_nop 1\n\tv_permlane32_swap_b32 %0, %1" : "+v"(a), "+v"(b)); return a + b; }
DI float swap16_sum(float a, float b) { asm volatile("s_nop 1\n\tv_permlane16_swap_b32 %0, %1" : "+v"(a), "+v"(b)); return a + b; }
DI float reduce8(const float (&x)[8], int lane) {
    float y0, y1, y2, y3, z0, z1, w;
#if SC_L32_PERM
    y0 = swap32_sum(x[0], x[4]); y1 = swap32_sum(x[1], x[5]); y2 = swap32_sum(x[2], x[6]); y3 = swap32_sum(x[3], x[7]);
#else
    { const bool up = (lane & 32) != 0;
      y0 = (up ? x[4] : x[0]) + __shfl_xor(up ? x[0] : x[4], 32); y1 = (up ? x[5] : x[1]) + __shfl_xor(up ? x[1] : x[5], 32);
      y2 = (up ? x[6] : x[2]) + __shfl_xor(up ? x[2] : x[6], 32); y3 = (up ? x[7] : x[3]) + __shfl_xor(up ? x[3] : x[7], 32); }
#endif
#if SC_L16_PERM
    z0 = swap16_sum(y0, y2); z1 = swap16_sum(y1, y3);
#else
    { const bool up = (lane & 16) != 0; z0 = (up ? y2 : y0) + __shfl_xor(up ? y0 : y2, 16); z1 = (up ? y3 : y1) + __shfl_xor(up ? y1 : y3, 16); }
#endif
    { const bool b3 = (lane & 8) != 0; const float keep = b3 ? z1 : z0, send = b3 ? z0 : z1;
#if SC_L8_DPP
      w = keep + SC_DPP(send, 0x128);
      w += SC_DPP(w, 0x141);
      w += SC_DPP(w, 0x4E);
      w += SC_DPP(w, 0xB1);
#else
      w = keep + __shfl_xor(send, 8); w += __shfl_xor(w, 4); w += __shfl_xor(w, 2); w += __shfl_xor(w, 1);
#endif
    }
    return w;
}
constexpr int TB = 32, STEP_F = 384, BUF_F = TB * STEP_F;

DI void rwkv_scan(const LAS NaiveCtx* Cp_, LAS unsigned char* lds, int wv_) {
    const int tid = otid(wv_), lane = tid & 63, wid = tid >> 6;
    LAS float* ldsf = (LAS float*)lds; LAS float* ybuf = ldsf + 2 * BUF_F;
    for (int chain = opaque_bid(); chain < 2 * BATCH * RW_HEADS; chain += gridDim.x) {
        const int d = chain / (BATCH * RW_HEADS), b = (chain / RW_HEADS) % BATCH, h = chain % RW_HEADS;
        const float* pA = (*Cp_).NKK + h * 64; const float* pW = (*Cp_).DEC + (size_t)d * NT_ * 512 + h * 64; const float* pB = (*Cp_).BB + (size_t)d * NT_ * 512 + h * 64;
        const float* pK = (*Cp_).KD + (size_t)d * NT_ * 512 + h * 64; const float* pR = (*Cp_).R + h * 64; const float* pV = (*Cp_).V + h * 64;
        float* pY = (*Cp_).Y + (size_t)d * NT_ * 512 + h * 64;
        float S[8];
#pragma unroll
        for (int j = 0; j < 8; ++j) S[j] = 0.f;
        f32x4 st[6];
#define SC_LOAD(T0) do { _Pragma("unroll") for (int q = 0; q < 6; ++q) { const int idx = tid + 512 * q, i = idx / 96, rem = idx % 96, arr = rem >> 4, part = rem & 15; \
            const size_t row = (size_t)tokrow(b, scan_pos(d, (T0) + i)); const float* src = arr == 0 ? pA : arr == 1 ? pW : arr == 2 ? pB : arr == 3 ? pK : arr == 4 ? pR : pV; \
            st[q] = *(const f32x4*)(src + row * 512 + part * 4); } } while (0)
#define SC_STORE(BUFI) do { _Pragma("unroll") for (int q = 0; q < 6; ++q) { const int idx = tid + 512 * q, i = idx / 96, rem = idx % 96; *(LAS f32x4*)(ldsf + (BUFI) * BUF_F + i * STEP_F + rem * 4) = st[q]; } } while (0)
        SC_LOAD(0); SC_STORE(0);
        __syncthreads();
        constexpr int NB = TT_ / TB;
        for (int blk = 0; blk < NB; ++blk) {
            if (blk + 1 < NB) SC_LOAD((blk + 1) * TB);
            const LAS float* buf = ldsf + (blk & 1) * BUF_F;
#pragma unroll 2
            for (int i = 0; i < TB; ++i) { const LAS float* sp = buf + i * STEP_F;
                const float a = sp[lane], w = sp[64 + lane], bb = sp[128 + lane], kd = sp[192 + lane], r = sp[256 + lane];
                const f32x4 v0 = *(const LAS f32x4*)(sp + 320 + 8 * wid), v1 = *(const LAS f32x4*)(sp + 324 + 8 * wid);
                float p[8];
#pragma unroll
                for (int j = 0; j < 8; ++j) p[j] = S[j] * a;
                const float wsa = reduce8(p, lane);
#pragma unroll
                for (int j = 0; j < 8; ++j) { const float sa = __builtin_bit_cast(float, __builtin_amdgcn_readlane(__builtin_bit_cast(int, wsa), 8 * j)); const float vv = j < 4 ? v0[j & 3] : v1[j & 3];
                    S[j] = S[j] * w + sa * bb + vv * kd; p[j] = S[j] * r; }
                const float wy = reduce8(p, lane);
                if ((lane & 7) == 0) ybuf[i * 64 + 8 * wid + (lane >> 3)] = wy; }
            __syncthreads();
            { const int i = tid >> 4, v4 = (tid & 15) * 4; const size_t row = (size_t)tokrow(b, scan_pos(d, blk * TB + i)); *(f32x4*)(pY + row * 512 + v4) = *(const LAS f32x4*)(ybuf + i * 64 + v4); }
            if (blk + 1 < NB) SC_STORE((blk + 1) & 1);
            __syncthreads();
        }
#undef SC_LOAD
#undef SC_STORE
    }
}
}

namespace hg {
typedef short s16x4 __attribute__((ext_vector_type(4)));
constexpr int RS = 272, RS2 = 40;
constexpr int OFF_QT = 0, OFF_KT = OFF_QT + 16 * RS, OFF_KH = OFF_KT + 16 * RS, OFF_VT = OFF_KH + 128 * RS2, OFF_ST = OFF_VT + 64 * RS2, OFF_P = OFF_ST + 2 * 64 * RS, OFF_GS = OFF_P + 512, OFF_SC = OFF_GS + 2048, OFF_V32 = OFF_SC + 4 * 16 * 80, HG_LDS = OFF_V32 + 64 * 80;
#define HG_MFMA16(a, b, c) __builtin_amdgcn_mfma_f32_16x16x16bf16_1k((a), (b), (c), 0, 0, 0)
#define HG_MFMA32(a, b, c) __builtin_amdgcn_mfma_f32_16x16x32_bf16((a), (b), (c), 0, 0, 0)
DI unsigned short bfr(float x) { return (unsigned short)(att::pk2(x, 0.f) & 0xffffu); }

DI void hgrn_scan(const LAS NaiveCtx* Cp_, LAS unsigned char* lds, long layer, int wv_) {
    const int tid = otid(wv_), lane = tid & 63, wid = tid >> 6, l15 = lane & 15, g = lane >> 4;
    const int k = tid & 127, tq = tid >> 7;
    LAS float* gsum = (LAS float*)(lds + OFF_GS); LAS float* p15 = (LAS float*)(lds + OFF_P);
    for (int unit = opaque_bid(); unit < 2 * BATCH * HG_HEADS * 2; unit += gridDim.x) {
        const int vh = unit & 1, h = (unit >> 1) % HG_HEADS, b = (unit / (2 * HG_HEADS)) % BATCH, d = unit / (2 * HG_HEADS * BATCH);
        const GAS bf16_t* pF = (const GAS bf16_t*)((*Cp_).ZB + RW_IN + 512 + d * 512 + h * 128 + k); const GAS bf16_t* pQ = (const GAS bf16_t*)((*Cp_).ZB + RW_IN + h * 128 + k);
        const GAS bf16_t* pV = (const GAS bf16_t*)((*Cp_).ZB + RW_IN + 1536 + h * 128 + vh * 64 + (tid & 15) * 4);
        float lower;
        { const long j2 = layer / 2; float mx = -1e30f;
#pragma unroll
          for (int qq = 0; qq < N_EVEN; ++qq) mx = fmaxf(mx, (*Cp_).hg_lb[((size_t)qq * 2 + d) * 512 + h * 128 + k]);
          float den = 0.f, num = 0.f;
#pragma unroll
          for (int qq = 0; qq < N_EVEN; ++qq) { const float e = fexp((*Cp_).hg_lb[((size_t)qq * 2 + d) * 512 + h * 128 + k] - mx); den += e; if (qq >= 1 && qq <= j2) num += e; }
          lower = num / den; }
        GAS bf16_t* pO = (GAS bf16_t*)((*Cp_).OBh + (size_t)d * NT_ * 512 + h * 128 + vh * 64);
        f32x4 acc[4];
#pragma unroll
        for (int n = 0; n < 4; ++n) acc[n] = (f32x4){0.f, 0.f, 0.f, 0.f};
        for (int i = tid; i < 64 * RS / 4; i += PB_THREADS) ((LAS unsigned*)(lds + OFF_ST))[i] = 0u;
        for (int i = tid; i < (4 * 16 * 80) / 4; i += PB_THREADS) ((LAS unsigned*)(lds + OFF_SC))[i] = 0u;
        unsigned fX[4][4], qX[4][4]; u32x2 vX[4];
        vX[0] = (u32x2){0u, 0u}; vX[1] = vX[0]; vX[2] = vX[0]; vX[3] = vX[0];
#define HG_ROWBASE(C0, rb) long rb; { const int i0_ = (C0) * 16; if (i0_ < CTX_LEN) rb = (long)b * CTX_LEN + (d ? CTX_LEN - 1 - i0_ : i0_); else rb = (long)NC_ + (long)b * SEQ + (d ? SEQ - 1 - (i0_ - CTX_LEN) : (i0_ - CTX_LEN)); }
#define HG_LOAD(C0, S) do { HG_ROWBASE(C0, rb_) const long sg_ = d ? -1 : 1; _Pragma("unroll") for (int i = 0; i < 4; ++i) { const long row = rb_ + sg_ * (4 * tq + i); fX[S][i] = pF[row * 4608]; qX[S][i] = pQ[row * 4608]; } \
            if (tid < 256) { const long row = rb_ + sg_ * (tid >> 4); vX[S] = *(const GAS u32x2*)(pV + row * 4608); } } while (0)
        HG_LOAD(0, 0); HG_LOAD(1, 1); HG_LOAD(2, 2); HG_LOAD(3, 3);
        constexpr int NCH = TT_ / 16;
        static_assert(NCH % 4 == 0, "chunks per trip");
        for (int c4 = 0; c4 < NCH; c4 += 4) {
            { const int c = c4 + 0;

            float f[4], kin[4], q[4], cum[4];
#pragma unroll
            for (int i = 0; i < 4; ++i) { const float sg = fsigmoid(bf_lo(fX[0][i])); f[i] = fmaxf(lower + (1.f - lower) * sg, 1e-30f); kin[i] = (1.f - lower) * (1.f - sg); q[i] = fsilu(bf_lo(qX[0][i])); }
            const f32x4 val = (f32x4){bf_lo(vX[0].x), bf_hi(vX[0].x), bf_lo(vX[0].y), bf_hi(vX[0].y)};
            cum[0] = flog2(f[0]); cum[1] = cum[0] + flog2(f[1]); cum[2] = cum[1] + flog2(f[2]); cum[3] = cum[2] + flog2(f[3]);
            gsum[tq * 128 + k] = cum[3];
            lds_barrier();
            { const float g0 = gsum[k], g1 = gsum[128 + k], g2 = gsum[256 + k], g3 = gsum[384 + k];
              const float base = tq == 0 ? 0.f : tq == 1 ? g0 : tq == 2 ? g0 + g1 : g0 + g1 + g2, tot = g0 + g1 + g2 + g3;
              float kh[4];
#pragma unroll
              for (int i = 0; i < 4; ++i) { const float cu = base + cum[i]; const int t = 4 * tq + i;
                  *(LAS unsigned short*)(lds + OFF_QT + t * RS + 2 * k) = bfr(q[i] * fexp2(cu));
                  *(LAS unsigned short*)(lds + OFF_KT + t * RS + 2 * k) = bfr(kin[i] * fexp2(fminf(-cu, 115.f)));
                  kh[i] = kin[i] * fexp2(tot - cu); }
              *(LAS u32x2*)(lds + OFF_KH + k * RS2 + 8 * tq) = (u32x2){att::pk2(kh[0], kh[1]), att::pk2(kh[2], kh[3])};
              if (tq == 0) p15[k] = fexp2(tot);
              if (tid < 256) { const int t = tid >> 4, v4 = (tid & 15) * 4;
#pragma unroll
                  for (int j = 0; j < 4; ++j) { const unsigned short hv = bfr(val[j]); *(LAS unsigned short*)(lds + OFF_VT + (v4 + j) * RS2 + 2 * t) = hv; } } }
            if (c + 4 < NCH) HG_LOAD(c + 4, 0);
            lds_barrier();
            const LAS unsigned char* stc = lds + OFF_ST + (c & 1) * 64 * RS; LAS unsigned char* stn = lds + OFF_ST + ((c + 1) & 1) * 64 * RS;
            if (wid < 4) {
                f32x4 sc = (f32x4){0.f, 0.f, 0.f, 0.f};
#pragma unroll
                for (int kk = 0; kk < 4; ++kk) { const bf16x8 a = *(const LAS bf16x8*)(lds + OFF_KT + l15 * RS + (32 * kk + 8 * g) * 2), bq = *(const LAS bf16x8*)(lds + OFF_QT + l15 * RS + (32 * kk + 8 * g) * 2); sc = HG_MFMA32(a, bq, sc); }
#pragma unroll
                for (int r = 0; r < 4; ++r) if (4 * g + r > l15) sc[r] = 0.f;
                const u32x2 pk = (u32x2){att::pk2(sc[0], sc[1]), att::pk2(sc[2], sc[3])};
                f32x4 o = (f32x4){0.f, 0.f, 0.f, 0.f};
                { LAS unsigned char* scw = lds + OFF_SC + wid * 16 * 80;
                  *(LAS u32x2*)(scw + l15 * 80 + 8 * g) = pk;
                  const bf16x8 sb = *(const LAS bf16x8*)(scw + l15 * 80 + 16 * g); bf16x8 va = (bf16x8){0, 0, 0, 0, 0, 0, 0, 0};
                  if (g < 2) { const LAS unsigned char* vp_ = lds + OFF_VT + (16 * wid + l15) * RS2 + 16 * g; const s16x4 lo_ = *(const LAS s16x4*)vp_, hi_ = *(const LAS s16x4*)(vp_ + 8); va = __builtin_shufflevector(lo_, hi_, 0, 1, 2, 3, 4, 5, 6, 7); }
                  o = HG_MFMA32(va, sb, o); }
#pragma unroll
                for (int kk = 0; kk < 4; ++kk) { const bf16x8 a = *(const LAS bf16x8*)(stc + (16 * wid + l15) * RS + (32 * kk + 8 * g) * 2), bq = *(const LAS bf16x8*)(lds + OFF_QT + l15 * RS + (32 * kk + 8 * g) * 2); o = HG_MFMA32(a, bq, o); }
                { HG_ROWBASE(c, rbo_) const long row = rbo_ + (d ? -l15 : l15); *(GAS u32x2*)(pO + row * 512 + 16 * wid + 4 * g) = (u32x2){att::pk2(o[0], o[1]), att::pk2(o[2], o[3])}; }
            }
            { const f32x4 pd = *(const LAS f32x4*)(p15 + 16 * wid + 4 * g); const s16x4 ka = *(const LAS s16x4*)(lds + OFF_KH + (16 * wid + l15) * RS2 + 8 * g);
#pragma unroll
              for (int n = 0; n < 4; ++n) { const s16x4 vb = *(const LAS s16x4*)(lds + OFF_VT + (16 * n + l15) * RS2 + 8 * g);
                  acc[n] = HG_MFMA16(ka, vb, acc[n] * pd);
                  *(LAS u32x2*)(stn + (16 * n + l15) * RS + (16 * wid + 4 * g) * 2) = (u32x2){att::pk2(acc[n][0], acc[n][1]), att::pk2(acc[n][2], acc[n][3])}; } }
                    }
            { const int c = c4 + 1;

            float f[4], kin[4], q[4], cum[4];
#pragma unroll
            for (int i = 0; i < 4; ++i) { const float sg = fsigmoid(bf_lo(fX[1][i])); f[i] = fmaxf(lower + (1.f - lower) * sg, 1e-30f); kin[i] = (1.f - lower) * (1.f - sg); q[i] = fsilu(bf_lo(qX[1][i])); }
            const f32x4 val = (f32x4){bf_lo(vX[1].x), bf_hi(vX[1].x), bf_lo(vX[1].y), bf_hi(vX[1].y)};
            cum[0] = flog2(f[0]); cum[1] = cum[0] + flog2(f[1]); cum[2] = cum[1] + flog2(f[2]); cum[3] = cum[2] + flog2(f[3]);
            gsum[tq * 128 + k] = cum[3];
            lds_barrier();
            { const float g0 = gsum[k], g1 = gsum[128 + k], g2 = gsum[256 + k], g3 = gsum[384 + k];
              const float base = tq == 0 ? 0.f : tq == 1 ? g0 : tq == 2 ? g0 + g1 : g0 + g1 + g2, tot = g0 + g1 + g2 + g3;
              float kh[4];
#pragma unroll
              for (int i = 0; i < 4; ++i) { const float cu = base + cum[i]; const int t = 4 * tq + i;
                  *(LAS unsigned short*)(lds + OFF_QT + t * RS + 2 * k) = bfr(q[i] * fexp2(cu));
                  *(LAS unsigned short*)(lds + OFF_KT + t * RS + 2 * k) = bfr(kin[i] * fexp2(fminf(-cu, 115.f)));
                  kh[i] = kin[i] * fexp2(tot - cu); }
              *(LAS u32x2*)(lds + OFF_KH + k * RS2 + 8 * tq) = (u32x2){att::pk2(kh[0], kh[1]), att::pk2(kh[2], kh[3])};
              if (tq == 0) p15[k] = fexp2(tot);
              if (tid < 256) { const int t = tid >> 4, v4 = (tid & 15) * 4;
#pragma unroll
                  for (int j = 0; j < 4; ++j) { const unsigned short hv = bfr(val[j]); *(LAS unsigned short*)(lds + OFF_VT + (v4 + j) * RS2 + 2 * t) = hv; } } }
            if (c + 4 < NCH) HG_LOAD(c + 4, 1);
            lds_barrier();
            const LAS unsigned char* stc = lds + OFF_ST + (c & 1) * 64 * RS; LAS unsigned char* stn = lds + OFF_ST + ((c + 1) & 1) * 64 * RS;
            if (wid < 4) {
                f32x4 sc = (f32x4){0.f, 0.f, 0.f, 0.f};
#pragma unroll
                for (int kk = 0; kk < 4; ++kk) { const bf16x8 a = *(const LAS bf16x8*)(lds + OFF_KT + l15 * RS + (32 * kk + 8 * g) * 2), bq = *(const LAS bf16x8*)(lds + OFF_QT + l15 * RS + (32 * kk + 8 * g) * 2); sc = HG_MFMA32(a, bq, sc); }
#pragma unroll
                for (int r = 0; r < 4; ++r) if (4 * g + r > l15) sc[r] = 0.f;
                const u32x2 pk = (u32x2){att::pk2(sc[0], sc[1]), att::pk2(sc[2], sc[3])};
                f32x4 o = (f32x4){0.f, 0.f, 0.f, 0.f};
                { LAS unsigned char* scw = lds + OFF_SC + wid * 16 * 80;
                  *(LAS u32x2*)(scw + l15 * 80 + 8 * g) = pk;
                  const bf16x8 sb = *(const LAS bf16x8*)(scw + l15 * 80 + 16 * g); bf16x8 va = (bf16x8){0, 0, 0, 0, 0, 0, 0, 0};
                  if (g < 2) { const LAS unsigned char* vp_ = lds + OFF_VT + (16 * wid + l15) * RS2 + 16 * g; const s16x4 lo_ = *(const LAS s16x4*)vp_, hi_ = *(const LAS s16x4*)(vp_ + 8); va = __builtin_shufflevector(lo_, hi_, 0, 1, 2, 3, 4, 5, 6, 7); }
                  o = HG_MFMA32(va, sb, o); }
#pragma unroll
                for (int kk = 0; kk < 4; ++kk) { const bf16x8 a = *(const LAS bf16x8*)(stc + (16 * wid + l15) * RS + (32 * kk + 8 * g) * 2), bq = *(const LAS bf16x8*)(lds + OFF_QT + l15 * RS + (32 * kk + 8 * g) * 2); o = HG_MFMA32(a, bq, o); }
                { HG_ROWBASE(c, rbo_) const long row = rbo_ + (d ? -l15 : l15); *(GAS u32x2*)(pO + row * 512 + 16 * wid + 4 * g) = (u32x2){att::pk2(o[0], o[1]), att::pk2(o[2], o[3])}; }
            }
            { const f32x4 pd = *(const LAS f32x4*)(p15 + 16 * wid + 4 * g); const s16x4 ka = *(const LAS s16x4*)(lds + OFF_KH + (16 * wid + l15) * RS2 + 8 * g);
#pragma unroll
              for (int n = 0; n < 4; ++n) { const s16x4 vb = *(const LAS s16x4*)(lds + OFF_VT + (16 * n + l15) * RS2 + 8 * g);
                  acc[n] = HG_MFMA16(ka, vb, acc[n] * pd);
                  *(LAS u32x2*)(stn + (16 * n + l15) * RS + (16 * wid + 4 * g) * 2) = (u32x2){att::pk2(acc[n][0], acc[n][1]), att::pk2(acc[n][2], acc[n][3])}; } }
                    }
            { const int c = c4 + 2;

            float f[4], kin[4], q[4], cum[4];
#pragma unroll
            for (int i = 0; i < 4; ++i) { const float sg = fsigmoid(bf_lo(fX[2][i])); f[i] = fmaxf(lower + (1.f - lower) * sg, 1e-30f); kin[i] = (1.f - lower) * (1.f - sg); q[i] = fsilu(bf_lo(qX[2][i])); }
            const f32x4 val = (f32x4){bf_lo(vX[2].x), bf_hi(vX[2].x), bf_lo(vX[2].y), bf_hi(vX[2].y)};
            cum[0] = flog2(f[0]); cum[1] = cum[0] + flog2(f[1]); cum[2] = cum[1] + flog2(f[2]); cum[3] = cum[2] + flog2(f[3]);
            gsum[tq * 128 + k] = cum[3];
            lds_barrier();
            { const float g0 = gsum[k], g1 = gsum[128 + k], g2 = gsum[256 + k], g3 = gsum[384 + k];
              const float base = tq == 0 ? 0.f : tq == 1 ? g0 : tq == 2 ? g0 + g1 : g0 + g1 + g2, tot = g0 + g1 + g2 + g3;
              float kh[4];
#pragma unroll
              for (int i = 0; i < 4; ++i) { const float cu = base + cum[i]; const int t = 4 * tq + i;
                  *(LAS unsigned short*)(lds + OFF_QT + t * RS + 2 * k) = bfr(q[i] * fexp2(cu));
                  *(LAS unsigned short*)(lds + OFF_KT + t * RS + 2 * k) = bfr(kin[i] * fexp2(fminf(-cu, 115.f)));
                  kh[i] = kin[i] * fexp2(tot - cu); }
              *(LAS u32x2*)(lds + OFF_KH + k * RS2 + 8 * tq) = (u32x2){att::pk2(kh[0], kh[1]), att::pk2(kh[2], kh[3])};
              if (tq == 0) p15[k] = fexp2(tot);
              if (tid < 256) { const int t = tid >> 4, v4 = (tid & 15) * 4;
#pragma unroll
                  for (int j = 0; j < 4; ++j) { const unsigned short hv = bfr(val[j]); *(LAS unsigned short*)(lds + OFF_VT + (v4 + j) * RS2 + 2 * t) = hv; } } }
            if (c + 4 < NCH) HG_LOAD(c + 4, 2);
            lds_barrier();
            const LAS unsigned char* stc = lds + OFF_ST + (c & 1) * 64 * RS; LAS unsigned char* stn = lds + OFF_ST + ((c + 1) & 1) * 64 * RS;
            if (wid < 4) {
                f32x4 sc = (f32x4){0.f, 0.f, 0.f, 0.f};
#pragma unroll
                for (int kk = 0; kk < 4; ++kk) { const bf16x8 a = *(const LAS bf16x8*)(lds + OFF_KT + l15 * RS + (32 * kk + 8 * g) * 2), bq = *(const LAS bf16x8*)(lds + OFF_QT + l15 * RS + (32 * kk + 8 * g) * 2); sc = HG_MFMA32(a, bq, sc); }
#pragma unroll
                for (int r = 0; r < 4; ++r) if (4 * g + r > l15) sc[r] = 0.f;
                const u32x2 pk = (u32x2){att::pk2(sc[0], sc[1]), att::pk2(sc[2], sc[3])};
                f32x4 o = (f32x4){0.f, 0.f, 0.f, 0.f};
                { LAS unsigned char* scw = lds + OFF_SC + wid * 16 * 80;
                  *(LAS u32x2*)(scw + l15 * 80 + 8 * g) = pk;
                  const bf16x8 sb = *(const LAS bf16x8*)(scw + l15 * 80 + 16 * g); bf16x8 va = (bf16x8){0, 0, 0, 0, 0, 0, 0, 0};
                  if (g < 2) { const LAS unsigned char* vp_ = lds + OFF_VT + (16 * wid + l15) * RS2 + 16 * g; const s16x4 lo_ = *(const LAS s16x4*)vp_, hi_ = *(const LAS s16x4*)(vp_ + 8); va = __builtin_shufflevector(lo_, hi_, 0, 1, 2, 3, 4, 5, 6, 7); }
                  o = HG_MFMA32(va, sb, o); }
#pragma unroll
                for (int kk = 0; kk < 4; ++kk) { const bf16x8 a = *(const LAS bf16x8*)(stc + (16 * wid + l15) * RS + (32 * kk + 8 * g) * 2), bq = *(const LAS bf16x8*)(lds + OFF_QT + l15 * RS + (32 * kk + 8 * g) * 2); o = HG_MFMA32(a, bq, o); }
                { HG_ROWBASE(c, rbo_) const long row = rbo_ + (d ? -l15 : l15); *(GAS u32x2*)(pO + row * 512 + 16 * wid + 4 * g) = (u32x2){att::pk2(o[0], o[1]), att::pk2(o[2], o[3])}; }
            }
            { const f32x4 pd = *(const LAS f32x4*)(p15 + 16 * wid + 4 * g); const s16x4 ka = *(const LAS s16x4*)(lds + OFF_KH + (16 * wid + l15) * RS2 + 8 * g);
#pragma unroll
              for (int n = 0; n < 4; ++n) { const s16x4 vb = *(const LAS s16x4*)(lds + OFF_VT + (16 * n + l15) * RS2 + 8 * g);
                  acc[n] = HG_MFMA16(ka, vb, acc[n] * pd);
                  *(LAS u32x2*)(stn + (16 * n + l15) * RS + (16 * wid + 4 * g) * 2) = (u32x2){att::pk2(acc[n][0], acc[n][1]), att::pk2(acc[n][2], acc[n][3])}; } }
                    }
            { const int c = c4 + 3;

            float f[4], kin[4], q[4], cum[4];
#pragma unroll
            for (int i = 0; i < 4; ++i) { const float sg = fsigmoid(bf_lo(fX[3][i])); f[i] = fmaxf(lower + (1.f - lower) * sg, 1e-30f); kin[i] = (1.f - lower) * (1.f - sg); q[i] = fsilu(bf_lo(qX[3][i])); }
            const f32x4 val = (f32x4){bf_lo(vX[3].x), bf_hi(vX[3].x), bf_lo(vX[3].y), bf_hi(vX[3].y)};
            cum[0] = flog2(f[0]); cum[1] = cum[0] + flog2(f[1]); cum[2] = cum[1] + flog2(f[2]); cum[3] = cum[2] + flog2(f[3]);
            gsum[tq * 128 + k] = cum[3];
            lds_barrier();
            { const float g0 = gsum[k], g1 = gsum[128 + k], g2 = gsum[256 + k], g3 = gsum[384 + k];
              const float base = tq == 0 ? 0.f : tq == 1 ? g0 : tq == 2 ? g0 + g1 : g0 + g1 + g2, tot = g0 + g1 + g2 + g3;
              float kh[4];
#pragma unroll
              for (int i = 0; i < 4; ++i) { const float cu = base + cum[i]; const int t = 4 * tq + i;
                  *(LAS unsigned short*)(lds + OFF_QT + t * RS + 2 * k) = bfr(q[i] * fexp2(cu));
                  *(LAS unsigned short*)(lds + OFF_KT + t * RS + 2 * k) = bfr(kin[i] * fexp2(fminf(-cu, 115.f)));
                  kh[i] = kin[i] * fexp2(tot - cu); }
              *(LAS u32x2*)(lds + OFF_KH + k * RS2 + 8 * tq) = (u32x2){att::pk2(kh[0], kh[1]), att::pk2(kh[2], kh[3])};
              if (tq == 0) p15[k] = fexp2(tot);
              if (tid < 256) { const int t = tid >> 4, v4 = (tid & 15) * 4;
#pragma unroll
                  for (int j = 0; j < 4; ++j) { const unsigned short hv = bfr(val[j]); *(LAS unsigned short*)(lds + OFF_VT + (v4 + j) * RS2 + 2 * t) = hv; } } }
            if (c + 4 < NCH) HG_LOAD(c + 4, 3);
            lds_barrier();
            const LAS unsigned char* stc = lds + OFF_ST + (c & 1) * 64 * RS; LAS unsigned char* stn = lds + OFF_ST + ((c + 1) & 1) * 64 * RS;
            if (wid < 4) {
                f32x4 sc = (f32x4){0.f, 0.f, 0.f, 0.f};
#pragma unroll
                for (int kk = 0; kk < 4; ++kk) { const bf16x8 a = *(const LAS bf16x8*)(lds + OFF_KT + l15 * RS + (32 * kk + 8 * g) * 2), bq = *(const LAS bf16x8*)(lds + OFF_QT + l15 * RS + (32 * kk + 8 * g) * 2); sc = HG_MFMA32(a, bq, sc); }
#pragma unroll
                for (int r = 0; r < 4; ++r) if (4 * g + r > l15) sc[r] = 0.f;
                const u32x2 pk = (u32x2){att::pk2(sc[0], sc[1]), att::pk2(sc[2], sc[3])};
                f32x4 o = (f32x4){0.f, 0.f, 0.f, 0.f};
                { LAS unsigned char* scw = lds + OFF_SC + wid * 16 * 80;
                  *(LAS u32x2*)(scw + l15 * 80 + 8 * g) = pk;
                  const bf16x8 sb = *(const LAS bf16x8*)(scw + l15 * 80 + 16 * g); bf16x8 va = (bf16x8){0, 0, 0, 0, 0, 0, 0, 0};
                  if (g < 2) { const LAS unsigned char* vp_ = lds + OFF_VT + (16 * wid + l15) * RS2 + 16 * g; const s16x4 lo_ = *(const LAS s16x4*)vp_, hi_ = *(const LAS s16x4*)(vp_ + 8); va = __builtin_shufflevector(lo_, hi_, 0, 1, 2, 3, 4, 5, 6, 7); }
                  o = HG_MFMA32(va, sb, o); }
#pragma unroll
                for (int kk = 0; kk < 4; ++kk) { const bf16x8 a = *(const LAS bf16x8*)(stc + (16 * wid + l15) * RS + (32 * kk + 8 * g) * 2), bq = *(const LAS bf16x8*)(lds + OFF_QT + l15 * RS + (32 * kk + 8 * g) * 2); o = HG_MFMA32(a, bq, o); }
                { HG_ROWBASE(c, rbo_) const long row = rbo_ + (d ? -l15 : l15); *(GAS u32x2*)(pO + row * 512 + 16 * wid + 4 * g) = (u32x2){att::pk2(o[0], o[1]), att::pk2(o[2], o[3])}; }
            }
            { const f32x4 pd = *(const LAS f32x4*)(p15 + 16 * wid + 4 * g); const s16x4 ka = *(const LAS s16x4*)(lds + OFF_KH + (16 * wid + l15) * RS2 + 8 * g);
#pragma unroll
              for (int n = 0; n < 4; ++n) { const s16x4 vb = *(const LAS s16x4*)(lds + OFF_VT + (16 * n + l15) * RS2 + 8 * g);
                  acc[n] = HG_MFMA16(ka, vb, acc[n] * pd);
                  *(LAS u32x2*)(stn + (16 * n + l15) * RS + (16 * wid + 4 * g) * 2) = (u32x2){att::pk2(acc[n][0], acc[n][1]), att::pk2(acc[n][2], acc[n][3])}; } }
                    }
        }
        lds_barrier();
#undef HG_LOAD
    }
}
}

namespace rwc {
constexpr int RS = 144, RS40 = 80;
constexpr int O_AT = 0, O_RT = 2304, O_BT = 4608, O_KT = 6912, O_BH = 9216, O_KH = 14336, O_VT = 19456, O_UT = 24576, O_HT = 29696, O_GAK = 48128, O_GRB = 49408, O_GRK = 50688,
              O_GAB = 51968, O_XS = 52992, O_P15 = 57088, O_GS = 57344, RW_LDS = 59392;
#define RW_MFMA(a, b, c) __builtin_amdgcn_mfma_f32_16x16x32_bf16((a), (b), (c), 0, 0, 0)
#define RW_FRAG(img, row, RSB, byteoff) (*(const LAS bf16x8*)(lds + (img) + (row) * (RSB) + (byteoff)))
DI unsigned short bfr(float x) { return (unsigned short)(att::pk2(x, 0.f) & 0xffffu); }

DI void rwkv_chunk_scan(const LAS NaiveCtx* Cp_, LAS unsigned char* lds, int wv_) {
    const int tid = otid(wv_), lane = tid & 63, wid = tid >> 6, l15 = lane & 15, g = lane >> 4;
    const int k = tid & 63, tq = tid >> 6;
    LAS float* gsum = (LAS float*)(lds + O_GS); LAS float* p15 = (LAS float*)(lds + O_P15); LAS float* gab = (LAS float*)(lds + O_GAB); LAS float* xs = (LAS float*)(lds + O_XS);
    for (int chain = opaque_bid(); chain < 2 * BATCH * RW_HEADS; chain += gridDim.x) {
        const int d = chain / (BATCH * RW_HEADS), b = (chain / RW_HEADS) % BATCH, h = chain % RW_HEADS;
        const GAS bf16_t* pA = (const GAS bf16_t*)((*Cp_).NKh + h * 64 + k); const GAS float* pW = (const GAS float*)((*Cp_).DEC + (size_t)d * NT_ * 512 + h * 64 + k); const GAS bf16_t* pB = (const GAS bf16_t*)((*Cp_).BBh + (size_t)d * NT_ * 512 + h * 64 + k);
        const GAS bf16_t* pK = (const GAS bf16_t*)((*Cp_).KDh + (size_t)d * NT_ * 512 + h * 64 + k); const GAS bf16_t* pR = (const GAS bf16_t*)((*Cp_).RBh + h * 64 + k); const GAS bf16_t* pV = (const GAS bf16_t*)((*Cp_).VBh + h * 64 + (tid & 31) * 2);
        GAS bf16_t* pY = (GAS bf16_t*)((*Cp_).YBh + (size_t)d * NT_ * 512 + h * 64);
        for (int i = tid; i < RW_LDS / 4; i += PB_THREADS) ((LAS unsigned*)lds)[i] = 0u;
        f32x4 acc[2];
        acc[0] = (f32x4){0.f, 0.f, 0.f, 0.f}; acc[1] = acc[0];
        float lwX[4][2]; unsigned aX[4][2], bX[4][2], kX[4][2], rX[4][2], vX[4];
#define RW_ROWBASE(C0, rb) long rb; { const int i0_ = (C0) * 16; if (i0_ < CTX_LEN) rb = (long)b * CTX_LEN + (d ? CTX_LEN - 1 - i0_ : i0_); else rb = (long)NC_ + (long)b * SEQ + (d ? SEQ - 1 - (i0_ - CTX_LEN) : (i0_ - CTX_LEN)); }
#define RW_LOAD(C0, S) do { RW_ROWBASE(C0, rb_) const long sg_ = d ? -1 : 1; _Pragma("unroll") for (int i = 0; i < 2; ++i) { const long row = rb_ + sg_ * (2 * tq + i); lwX[S][i] = pW[row * 512]; aX[S][i] = pA[row * 512]; bX[S][i] = pB[row * 512]; kX[S][i] = pK[row * 512]; rX[S][i] = pR[row * 512]; } \
            { const long row = rb_ + sg_ * (tid >> 5); vX[S] = *(const GAS unsigned*)(pV + row * 512); } } while (0)
        RW_LOAD(0, 0); RW_LOAD(1, 1); RW_LOAD(2, 2); RW_LOAD(3, 3);
        lds_barrier();
        constexpr int NCH = TT_ / 16;
        static_assert(NCH % 4 == 0, "chunks per trip");
        for (int c4 = 0; c4 < NCH; c4 += 4) {
            { const int c = c4 + 0;

            float lw[2], a[2], bb[2], kd[2], r[2];
#pragma unroll
            for (int i = 0; i < 2; ++i) { lw[i] = lwX[0][i]; a[i] = bf_lo(aX[0][i]); bb[i] = bf_lo(bX[0][i]); kd[i] = bf_lo(kX[0][i]); r[i] = bf_lo(rX[0][i]); }
            const float v0 = bf_lo(vX[0]), v1 = bf_hi(vX[0]);
            const float c0 = lw[0], c1 = lw[0] + lw[1];
            gsum[tq * 64 + k] = c1;
            lds_barrier();
            { float base = 0.f, tot = 0.f;
#pragma unroll
              for (int q = 0; q < 8; ++q) { const float gq = gsum[q * 64 + k]; tot += gq; base += q < tq ? gq : 0.f; }
              float bh[2], kh[2];
#pragma unroll
              for (int i = 0; i < 2; ++i) { const float cu = base + (i ? c1 : c0); const int t = 2 * tq + i; const float ep = fexp2(cu), em = fexp2(-cu), eh = fexp2(tot - cu);
                  *(LAS unsigned short*)(lds + O_AT + t * RS + 2 * k) = bfr(a[i] * fexp2(cu - lw[i]));
                  *(LAS unsigned short*)(lds + O_RT + t * RS + 2 * k) = bfr(r[i] * ep);
                  *(LAS unsigned short*)(lds + O_BT + t * RS + 2 * k) = bfr(bb[i] * em);
                  *(LAS unsigned short*)(lds + O_KT + t * RS + 2 * k) = bfr(kd[i] * em);
                  bh[i] = bb[i] * eh; kh[i] = kd[i] * eh; }
              *(LAS unsigned*)(lds + O_BH + k * RS40 + 4 * tq) = att::pk2(bh[0], bh[1]);
              *(LAS unsigned*)(lds + O_KH + k * RS40 + 4 * tq) = att::pk2(kh[0], kh[1]);
              if (tq == 0) p15[k] = fexp2(tot);
              { const int t = tid >> 5, v2 = (tid & 31) * 2; *(LAS unsigned short*)(lds + O_VT + v2 * RS40 + 2 * t) = bfr(v0); *(LAS unsigned short*)(lds + O_VT + (v2 + 1) * RS40 + 2 * t) = bfr(v1); } }
            if (c + 4 < NCH) RW_LOAD(c + 4, 0);
            lds_barrier();
            const int htc = O_HT + (c & 1) * 64 * RS, htn = O_HT + ((c + 1) & 1) * 64 * RS;
            if (wid < 4) { const int ia = wid < 2 ? O_AT : O_RT, ib = (wid & 1) ? O_KT : O_BT;
                f32x4 gm = (f32x4){0.f, 0.f, 0.f, 0.f};
#pragma unroll
                for (int kk = 0; kk < 2; ++kk) gm = RW_MFMA(RW_FRAG(ia, l15, RS, 64 * kk + 16 * g), RW_FRAG(ib, l15, RS, 64 * kk + 16 * g), gm);
#pragma unroll
                for (int rr = 0; rr < 4; ++rr) { const int t = 4 * g + rr; const bool keep = wid < 2 ? (l15 < t) : (l15 <= t); const float val = keep ? gm[rr] : 0.f;
                    if (wid == 0) gab[l15 * 16 + t] = val;
                    else *(LAS unsigned short*)(lds + (wid == 1 ? O_GAK : wid == 2 ? O_GRB : O_GRK) + t * RS40 + 2 * l15) = bfr(val); } }
            lds_barrier();
            if (wid < 4) { f32x4 x = (f32x4){0.f, 0.f, 0.f, 0.f};
#pragma unroll
                for (int kk = 0; kk < 2; ++kk) x = RW_MFMA(RW_FRAG(O_AT, l15, RS, 64 * kk + 16 * g), RW_FRAG(htc, 16 * wid + l15, RS, 64 * kk + 16 * g), x);
                x = RW_MFMA(RW_FRAG(O_GAK, l15, RS40, 16 * g), RW_FRAG(O_VT, 16 * wid + l15, RS40, 16 * g), x);
#pragma unroll
                for (int rr = 0; rr < 4; ++rr) xs[(4 * g + rr) * 64 + 16 * wid + l15] = x[rr]; }
            lds_barrier();
            if (wid == 0) { float u[16];
#pragma unroll
                for (int t = 0; t < 16; ++t) u[t] = xs[t * 64 + lane];
#pragma unroll
                for (int s = 0; s < 15; ++s) {
#pragma unroll
                    for (int q4 = (s + 1) / 4; q4 < 4; ++q4) { const f32x4 gc = *(const LAS f32x4*)(gab + s * 16 + 4 * q4);
#pragma unroll
                        for (int j = 0; j < 4; ++j) if (4 * q4 + j > s) u[4 * q4 + j] += gc[j] * u[s]; } }
                u32x4 w0, w1; w0.x = att::pk2(u[0], u[1]); w0.y = att::pk2(u[2], u[3]); w0.z = att::pk2(u[4], u[5]); w0.w = att::pk2(u[6], u[7]);
                w1.x = att::pk2(u[8], u[9]); w1.y = att::pk2(u[10], u[11]); w1.z = att::pk2(u[12], u[13]); w1.w = att::pk2(u[14], u[15]);
                *(LAS u32x4*)(lds + O_UT + lane * RS40) = w0; *(LAS u32x4*)(lds + O_UT + lane * RS40 + 16) = w1; }
            lds_barrier();
            if (wid < 4) { f32x4 y = (f32x4){0.f, 0.f, 0.f, 0.f};
#pragma unroll
                for (int kk = 0; kk < 2; ++kk) y = RW_MFMA(RW_FRAG(O_RT, l15, RS, 64 * kk + 16 * g), RW_FRAG(htc, 16 * wid + l15, RS, 64 * kk + 16 * g), y);
                y = RW_MFMA(RW_FRAG(O_GRB, l15, RS40, 16 * g), RW_FRAG(O_UT, 16 * wid + l15, RS40, 16 * g), y);
                y = RW_MFMA(RW_FRAG(O_GRK, l15, RS40, 16 * g), RW_FRAG(O_VT, 16 * wid + l15, RS40, 16 * g), y);
                { RW_ROWBASE(c, rby_) const long sgy_ = d ? -1 : 1;
#pragma unroll
                for (int rr = 0; rr < 4; ++rr) { const long row = rby_ + sgy_ * (4 * g + rr); pY[row * 512 + 16 * wid + l15] = bfr(y[rr]); } } }
            { const int kt = wid >> 1; const f32x4 pd = *(const LAS f32x4*)(p15 + 16 * kt + 4 * g);
              const bf16x8 fb = RW_FRAG(O_BH, 16 * kt + l15, RS40, 16 * g), fk = RW_FRAG(O_KH, 16 * kt + l15, RS40, 16 * g);
#pragma unroll
              for (int j = 0; j < 2; ++j) { const int vt = 2 * (wid & 1) + j;
                  acc[j] = RW_MFMA(fb, RW_FRAG(O_UT, 16 * vt + l15, RS40, 16 * g), acc[j] * pd);
                  acc[j] = RW_MFMA(fk, RW_FRAG(O_VT, 16 * vt + l15, RS40, 16 * g), acc[j]);
                  *(LAS u32x2*)(lds + htn + (16 * vt + l15) * RS + (16 * kt + 4 * g) * 2) = (u32x2){att::pk2(acc[j][0], acc[j][1]), att::pk2(acc[j][2], acc[j][3])}; } }
                    }
            { const int c = c4 + 1;

            float lw[2], a[2], bb[2], kd[2], r[2];
#pragma unroll
            for (int i = 0; i < 2; ++i) { lw[i] = lwX[1][i]; a[i] = bf_lo(aX[1][i]); bb[i] = bf_lo(bX[1][i]); kd[i] = bf_lo(kX[1][i]); r[i] = bf_lo(rX[1][i]); }
            const float v0 = bf_lo(vX[1]), v1 = bf_hi(vX[1]);
            const float c0 = lw[0], c1 = lw[0] + lw[1];
            gsum[tq * 64 + k] = c1;
            lds_barrier();
            { float base = 0.f, tot = 0.f;
#pragma unroll
              for (int q = 0; q < 8; ++q) { const float gq = gsum[q * 64 + k]; tot += gq; base += q < tq ? gq : 0.f; }
              float bh[2], kh[2];
#pragma unroll
              for (int i = 0; i < 2; ++i) { const float cu = base + (i ? c1 : c0); const int t = 2 * tq + i; const float ep = fexp2(cu), em = fexp2(-cu), eh = fexp2(tot - cu);
                  *(LAS unsigned short*)(lds + O_AT + t * RS + 2 * k) = bfr(a[i] * fexp2(cu - lw[i]));
                  *(LAS unsigned short*)(lds + O_RT + t * RS + 2 * k) = bfr(r[i] * ep);
                  *(LAS unsigned short*)(lds + O_BT + t * RS + 2 * k) = bfr(bb[i] * em);
                  *(LAS unsigned short*)(lds + O_KT + t * RS + 2 * k) = bfr(kd[i] * em);
                  bh[i] = bb[i] * eh; kh[i] = kd[i] * eh; }
              *(LAS unsigned*)(lds + O_BH + k * RS40 + 4 * tq) = att::pk2(bh[0], bh[1]);
              *(LAS unsigned*)(lds + O_KH + k * RS40 + 4 * tq) = att::pk2(kh[0], kh[1]);
              if (tq == 0) p15[k] = fexp2(tot);
              { const int t = tid >> 5, v2 = (tid & 31) * 2; *(LAS unsigned short*)(lds + O_VT + v2 * RS40 + 2 * t) = bfr(v0); *(LAS unsigned short*)(lds + O_VT + (v2 + 1) * RS40 + 2 * t) = bfr(v1); } }
            if (c + 4 < NCH) RW_LOAD(c + 4, 1);
            lds_barrier();
            const int htc = O_HT + (c & 1) * 64 * RS, htn = O_HT + ((c + 1) & 1) * 64 * RS;
            if (wid < 4) { const int ia = wid < 2 ? O_AT : O_RT, ib = (wid & 1) ? O_KT : O_BT;
                f32x4 gm = (f32x4){0.f, 0.f, 0.f, 0.f};
#pragma unroll
                for (int kk = 0; kk < 2; ++kk) gm = RW_MFMA(RW_FRAG(ia, l15, RS, 64 * kk + 16 * g), RW_FRAG(ib, l15, RS, 64 * kk + 16 * g), gm);
#pragma unroll
                for (int rr = 0; rr < 4; ++rr) { const int t = 4 * g + rr; const bool keep = wid < 2 ? (l15 < t) : (l15 <= t); const float val = keep ? gm[rr] : 0.f;
                    if (wid == 0) gab[l15 * 16 + t] = val;
                    else *(LAS unsigned short*)(lds + (wid == 1 ? O_GAK : wid == 2 ? O_GRB : O_GRK) + t * RS40 + 2 * l15) = bfr(val); } }
            lds_barrier();
            if (wid < 4) { f32x4 x = (f32x4){0.f, 0.f, 0.f, 0.f};
#pragma unroll
                for (int kk = 0; kk < 2; ++kk) x = RW_MFMA(RW_FRAG(O_AT, l15, RS, 64 * kk + 16 * g), RW_FRAG(htc, 16 * wid + l15, RS, 64 * kk + 16 * g), x);
                x = RW_MFMA(RW_FRAG(O_GAK, l15, RS40, 16 * g), RW_FRAG(O_VT, 16 * wid + l15, RS40, 16 * g), x);
#pragma unroll
                for (int rr = 0; rr < 4; ++rr) xs[(4 * g + rr) * 64 + 16 * wid + l15] = x[rr]; }
            lds_barrier();
            if (wid == 0) { float u[16];
#pragma unroll
                for (int t = 0; t < 16; ++t) u[t] = xs[t * 64 + lane];
#pragma unroll
                for (int s = 0; s < 15; ++s) {
#pragma unroll
                    for (int q4 = (s + 1) / 4; q4 < 4; ++q4) { const f32x4 gc = *(const LAS f32x4*)(gab + s * 16 + 4 * q4);
#pragma unroll
                        for (int j = 0; j < 4; ++j) if (4 * q4 + j > s) u[4 * q4 + j] += gc[j] * u[s]; } }
                u32x4 w0, w1; w0.x = att::pk2(u[0], u[1]); w0.y = att::pk2(u[2], u[3]); w0.z = att::pk2(u[4], u[5]); w0.w = att::pk2(u[6], u[7]);
                w1.x = att::pk2(u[8], u[9]); w1.y = att::pk2(u[10], u[11]); w1.z = att::pk2(u[12], u[13]); w1.w = att::pk2(u[14], u[15]);
                *(LAS u32x4*)(lds + O_UT + lane * RS40) = w0; *(LAS u32x4*)(lds + O_UT + lane * RS40 + 16) = w1; }
            lds_barrier();
            if (wid < 4) { f32x4 y = (f32x4){0.f, 0.f, 0.f, 0.f};
#pragma unroll
                for (int kk = 0; kk < 2; ++kk) y = RW_MFMA(RW_FRAG(O_RT, l15, RS, 64 * kk + 16 * g), RW_FRAG(htc, 16 * wid + l15, RS, 64 * kk + 16 * g), y);
                y = RW_MFMA(RW_FRAG(O_GRB, l15, RS40, 16 * g), RW_FRAG(O_UT, 16 * wid + l15, RS40, 16 * g), y);
                y = RW_MFMA(RW_FRAG(O_GRK, l15, RS40, 16 * g), RW_FRAG(O_VT, 16 * wid + l15, RS40, 16 * g), y);
                { RW_ROWBASE(c, rby_) const long sgy_ = d ? -1 : 1;
#pragma unroll
                for (int rr = 0; rr < 4; ++rr) { const long row = rby_ + sgy_ * (4 * g + rr); pY[row * 512 + 16 * wid + l15] = bfr(y[rr]); } } }
            { const int kt = wid >> 1; const f32x4 pd = *(const LAS f32x4*)(p15 + 16 * kt + 4 * g);
              const bf16x8 fb = RW_FRAG(O_BH, 16 * kt + l15, RS40, 16 * g), fk = RW_FRAG(O_KH, 16 * kt + l15, RS40, 16 * g);
#pragma unroll
              for (int j = 0; j < 2; ++j) { const int vt = 2 * (wid & 1) + j;
                  acc[j] = RW_MFMA(fb, RW_FRAG(O_UT, 16 * vt + l15, RS40, 16 * g), acc[j] * pd);
                  acc[j] = RW_MFMA(fk, RW_FRAG(O_VT, 16 * vt + l15, RS40, 16 * g), acc[j]);
                  *(LAS u32x2*)(lds + htn + (16 * vt + l15) * RS + (16 * kt + 4 * g) * 2) = (u32x2){att::pk2(acc[j][0], acc[j][1]), att::pk2(acc[j][2], acc[j][3])}; } }
                    }
            { const int c = c4 + 2;

            float lw[2], a[2], bb[2], kd[2], r[2];
#pragma unroll
            for (int i = 0; i < 2; ++i) { lw[i] = lwX[2][i]; a[i] = bf_lo(aX[2][i]); bb[i] = bf_lo(bX[2][i]); kd[i] = bf_lo(kX[2][i]); r[i] = bf_lo(rX[2][i]); }
            const float v0 = bf_lo(vX[2]), v1 = bf_hi(vX[2]);
            const float c0 = lw[0], c1 = lw[0] + lw[1];
            gsum[tq * 64 + k] = c1;
            lds_barrier();
            { float base = 0.f, tot = 0.f;
#pragma unroll
              for (int q = 0; q < 8; ++q) { const float gq = gsum[q * 64 + k]; tot += gq; base += q < tq ? gq : 0.f; }
              float bh[2], kh[2];
#pragma unroll
              for (int i = 0; i < 2; ++i) { const float cu = base + (i ? c1 : c0); const int t = 2 * tq + i; const float ep = fexp2(cu), em = fexp2(-cu), eh = fexp2(tot - cu);
                  *(LAS unsigned short*)(lds + O_AT + t * RS + 2 * k) = bfr(a[i] * fexp2(cu - lw[i]));
                  *(LAS unsigned short*)(lds + O_RT + t * RS + 2 * k) = bfr(r[i] * ep);
                  *(LAS unsigned short*)(lds + O_BT + t * RS + 2 * k) = bfr(bb[i] * em);
                  *(LAS unsigned short*)(lds + O_KT + t * RS + 2 * k) = bfr(kd[i] * em);
                  bh[i] = bb[i] * eh; kh[i] = kd[i] * eh; }
              *(LAS unsigned*)(lds + O_BH + k * RS40 + 4 * tq) = att::pk2(bh[0], bh[1]);
              *(LAS unsigned*)(lds + O_KH + k * RS40 + 4 * tq) = att::pk2(kh[0], kh[1]);
              if (tq == 0) p15[k] = fexp2(tot);
              { const int t = tid >> 5, v2 = (tid & 31) * 2; *(LAS unsigned short*)(lds + O_VT + v2 * RS40 + 2 * t) = bfr(v0); *(LAS unsigned short*)(lds + O_VT + (v2 + 1) * RS40 + 2 * t) = bfr(v1); } }
            if (c + 4 < NCH) RW_LOAD(c + 4, 2);
            lds_barrier();
            const int htc = O_HT + (c & 1) * 64 * RS, htn = O_HT + ((c + 1) & 1) * 64 * RS;
            if (wid < 4) { const int ia = wid < 2 ? O_AT : O_RT, ib = (wid & 1) ? O_KT : O_BT;
                f32x4 gm = (f32x4){0.f, 0.f, 0.f, 0.f};
#pragma unroll
                for (int kk = 0; kk < 2; ++kk) gm = RW_MFMA(RW_FRAG(ia, l15, RS, 64 * kk + 16 * g), RW_FRAG(ib, l15, RS, 64 * kk + 16 * g), gm);
#pragma unroll
                for (int rr = 0; rr < 4; ++rr) { const int t = 4 * g + rr; const bool keep = wid < 2 ? (l15 < t) : (l15 <= t); const float val = keep ? gm[rr] : 0.f;
                    if (wid == 0) gab[l15 * 16 + t] = val;
                    else *(LAS unsigned short*)(lds + (wid == 1 ? O_GAK : wid == 2 ? O_GRB : O_GRK) + t * RS40 + 2 * l15) = bfr(val); } }
            lds_barrier();
            if (wid < 4) { f32x4 x = (f32x4){0.f, 0.f, 0.f, 0.f};
#pragma unroll
                for (int kk = 0; kk < 2; ++kk) x = RW_MFMA(RW_FRAG(O_AT, l15, RS, 64 * kk + 16 * g), RW_FRAG(htc, 16 * wid + l15, RS, 64 * kk + 16 * g), x);
                x = RW_MFMA(RW_FRAG(O_GAK, l15, RS40, 16 * g), RW_FRAG(O_VT, 16 * wid + l15, RS40, 16 * g), x);
#pragma unroll
                for (int rr = 0; rr < 4; ++rr) xs[(4 * g + rr) * 64 + 16 * wid + l15] = x[rr]; }
            lds_barrier();
            if (wid == 0) { float u[16];
#pragma unroll
                for (int t = 0; t < 16; ++t) u[t] = xs[t * 64 + lane];
#pragma unroll
                for (int s = 0; s < 15; ++s) {
#pragma unroll
                    for (int q4 = (s + 1) / 4; q4 < 4; ++q4) { const f32x4 gc = *(const LAS f32x4*)(gab + s * 16 + 4 * q4);
#pragma unroll
                        for (int j = 0; j < 4; ++j) if (4 * q4 + j > s) u[4 * q4 + j] += gc[j] * u[s]; } }
                u32x4 w0, w1; w0.x = att::pk2(u[0], u[1]); w0.y = att::pk2(u[2], u[3]); w0.z = att::pk2(u[4], u[5]); w0.w = att::pk2(u[6], u[7]);
                w1.x = att::pk2(u[8], u[9]); w1.y = att::pk2(u[10], u[11]); w1.z = att::pk2(u[12], u[13]); w1.w = att::pk2(u[14], u[15]);
                *(LAS u32x4*)(lds + O_UT + lane * RS40) = w0; *(LAS u32x4*)(lds + O_UT + lane * RS40 + 16) = w1; }
            lds_barrier();
            if (wid < 4) { f32x4 y = (f32x4){0.f, 0.f, 0.f, 0.f};
#pragma unroll
                for (int kk = 0; kk < 2; ++kk) y = RW_MFMA(RW_FRAG(O_RT, l15, RS, 64 * kk + 16 * g), RW_FRAG(htc, 16 * wid + l15, RS, 64 * kk + 16 * g), y);
                y = RW_MFMA(RW_FRAG(O_GRB, l15, RS40, 16 * g), RW_FRAG(O_UT, 16 * wid + l15, RS40, 16 * g), y);
                y = RW_MFMA(RW_FRAG(O_GRK, l15, RS40, 16 * g), RW_FRAG(O_VT, 16 * wid + l15, RS40, 16 * g), y);
                { RW_ROWBASE(c, rby_) const long sgy_ = d ? -1 : 1;
#pragma unroll
                for (int rr = 0; rr < 4; ++rr) { const long row = rby_ + sgy_ * (4 * g + rr); pY[row * 512 + 16 * wid + l15] = bfr(y[rr]); } } }
            { const int kt = wid >> 1; const f32x4 pd = *(const LAS f32x4*)(p15 + 16 * kt + 4 * g);
              const bf16x8 fb = RW_FRAG(O_BH, 16 * kt + l15, RS40, 16 * g), fk = RW_FRAG(O_KH, 16 * kt + l15, RS40, 16 * g);
#pragma unroll
              for (int j = 0; j < 2; ++j) { const int vt = 2 * (wid & 1) + j;
                  acc[j] = RW_MFMA(fb, RW_FRAG(O_UT, 16 * vt + l15, RS40, 16 * g), acc[j] * pd);
                  acc[j] = RW_MFMA(fk, RW_FRAG(O_VT, 16 * vt + l15, RS40, 16 * g), acc[j]);
                  *(LAS u32x2*)(lds + htn + (16 * vt + l15) * RS + (16 * kt + 4 * g) * 2) = (u32x2){att::pk2(acc[j][0], acc[j][1]), att::pk2(acc[j][2], acc[j][3])}; } }
                    }
            { const int c = c4 + 3;

            float lw[2], a[2], bb[2], kd[2], r[2];
#pragma unroll
            for (int i = 0; i < 2; ++i) { lw[i] = lwX[3][i]; a[i] = bf_lo(aX[3][i]); bb[i] = bf_lo(bX[3][i]); kd[i] = bf_lo(kX[3][i]); r[i] = bf_lo(rX[3][i]); }
            const float v0 = bf_lo(vX[3]), v1 = bf_hi(vX[3]);
            const float c0 = lw[0], c1 = lw[0] + lw[1];
            gsum[tq * 64 + k] = c1;
            lds_barrier();
            { float base = 0.f, tot = 0.f;
#pragma unroll
              for (int q = 0; q < 8; ++q) { const float gq = gsum[q * 64 + k]; tot += gq; base += q < tq ? gq : 0.f; }
              float bh[2], kh[2];
#pragma unroll
              for (int i = 0; i < 2; ++i) { const float cu = base + (i ? c1 : c0); const int t = 2 * tq + i; const float ep = fexp2(cu), em = fexp2(-cu), eh = fexp2(tot - cu);
                  *(LAS unsigned short*)(lds + O_AT + t * RS + 2 * k) = bfr(a[i] * fexp2(cu - lw[i]));
                  *(LAS unsigned short*)(lds + O_RT + t * RS + 2 * k) = bfr(r[i] * ep);
                  *(LAS unsigned short*)(lds + O_BT + t * RS + 2 * k) = bfr(bb[i] * em);
                  *(LAS unsigned short*)(lds + O_KT + t * RS + 2 * k) = bfr(kd[i] * em);
                  bh[i] = bb[i] * eh; kh[i] = kd[i] * eh; }
              *(LAS unsigned*)(lds + O_BH + k * RS40 + 4 * tq) = att::pk2(bh[0], bh[1]);
              *(LAS unsigned*)(lds + O_KH + k * RS40 + 4 * tq) = att::pk2(kh[0], kh[1]);
              if (tq == 0) p15[k] = fexp2(tot);
              { const int t = tid >> 5, v2 = (tid & 31) * 2; *(LAS unsigned short*)(lds + O_VT + v2 * RS40 + 2 * t) = bfr(v0); *(LAS unsigned short*)(lds + O_VT + (v2 + 1) * RS40 + 2 * t) = bfr(v1); } }
            if (c + 4 < NCH) RW_LOAD(c + 4, 3);
            lds_barrier();
            const int htc = O_HT + (c & 1) * 64 * RS, htn = O_HT + ((c + 1) & 1) * 64 * RS;
            if (wid < 4) { const int ia = wid < 2 ? O_AT : O_RT, ib = (wid & 1) ? O_KT : O_BT;
                f32x4 gm = (f32x4){0.f, 0.f, 0.f, 0.f};
#pragma unroll
                for (int kk = 0; kk < 2; ++kk) gm = RW_MFMA(RW_FRAG(ia, l15, RS, 64 * kk + 16 * g), RW_FRAG(ib, l15, RS, 64 * kk + 16 * g), gm);
#pragma unroll
                for (int rr = 0; rr < 4; ++rr) { const int t = 4 * g + rr; const bool keep = wid < 2 ? (l15 < t) : (l15 <= t); const float val = keep ? gm[rr] : 0.f;
                    if (wid == 0) gab[l15 * 16 + t] = val;
                    else *(LAS unsigned short*)(lds + (wid == 1 ? O_GAK : wid == 2 ? O_GRB : O_GRK) + t * RS40 + 2 * l15) = bfr(val); } }
            lds_barrier();
            if (wid < 4) { f32x4 x = (f32x4){0.f, 0.f, 0.f, 0.f};
#pragma unroll
                for (int kk = 0; kk < 2; ++kk) x = RW_MFMA(RW_FRAG(O_AT, l15, RS, 64 * kk + 16 * g), RW_FRAG(htc, 16 * wid + l15, RS, 64 * kk + 16 * g), x);
                x = RW_MFMA(RW_FRAG(O_GAK, l15, RS40, 16 * g), RW_FRAG(O_VT, 16 * wid + l15, RS40, 16 * g), x);
#pragma unroll
                for (int rr = 0; rr < 4; ++rr) xs[(4 * g + rr) * 64 + 16 * wid + l15] = x[rr]; }
            lds_barrier();
            if (wid == 0) { float u[16];
#pragma unroll
                for (int t = 0; t < 16; ++t) u[t] = xs[t * 64 + lane];
#pragma unroll
                for (int s = 0; s < 15; ++s) {
#pragma unroll
                    for (int q4 = (s + 1) / 4; q4 < 4; ++q4) { const f32x4 gc = *(const LAS f32x4*)(gab + s * 16 + 4 * q4);
#pragma unroll
                        for (int j = 0; j < 4; ++j) if (4 * q4 + j > s) u[4 * q4 + j] += gc[j] * u[s]; } }
                u32x4 w0, w1; w0.x = att::pk2(u[0], u[1]); w0.y = att::pk2(u[2], u[3]); w0.z = att::pk2(u[4], u[5]); w0.w = att::pk2(u[6], u[7]);
                w1.x = att::pk2(u[8], u[9]); w1.y = att::pk2(u[10], u[11]); w1.z = att::pk2(u[12], u[13]); w1.w = att::pk2(u[14], u[15]);
                *(LAS u32x4*)(lds + O_UT + lane * RS40) = w0; *(LAS u32x4*)(lds + O_UT + lane * RS40 + 16) = w1; }
            lds_barrier();
            if (wid < 4) { f32x4 y = (f32x4){0.f, 0.f, 0.f, 0.f};
#pragma unroll
                for (int kk = 0; kk < 2; ++kk) y = RW_MFMA(RW_FRAG(O_RT, l15, RS, 64 * kk + 16 * g), RW_FRAG(htc, 16 * wid + l15, RS, 64 * kk + 16 * g), y);
                y = RW_MFMA(RW_FRAG(O_GRB, l15, RS40, 16 * g), RW_FRAG(O_UT, 16 * wid + l15, RS40, 16 * g), y);
                y = RW_MFMA(RW_FRAG(O_GRK, l15, RS40, 16 * g), RW_FRAG(O_VT, 16 * wid + l15, RS40, 16 * g), y);
                { RW_ROWBASE(c, rby_) const long sgy_ = d ? -1 : 1;
#pragma unroll
                for (int rr = 0; rr < 4; ++rr) { const long row = rby_ + sgy_ * (4 * g + rr); pY[row * 512 + 16 * wid + l15] = bfr(y[rr]); } } }
            { const int kt = wid >> 1; const f32x4 pd = *(const LAS f32x4*)(p15 + 16 * kt + 4 * g);
              const bf16x8 fb = RW_FRAG(O_BH, 16 * kt + l15, RS40, 16 * g), fk = RW_FRAG(O_KH, 16 * kt + l15, RS40, 16 * g);
#pragma unroll
              for (int j = 0; j < 2; ++j) { const int vt = 2 * (wid & 1) + j;
                  acc[j] = RW_MFMA(fb, RW_FRAG(O_UT, 16 * vt + l15, RS40, 16 * g), acc[j] * pd);
                  acc[j] = RW_MFMA(fk, RW_FRAG(O_VT, 16 * vt + l15, RS40, 16 * g), acc[j]);
                  *(LAS u32x2*)(lds + htn + (16 * vt + l15) * RS + (16 * kt + 4 * g) * 2) = (u32x2){att::pk2(acc[j][0], acc[j][1]), att::pk2(acc[j][2], acc[j][3])}; } }
                    }
        }
        lds_barrier();
#undef RW_LOAD
    }
}
}

#if defined(PERSISTENT)
#define DENSE_GEMM(Af, lda, Kreal, KP, WT, Wf, ldb, Cout, ldc, Mrows, Nvalid, NP) do { \
    conv_act((Af), (lda), (Kreal), C.ABF, (KP), (Mrows), wv_); grid_sync(bar); \
    { g8::DenseSched S_; S_.init(C.ABF, (WT), (Mrows), (NP), (KP), gridDim.x, opaque_bid()); g8::EpiF32 E_{(Cout), (ldc), (Nvalid)}; g8::gemm_phase<(KP), g8::EpiF32, g8::DenseSched>(lds, S_, E_, wv_); } \
    grid_sync(bar); } while (0)
#define DENSE_GEMM_UB(Af, lda, Kreal, KP, WT, Wf, ldb, Cout, ldc, Mrows, Nvalid, NP) do { \
    { g8::DenseSched S_; S_.init(C.UB, (WT), (Mrows), (NP), (KP), gridDim.x, opaque_bid()); g8::EpiF32 E_{(Cout), (ldc), (Nvalid)}; g8::gemm_phase<(KP), g8::EpiF32, g8::DenseSched>(lds, S_, E_, wv_); } \
    grid_sync(bar); } while (0)
#else
#define DENSE_GEMM_UB DENSE_GEMM
#define DENSE_GEMM(Af, lda, Kreal, KP, WT, Wf, ldb, Cout, ldc, Mrows, Nvalid, NP) ngemm((Af), (lda), nullptr, (Wf), 0, (ldb), nullptr, 0, (Cout), (ldc), (Mrows), (Nvalid), (Kreal), nullptr)
#endif
#ifdef PERSIST_C_MACRO
#define C (*Cp_)
#endif
#define MODL (C.MOD + (size_t)layer * (BATCH + 1) * N_MOD * D_MODEL)
FWD_QUAL void naive_prologue(FWD_SIG) {
    const int D = D_MODEL, NT = NT_, NC = NC_;
#if defined(PERSISTENT)
    tl::mod_phase(Cp_, lds, wv_);
    tl::rope_table(Cp_, wv_); tl::lora_weights(Cp_, wv_);
    conv_weight_b(lds, C.moe_w_gu, (size_t)D_MODEL * 2 * EXPERT_DIM, C.Wgu, (size_t)2 * EXPERT_DIM * D_MODEL, CV_PRO_LAYERS * N_EXPERTS, D_MODEL, 2 * EXPERT_DIM, 2 * EXPERT_DIM, D_MODEL, 2 * EXPERT_DIM, 1, wv_);
    conv_weight_b(lds, C.moe_w_down, (size_t)EXPERT_DIM * D_MODEL, C.Wdn, (size_t)D_MODEL * EXPERT_DIM, CV_PRO_LAYERS * N_EXPERTS, EXPERT_DIM, D_MODEL, D_MODEL, EXPERT_DIM, D_MODEL, 0, wv_);
    conv_weight_b(lds, C.ev_w_in, (size_t)D_MODEL * EVEN_IN, C.WinE, (size_t)4608 * 1024, N_EVEN, D_MODEL, EVEN_IN, EVEN_IN, 1024, 4608, 0, wv_);
    conv_weight_b(lds, C.ev_w_out, (size_t)1024 * D_MODEL, C.WoutE, (size_t)1024 * 1024, N_EVEN, 1024, D_MODEL, D_MODEL, 1024, 1024, 0, wv_);
    conv_weight_b(lds, C.od_w_in, (size_t)D_MODEL * MLA_IN, C.WinO, (size_t)512 * 1024, N_ODD, D_MODEL, MLA_IN, MLA_IN, 1024, 512, 0, wv_);
    conv_weight_b(lds, C.mla_w_qb, (size_t)MLA_QR * 1536, C.Wqb, (size_t)1536 * 256, N_ODD, MLA_QR, 1536, 1536, 256, 1536, 0, wv_);
    conv_weight_b(lds, C.mla_w_kvb, (size_t)MLA_KVR * 2048, C.Wkvb, (size_t)2048 * 256, N_ODD, MLA_KVR, 2048, 2048, 256, 2048, 0, wv_);
    conv_weight_b(lds, C.od_w_out, (size_t)1024 * D_MODEL, C.WoutO, (size_t)1024 * 1024, N_ODD, 1024, D_MODEL, D_MODEL, 1024, 1024, 0, wv_);
    grid_sync(bar);
#endif
#if !defined(PERSISTENT)
    NLAUNCH((long)NT * D, [=] HD(long i) { long row = i / D_MODEL; int d = (int)(i % D_MODEL); C.H[i] = row < NC_ ? C.ctx[row * D_MODEL + d] : C.x[(row - NC_) * D_MODEL + d]; });
#endif
#if !defined(PERSISTENT)
    NLAUNCH((long)DEPTH * (BATCH + 1) * N_MOD * D, [=] HD(long i) {
        const int W = N_MOD * D_MODEL; int j = (int)(i % W); long t = i / W; int r = (int)(t % (BATCH + 1)); int l = (int)(t / (BATCH + 1));
        const float* cv = r < BATCH ? C.c + (size_t)r * D_MODEL : C.c_ctx; const float* w = C.mod_w + (size_t)l * D_MODEL * W;
        float s = 0.f; for (int k = 0; k < D_MODEL; ++k) s += siluf_(cv[k]) * w[(size_t)k * W + j];
        C.MOD[i] = s + C.mod_b[(size_t)l * W + j]; });
#endif
#if defined(PERSISTENT)
    tl::init_h(Cp_, wv_); grid_sync(bar);
#endif
}
FWD_QUAL void naive_modu(FWD_SIG, long layer) {
#if !defined(PERSISTENT)
    const int D = D_MODEL, NT = NT_, NC = NC_; (void)D; (void)NT; (void)NC;
    const bool need_ctx = layer < DEPTH - 1; const long j2 = layer / 2; (void)need_ctx; (void)j2;
        NLAUNCH((long)NT * D, [=] HD(long i) { long row = i / D_MODEL; int d = (int)(i % D_MODEL); const float* m = MODL + (size_t)modrow((int)row) * N_MOD * D_MODEL; C.U[i] = C.H[i] * (1.f + m[D_MODEL + d]) + m[d]; });
#endif
}
FWD_QUAL void naive_even(FWD_SIG, long layer) {
    const int D = D_MODEL, NT = NT_, NC = NC_; (void)D; (void)NT; (void)NC;
    const bool need_ctx = layer < DEPTH - 1; const long j2 = layer / 2; (void)need_ctx; (void)j2;
            DENSE_GEMM_UB(C.U, D_MODEL, D_MODEL, 1024, C.WinE + (size_t)j2 * 4608 * 1024, C.ev_w_in + (size_t)j2 * D * EVEN_IN, EVEN_IN, C.Z, EVEN_IN, NT_, EVEN_IN, 4608);
#define mu (C.rw_mu + (size_t)j2 * RW_IN)
            NLAUNCH((long)NT * RW_IN, [=] HD(long i) { int row = (int)(i / RW_IN), c = (int)(i % RW_IN);
                int t, len; if (row < NC_) { t = row % CTX_LEN; len = CTX_LEN; } else { t = (row - NC_) % SEQ; len = SEQ; }
                float z = C.Z[(size_t)row * EVEN_IN + c]; float p = t > 0 ? C.Z[(size_t)(row - 1) * EVEN_IN + c] : 0.f; float n = t < len - 1 ? C.Z[(size_t)(row + 1) * EVEN_IN + c] : 0.f;
                C.ZS[i] = z + mu[c] * (0.5f * (p + n) - z); });
#define w0 (C.rw_w0 + (size_t)j2 * 2 * 512)
#define w2 (C.rw_w2 + (size_t)j2 * 2 * 64 * 512)
#define a0 (C.rw_a0 + (size_t)j2 * 2 * 512)
#define a2 (C.rw_a2 + (size_t)j2 * 2 * 64 * 512)
#define g2 (C.rw_g2 + (size_t)j2 * 128 * 512)
#define k_k (C.rw_k_k + (size_t)j2 * 512)
#define k_a (C.rw_k_a + (size_t)j2 * 512)
#define r_k (C.rw_r_k + (size_t)j2 * 512)
#define gn_g (C.rw_gn_g + (size_t)j2 * 512)
#define gn_b (C.rw_gn_b + (size_t)j2 * 512)
            NLAUNCH((long)NT * 512, [=] HD(long i) { int row = (int)(i / 512), c = (int)(i % 512); const float* zs = C.ZS + (size_t)row * RW_IN;
                float r = zs[c], k = zs[512 + c], v = zs[1024 + c];
                C.R[i] = r; C.V[i] = v; C.KKR[i] = k * k_k[c];
                float g = 0.f; for (int q = 0; q < 128; ++q) g += sigmoidf_(zs[1792 + q]) * g2[(size_t)q * 512 + c];
                C.G[i] = g;
                for (int d = 0; d < 2; ++d) {
                    float wl = 0.f, al = 0.f;
                    for (int q = 0; q < 64; ++q) { wl += tanhf(zs[1536 + d * 64 + q]) * w2[((size_t)d * 64 + q) * 512 + c]; al += zs[1664 + d * 64 + q] * a2[((size_t)d * 64 + q) * 512 + c]; }
                    float wpre = w0[d * 512 + c] + wl; float dec = expf(-expf(-softplusf_(-wpre) - 0.5f)); float a = sigmoidf_(a0[d * 512 + c] + al);
                    size_t o = ((size_t)d * NT_ + row) * 512 + c;
                    C.DEC[o] = dec; C.AG[o] = a; C.KD[o] = k * (1.f + (a - 1.f) * k_a[c]);
                } });
            NLAUNCH((long)NT * RW_HEADS, [=] HD(long i) { int row = (int)(i / RW_HEADS), h = (int)(i % RW_HEADS); size_t b0 = (size_t)row * 512 + h * 64;
                float ss = 0.f; for (int n = 0; n < 64; ++n) ss += C.KKR[b0 + n] * C.KKR[b0 + n];
                float inv = 1.f / sqrtf(fmaxf(ss, 1e-24f));
                for (int n = 0; n < 64; ++n) { float kk = C.KKR[b0 + n] * inv; C.NKK[b0 + n] = -kk; for (int d = 0; d < 2; ++d) { size_t o = ((size_t)d * NT_ + row) * 512 + h * 64 + n; C.BB[o] = kk * C.AG[o]; } } });
            NLAUNCH((long)2 * BATCH * RW_HEADS * 64, [=] HD(long i) { int v = (int)(i % 64); long t = i / 64; int h = (int)(t % RW_HEADS); t /= RW_HEADS; int b = (int)(t % BATCH); int d = (int)(t / BATCH);
                float S[64];
_Pragma("unroll")
                for (int k = 0; k < 64; ++k) S[k] = 0.f;
                for (int st = 0; st < TT_; ++st) { int row = tokrow(b, scan_pos(d, st)); size_t s0 = (size_t)row * 512 + h * 64, s1 = ((size_t)d * NT_ + row) * 512 + h * 64;
                    float sa = 0.f;
_Pragma("unroll")
                    for (int k = 0; k < 64; ++k) { sa += S[k] * C.NKK[s0 + k]; MEMFENCE_EVERY(k, 16); }
                    float vv = C.V[s0 + v], y = 0.f;
_Pragma("unroll")
                    for (int k = 0; k < 64; ++k) { S[k] = S[k] * C.DEC[s1 + k] + sa * C.BB[s1 + k] + vv * C.KD[s1 + k]; y += S[k] * C.R[s0 + k]; MEMFENCE_EVERY(k, 8); }
                    C.Y[s1 + v] = y; } });
#define lbp (C.hg_lb)
#define hgn (C.hg_norm_g + (size_t)j2 * 512)
            NLAUNCH((long)NT * 512, [=] HD(long i) { int row = (int)(i / 512), c = (int)(i % 512); const float* zb = C.Z + (size_t)row * EVEN_IN + RW_IN;
                C.HQ[i] = siluf_(zb[c]);
                for (int d = 0; d < 2; ++d) {
                    float mx = -1e30f; for (int q = 0; q < N_EVEN; ++q) mx = fmaxf(mx, lbp[((size_t)q * 2 + d) * 512 + c]);
                    float den = 0.f, num = 0.f; for (int q = 0; q < N_EVEN; ++q) { float e = expf(lbp[((size_t)q * 2 + d) * 512 + c] - mx); den += e; if (q >= 1 && q <= j2) num += e; }
                    float lower = num / den;
                    float sig = sigmoidf_(zb[512 + d * 512 + c]); float f = lower + (1.f - lower) * sig; f = fmaxf(f, 1e-30f);
                    size_t o = ((size_t)d * NT_ + row) * 512 + c; C.HF[o] = f; C.HK[o] = (1.f - lower) * (1.f - sig);
                } });
            NLAUNCH((long)2 * BATCH * HG_HEADS * 128 * 2, [=] HD(long i) { int kh = (int)(i & 1); int v = (int)((i >> 1) % 128); long t = (i >> 1) / 128; int h = (int)(t % HG_HEADS); t /= HG_HEADS; int b = (int)(t % BATCH); int d = (int)(t / BATCH);
                float S[64];
_Pragma("unroll")
                for (int k = 0; k < 64; ++k) S[k] = 0.f;
                for (int st = 0; st < TT_; ++st) { int row = tokrow(b, scan_pos(d, st)); size_t s0 = (size_t)row * 512 + h * 128 + kh * 64, s1 = ((size_t)d * NT_ + row) * 512 + h * 128 + kh * 64;
                    float val = C.Z[(size_t)row * EVEN_IN + RW_IN + 1536 + h * 128 + v], o = 0.f;
_Pragma("unroll")
                    for (int k = 0; k < 64; ++k) { S[k] = C.HF[s1 + k] * S[k] + C.HK[s1 + k] * val; o += S[k] * C.HQ[s0 + k]; MEMFENCE_EVERY(k, 16); }
                    C.OP[(((size_t)d * NT_ + row) * 512 + h * 128 + v) * 2 + kh] = o; } });
            NLAUNCH((long)NT * RW_HEADS, [=] HD(long i) { int row = (int)(i / RW_HEADS), h = (int)(i % RW_HEADS); size_t b0 = (size_t)row * 512 + h * 64, b1 = ((size_t)NT_ + row) * 512 + h * 64;
                float mu_ = 0.f; for (int n = 0; n < 64; ++n) mu_ += C.Y[b0 + n] + C.Y[b1 + n]; mu_ /= 64.f;
                float var = 0.f; for (int n = 0; n < 64; ++n) { float y = C.Y[b0 + n] + C.Y[b1 + n] - mu_; var += y * y; } var /= 64.f;
                float rs = 1.f / sqrtf(var + 64e-5f);
                float bon = 0.f; for (int n = 0; n < 64; ++n) bon += C.R[b0 + n] * (C.KD[b0 + n] + C.KD[b1 + n]) * r_k[h * 64 + n];
                for (int n = 0; n < 64; ++n) { int c = h * 64 + n; float y = (C.Y[b0 + n] + C.Y[b1 + n] - mu_) * rs * gn_g[c] + gn_b[c]; C.YCAT[(size_t)row * 1024 + c] = (y + bon * C.V[b0 + n]) * C.G[b0 + n]; } });
            NLAUNCH((long)NT * HG_HEADS, [=] HD(long i) { int row = (int)(i / HG_HEADS), h = (int)(i % HG_HEADS); size_t b0 = (size_t)row * 512 + h * 128, b1 = ((size_t)NT_ + row) * 512 + h * 128;
                float ss = 0.f; for (int n = 0; n < 128; ++n) { float o = C.OP[(b0 + n) * 2] + C.OP[(b0 + n) * 2 + 1] + C.OP[(b1 + n) * 2] + C.OP[(b1 + n) * 2 + 1]; ss += o * o; }
                float rs = 1.f / sqrtf(ss / 128.f + 1e-6f);
                for (int n = 0; n < 128; ++n) { int c = h * 128 + n; float o = (C.OP[(b0 + n) * 2] + C.OP[(b0 + n) * 2 + 1] + C.OP[(b1 + n) * 2] + C.OP[(b1 + n) * 2 + 1]) * rs * hgn[c]; C.YCAT[(size_t)row * 1024 + 512 + c] = o * siluf_(C.Z[(size_t)row * EVEN_IN + RW_IN + 2048 + c]); } });
            DENSE_GEMM(C.YCAT, 1024, 1024, 1024, C.WoutE + (size_t)j2 * 1024 * 1024, C.ev_w_out + (size_t)j2 * 1024 * D, D_MODEL, C.YO, D_MODEL, NT_, D_MODEL, 1024);
}
FWD_QUAL void naive_scans(FWD_SIG, long layer) {
    const long j2 = layer / 2; (void)j2;
            NLAUNCH((long)2 * BATCH * RW_HEADS * 64, [=] HD(long i) { int v = (int)(i % 64); long t = i / 64; int h = (int)(t % RW_HEADS); t /= RW_HEADS; int b = (int)(t % BATCH); int d = (int)(t / BATCH);
                float S[64];
_Pragma("unroll")
                for (int k = 0; k < 64; ++k) S[k] = 0.f;
                for (int st = 0; st < TT_; ++st) { int row = tokrow(b, scan_pos(d, st)); size_t s0 = (size_t)row * 512 + h * 64, s1 = ((size_t)d * NT_ + row) * 512 + h * 64;
                    float sa = 0.f;
_Pragma("unroll")
                    for (int k = 0; k < 64; ++k) { sa += S[k] * C.NKK[s0 + k]; MEMFENCE_EVERY(k, 16); }
                    float vv = C.V[s0 + v], y = 0.f;
_Pragma("unroll")
                    for (int k = 0; k < 64; ++k) { S[k] = S[k] * C.DEC[s1 + k] + sa * C.BB[s1 + k] + vv * C.KD[s1 + k]; y += S[k] * C.R[s0 + k]; MEMFENCE_EVERY(k, 8); }
                    C.Y[s1 + v] = y; } });
            NLAUNCH((long)2 * BATCH * HG_HEADS * 128 * 2, [=] HD(long i) { int kh = (int)(i & 1); int v = (int)((i >> 1) % 128); long t = (i >> 1) / 128; int h = (int)(t % HG_HEADS); t /= HG_HEADS; int b = (int)(t % BATCH); int d = (int)(t / BATCH);
                float S[64];
_Pragma("unroll")
                for (int k = 0; k < 64; ++k) S[k] = 0.f;
                for (int st = 0; st < TT_; ++st) { int row = tokrow(b, scan_pos(d, st)); size_t s0 = (size_t)row * 512 + h * 128 + kh * 64, s1 = ((size_t)d * NT_ + row) * 512 + h * 128 + kh * 64;
                    float val = C.Z[(size_t)row * EVEN_IN + RW_IN + 1536 + h * 128 + v], o = 0.f;
_Pragma("unroll")
                    for (int k = 0; k < 64; ++k) { S[k] = C.HF[s1 + k] * S[k] + C.HK[s1 + k] * val; o += S[k] * C.HQ[s0 + k]; MEMFENCE_EVERY(k, 16); }
                    C.OP[(((size_t)d * NT_ + row) * 512 + h * 128 + v) * 2 + kh] = o; } });
}
FWD_QUAL void naive_scan_hgrn(FWD_SIG, long layer) {
    const long j2 = layer / 2; (void)j2;
            NLAUNCH((long)2 * BATCH * HG_HEADS * 128 * 2, [=] HD(long i) { int kh = (int)(i & 1); int v = (int)((i >> 1) % 128); long t = (i >> 1) / 128; int h = (int)(t % HG_HEADS); t /= HG_HEADS; int b = (int)(t % BATCH); int d = (int)(t / BATCH);
                float S[64];
_Pragma("unroll")
                for (int k = 0; k < 64; ++k) S[k] = 0.f;
                for (int st = 0; st < TT_; ++st) { int row = tokrow(b, scan_pos(d, st)); size_t s0 = (size_t)row * 512 + h * 128 + kh * 64, s1 = ((size_t)d * NT_ + row) * 512 + h * 128 + kh * 64;
                    float val = C.Z[(size_t)row * EVEN_IN + RW_IN + 1536 + h * 128 + v], o = 0.f;
_Pragma("unroll")
                    for (int k = 0; k < 64; ++k) { S[k] = C.HF[s1 + k] * S[k] + C.HK[s1 + k] * val; o += S[k] * C.HQ[s0 + k]; MEMFENCE_EVERY(k, 16); }
                    C.OP[(((size_t)d * NT_ + row) * 512 + h * 128 + v) * 2 + kh] = o; } });
}
FWD_QUAL void naive_odd(FWD_SIG, long layer) {
    const int D = D_MODEL, NT = NT_, NC = NC_; (void)D; (void)NT; (void)NC;
    const bool need_ctx = layer < DEPTH - 1; const long j2 = layer / 2; (void)need_ctx; (void)j2;
            DENSE_GEMM_UB(C.U, D_MODEL, D_MODEL, 1024, C.WinO + (size_t)j2 * 512 * 1024, C.od_w_in + (size_t)j2 * D * MLA_IN, MLA_IN, C.Z, EVEN_IN, NT_, MLA_IN, 512);
#define qng (C.mla_q_norm_g + (size_t)j2 * MLA_QR)
#define kvng (C.mla_kv_norm_g + (size_t)j2 * MLA_KVR)
            NLAUNCH((long)NT, [=] HD(long i) { int row = (int)i; const float* z = C.Z + (size_t)row * EVEN_IN;
                float ss = 0.f; for (int k = 0; k < MLA_QR; ++k) ss += z[k] * z[k]; float rs = 1.f / sqrtf(ss / MLA_QR + 1e-6f);
                for (int k = 0; k < MLA_QR; ++k) C.QN[(size_t)row * MLA_QR + k] = z[k] * rs * qng[k];
                ss = 0.f; for (int k = 0; k < MLA_KVR; ++k) ss += z[MLA_QR + k] * z[MLA_QR + k]; rs = 1.f / sqrtf(ss / MLA_KVR + 1e-6f);
                for (int k = 0; k < MLA_KVR; ++k) C.KVN[(size_t)row * MLA_KVR + k] = z[MLA_QR + k] * rs * kvng[k];
                const float* kp = z + MLA_QR + MLA_KVR; float* o = C.KPE + (size_t)row * 32;
                if (row < NC_) { for (int k = 0; k < 32; ++k) o[k] = kp[k]; }
                else { int s = (row - NC_) % SEQ; float fr = (float)(s / GRID_W), fc = (float)(s % GRID_W);
                    for (int q = 0; q < 8; ++q) { float inv = powf(10000.f, -(float)(2 * q) / 16.f); float ar = fr * inv, ac = fc * inv; float cr = cosf(ar), sr = sinf(ar), cc = cosf(ac), sc = sinf(ac);
                        o[q] = kp[q] * cr - kp[8 + q] * sr; o[8 + q] = kp[8 + q] * cr + kp[q] * sr; o[16 + q] = kp[16 + q] * cc - kp[24 + q] * sc; o[24 + q] = kp[24 + q] * cc + kp[16 + q] * sc; } } });
            DENSE_GEMM(C.QN, MLA_QR, MLA_QR, 256, C.Wqb + (size_t)j2 * 1536 * 256, C.mla_w_qb + (size_t)j2 * MLA_QR * 1536, 1536, C.Q, 1536, NT_, 1536, 1536);
            DENSE_GEMM(C.KVN, MLA_KVR, MLA_KVR, 256, C.Wkvb + (size_t)j2 * 2048 * 256, C.mla_w_kvb + (size_t)j2 * MLA_KVR * 2048, 2048, C.KV, 2048, NT_, 2048, 2048);
            NLAUNCH((long)NL_ * MLA_HEADS * 8, [=] HD(long i) { int q = (int)(i % 8); long t = i / 8; int h = (int)(t % MLA_HEADS); int lr = (int)(t / MLA_HEADS); int s = lr % SEQ;
                float* p = C.Q + (size_t)(NC_ + lr) * 1536 + h * 96 + 64; float fr = (float)(s / GRID_W), fc = (float)(s % GRID_W);
                float inv = powf(10000.f, -(float)(2 * q) / 16.f); float ar = fr * inv, ac = fc * inv; float cr = cosf(ar), sr = sinf(ar), cc = cosf(ac), sc = sinf(ac);
                float r1 = p[q], r2 = p[8 + q], c1 = p[16 + q], c2 = p[24 + q];
                p[q] = r1 * cr - r2 * sr; p[8 + q] = r2 * cr + r1 * sr; p[16 + q] = c1 * cc - c2 * sc; p[24 + q] = c2 * cc + c1 * sc; });
#if defined(PERSISTENT)
            GRID_STRIDE_WAVES(i, (long)NT_ * (MLA_HEADS * 96 / 8)) { const long row = i / (MLA_HEADS * 96 / 8); const int c8 = (int)(i % (MLA_HEADS * 96 / 8)) * 8; const float* q = C.Q + row * 1536 + c8; const float sc = 0.14724445136f;
                u32x4 w; w.x = att::pk2(q[0] * sc, q[1] * sc); w.y = att::pk2(q[2] * sc, q[3] * sc); w.z = att::pk2(q[4] * sc, q[5] * sc); w.w = att::pk2(q[6] * sc, q[7] * sc); *(u32x4*)(C.QB + row * 1536 + c8) = w; }
            GRID_STRIDE_WAVES(i, (long)NT_ * MLA_HEADS * 20) { const int c8 = (int)(i % 20); const long rh = i / 20; const int h = (int)(rh % MLA_HEADS); const int row = (int)(rh / MLA_HEADS);
                int b, t; if (row < NC_) { b = row / CTX_LEN; t = row % CTX_LEN; } else { b = (row - NC_) / SEQ; t = CTX_LEN + (row - NC_) % SEQ; }
                const size_t kvrow = (size_t)(b * MLA_HEADS + h) * TT_ + t;
                const float* src = c8 < 8 ? C.KV + (size_t)row * 2048 + h * 128 + c8 * 8 : (c8 < 12 ? C.KPE + (size_t)row * 32 + (c8 - 8) * 8 : C.KV + (size_t)row * 2048 + h * 128 + 64 + (c8 - 12) * 8);
                u32x4 w; w.x = att::pk2(src[0], src[1]); w.y = att::pk2(src[2], src[3]); w.z = att::pk2(src[4], src[5]); w.w = att::pk2(src[6], src[7]);
                if (c8 < 12) *(u32x4*)(C.KB + kvrow * 96 + c8 * 8) = w; else *(u32x4*)(C.VB + kvrow * 64 + (c8 - 12) * 8) = w; }
            grid_sync(bar);
            att::attn_phase<false, 0>(lds, C.QB, C.KB, C.VB, C.AO, nullptr, need_ctx ? 1 : 0, wv_);
            grid_sync(bar);
#else
            const long row_lo = need_ctx ? 0 : NC;
            NLAUNCH((long)(NT - row_lo) * MLA_HEADS * 2, [=] HD(long i) { const int nrows_ = NT_ - (int)row_lo; int hv = (int)(i / nrows_); int row = (int)row_lo + (int)(i % nrows_); const int h = hv >> 1, vh = hv & 1;
                int b, nkeys; if (row < NC_) { b = row / CTX_LEN; nkeys = CTX_LEN; } else { b = (row - NC_) / SEQ; nkeys = TT_; }
                float q[96];
_Pragma("unroll")
                for (int k = 0; k < 96; ++k) q[k] = C.Q[(size_t)row * 1536 + h * 96 + k];
                float o[32];
_Pragma("unroll")
                for (int k = 0; k < 32; ++k) o[k] = 0.f;
                float m = -1e30f, l = 0.f; const float scale = 0.10206207261596577f;
                for (int t = 0; t < nkeys; ++t) { int kr = tokrow(b, t); const float* kn = C.KV + (size_t)kr * 2048 + h * 128; const float* kp = C.KPE + (size_t)kr * 32;
                    float s = 0.f;
_Pragma("unroll")
                    for (int k = 0; k < 64; ++k) { s += q[k] * kn[k]; MEMFENCE_EVERY(k, 16); }
_Pragma("unroll")
                    for (int k = 0; k < 32; ++k) { s += q[64 + k] * kp[k]; MEMFENCE_EVERY(k, 16); }
                    s *= scale; float mn = fmaxf(m, s); float corr = expf(m - mn), p = expf(s - mn); l = l * corr + p;
_Pragma("unroll")
                    for (int k = 0; k < 32; ++k) { o[k] = o[k] * corr + p * kn[64 + vh * 32 + k]; MEMFENCE_EVERY(k, 16); }
                    m = mn; }
                float il = 1.f / l;
_Pragma("unroll")
                for (int k = 0; k < 32; ++k) C.AO[(size_t)row * 1024 + h * 64 + vh * 32 + k] = o[k] * il; });
#endif
            DENSE_GEMM(C.AO, 1024, 1024, 1024, C.WoutO + (size_t)j2 * 1024 * 1024, C.od_w_out + (size_t)j2 * 1024 * D, D_MODEL, C.YO, D_MODEL, NT_, D_MODEL, 1024);
}
FWD_QUAL void naive_common(FWD_SIG, long layer) {
#if defined(PERSISTENT)
    {
        const int row_lo = layer < DEPTH - 1 ? 0 : NC_, nrows = NT_ - row_lo;
#if CV_BACKGROUND
        if (layer > 0) cv_catchup(Cp_, layer, wv_);
#endif
#if CV_TAIL && !CV_BACKGROUND
        if (layer > 0) cv_catch(Cp_, lds, layer, wv_);
#endif
        tl::ln1_router(Cp_, lds, layer, row_lo, nrows, wv_); grid_sync(bar);
        tl::slots_gather(Cp_, layer, row_lo, nrows, wv_); grid_sync(bar);
        RP(REP_MOE,
        { g8::MoeSched S_; S_.init(C.UB, C.Wgu + (size_t)layer * N_EXPERTS * 2 * EXPERT_DIM * D_MODEL, D_MODEL, 2 * EXPERT_DIM, N_EXPERTS, (const LAS int*)tl::tl_tstart, gridDim.x, moe_remap(opaque_bid(), gridDim.x, 2 * EXPERT_DIM / 256)); S_.gather = true; MOE_SET_CHUNK
          LAS int* gtab = (LAS int*)(lds + 131072);
          { const int t_ = otid(wv_); const GAS int* tok_ = (const GAS int*)C.TOKOF; int gv_[20];
            _Pragma("unroll") for (int i_ = 0; i_ < 20; ++i_) { const long L_ = S_.unit(i_); const int rt_ = (int)((L_ < 0 ? 0 : L_) / S_.NCT); gv_[i_] = (L_ >= 0 && t_ < 256) ? tok_[(size_t)rt_ * 256 + t_] : 0; }
            _Pragma("unroll") for (int i_ = 0; i_ < 20; ++i_) { const long L_ = S_.unit(i_); if (L_ >= 0 && t_ < 256) gtab[i_ * 256 + t_] = gv_[i_]; } }
          __syncthreads();
          g8::EpiSwiGLU E_{C.ACTB, C.moe_b_gu + (size_t)layer * N_EXPERTS * 2 * EXPERT_DIM, EXPERT_DIM}; g8::gemm_phase<D_MODEL, g8::EpiSwiGLU, g8::MoeSched, true>(lds, S_, E_, wv_, gtab, CV_CTX);
#if CV_TAIL && !CV_BACKGROUND
          if (layer < DEPTH - 1) cv_tail(Cp_, lds, S_, wv_);
#endif
          }
        grid_sync(bar);
        { g8::MoeSched S_; S_.init(C.ACTB, C.Wdn + (size_t)layer * N_EXPERTS * D_MODEL * EXPERT_DIM, EXPERT_DIM, D_MODEL, N_EXPERTS, (const LAS int*)tl::tl_tstart, gridDim.x, moe_remap(opaque_bid(), gridDim.x, D_MODEL / 256)); MOE_SET_CHUNK
          g8::EpiDownBf16 E_{C.OUT2B, D_MODEL, C.moe_b_down + (size_t)layer * N_EXPERTS * D_MODEL}; g8::gemm_phase<EXPERT_DIM, g8::EpiDownBf16, g8::MoeSched>(lds, S_, E_, wv_, nullptr, CV_CTX);
#if CV_TAIL && !CV_BACKGROUND
          if (layer < DEPTH - 1) cv_tail(Cp_, lds, S_, wv_);
#endif
          }
        grid_sync(bar);
        )
        tl::combine_ln2(Cp_, layer, row_lo, nrows, wv_); grid_sync(bar);
    }
#else

    const int D = D_MODEL, NT = NT_, NC = NC_; (void)D; (void)NT; (void)NC;
    const bool need_ctx = layer < DEPTH - 1; const long j2 = layer / 2; (void)need_ctx; (void)j2;
#define lng0 (C.ln_g + ((size_t)layer * 2 + 0) * D_MODEL)
#define lnb0 (C.ln_b + ((size_t)layer * 2 + 0) * D_MODEL)
#define lng1 (C.ln_g + ((size_t)layer * 2 + 1) * D_MODEL)
#define lnb1 (C.ln_b + ((size_t)layer * 2 + 1) * D_MODEL)
        const long row_lo = need_ctx ? 0 : NC;
        NLAUNCH((long)(NT - row_lo), [=] HD(long i) { int row = (int)row_lo + (int)i; const float* m = MODL + (size_t)modrow(row) * N_MOD * D_MODEL; float* h = C.H + (size_t)row * D_MODEL; const float* yo = C.YO + (size_t)row * D_MODEL;
            float mu_ = 0.f; for (int d = 0; d < D_MODEL; ++d) mu_ += ALPHA * h[d] + m[2 * D_MODEL + d] * yo[d]; mu_ /= D_MODEL;
            float var = 0.f; for (int d = 0; d < D_MODEL; ++d) { float t = ALPHA * h[d] + m[2 * D_MODEL + d] * yo[d] - mu_; var += t * t; } var /= D_MODEL;
            float rs = 1.f / sqrtf(var + 1e-5f);
            for (int d = 0; d < D_MODEL; ++d) { float t = (ALPHA * h[d] + m[2 * D_MODEL + d] * yo[d] - mu_) * rs * lng0[d] + lnb0[d]; h[d] = t; C.U[(size_t)row * D_MODEL + d] = t * (1.f + m[4 * D_MODEL + d]) + m[3 * D_MODEL + d]; } });
#define wr (C.moe_w_router + (size_t)layer * D_MODEL * N_EXPERTS)
#define br (C.moe_b_router + (size_t)layer * N_EXPERTS)
        NLAUNCH((long)(NT - row_lo) * N_EXPERTS, [=] HD(long i) { int e = (int)(i % N_EXPERTS); int row = (int)row_lo + (int)(i / N_EXPERTS); const float* u = C.U + (size_t)row * D_MODEL;
            float s = 0.f; for (int k = 0; k < D_MODEL; ++k) s += u[k] * wr[(size_t)k * N_EXPERTS + e]; C.LOGIT[(size_t)row * N_EXPERTS + e] = s + br[e]; });
#define CNTL (C.CNT + layer * 64)
#define CURL (C.CUR + layer * 64)
        NLAUNCH((long)(NT - row_lo), [=] HD(long i) { int row = (int)row_lo + (int)i; const float* lg = C.LOGIT + (size_t)row * N_EXPERTS; int idx[TOP_K]; float val[TOP_K];
            for (int k = 0; k < TOP_K; ++k) { int best = -1; float bv = -3.4e38f; for (int e = 0; e < N_EXPERTS; ++e) { bool used = false; for (int q = 0; q < k; ++q) used |= (idx[q] == e); if (!used && lg[e] > bv) { bv = lg[e]; best = e; } } idx[k] = best; val[k] = bv; }
            float den = 0.f; for (int k = 0; k < TOP_K; ++k) den += expf(val[k] - val[0]);
            for (int k = 0; k < TOP_K; ++k) { C.TOPI[(size_t)row * TOP_K + k] = idx[k]; C.TOPG[(size_t)row * TOP_K + k] = expf(val[k] - val[0]) / den;
#ifdef HOST_TEST
                CNTL[idx[k]]++;
#else
                atomicAdd(&CNTL[idx[k]], 1);
#endif
            } });
        NLAUNCH(1, [=] HD(long) { int off = 0; for (int e = 0; e < N_EXPERTS; ++e) { C.OFF[e] = off; const int cnt = ld_cnt(CNTL + e); int nt = (cnt + MOE_PAD - 1) / MOE_PAD * MOE_PAD; for (int t = 0; t < nt / 64; ++t) C.TILE_E[off / 64 + t] = (t * 64 < cnt) ? e : -1; off += nt; }
            for (int t = off / 64; t < NSLOT_ / 64; ++t) C.TILE_E[t] = -1; });
        NLAUNCH((long)NSLOT_, [=] HD(long i) { C.TOKOF[i] = -1; });
        NLAUNCH((long)(NT - row_lo) * TOP_K, [=] HD(long i) { int row = (int)row_lo + (int)(i / TOP_K); int k = (int)(i % TOP_K); int e = C.TOPI[(size_t)row * TOP_K + k];
#ifdef HOST_TEST
            int r = CURL[e]++;
#else
            int r = atomicAdd(&CURL[e], 1);
#endif
            int s = C.OFF[e] + r; C.SLOT[(size_t)row * TOP_K + k] = s; C.TOKOF[s] = row; });
#if defined(PERSISTENT)
        {
            __shared__ int tstart_s[40];
            if (otid(wv_) == 0) { int acc_t = 0; for (int e = 0; e < N_EXPERTS; ++e) { tstart_s[e] = acc_t; acc_t += (ld_cnt(CNTL + e) + MOE_PAD - 1) / MOE_PAD; } tstart_s[N_EXPERTS] = acc_t; }
            GRID_STRIDE_WAVES(i, (long)NSLOT_ * (D_MODEL / 8)) { const long sl = i / (D_MODEL / 8); const int c8 = (int)(i % (D_MODEL / 8)) * 8; const int tk = C.TOKOF[sl]; u32x4 w = (u32x4){0u, 0u, 0u, 0u};
                if (tk >= 0) { const float4 a = *(const float4*)(C.U + (size_t)tk * D_MODEL + c8), b = *(const float4*)(C.U + (size_t)tk * D_MODEL + c8 + 4);
                    w.x = cvt_pk_bf16(a.x, a.y); w.y = cvt_pk_bf16(a.z, a.w); w.z = cvt_pk_bf16(b.x, b.y); w.w = cvt_pk_bf16(b.z, b.w); }
                *(u32x4*)(C.XPB + sl * D_MODEL + c8) = w; }
            grid_sync(bar);
            { g8::MoeSched S_; S_.init(C.XPB, C.Wgu + (size_t)layer * N_EXPERTS * 2 * EXPERT_DIM * D_MODEL, D_MODEL, 2 * EXPERT_DIM, N_EXPERTS, (const LAS int*)tstart_s, gridDim.x, opaque_bid());
              g8::EpiSwiGLU E_{C.ACTB, C.moe_b_gu + (size_t)layer * N_EXPERTS * 2 * EXPERT_DIM, EXPERT_DIM}; g8::gemm_phase<D_MODEL, g8::EpiSwiGLU, g8::MoeSched>(lds, S_, E_, wv_); }
            grid_sync(bar);
            { g8::MoeSched S_; S_.init(C.ACTB, C.Wdn + (size_t)layer * N_EXPERTS * D_MODEL * EXPERT_DIM, EXPERT_DIM, D_MODEL, N_EXPERTS, (const LAS int*)tstart_s, gridDim.x, opaque_bid());
              g8::EpiDownF32 E_{C.OUT2, D_MODEL, C.moe_b_down + (size_t)layer * N_EXPERTS * D_MODEL}; g8::gemm_phase<EXPERT_DIM, g8::EpiDownF32, g8::MoeSched>(lds, S_, E_, wv_); }
            grid_sync(bar);
        }
#else
        const int F = EXPERT_DIM;
        ngemm(C.U, D, C.TOKOF, C.moe_w_gu + (size_t)layer * N_EXPERTS * D * 2 * F, (long)D * 2 * F, 2 * F, C.moe_b_gu + (size_t)layer * N_EXPERTS * 2 * F, 2 * F, C.H1, 2 * F, NSLOT_, 2 * F, D, C.TILE_E);
        NLAUNCH((long)NSLOT_ * F, [=] HD(long i) { long s = i / EXPERT_DIM; int j = (int)(i % EXPERT_DIM); if (C.TOKOF[s] < 0) { C.ACT[i] = 0.f; return; }
            float glu = fminf(C.H1[s * 2 * EXPERT_DIM + j], 7.f), lin = fminf(fmaxf(C.H1[s * 2 * EXPERT_DIM + EXPERT_DIM + j], -7.f), 7.f);
            C.ACT[i] = glu * sigmoidf_(1.702f * glu) * (lin + 1.f); });
        ngemm(C.ACT, F, nullptr, C.moe_w_down + (size_t)layer * N_EXPERTS * F * D, (long)F * D, D, C.moe_b_down + (size_t)layer * N_EXPERTS * D, D, C.OUT2, D, NSLOT_, D, F, C.TILE_E);
#endif
#define outp (C.out)
        const long last = (layer == DEPTH - 1);
        NLAUNCH((long)(NT - row_lo), [=] HD(long i) { int row = (int)row_lo + (int)i; const float* m = MODL + (size_t)modrow(row) * N_MOD * D_MODEL; float* h = C.H + (size_t)row * D_MODEL;
            const int* sl = C.SLOT + (size_t)row * TOP_K; const float* tg = C.TOPG + (size_t)row * TOP_K;
            float mu_ = 0.f; for (int d = 0; d < D_MODEL; ++d) { float f = 0.f; for (int k = 0; k < TOP_K; ++k) f += tg[k] * C.OUT2[(size_t)sl[k] * D_MODEL + d]; mu_ += ALPHA * h[d] + m[5 * D_MODEL + d] * f; } mu_ /= D_MODEL;
            float var = 0.f; for (int d = 0; d < D_MODEL; ++d) { float f = 0.f; for (int k = 0; k < TOP_K; ++k) f += tg[k] * C.OUT2[(size_t)sl[k] * D_MODEL + d]; float t = ALPHA * h[d] + m[5 * D_MODEL + d] * f - mu_; var += t * t; } var /= D_MODEL;
            float rs = 1.f / sqrtf(var + 1e-5f);
            for (int d = 0; d < D_MODEL; ++d) { float f = 0.f; for (int k = 0; k < TOP_K; ++k) f += tg[k] * C.OUT2[(size_t)sl[k] * D_MODEL + d]; float t = (ALPHA * h[d] + m[5 * D_MODEL + d] * f - mu_) * rs * lng1[d] + lnb1[d]; h[d] = t; if (last) outp[(size_t)(row - NC_) * D_MODEL + d] = t; } });
#endif
}


#if defined(PERSISTENT)
#define MG_DENSE(KP, EPI, Aptr, Wptr, Mrows, NP, ...) do { g8::DenseSched S_; S_.init((Aptr), (Wptr), (Mrows), (NP), (KP), gridDim.x, opaque_bid()); g8::EPI E_{__VA_ARGS__}; g8::gemm_phase<(KP), g8::EPI, g8::DenseSched>(lds, S_, E_, wv_, nullptr, CV_CTX); } while (0)
FWD_QUAL void mega_even(FWD_SIG, long layer) {
    const long j2 = layer / 2;
    RP(REP_DEN, MG_DENSE(1024, EpiBf16, C.UB, C.WinE + (size_t)j2 * 4608 * 1024, NT_, 4608, C.ZB, 4608, 1.f); grid_sync(bar);)
    RP(REP_TLE, tl::rw_tw(Cp_, layer, wv_); grid_sync(bar);)
    RP(REP_DEN, { g8::LoraSched S_; S_.init(C.TW, C.Wlora + (size_t)j2 * 2560 * 384, NT_, 2560, 384, gridDim.x, opaque_bid()); g8::EpiBf16 E_{C.LOB, 2560, 1.f}; g8::gemm_phase<256, g8::EpiBf16, g8::LoraSched, false, 384>(lds, S_, E_, wv_, nullptr, CV_CTX); } grid_sync(bar);)
    RP(REP_TLE, tl::rw_prep(Cp_, layer, wv_); grid_sync(bar);)
    RP(REP_RWS, rwc::rwkv_chunk_scan(Cp_, lds, wv_);)
    RP(REP_HGS, hg::hgrn_scan(Cp_, lds, layer, wv_); grid_sync(bar);)
    RP(REP_TLE, tl::even_post(Cp_, layer, wv_); grid_sync(bar);)
    RP(REP_DEN, MG_DENSE(1024, EpiBf16, C.YCATB, C.WoutE + (size_t)j2 * 1024 * 1024, NT_, 1024, C.YOB, D_MODEL, 1.f); grid_sync(bar);)
}
FWD_QUAL void mega_odd(FWD_SIG, long layer) {
    const long j2 = layer / 2; const bool need_ctx = layer < DEPTH - 1;
    RP(REP_DEN, MG_DENSE(1024, EpiF32, C.UB, C.WinO + (size_t)j2 * 512 * 1024, NT_, 512, C.Z, 512, 512); grid_sync(bar);)
    RP(REP_TLE, tl::mla_prep(Cp_, layer, wv_); grid_sync(bar);)
    const size_t r0 = need_ctx ? 0 : (size_t)NC_; const int mq = need_ctx ? NT_ : NT_ - NC_;
    RP(REP_DEN, MG_DENSE(256, EpiBf16, C.QNB + r0 * 256, C.Wqb + (size_t)j2 * 1536 * 256, mq, 1536, C.QB + r0 * 1536, 1536, 0.14724445136f);)
    RP(REP_DEN, MG_DENSE(256, EpiBf16, C.KVNB, C.Wkvb + (size_t)j2 * 2048 * 256, NT_, 2048, C.KVB, 2048, 1.f); grid_sync(bar);)
    RP(REP_ATT, att::attn_phase<true, 1>(lds, C.QB, C.KVB, C.KPEB, nullptr, C.AOB, need_ctx ? 1 : 0, wv_, C.ROPE); grid_sync(bar);)
    RP(REP_DEN, MG_DENSE(1024, EpiBf16, C.AOB + r0 * 1024, C.WoutO + (size_t)j2 * 1024 * 1024, mq, 1024, C.YOB + r0 * D_MODEL, D_MODEL, 1.f); grid_sync(bar);)
}
#endif
FWD_QUAL void naive_forward(FWD_SIG) {
#if defined(PERSISTENT)
    RP(REP_PRO, naive_prologue(FWD_ARGS);)
#else
    naive_prologue(FWD_ARGS);
#endif
#if defined(PERSISTENT)
    mega_even(FWD_ARGS, 0); naive_common(FWD_ARGS, 0);
    mega_odd(FWD_ARGS, 1); naive_common(FWD_ARGS, 1);
    mega_even(FWD_ARGS, 2); naive_common(FWD_ARGS, 2);
    mega_odd(FWD_ARGS, 3); naive_common(FWD_ARGS, 3);
#else
    for (long p = 0; p < DEPTH / 2; ++p) {
        naive_modu(FWD_ARGS, 2 * p); naive_even(FWD_ARGS, 2 * p); naive_common(FWD_ARGS, 2 * p);
        naive_modu(FWD_ARGS, 2 * p + 1); naive_odd(FWD_ARGS, 2 * p + 1); naive_common(FWD_ARGS, 2 * p + 1);
    }
#endif
}

#undef MODL
#undef mu
#undef w0
#undef w2
#undef a0
#undef a2
#undef g2
#undef k_k
#undef k_a
#undef r_k
#undef gn_g
#undef gn_b
#undef lbp
#undef hgn
#undef qng
#undef kvng
#undef lng0
#undef lnb0
#undef lng1
#undef lnb1
#undef wr
#undef br
#undef CNTL
#undef CURL
#undef outp

#ifdef PERSIST_C_MACRO
#undef C
#endif
struct Params { NaiveCtx C; unsigned* bar; };
__global__ void __launch_bounds__(PB_THREADS, 2) mega_fwd(Params p) {
    extern __shared__ __attribute__((aligned(16))) unsigned char dyn_lds[];
    __shared__ NaiveCtx sC;
    __shared__ uint4 xb_words;
    typedef unsigned long long u64;
    const __attribute__((address_space(4))) u64* ka = (const __attribute__((address_space(4))) u64*)__builtin_amdgcn_kernarg_segment_ptr();
    constexpr int NW = (int)(sizeof(NaiveCtx) / 8);
    if (threadIdx.x < NW) ((LAS u64*)&sC)[threadIdx.x] = ka[threadIdx.x];
    if (threadIdx.x == 0) xb_words = make_uint4(0u, 0u, 0u, 0u);
    __syncthreads();
    unsigned* barp = (unsigned*)ka[NW];
    XcdBarrier bar = xcd_barrier_post(barp, (volatile LAS unsigned*)&xb_words);
    naive_forward((const LAS NaiveCtx*)&sC, bar, (LAS unsigned char*)dyn_lds, __builtin_amdgcn_readfirstlane(threadIdx.x >> 6));
}
extern "C" void kernel_launch(void* const* d_in, const int* in_sizes, int n_in, void* d_out, int out_size, void* d_ws, size_t ws_size, hipStream_t stream) {
    static int grid = 0;
    constexpr size_t kDynLds = 152 * 1024;
    if (grid == 0) {
        int dev = 0, cus = 0, per_cu = 0;
        hipGetDevice(&dev); hipDeviceGetAttribute(&cus, hipDeviceAttributeMultiprocessorCount, dev);
        hipFuncSetAttribute((const void*)mega_fwd, hipFuncAttributeMaxDynamicSharedMemorySize, (int)kDynLds);
        hipOccupancyMaxActiveBlocksPerMultiprocessor(&per_cu, (const void*)mega_fwd, PB_THREADS, kDynLds);
        if (per_cu < 1) { fprintf(stderr, "kernel_launch: occupancy query says %d blocks per CU\n", per_cu); grid = -1; return; }
        grid = cus;
    }
    if (grid < 0) return;
    Params p; memset(&p, 0, sizeof(p));
    const float** ip = (const float**)&p.C.x; for (int i = 0; i < 35; ++i) ip[i] = (const float*)d_in[i];
    p.C.out = (float*)d_out;
    const size_t ctl_bytes = 64 * 1024;
    p.bar = (unsigned*)d_ws;
    size_t need = ctl_bytes + mega_carve(p.C, (char*)d_ws + ctl_bytes);
    if (n_in != 35 || need > ws_size) { fprintf(stderr, "kernel_launch: n_in %d ws need %zu have %zu\n", n_in, need, ws_size); return; }
    hipMemsetAsync(d_ws, 0, ctl_bytes, stream);
    hipMemsetAsync(p.C.CNT, 0, 64 * DEPTH * 4 * 2 + 512, stream);
    hipLaunchKernelGGL(mega_fwd, dim3(grid), dim3(PB_THREADS), kDynLds, stream, p);
}
```

```cpp
#include <hip/hip_runtime.h>
#include <cstdio>
#include <cstring>
#include <cmath>
#define PERSISTENT 1

#define PB_THREADS 512
#define XB_TMO      128
#define XB_XCNT(j)  (256  + 64 * (j))
#define XB_XSUB(j)  (1280 + 64 * (j))
#define XB_XGEN(j)  (2304 + 64 * (j))
#define XB_TOP      3328
#define XB_TOPGEN   3392
#define XCD_BAR_WORDS 3456
#define XB_SPIN_CAP (1u << 22)
#define LAS __attribute__((address_space(3)))

__device__ __forceinline__ unsigned xb_ld(unsigned* p)              { return __hip_atomic_load(p, __ATOMIC_RELAXED, __HIP_MEMORY_SCOPE_AGENT); }
__device__ __forceinline__ unsigned xb_add(unsigned* p, unsigned v) { return __hip_atomic_fetch_add(p, v, __ATOMIC_RELAXED, __HIP_MEMORY_SCOPE_AGENT); }
__device__ __forceinline__ unsigned xb_xcc_id() { return (unsigned)__builtin_amdgcn_s_getreg((3 << 11) | 20) & 0xFu; }
#define XB_SPIN(cond, bar) do { unsigned _sp = 0; while (cond) { __builtin_amdgcn_s_sleep(1); \
    if ((++_sp & 255u) == 0u) { if (xb_ld(&(bar)[XB_TMO])) break; if (_sp > XB_SPIN_CAP) { atomicAdd(&(bar)[XB_TMO], 1u); break; } } } } while (0)

struct XcdBarrier {
    unsigned* bar; unsigned x;
    volatile LAS unsigned* st;
};

__device__ __forceinline__ XcdBarrier xcd_barrier_post(unsigned* bar, volatile LAS unsigned* st) {
    XcdBarrier b; b.bar = bar; b.x = xb_xcc_id(); b.st = st;
    if (threadIdx.x == 0) (void)xb_add(&bar[XB_XCNT(b.x)], 1u);
    return b;
}
__device__ __forceinline__ void xcd_barrier_complete(unsigned* bar, unsigned x, unsigned& nloc, unsigned& nx) {
    const unsigned G = gridDim.x * gridDim.y * gridDim.z;
    unsigned sum, cnt, mine, sp = 0u;
    for (;;) {
        sum = 0u; cnt = 0u; mine = 0u;
#pragma unroll
        for (unsigned j = 0; j < 16; ++j) { const unsigned c = xb_ld(&bar[XB_XCNT(j)]); sum += c; cnt += (c > 0u) ? 1u : 0u; mine = (j == x) ? c : mine; }
        if (sum == G) break;
        __builtin_amdgcn_s_sleep(1);
        if ((++sp & 255u) == 0u) { if (xb_ld(&bar[XB_TMO])) break; if (sp > XB_SPIN_CAP) { atomicAdd(&bar[XB_TMO], 1u); break; } }
    }
    nloc = mine > 0u ? mine : 1u; nx = cnt > 0u ? cnt : 1u;
}

__device__ __forceinline__ void xcd_barrier(const XcdBarrier& b) {
    asm volatile("s_waitcnt vmcnt(0)" ::: "memory");
    __syncthreads();
    if (threadIdx.x == 0) {
        unsigned* bar = b.bar;
        __builtin_amdgcn_s_waitcnt(0);
        unsigned nloc = b.st[0], nx = b.st[1];
        if (nloc == 0u) { xcd_barrier_complete(bar, b.x, nloc, nx); b.st[0] = nloc; b.st[1] = nx; }
        const unsigned old = xb_add(&bar[XB_XSUB(b.x)], 1u);
        const unsigned gen = old / nloc;
        if (old + 1u == (gen + 1u) * nloc) {
            __builtin_amdgcn_fence(__ATOMIC_RELEASE, "agent");
            asm volatile("s_waitcnt vmcnt(0)" ::: "memory");
            const unsigned og = xb_add(&bar[XB_TOP], 1u);
            const unsigned tg = og / nx;
            if (og + 1u == (tg + 1u) * nx) xb_add(&bar[XB_TOPGEN], 1u);
            else XB_SPIN(xb_ld(&bar[XB_TOPGEN]) == tg, bar);
            __builtin_amdgcn_fence(__ATOMIC_ACQUIRE, "agent");
            xb_add(&bar[XB_XGEN(b.x)], 1u);
            asm volatile("s_waitcnt vmcnt(0)" ::: "memory");
        } else {
            XB_SPIN(xb_ld(&bar[XB_XGEN(b.x)]) == gen, bar);
            __builtin_amdgcn_fence(__ATOMIC_ACQUIRE, "agent");
            asm volatile("s_waitcnt vmcnt(0)" ::: "memory");
        }
    }
    __syncthreads();
}
typedef unsigned short bf16_t;
typedef short bf16x8 __attribute__((ext_vector_type(8)));
typedef float f32x4 __attribute__((ext_vector_type(4)));
typedef unsigned u32x4 __attribute__((ext_vector_type(4)));
typedef unsigned u32x2 __attribute__((ext_vector_type(2)));
#define DI __device__ __forceinline__
#define GAS __attribute__((address_space(1)))
DI int opaque_bid() { int b = blockIdx.x; asm volatile("" : "+s"(b)); return b; }
DI int otid(int wv) { int l; asm volatile("v_mbcnt_lo_u32_b32 %0, -1, 0\n\tv_mbcnt_hi_u32_b32 %0, -1, %0" : "=v"(l) : "s"(wv)); return (wv << 6) | l; }
DI void grid_sync(const XcdBarrier& b) { XcdBarrier t = b; asm volatile("" : "+s"(t.bar), "+s"(t.x)); xcd_barrier(t); }
DI void lds_barrier() { asm volatile("s_waitcnt lgkmcnt(0)\n\ts_barrier" ::: "memory"); }
DI float fexp2(float x) { return __builtin_amdgcn_exp2f(x); }
DI float fexp(float x) { return __builtin_amdgcn_exp2f(x * 1.4426950408889634f); }
DI float flog2(float x) { return __builtin_amdgcn_logf(x); }
DI float flog(float x) { return __builtin_amdgcn_logf(x) * 0.6931471805599453f; }
DI float fsigmoid(float x) { return __builtin_amdgcn_rcpf(1.f + fexp(-x)); }
DI float fsilu(float x) { return x * fsigmoid(x); }
DI float ftanh(float x) { return 2.f * fsigmoid(2.f * x) - 1.f; }
DI float fsoftplus(float x) { return x > 20.f ? x : flog(1.f + fexp(x)); }
DI unsigned cvt_pk_bf16(float lo, float hi) { unsigned r; asm volatile("v_cvt_pk_bf16_f32 %0, %1, %2" : "=v"(r) : "v"(lo), "v"(hi)); return r; }
DI float bf_lo(unsigned w) { return __uint_as_float(w << 16); }
DI float bf_hi(unsigned w) { return __uint_as_float(w & 0xffff0000u); }
#ifndef REP_EPI
#define REP_EPI 1
#endif
struct NaiveCtx;
DI LAS int* cv_counter(const LAS NaiveCtx* Cp_);
DI bool cv_addr(const LAS NaiveCtx* Cp_, int T, int tid, const float*& sp, bf16_t*& dp, int& ld);
#ifndef CV_CARRY
#define CV_CARRY 1
#endif
#ifndef CV_NH
#define CV_NH 1
#endif
#define CV_LOADS(V, sp, ld) do { _Pragma("unroll") for (int i_ = 0; i_ < 4; ++i_) _Pragma("unroll") for (int h_ = 0; h_ < CV_NH; ++h_) V[i_][h_] = __builtin_nontemporal_load((const GAS f32x4*)((sp) + (size_t)i_ * (ld) + 4 * h_)); } while (0)
#define CV_STORES(V, dp) do { _Pragma("unroll") for (int j_ = 0; j_ < 4 * CV_NH; ++j_) { u32x2 w_; w_.x = cvt_pk_bf16(V[0][j_ >> 2][j_ & 3], V[1][j_ >> 2][j_ & 3]); w_.y = cvt_pk_bf16(V[2][j_ >> 2][j_ & 3], V[3][j_ >> 2][j_ & 3]); \
        *(GAS u32x2*)((dp) + (size_t)j_ * 1024) = w_; } } while (0)
namespace g8 {
constexpr int BM = 256, BK = 64, HALF = 128, HTB = HALF * BK * 2, STAGE_BYTES = 8 * HTB, NXCD = 8, WGM = 8;
__host__ __device__ __forceinline__ int lds_byte(int r, int c) { const int st = (r >> 4) * 2 + (c >> 5), rr = r & 15, cc = c & 31, ob = rr * 64 + cc * 2; return st * 1024 + (ob ^ (((ob >> 9) & 1) << 5)); }
__host__ __device__ __forceinline__ void stage_rc(int b, int& R, int& C) { const int st = b / 1024, sb = b % 1024, swz = sb ^ (((sb >> 9) & 1) << 5); R = (st >> 1) * 16 + swz / 64; C = (st & 1) * 32 + (swz % 64) / 2; }
__host__ __device__ __forceinline__ int perm32(int rho) { const int n = rho >> 4, i = rho & 15; return 8 * (i >> 2) + 4 * n + (i & 3); }
struct Unit { int pm, pn, e; };

struct DenseSched {
    const char* A; const char* Bt; size_t tstep; int nM, nN, nwg, G, c;
    DI void init(const bf16_t* A_, const bf16_t* Bt_, int M, int N, int K, int G_, int c_) { A = (const char*)A_; Bt = (const char*)Bt_; tstep = (size_t)BM * K * 2; nM = M / BM; nN = N / BM; nwg = nM * nN; G = G_; c = c_; }
    DI bool next(int i, Unit& u) const {
        const long L = (long)i * G + c; if (L >= nwg) return false;
        int wgid = (int)L; { const int q = nwg / NXCD, r = nwg % NXCD, xcd = wgid % NXCD, off = wgid / NXCD; wgid = (xcd < r ? xcd * (q + 1) : r * (q + 1) + (xcd - r) * q) + off; }
        const int nig = WGM * nN, gid = wgid / nig, fm = gid * WGM, gsz = (nM - fm) < WGM ? (nM - fm) : WGM;
        u.pm = fm + ((wgid % nig) % gsz); u.pn = (wgid % nig) / gsz; u.e = 0; return true;
    }
    DI const char* a(const Unit& u) const { return A + (size_t)u.pm * tstep; }
    DI const char* b(const Unit& u) const { return Bt + (size_t)u.pn * tstep; }
};

struct LoraSched : DenseSched {
    DI const char* a(const Unit& u) const { return A + (size_t)u.pm * tstep + (u.pn < 8 ? 0 : 256); }
    DI const char* b(const Unit& u) const { return Bt + (size_t)u.pn * tstep + (u.pn < 8 ? 0 : 256); }
};

struct EpiF32 {
    static constexpr bool PERM = false;
    float* C; int ldc; int ncols;
    DI void operator()(const f32x4 (&acc)[2][2][4][2], const Unit& u, int wr, int wc, int fr, int fq) const {
        const int row0 = u.pm * BM + wr * 64 + fr, col0 = u.pn * BM + wc * 32 + 4 * fq;
#pragma unroll
        for (int ai = 0; ai < 2; ++ai)
#pragma unroll
            for (int m = 0; m < 4; ++m) { float* rowp = C + (size_t)(row0 + ai * HALF + m * 16) * ldc + col0;
#pragma unroll
                for (int bj = 0; bj < 2; ++bj)
#pragma unroll
                    for (int n = 0; n < 2; ++n) if (col0 + bj * HALF + n * 16 < ncols) *(GAS f32x4*)(rowp + bj * HALF + n * 16) = acc[ai][bj][m][n]; }
    }
};


struct MoeSched {
    const char* A; const char* Bt; size_t tstep, bstride; const LAS int* tstart; int NCT, nE, nunits, G, c;
    DI void init(const bf16_t* A_, const bf16_t* Bt_, int K, int N, int nE_, const LAS int* tstart_, int G_, int c_) { A = (const char*)A_; Bt = (const char*)Bt_; tstep = (size_t)BM * K * 2; bstride = (size_t)N * K * 2; tstart = tstart_; NCT = N / BM; nE = nE_; nunits = tstart_[nE_] * NCT; G = G_; c = c_; }
    int cs = 0, cl = 0, jj = 0; bool chunk = false;
    DI void set_chunk(int craw) { if (G != 256) return; const int x = craw & 7, q = nunits / NXCD, r = nunits % NXCD; jj = craw >> 3; cs = x * q + (x < r ? x : r); cl = q + (x < r ? 1 : 0); chunk = true; }
    DI long unit(int i) const { if (chunk) { const int k = i * 32 + jj; return k < cl ? (long)cs + k : -1L; } const long L = (long)i * G + c; return L < nunits ? L : -1L; }
    DI bool next(int i, Unit& u) const {
        const long L = unit(i); if (L < 0) return false;
        const int rt = (int)(L / NCT); u.pm = rt; u.pn = (int)(L % NCT);
        const int ln_ = (int)__builtin_amdgcn_mbcnt_hi(~0u, __builtin_amdgcn_mbcnt_lo(~0u, 0u));
        const bool hit_ = (ln_ >= 1 && ln_ < nE) ? (tstart[ln_] <= rt) : false;
        u.e = (int)__builtin_popcountll(__ballot(hit_)); return true;
    }
    bool gather = false;
    DI const char* a(const Unit& u) const { return gather ? A : A + (size_t)u.pm * tstep; }
    DI const char* b(const Unit& u) const { return Bt + (size_t)u.e * bstride + (size_t)u.pn * tstep; }
};
struct EpiSwiGLU {
    static constexpr bool PERM = true;
    bf16_t* ACT; const float* bgu; int F;
    DI void operator()(const f32x4 (&acc)[2][2][4][2], const Unit& u, int wr, int wc, int fr, int fq) const {
        const int row0 = u.pm * BM + wr * 64 + fr, j0 = u.pn * HALF + wc * 32 + 8 * fq;
        const float* bp = bgu + (size_t)u.e * 2 * F + j0;
        f32x4 bg[2], bl[2];
#pragma unroll
        for (int n = 0; n < 2; ++n) { bg[n] = *(const GAS f32x4*)(bp + 4 * n); bl[n] = *(const GAS f32x4*)(bp + F + 4 * n); }
#pragma unroll
        for (int ai = 0; ai < 2; ++ai)
#pragma unroll
            for (int m = 0; m < 4; ++m) { float o[8];
#pragma unroll
                for (int n = 0; n < 2; ++n)
#pragma unroll
                    for (int j = 0; j < 4; j += 2) {
                        typedef float f32x2_ __attribute__((ext_vector_type(2)));
                        f32x2_ gl = (f32x2_){acc[ai][0][m][n][j], acc[ai][0][m][n][j + 1]} + (f32x2_){bg[n][j], bg[n][j + 1]};
                        f32x2_ li = (f32x2_){acc[ai][1][m][n][j], acc[ai][1][m][n][j + 1]} + (f32x2_){bl[n][j], bl[n][j + 1]};
                        gl = __builtin_elementwise_min(gl, (f32x2_){7.f, 7.f}); li = __builtin_elementwise_min(__builtin_elementwise_max(li, (f32x2_){-7.f, -7.f}), (f32x2_){7.f, 7.f});
                        const f32x2_ ex = gl * (f32x2_){-2.4554669595930156f, -2.4554669595930156f};
                        f32x2_ den; den.x = __builtin_amdgcn_exp2f(ex.x); den.y = __builtin_amdgcn_exp2f(ex.y); den = den + (f32x2_){1.f, 1.f};
                        f32x2_ sg; sg.x = __builtin_amdgcn_rcpf(den.x); sg.y = __builtin_amdgcn_rcpf(den.y);
                        const f32x2_ r2 = (gl * sg) * (li + (f32x2_){1.f, 1.f});
                        o[4 * n + j] = r2.x; o[4 * n + j + 1] = r2.y; }
                u32x4 w; w.x = cvt_pk_bf16(o[0], o[1]); w.y = cvt_pk_bf16(o[2], o[3]); w.z = cvt_pk_bf16(o[4], o[5]); w.w = cvt_pk_bf16(o[6], o[7]);
                *(GAS u32x4*)(ACT + (size_t)(row0 + ai * HALF + m * 16) * F + j0) = w; }
    }
};
struct EpiDownF32 {
    static constexpr bool PERM = false;
    float* C; int ldc; const float* bd;
    DI void operator()(const f32x4 (&acc)[2][2][4][2], const Unit& u, int wr, int wc, int fr, int fq) const {
        const int row0 = u.pm * BM + wr * 64 + fr, col0 = u.pn * BM + wc * 32 + 4 * fq;
        const float* bp = bd + (size_t)u.e * ldc + col0;
        f32x4 bv[2][2];
#pragma unroll
        for (int bj = 0; bj < 2; ++bj)
#pragma unroll
            for (int n = 0; n < 2; ++n) bv[bj][n] = *(const GAS f32x4*)(bp + bj * HALF + n * 16);
#pragma unroll
        for (int ai = 0; ai < 2; ++ai)
#pragma unroll
            for (int m = 0; m < 4; ++m) { float* rowp = C + (size_t)(row0 + ai * HALF + m * 16) * ldc + col0;
#pragma unroll
                for (int bj = 0; bj < 2; ++bj)
#pragma unroll
                    for (int n = 0; n < 2; ++n) *(GAS f32x4*)(rowp + bj * HALF + n * 16) = acc[ai][bj][m][n] + bv[bj][n]; }
    }
};
struct EpiDownBf16 {
    static constexpr bool PERM = true;
    bf16_t* O; int ldc; const float* bd;
    DI void operator()(const f32x4 (&acc)[2][2][4][2], const Unit& u, int wr, int wc, int fr, int fq) const {
        const int row0 = u.pm * BM + wr * 64 + fr, col0 = u.pn * BM + wc * 32 + 8 * fq;
        const float* bp = bd + (size_t)u.e * ldc + col0;
        f32x4 bv[2][2];
#pragma unroll
        for (int bj = 0; bj < 2; ++bj)
#pragma unroll
            for (int n = 0; n < 2; ++n) bv[bj][n] = *(const GAS f32x4*)(bp + bj * HALF + 4 * n);
#pragma unroll
        for (int ai = 0; ai < 2; ++ai)
#pragma unroll
            for (int m = 0; m < 4; ++m) { bf16_t* rowp = O + (size_t)(row0 + ai * HALF + m * 16) * ldc + col0;
#pragma unroll
                for (int bj = 0; bj < 2; ++bj) { const f32x4 v0 = acc[ai][bj][m][0] + bv[bj][0], v1 = acc[ai][bj][m][1] + bv[bj][1];
                    u32x4 w; w.x = cvt_pk_bf16(v0[0], v0[1]); w.y = cvt_pk_bf16(v0[2], v0[3]); w.z = cvt_pk_bf16(v1[0], v1[1]); w.w = cvt_pk_bf16(v1[2], v1[3]);
                    *(GAS u32x4*)(rowp + bj * HALF) = w; } }
    }
};
struct EpiBf16 {
    static constexpr bool PERM = true;
    bf16_t* O; int ldc; float scale;
    DI void operator()(const f32x4 (&acc)[2][2][4][2], const Unit& u, int wr, int wc, int fr, int fq) const {
        const int row0 = u.pm * BM + wr * 64 + fr, col0 = u.pn * BM + wc * 32 + 8 * fq;
#pragma unroll
        for (int ai = 0; ai < 2; ++ai)
#pragma unroll
            for (int m = 0; m < 4; ++m) { bf16_t* rowp = O + (size_t)(row0 + ai * HALF + m * 16) * ldc + col0;
#pragma unroll
                for (int bj = 0; bj < 2; ++bj) { const f32x4 v0 = acc[ai][bj][m][0] * scale, v1 = acc[ai][bj][m][1] * scale;
                    u32x4 w; w.x = cvt_pk_bf16(v0[0], v0[1]); w.y = cvt_pk_bf16(v0[2], v0[3]); w.z = cvt_pk_bf16(v1[0], v1[1]); w.w = cvt_pk_bf16(v1[2], v1[3]);
                    *(GAS u32x4*)(rowp + bj * HALF) = w; } }
    }
};

template <int K, class Epi, class Sched, bool GATHER = false, int LD = K>
DI void gemm_phase(LAS unsigned char* lds, const Sched& S, const Epi& E, int wv_, const LAS int* gtab = nullptr, const LAS NaiveCtx* cvC = nullptr) {
    const int tid = otid(wv_);
    int cvbase = 0;
    if (cvC) cvbase = __builtin_amdgcn_readfirstlane(*cv_counter(cvC));
    const int wid = __builtin_amdgcn_readfirstlane(tid >> 6), lane = tid & 63, wr = wid >> 2, wc = wid & 3, fr = lane & 15, fq = lane >> 4;
    constexpr int nt = K / BK;
    static_assert(K % 128 == 0 && K >= 256, "K");
    unsigned voffB[2], cvo[2][2], nvo[2][2];
#pragma unroll
    for (int i = 0; i < 2; ++i) { int R, C; stage_rc(tid * 16 + i * 8192, R, C); const int Rb = Epi::PERM ? ((R & ~31) + perm32(R & 31)) : R; voffB[i] = (unsigned)(Rb * LD + C) * 2u; }
#define PG8_CALC_VO(VO, UI) do { _Pragma("unroll") for (int h_ = 0; h_ < 2; ++h_) _Pragma("unroll") for (int i_ = 0; i_ < 2; ++i_) { int R_, C_; stage_rc(tid * 16 + i_ * 8192, R_, C_); \
        const int row_ = GATHER ? gtab[(UI) * 256 + h_ * HALF + R_] : h_ * HALF + R_; VO[h_][i_] = (unsigned)(row_ * LD + C_) * 2u; } } while (0)
    constexpr size_t kstep = (size_t)(BK * 2);
    constexpr size_t hstep = (size_t)HALF * LD * 2;
    const unsigned ldsw = (unsigned)wid * 1024u;
    const int aoff = lds_byte(wr * 64 + fr, fq * 8), boff = lds_byte(wc * 32 + fr, fq * 8);
#define PG8_SA(b, h) (((b) * 2 + (h)) * HTB)
#define PG8_SB(b, h) ((4 + (b) * 2 + (h)) * HTB)
#define PG8_STAGE(bufoff, gbase, voff) do { _Pragma("unroll") for (int _i = 0; _i < 2; ++_i) \
        __builtin_amdgcn_global_load_lds((const unsigned*)((const char*)(gbase) + (voff)[_i]), (LAS unsigned*)(lds + (bufoff) + ldsw + _i * 8192), 16, 0, 0); } while (0)
#define PG8_LDA(dst, b, h) do { _Pragma("unroll") for (int m = 0; m < 4; ++m) _Pragma("unroll") for (int k = 0; k < 2; ++k) dst[m][k] = *(const LAS bf16x8*)(lds + PG8_SA(b, h) + aoff + m * 2048 + k * 1024); } while (0)
#define PG8_LDB(dst, b, h) do { _Pragma("unroll") for (int n = 0; n < 2; ++n) _Pragma("unroll") for (int k = 0; k < 2; ++k) dst[n][k] = *(const LAS bf16x8*)(lds + PG8_SB(b, h) + boff + n * 2048 + k * 1024); } while (0)
#define PG8_MMA(ai, bj, At, Bt) do { __builtin_amdgcn_s_setprio(1); _Pragma("unroll") for (int m = 0; m < 4; ++m) _Pragma("unroll") for (int n = 0; n < 2; ++n) _Pragma("unroll") for (int k = 0; k < 2; ++k) \
        acc[ai][bj][m][n] = __builtin_amdgcn_mfma_f32_16x16x32_bf16(Bt[n][k], At[m][k], acc[ai][bj][m][n], 0, 0, 0); __builtin_amdgcn_s_setprio(0); } while (0)
#define PG8_WAIT_V(n) asm volatile("s_waitcnt vmcnt(" #n ")" ::: "memory")
#define PG8_WAIT_L(n) asm volatile("s_waitcnt lgkmcnt(" #n ")" ::: "memory")
#define PG8_BAR __builtin_amdgcn_s_barrier()
#define PG8_SCHED __builtin_amdgcn_sched_barrier(0)
    Unit cur, nxt; int ui = 0;
#if CV_CARRY
    f32x4 cvv[4][CV_NH]; bool cvon = false;
#endif
    if (!S.next(0, cur)) return;
    f32x4 acc[2][2][4][2];
#pragma unroll
    for (int a = 0; a < 2; ++a)
#pragma unroll
        for (int b = 0; b < 2; ++b)
#pragma unroll
            for (int m = 0; m < 4; ++m)
#pragma unroll
                for (int n = 0; n < 2; ++n) acc[a][b][m][n] = (f32x4){0.f, 0.f, 0.f, 0.f};
    bf16x8 At[4][2], B0[2][2], B1[2][2];
    const char* cA = S.a(cur); const char* cB = S.b(cur);
    PG8_CALC_VO(cvo, 0);
    PG8_STAGE(PG8_SB(0, 0), cB, voffB); PG8_STAGE(PG8_SB(0, 1), cB + hstep, voffB); PG8_STAGE(PG8_SA(0, 0), cA, cvo[0]); PG8_STAGE(PG8_SA(0, 1), cA, cvo[1]);
    if (wr == 1) PG8_BAR;
    PG8_WAIT_V(2); PG8_BAR;
    PG8_STAGE(PG8_SB(1, 0), cB + kstep, voffB); PG8_STAGE(PG8_SA(1, 0), cA + kstep, cvo[0]); PG8_STAGE(PG8_SB(1, 1), cB + hstep + kstep, voffB);
    PG8_WAIT_V(6); PG8_BAR;
    for (;;) {
        const bool has_next = S.next(ui + 1, nxt);
        const char* nA = has_next ? S.a(nxt) : cA; const char* nB = has_next ? S.b(nxt) : cB;
        if (has_next) PG8_CALC_VO(nvo, ui + 1); else { nvo[0][0] = cvo[0][0]; nvo[0][1] = cvo[0][1]; nvo[1][0] = cvo[1][0]; nvo[1][1] = cvo[1][1]; }
#pragma unroll 1
        for (int t = 0; t < nt; t += 2) {
            const bool last = (t == nt - 2);
            const char* a1 = cA + (size_t)(t + 1) * kstep;
            const char* a2 = last ? nA : cA + (size_t)(t + 2) * kstep; const char* b2 = last ? nB : cB + (size_t)(t + 2) * kstep;
            const char* a3 = a2 + kstep; const char* b3 = b2 + kstep;
            unsigned s0[2], s1[2]; s0[0] = last ? nvo[0][0] : cvo[0][0]; s0[1] = last ? nvo[0][1] : cvo[0][1]; s1[0] = last ? nvo[1][0] : cvo[1][0]; s1[1] = last ? nvo[1][1] : cvo[1][1];
            PG8_LDB(B0, 0, 0); PG8_LDB(B1, 0, 1); PG8_SCHED; PG8_LDA(At, 0, 0); PG8_STAGE(PG8_SA(1, 1), a1, cvo[1]);
            PG8_WAIT_V(8); PG8_WAIT_L(0); PG8_BAR; PG8_MMA(0, 0, At, B0); PG8_MMA(0, 1, At, B1); PG8_BAR; PG8_SCHED;
            PG8_LDA(At, 0, 1); PG8_STAGE(PG8_SB(0, 0), b2, voffB); PG8_STAGE(PG8_SB(0, 1), b2 + hstep, voffB); PG8_STAGE(PG8_SA(0, 0), a2, s0);
            PG8_WAIT_V(8); PG8_WAIT_L(0); PG8_BAR; PG8_MMA(1, 0, At, B0); PG8_MMA(1, 1, At, B1); PG8_BAR; PG8_SCHED;
            PG8_LDB(B0, 1, 0); PG8_LDB(B1, 1, 1); PG8_SCHED; PG8_LDA(At, 1, 0); PG8_STAGE(PG8_SA(0, 1), a2, s1);
            PG8_WAIT_V(8); PG8_WAIT_L(0); PG8_BAR; PG8_MMA(0, 0, At, B0); PG8_MMA(0, 1, At, B1); PG8_BAR; PG8_SCHED;
            PG8_LDA(At, 1, 1); PG8_STAGE(PG8_SB(1, 0), b3, voffB); PG8_STAGE(PG8_SB(1, 1), b3 + hstep, voffB); PG8_STAGE(PG8_SA(1, 0), a3, s0);
            PG8_WAIT_V(8); PG8_WAIT_L(0); PG8_BAR; PG8_MMA(1, 0, At, B0); PG8_MMA(1, 1, At, B1); PG8_BAR; PG8_SCHED;
        }
        if (wr == 0) PG8_BAR;
#if CV_CARRY
        if (cvC) { const float* cvs = nullptr; bf16_t* cvd = nullptr; int cvl = 0;
            if (cvon) { cv_addr(cvC, (cvbase + ui - 1) * S.G + S.c, otid(wv_), cvs, cvd, cvl); CV_STORES(cvv, cvd); }
            cvon = cv_addr(cvC, (cvbase + ui) * S.G + S.c, otid(wv_), cvs, cvd, cvl); if (cvon) CV_LOADS(cvv, cvs, cvl); }
#else
        f32x4 cvv[4][CV_NH]; const float* cvs = nullptr; bf16_t* cvd = nullptr; int cvl = 0; bool cvon = false;
        if (cvC) { cvon = cv_addr(cvC, (cvbase + ui) * S.G + S.c, otid(wv_), cvs, cvd, cvl); if (cvon) CV_LOADS(cvv, cvs, cvl); }
#endif
        { const int t2_ = otid(wv_), fr_ = t2_ & 15, fq_ = (t2_ & 63) >> 4;
          _Pragma("unroll") for (int re_ = 0; re_ < REP_EPI; ++re_) E(acc, cur, wr, wc, fr_, fq_); }
#if !CV_CARRY
        if (cvC) { if (cvon) CV_STORES(cvv, cvd); }
#endif
        if (!has_next) break;
#pragma unroll
        for (int a = 0; a < 2; ++a)
#pragma unroll
            for (int b = 0; b < 2; ++b)
#pragma unroll
                for (int m = 0; m < 4; ++m)
#pragma unroll
                    for (int n = 0; n < 2; ++n) acc[a][b][m][n] = (f32x4){0.f, 0.f, 0.f, 0.f};
        cur = nxt; cA = nA; cB = nB; ++ui; cvo[0][0] = nvo[0][0]; cvo[0][1] = nvo[0][1]; cvo[1][0] = nvo[1][0]; cvo[1][1] = nvo[1][1];
        if (wr == 1) PG8_BAR;
    }
#if CV_CARRY
    if (cvC) { if (cvon) { const float* cvs = nullptr; bf16_t* cvd = nullptr; int cvl = 0; cv_addr(cvC, (cvbase + ui) * S.G + S.c, otid(wv_), cvs, cvd, cvl); CV_STORES(cvv, cvd); } }
#endif
    PG8_WAIT_V(0);
    PG8_BAR;
    if (cvC) { if (otid(wv_) == 0) *cv_counter(cvC) = cvbase + ui + 1; }
#undef PG8_CALC_VO
#undef PG8_SA
#undef PG8_SB
#undef PG8_STAGE
#undef PG8_LDA
#undef PG8_LDB
#undef PG8_MMA
#undef PG8_WAIT_V
#undef PG8_WAIT_L
#undef PG8_BAR
#undef PG8_SCHED
}
}
#define GRID_STRIDE_WAVES(i_, n_) for (long tz_ = otid(wv_), i_ = ((long)(tz_ >> 6) * gridDim.x + opaque_bid()) * 64 + (tz_ & 63); i_ < (long)(n_); i_ += (long)gridDim.x * PB_THREADS)
DI bf16_t f2bf(float x) { return (bf16_t)(cvt_pk_bf16(x, 0.f) & 0xffffu); }

DI void conv_weight_r(LAS unsigned char* lds, const float* __restrict__ src, size_t sstride, bf16_t* __restrict__ dst, size_t dstride, int K, int N, int ldsrc, int Kpad, int Npad, int mode, int ti0, int G, int total, int wv_) {
    const int t = otid(wv_), nkt = Kpad / 64, nnt = Npad / 256, tpm = nkt * nnt;
    const int kk = t >> 6, c4 = (t & 63) * 4;
    float4 v[8];
#define CW_LOAD(TI) do { const int mat_ = (TI) / tpm, tile_ = (TI) % tpm, n0_ = (tile_ / nkt) * 256, k0_ = (tile_ % nkt) * 64; \
        const int sc_ = mode == 1 ? (c4 < 128 ? 0 : N / 2) + (n0_ / 256) * 128 + (c4 & 127) : n0_ + c4; const float* sp_ = src + (size_t)mat_ * sstride; \
        _Pragma("unroll") for (int i = 0; i < 8; ++i) { const int k_ = k0_ + 8 * kk + i; v[i] = make_float4(0.f, 0.f, 0.f, 0.f); \
            if (k_ < K && sc_ < N) { const f32x4 g_ = *(const GAS f32x4*)(sp_ + (size_t)k_ * ldsrc + sc_); v[i] = make_float4(g_[0], g_[1], g_[2], g_[3]); } } } while (0)
    int ti = ti0, par = 0;
    if (ti < total) CW_LOAD(ti);
    while (ti < total) {
        LAS bf16_t* Ts = (LAS bf16_t*)(lds + par * (256 * 72 * 2));
        const int mat = ti / tpm, tile = ti % tpm, n0 = (tile / nkt) * 256, k0 = (tile % nkt) * 64;
#define CW_COL(J, F) { u32x4 w_; w_.x = cvt_pk_bf16(v[0].F, v[1].F); w_.y = cvt_pk_bf16(v[2].F, v[3].F); w_.z = cvt_pk_bf16(v[4].F, v[5].F); w_.w = cvt_pk_bf16(v[6].F, v[7].F); *(LAS u32x4*)(Ts + (c4 + J) * 72 + 8 * kk) = w_; }
        CW_COL(0, x) CW_COL(1, y) CW_COL(2, z) CW_COL(3, w)
#undef CW_COL
        const int tn = ti + G;
        if (tn < total) CW_LOAD(tn);
        lds_barrier();
        bf16_t* dp = dst + (size_t)mat * dstride;
#pragma unroll
        for (int q0 = 0; q0 < 4; ++q0) { const int q = t + 512 * q0, n = q >> 3, k8 = (q & 7) * 8;
            const u32x4 w = *(const LAS u32x4*)(Ts + n * 72 + k8);
            *(GAS u32x4*)(dp + (size_t)(n0 + n) * Kpad + k0 + k8) = w; }
        ti = tn; par ^= 1;
    }
    __syncthreads();
#undef CW_LOAD
}
DI void conv_weight_b(LAS unsigned char* lds, const float* __restrict__ src, size_t sstride, bf16_t* __restrict__ dst, size_t dstride, int nmat, int K, int N, int ldsrc, int Kpad, int Npad, int mode, int wv_) {
    conv_weight_r(lds, src, sstride, dst, dstride, K, N, ldsrc, Kpad, Npad, mode, opaque_bid(), gridDim.x, (Kpad / 64) * (Npad / 256) * nmat, wv_);
}
DI void conv_act(const float* __restrict__ src, int lda, int K, bf16_t* __restrict__ dst, int Kpad, long M, int wv_) {
    const int cpr = Kpad / 8;
    GRID_STRIDE_WAVES(i, M * cpr) { const long row = i / cpr; const int c = (int)(i % cpr) * 8; u32x4 w = (u32x4){0u, 0u, 0u, 0u};
        if (c < K) { const f32x4 a_ = *(const GAS f32x4*)(src + row * lda + c), b_ = *(const GAS f32x4*)(src + row * lda + c + 4); const float4 a = make_float4(a_[0], a_[1], a_[2], a_[3]), b = make_float4(b_[0], b_[1], b_[2], b_[3]);
            w.x = cvt_pk_bf16(a.x, a.y); w.y = cvt_pk_bf16(a.z, a.w); w.z = cvt_pk_bf16(b.x, b.y); w.w = cvt_pk_bf16(b.z, b.w); }
        *(GAS u32x4*)(dst + row * Kpad + c) = w; }
}
#ifdef HOST_TEST
static int D_MODEL = 128, BATCH = 2, SEQ = 128, CTX_LEN = 64, N_EXPERTS = 8, EXPERT_DIM = 64;
#define HD
#else
constexpr int D_MODEL = 1024, BATCH = 16, SEQ = 2048, CTX_LEN = 256, N_EXPERTS = 32, EXPERT_DIM = 1024;
#ifdef PERSISTENT
#define HD __device__
#else
#define HD __host__ __device__
#endif
#endif
constexpr int DEPTH = 4, GRID_W = 64, N_MOD = 6;
constexpr int RW_HEADS = 8, RW_HD = 64, RW_DIM = 512, RW_DL = 64, RW_IL = 64, RW_GL = 128, RW_IN = 1920;
constexpr int HG_HEADS = 4, HG_KD = 128, HG_VD = 128, HG_DIM = 512, HG_VDIM = 512, HG_IN = 2560;
constexpr int EVEN_IN = 4480, EVEN_OUT = 1024;
constexpr int MLA_HEADS = 16, MLA_NOPE = 64, MLA_ROPE = 32, MLA_V = 64, MLA_QR = 256, MLA_KVR = 128, MLA_IN = 416, MLA_QK = 96;
constexpr int TOP_K = 4, N_EVEN = 2, N_ODD = 2;
constexpr int MOE_PAD = 256;
#define ALPHA 1.681792830507429f

#ifndef REP_MOE
#define REP_MOE 1
#endif
#ifndef REP_ATT
#define REP_ATT 1
#endif
#ifndef REP_RWS
#define REP_RWS 1
#endif
#ifndef REP_HGS
#define REP_HGS 1
#endif
#ifndef REP_DEN
#define REP_DEN 1
#endif
#ifndef REP_TLE
#define REP_TLE 1
#endif
#ifndef REP_PRO
#define REP_PRO 1
#endif
#ifndef CV_BACKGROUND
#define CV_BACKGROUND 0
#endif
#ifndef CV_TAIL
#define CV_TAIL 1
#endif
#ifndef CV_TAILN
#define CV_TAILN 10
#endif
#if CV_BACKGROUND
#define CV_PRO_LAYERS 1
#define CV_CTX Cp_
#elif CV_TAIL
#define CV_PRO_LAYERS 1
#define CV_CTX nullptr
#else
#define CV_PRO_LAYERS DEPTH
#define CV_CTX nullptr
#endif
#define RP(N, ...) _Pragma("unroll") for (int rep_ = 0; rep_ < (N); ++rep_) { __VA_ARGS__ }
#define NC_ (BATCH * CTX_LEN)
#define NL_ (BATCH * SEQ)
#define NT_ (NC_ + NL_)
#define TT_ (CTX_LEN + SEQ)
#define NSLOT_ (NT_ * TOP_K + N_EXPERTS * MOE_PAD)

#ifdef HOST_TEST
#define MEMFENCE_EVERY(k, n) do {} while (0)
#else
#define MEMFENCE_EVERY(k, n) do { if (((k) % (n)) == (n) - 1) asm volatile("" ::: "memory"); } while (0)
#endif
HD inline float sigmoidf_(float x) { return 1.f / (1.f + expf(-x)); }
HD inline float siluf_(float x) { return x / (1.f + expf(-x)); }
HD inline float softplusf_(float x) { return x > 20.f ? x : log1pf(expf(x)); }
HD inline int tokrow(int b, int t) { return t < CTX_LEN ? b * CTX_LEN + t : NC_ + b * SEQ + (t - CTX_LEN); }
HD inline int scan_pos(int d, int i) { return d == 0 ? i : (i < CTX_LEN ? CTX_LEN - 1 - i : CTX_LEN + (SEQ - 1 - (i - CTX_LEN))); }
#ifdef HOST_TEST
inline int ld_cnt(const int* p) { return *p; }
#else
__device__ inline int ld_cnt(const int* p) { return __hip_atomic_load(p, __ATOMIC_RELAXED, __HIP_MEMORY_SCOPE_AGENT); }
#endif
HD inline int modrow(int row) { return row < NC_ ? BATCH : (row - NC_) / SEQ; }

struct NaiveCtx {
    const float *x, *c, *ctx, *c_ctx, *mod_w, *mod_b, *ln_g, *ln_b, *ev_w_in, *rw_mu, *rw_w0, *rw_w2, *rw_a0, *rw_a2, *rw_g2, *rw_k_k, *rw_k_a, *rw_r_k,
        *rw_gn_g, *rw_gn_b, *hg_lb, *hg_norm_g, *ev_w_out, *od_w_in, *mla_q_norm_g, *mla_w_qb, *mla_kv_norm_g, *mla_w_kvb, *od_w_out, *moe_w_router,
        *moe_b_router, *moe_w_gu, *moe_b_gu, *moe_w_down, *moe_b_down;
    float* out;
    float *H, *MOD, *U, *Z, *ZS, *R, *V, *KKR, *NKK, *G, *DEC, *AG, *KD, *BB, *Y, *HQ, *HF, *HK, *OP, *YCAT, *YO;
    float *QN, *KVN, *KPE, *Q, *KV, *AO, *LOGIT, *TOPG, *H1, *ACT, *OUT2;
    int *TOPI, *CNT, *OFF, *CUR, *SLOT, *TOKOF, *TILE_E;
    unsigned short *WinE, *WoutE, *WinO, *Wqb, *Wkvb, *WoutO, *Wgu, *Wdn, *ABF, *XPB, *ACTB, *QB, *KB, *VB, *UB, *OUT2B, *TW, *LOB, *YCATB, *QNB, *KVNB, *AOB, *Wlora, *KVB, *KPEB, *ZB, *RBh, *VBh, *NKh, *GBh, *KDh, *BBh, *YOB, *HB, *YBh, *OBh;
    float *BON, *ROPE, *O;
    long cvn;
};
#if defined(PERSISTENT)
constexpr int CV_TN = 64 * CV_NH, CV_GU = (2 * EXPERT_DIM / CV_TN) * 8, CV_DN = (D_MODEL / CV_TN) * 8;
constexpr int CV_TPL = N_EXPERTS * (CV_GU + CV_DN);
DI LAS int* cv_counter(const LAS NaiveCtx* Cp_) { return (LAS int*)&Cp_->cvn; }
DI bool cv_addr(const LAS NaiveCtx* Cp_, int T, int tid, const float*& sp, bf16_t*& dp, int& ld) {
    if (T >= (DEPTH - 1) * CV_TPL) return false;
    const int layer = 1 + T / CV_TPL, r = T % CV_TPL;
    const int kb = (tid & 15) + 16 * ((tid >> 6) & 1), nb = ((tid >> 4) & 3) + 4 * (tid >> 7);
    if (r < N_EXPERTS * CV_GU) {
        const int mat = layer * N_EXPERTS + r / CV_GU, tile = r % CV_GU, n0 = (tile / 8) * CV_TN, k0 = (tile % 8) * 128;
        const int cb = ((n0 % 256) / 128) * EXPERT_DIM + (n0 / 256) * 128 + n0 % 128;
        sp = Cp_->moe_w_gu + (size_t)mat * ((size_t)D_MODEL * 2 * EXPERT_DIM) + (size_t)(k0 + kb * 4) * (2 * EXPERT_DIM) + cb + nb * (4 * CV_NH); ld = 2 * EXPERT_DIM;
        dp = Cp_->Wgu + (size_t)mat * ((size_t)2 * EXPERT_DIM * D_MODEL) + (size_t)(n0 + nb * (4 * CV_NH)) * D_MODEL + k0 + kb * 4;
    } else {
        const int r2 = r - N_EXPERTS * CV_GU, mat = layer * N_EXPERTS + r2 / CV_DN, tile = r2 % CV_DN, n0 = (tile / 8) * CV_TN, k0 = (tile % 8) * 128;
        sp = Cp_->moe_w_down + (size_t)mat * ((size_t)EXPERT_DIM * D_MODEL) + (size_t)(k0 + kb * 4) * D_MODEL + n0 + nb * (4 * CV_NH); ld = D_MODEL;
        dp = Cp_->Wdn + (size_t)mat * ((size_t)D_MODEL * EXPERT_DIM) + (size_t)(n0 + nb * (4 * CV_NH)) * EXPERT_DIM + k0 + kb * 4;
    }
    return true;
}
DI void cv_catchup(const LAS NaiveCtx* Cp_, long layer, int wv_) {
    const int G = gridDim.x, bid = opaque_bid();
    const int need = (int)((layer * CV_TPL + G - 1) / G);
    int j = __builtin_amdgcn_readfirstlane(*cv_counter(Cp_));
    if (j >= need) return;
    for (; j < need; ++j) { f32x4 v[4][CV_NH]; const float* sp = nullptr; bf16_t* dp = nullptr; int ld = 0;
        if (cv_addr(Cp_, j * G + bid, otid(wv_), sp, dp, ld)) { CV_LOADS(v, sp, ld); CV_STORES(v, dp); } }
    __syncthreads();
    if (otid(wv_) == 0) *cv_counter(Cp_) = j;
}
#endif
#if defined(PERSISTENT)
constexpr int CVT_GU = N_EXPERTS * 128, CVT_DN = N_EXPERTS * 64, CVT_L = CVT_GU + CVT_DN, CVT_TOT = (DEPTH - 1) * CVT_L;
DI void cv_range(const LAS NaiveCtx* Cp_, LAS unsigned char* lds, int a, int b, int step, int wv_) {
#pragma unroll 1
    for (int j = 0; j < 2 * (DEPTH - 1); ++j) { const int Lx = 1 + j / 2; const bool dn = (j & 1) != 0;
        const int base = CVT_L * (Lx - 1) + (dn ? CVT_GU : 0), lim = CVT_L * (Lx - 1) + (dn ? CVT_L : CVT_GU);
        const int v0 = a >= base ? a : a + ((base - a + step - 1) / step) * step, hi = b < lim ? b : lim;
        if (v0 < hi) { const int tb = (dn ? CVT_DN : CVT_GU) * Lx;
            conv_weight_r(lds, dn ? (*Cp_).moe_w_down : (*Cp_).moe_w_gu, (size_t)D_MODEL * (dn ? D_MODEL : 2 * EXPERT_DIM), dn ? (*Cp_).Wdn : (*Cp_).Wgu, (size_t)D_MODEL * (dn ? EXPERT_DIM : 2 * EXPERT_DIM),
                          1024, dn ? D_MODEL : 2 * EXPERT_DIM, dn ? D_MODEL : 2 * EXPERT_DIM, 1024, dn ? D_MODEL : 2 * EXPERT_DIM, dn ? 0 : 1, tb + (v0 - base), step, tb + (hi - base), wv_); } }
}
#ifndef MOE_REMAP
#define MOE_REMAP 2
#endif
#ifndef MOE_CHUNK
#define MOE_CHUNK 1
#endif
#if MOE_CHUNK
#define MOE_SET_CHUNK S_.set_chunk(opaque_bid());
#else
#define MOE_SET_CHUNK
#endif
DI int moe_remap(int c, int G, int nct) {
#if MOE_REMAP
    if (G == 256) { const int x = c & 7, j = c >> 3;
#if MOE_REMAP == 2
        if (nct == 8) return 8 * (4 * (j >> 2) + (x >> 1)) + 4 * (x & 1) + (j & 3);
        if (nct == 4) return 4 * (8 * (j >> 2) + x) + (j & 3); }
#elif MOE_REMAP == 3
        if (nct == 8) return 8 * (4 * (j >> 2) + (x >> 1)) + 4 * (x & 1) + (j & 3);
        if (nct == 4) return 4 * (4 * (j >> 1) + (x >> 1)) + 2 * (x & 1) + (j & 1); }
#else
        if (nct == 8) return 8 * (2 * (j >> 1) + (x >> 2)) + 2 * (x & 3) + (j & 1);
        if (nct == 4) return 4 * (4 * (j >> 1) + (x >> 1)) + 2 * (x & 1) + (j & 1); }
#endif
#endif
    return c;
}
DI void cv_tail(const LAS NaiveCtx* Cp_, LAS unsigned char* lds, const g8::MoeSched& S, int wv_) {
    int done = __builtin_amdgcn_readfirstlane(*cv_counter(Cp_));
    if (done >= CVT_TOT) return;
    int nidle = 0, mine = -1;
    if (S.chunk) { const int q = S.nunits / 8, r = S.nunits % 8, maxr = (q + (r ? 1 : 0) + 31) / 32, myx = opaque_bid() & 7;
#pragma unroll
        for (int x = 0; x < 8; ++x) { const int len = q + (x < r ? 1 : 0), rounds = (len + 31) / 32, busy = rounds < maxr ? 0 : len - 32 * (maxr - 1);
            if (x == myx && S.jj >= busy) mine = nidle + (S.jj - busy);
            nidle += 32 - busy; } }
    else { const int G = gridDim.x, r = S.nunits % G; if (r != 0) { nidle = G - r; if (S.c >= r) mine = S.c - r; } }
    if (nidle == 0) return;
    if (mine >= 0) { const int a = done + mine * CV_TAILN, b = a + CV_TAILN < CVT_TOT ? a + CV_TAILN : CVT_TOT; if (a < b) cv_range(Cp_, lds, a, b, 1, wv_); }
    done += nidle * CV_TAILN; if (done > CVT_TOT) done = CVT_TOT;
    __syncthreads();
    if (otid(wv_) == 0) *cv_counter(Cp_) = done;
}
DI void cv_catch(const LAS NaiveCtx* Cp_, LAS unsigned char* lds, long layer, int wv_) {
    const int G = gridDim.x, c = opaque_bid(), need = CVT_L * (int)layer;
    const int done = __builtin_amdgcn_readfirstlane(*cv_counter(Cp_));
    if (done >= need) return;
    cv_range(Cp_, lds, done + c, need, G, wv_);
    __syncthreads();
    if (otid(wv_) == 0) *cv_counter(Cp_) = need;
}
#endif


struct NaiveWs { size_t total; };
static size_t naive_carve(NaiveCtx& C, char* base) {
    size_t off = 0;
    auto take = [&](size_t nfl) { size_t o = off; off += ((nfl * 4 + 255) / 256) * 256; return base ? (float*)(base + o) : (float*)nullptr; };
    const size_t NT = NT_, NS = NSLOT_;
    C.H = take(NT * D_MODEL); C.MOD = take((size_t)DEPTH * (BATCH + 1) * N_MOD * D_MODEL); C.YO = take(NT * D_MODEL);
#if defined(PERSISTENT)
    C.U = nullptr;
#else
    C.U = take(NT * D_MODEL);
#endif
    C.LOGIT = take(NT * N_EXPERTS); C.TOPG = take(NT * TOP_K);
    C.TOPI = (int*)take(NT * TOP_K); C.CNT = (int*)take(64 * DEPTH); C.CUR = (int*)take(64 * DEPTH); C.OFF = (int*)take(64); C.SLOT = (int*)take(NT * TOP_K); C.TOKOF = (int*)take(NS);
    C.TILE_E = (int*)take(NS / 64 + 64);
    C.WinE = (unsigned short*)take((size_t)N_EVEN * 4608 * D_MODEL / 2); C.WoutE = (unsigned short*)take((size_t)N_EVEN * D_MODEL * 1024 / 2); C.WinO = (unsigned short*)take((size_t)N_ODD * 512 * D_MODEL / 2);
    C.Wqb = (unsigned short*)take((size_t)N_ODD * 1536 * 256 / 2); C.Wkvb = (unsigned short*)take((size_t)N_ODD * 2048 * 256 / 2); C.WoutO = (unsigned short*)take((size_t)N_ODD * D_MODEL * 1024 / 2);
    C.Wgu = (unsigned short*)take((size_t)DEPTH * N_EXPERTS * 2 * EXPERT_DIM * D_MODEL / 2); C.Wdn = (unsigned short*)take((size_t)DEPTH * N_EXPERTS * D_MODEL * EXPERT_DIM / 2);
    C.ABF = (unsigned short*)take((size_t)NT * 1024 / 2); C.UB = (unsigned short*)take((size_t)NT * 1024 / 2);
    const size_t ubase = off; size_t umax = off;
    C.Z = take(NT * EVEN_IN); C.ZS = take(NT * RW_IN);
    C.R = take(NT * 512); C.V = take(NT * 512); C.KKR = take(NT * 512); C.NKK = take(NT * 512); C.G = take(NT * 512);
    C.DEC = take(2 * NT * 512); C.AG = take(2 * NT * 512); C.KD = take(2 * NT * 512); C.BB = take(2 * NT * 512); C.Y = take(2 * NT * 512);
    C.HQ = take(NT * 512); C.HF = take(2 * NT * 512); C.HK = take(2 * NT * 512); C.OP = take(4 * NT * 512);
    C.YCAT = take(NT * 1024);
    umax = off > umax ? off : umax; off = ubase;
    (void)take(NT * EVEN_IN);
    C.QN = take(NT * MLA_QR); C.KVN = take(NT * MLA_KVR); C.KPE = take(NT * MLA_ROPE); C.Q = take(NT * MLA_HEADS * MLA_QK); C.KV = take(NT * MLA_HEADS * 128);
    C.AO = take(NT * 1024);
    C.QB = (unsigned short*)take(NT * MLA_HEADS * 96 / 2); C.KB = (unsigned short*)take((size_t)BATCH * MLA_HEADS * TT_ * 96 / 2); C.VB = (unsigned short*)take((size_t)BATCH * MLA_HEADS * TT_ * 64 / 2);
    umax = off > umax ? off : umax; off = ubase;
    C.H1 = take(NS * 2 * EXPERT_DIM); C.ACT = take(NS * EXPERT_DIM); C.OUT2 = take(NS * D_MODEL);
    C.OUT2B = (unsigned short*)C.OUT2; C.XPB = (unsigned short*)C.H1; C.ACTB = (unsigned short*)(C.H1 ? C.H1 + NS * EXPERT_DIM / 2 + 64 : C.H1);
    umax = off > umax ? off : umax; off = umax;
    return off;
}


#if defined(PERSISTENT)
static size_t mega_carve(NaiveCtx& C, char* base) {
    size_t off = 0;
    auto takeb = [&](size_t nbytes) { size_t o = off; off += ((nbytes + 255) / 256) * 256; return base ? (void*)(base + o) : (void*)nullptr; };
    const size_t NT = NT_, NS = NSLOT_;
    C.HB = (unsigned short*)takeb(NT * D_MODEL * 2); C.H = nullptr; C.MOD = (float*)takeb((size_t)DEPTH * (BATCH + 1) * N_MOD * D_MODEL * 4); C.YOB = (unsigned short*)takeb(NT * D_MODEL * 2); C.YO = nullptr; C.UB = (unsigned short*)takeb(NT * D_MODEL * 2);
    C.TOPG = (float*)takeb(NT * TOP_K * 4); C.TOPI = (int*)takeb(NT * TOP_K * 4); C.SLOT = (int*)takeb(NT * TOP_K * 4); C.CNT = (int*)takeb(64 * DEPTH * 4); C.CUR = (int*)takeb(64 * DEPTH * 4); C.TOKOF = (int*)takeb(NS * 4);
    C.ROPE = (float*)takeb((size_t)SEQ * 32 * 4);
    C.WinE = (unsigned short*)takeb((size_t)N_EVEN * 4608 * D_MODEL * 2); C.WoutE = (unsigned short*)takeb((size_t)N_EVEN * D_MODEL * 1024 * 2); C.WinO = (unsigned short*)takeb((size_t)N_ODD * 512 * D_MODEL * 2);
    C.Wqb = (unsigned short*)takeb((size_t)N_ODD * 1536 * 256 * 2); C.Wkvb = (unsigned short*)takeb((size_t)N_ODD * 2048 * 256 * 2); C.WoutO = (unsigned short*)takeb((size_t)N_ODD * D_MODEL * 1024 * 2);
    C.Wlora = (unsigned short*)takeb((size_t)N_EVEN * 2560 * 384 * 2);
    C.Wgu = (unsigned short*)takeb((size_t)DEPTH * N_EXPERTS * 2 * EXPERT_DIM * D_MODEL * 2); C.Wdn = (unsigned short*)takeb((size_t)DEPTH * N_EXPERTS * D_MODEL * EXPERT_DIM * 2);
    const size_t ubase = off; size_t umax = off;
    C.ZB = (unsigned short*)takeb(NT * 4608 * 2); C.Z = (float*)C.ZB; C.TW = (unsigned short*)takeb(NT * 384 * 2); C.LOB = (unsigned short*)takeb(NT * 2560 * 2);
    C.RBh = (unsigned short*)takeb(NT * 512 * 2); C.VBh = (unsigned short*)takeb(NT * 512 * 2); C.NKh = (unsigned short*)takeb(NT * 512 * 2); C.GBh = (unsigned short*)takeb(NT * 512 * 2);
    C.KDh = (unsigned short*)takeb(2 * NT * 512 * 2); C.BBh = (unsigned short*)takeb(2 * NT * 512 * 2); C.DEC = (float*)takeb(2 * NT * 512 * 4); C.YBh = (unsigned short*)takeb(2 * NT * 512 * 2); C.Y = nullptr;
    C.OBh = (unsigned short*)takeb(2 * NT * 512 * 2); C.O = nullptr; C.BON = (float*)takeb(NT * 8 * 4); C.YCATB = (unsigned short*)takeb(NT * 1024 * 2);
    umax = off > umax ? off : umax; off = ubase;
    (void)takeb(NT * 512 * 4); C.QNB = (unsigned short*)takeb(NT * 256 * 2); C.KVNB = (unsigned short*)takeb(NT * 256 * 2);
    C.QB = (unsigned short*)takeb(NT * MLA_HEADS * 96 * 2); C.KVB = (unsigned short*)takeb(NT * MLA_HEADS * 128 * 2); C.KPEB = (unsigned short*)takeb(NT * 32 * 2);
    C.AOB = (unsigned short*)takeb(NT * 1024 * 2);
    umax = off > umax ? off : umax; off = ubase;
    C.XPB = (unsigned short*)takeb(NS * D_MODEL * 2); C.ACTB = (unsigned short*)takeb(NS * EXPERT_DIM * 2); C.OUT2B = (unsigned short*)takeb(NS * D_MODEL * 2);
    umax = off > umax ? off : umax; off = umax;
    return off;
}
#endif
#if defined(HOST_TEST)
#define FWD_QUAL static
#define FWD_SIG NaiveCtx C
#define FWD_ARGS C
#define NLAUNCH(n, ...) do { auto f_ = __VA_ARGS__; for (long i_ = 0; i_ < (long)(n); ++i_) f_(i_); } while (0)
#elif defined(PERSISTENT)
#define FWD_QUAL __device__ __forceinline__
#define FWD_SIG const LAS NaiveCtx* Cp_, const XcdBarrier& bar, LAS unsigned char* lds, int wv_
#define FWD_ARGS Cp_, bar, lds, wv_
#define PERSIST_C_MACRO 1
#define NLAUNCH(n, ...) do { auto f_ = __VA_ARGS__; const long n_ = (long)(n); int tz_ = otid(wv_); \
    for (long i_ = ((long)(tz_ >> 6) * gridDim.x + opaque_bid()) * 64 + (tz_ & 63); i_ < n_; i_ += (long)gridDim.x * PB_THREADS) f_(i_); \
    grid_sync(bar); } while (0)
#else
#define FWD_QUAL static
#define FWD_SIG NaiveCtx C
#define FWD_ARGS C
template <class F> __global__ void __launch_bounds__(256) k_run(long n, F f) { for (long i = (long)blockIdx.x * 256 + threadIdx.x; i < n; i += (long)gridDim.x * 256) f(i); }
template <class F> static void nlaunch_(long n, F f, hipStream_t st) { long nb = (n + 255) / 256; if (nb > 65536) nb = 65536; if (nb < 1) nb = 1; hipLaunchKernelGGL(k_run<F>, dim3((unsigned)nb), dim3(256), 0, st, n, f); }
#define NLAUNCH(n, ...) nlaunch_((long)(n), __VA_ARGS__, g_stream)
static hipStream_t g_stream;
#endif

#ifdef HOST_TEST
static void ngemm(const float* A, int lda, const int* arow, const float* B, long bstride, int ldb, const float* bias, long biasstride, float* Cm, int ldc, int M, int N, int K, const int* tile_e) {
    for (int m = 0; m < M; ++m) {
        int e = 0; if (tile_e) { e = tile_e[m / 64]; if (e < 0) continue; }
        int ar = arow ? arow[m] : m; if (ar < 0) continue;
        const float* Bp = B + (size_t)e * bstride;
        for (int n = 0; n < N; ++n) { double s = bias ? bias[(size_t)e * biasstride + n] : 0.0; for (int k = 0; k < K; ++k) s += (double)A[(size_t)ar * lda + k] * Bp[(size_t)k * ldb + n]; Cm[(size_t)m * ldc + n] = (float)s; }
    }
}
#elif defined(PERSISTENT)
__device__ __forceinline__ void pgemm_(const float* A, int lda, const int* arow, const float* B, long bstride, int ldb, const float* bias, long biasstride, float* Cm, int ldc, int M, int N, int K, const int* tile_e, int wv_) {
    constexpr int NH = PB_THREADS / 256;
    __shared__ float As[NH][16][68], Bs[NH][16][68];
    const int tz_ = otid(wv_);
    const int half = tz_ >> 8, tid = tz_ & 255, tx = tid & 15, ty = tid >> 4;
    const int ntn = (N + 63) / 64, ntm = (M + 63) / 64, ntiles = ntn * ntm;
    const int ar_l = tid >> 2, ak = (tid & 3) * 4, bk = tid >> 4, bn = (tid & 15) * 4;
    for (int t0 = opaque_bid() * NH; t0 < ntiles; t0 += gridDim.x * NH) {
        const int tile = t0 + half; bool active = tile < ntiles; const int rt = active ? tile / ntn : 0, ct = active ? tile % ntn : 0;
        int e = 0; if (tile_e && active) { e = tile_e[rt]; if (e < 0) { active = false; e = 0; } }
        const float* Bp = B + (size_t)e * bstride;
        const int m0 = rt * 64, n0 = ct * 64;
        float acc[4][4];
_Pragma("unroll")
        for (int i = 0; i < 4; ++i)
_Pragma("unroll")
            for (int j = 0; j < 4; ++j) acc[i][j] = 0.f;
        int am = m0 + ar_l; int arr = -1; if (active && am < M) arr = arow ? arow[am] : am;
        for (int k0 = 0; k0 < K; k0 += 16) {
            float4 av = make_float4(0, 0, 0, 0); if (arr >= 0) av = *(const float4*)(A + (size_t)arr * lda + k0 + ak);
            As[half][ak + 0][ar_l] = av.x; As[half][ak + 1][ar_l] = av.y; As[half][ak + 2][ar_l] = av.z; As[half][ak + 3][ar_l] = av.w;
_Pragma("unroll")
            for (int j = 0; j < 4; ++j) { int n = n0 + bn + j; Bs[half][bk][bn + j] = (active && n < N) ? Bp[(size_t)(k0 + bk) * ldb + n] : 0.f; }
            __syncthreads();
_Pragma("unroll")
            for (int k = 0; k < 16; ++k) {
                float a[4], b[4];
_Pragma("unroll")
                for (int i = 0; i < 4; ++i) { a[i] = As[half][k][ty * 4 + i]; b[i] = Bs[half][k][tx * 4 + i]; }
_Pragma("unroll")
                for (int i = 0; i < 4; ++i)
_Pragma("unroll")
                    for (int j = 0; j < 4; ++j) acc[i][j] += a[i] * b[j];
            }
            __syncthreads();
        }
        if (active) {
_Pragma("unroll")
            for (int i = 0; i < 4; ++i) { int m = m0 + ty * 4 + i; if (m >= M) continue;
_Pragma("unroll")
                for (int j = 0; j < 4; ++j) { int n = n0 + tx * 4 + j; if (n < N) Cm[(size_t)m * ldc + n] = acc[i][j] + (bias ? bias[(size_t)e * biasstride + n] : 0.f); } }
        }
    }
}
#define ngemm(...) do { pgemm_(__VA_ARGS__, wv_); grid_sync(bar); } while (0)
#else
__global__ void __launch_bounds__(256) k_ngemm(const float* A, const int* arow, const float* B, const float* bias, float* Cm, const int* tile_e, long bstride, long biasstride, int lda, int ldb, int ldc, int M, int N, int K) {
    __shared__ float As[16][68], Bs[16][68];
    const int rt = blockIdx.y, ct = blockIdx.x, tid = threadIdx.x, tx = tid & 15, ty = tid >> 4;
    int e = 0; if (tile_e) { e = tile_e[rt]; if (e < 0) return; }
    const float* Bp = B + (size_t)e * bstride;
    const int m0 = rt * 64, n0 = ct * 64;
    float acc[4][4] = {};
    const int ar_l = tid >> 2, ak = (tid & 3) * 4; int am = m0 + ar_l; int arr = -1; if (am < M) arr = arow ? arow[am] : am;
    const int bk = tid >> 4, bn = (tid & 15) * 4;
    for (int k0 = 0; k0 < K; k0 += 16) {
        float4 av = make_float4(0, 0, 0, 0); if (arr >= 0) av = *(const float4*)(A + (size_t)arr * lda + k0 + ak);
        As[ak + 0][ar_l] = av.x; As[ak + 1][ar_l] = av.y; As[ak + 2][ar_l] = av.z; As[ak + 3][ar_l] = av.w;
        float bv[4]; for (int j = 0; j < 4; ++j) { int n = n0 + bn + j; bv[j] = n < N ? Bp[(size_t)(k0 + bk) * ldb + n] : 0.f; }
        Bs[bk][bn + 0] = bv[0]; Bs[bk][bn + 1] = bv[1]; Bs[bk][bn + 2] = bv[2]; Bs[bk][bn + 3] = bv[3];
        __syncthreads();
_Pragma("unroll")
        for (int k = 0; k < 16; ++k) {
            float a[4], b[4];
_Pragma("unroll")
            for (int i = 0; i < 4; ++i) { a[i] = As[k][ty * 4 + i]; b[i] = Bs[k][tx * 4 + i]; }
_Pragma("unroll")
            for (int i = 0; i < 4; ++i)
_Pragma("unroll")
                for (int j = 0; j < 4; ++j) acc[i][j] += a[i] * b[j];
        }
        __syncthreads();
    }
_Pragma("unroll")
    for (int i = 0; i < 4; ++i) { int m = m0 + ty * 4 + i; if (m >= M) continue;
_Pragma("unroll")
        for (int j = 0; j < 4; ++j) { int n = n0 + tx * 4 + j; if (n < N) Cm[(size_t)m * ldc + n] = acc[i][j] + (bias ? bias[(size_t)e * biasstride + n] : 0.f); } }
}
static void ngemm(const float* A, int lda, const int* arow, const float* B, long bstride, int ldb, const float* bias, long biasstride, float* Cm, int ldc, int M, int N, int K, const int* tile_e) {
    dim3 grid((N + 63) / 64, (M + 63) / 64);
    hipLaunchKernelGGL(k_ngemm, grid, dim3(256), 0, g_stream, A, arow, B, bias, Cm, tile_e, bstride, biasstride, lda, ldb, ldc, M, N, K);
}
#endif


#ifndef ATT_REMAP
#define ATT_REMAP 1
#endif
namespace att {
typedef float f32x16 __attribute__((ext_vector_type(16)));
typedef short s16x4 __attribute__((ext_vector_type(4)));
typedef __bf16 bf16x2_t __attribute__((ext_vector_type(2)));
typedef float f32x2_t __attribute__((ext_vector_type(2)));
constexpr int KROWB = 208, KT_BYTES = 64 * KROWB, VT_BYTES = 8192, BUF = KT_BYTES + VT_BYTES;
DI unsigned pk2(float a, float b) { f32x2_t f = {a, b}; return __builtin_bit_cast(unsigned, __builtin_convertvector(f, bf16x2_t)); }
template <int S> DI bf16x8 pack8(const f32x16& x) { u32x4 p; p.x = pk2(x[8 * S], x[8 * S + 1]); p.y = pk2(x[8 * S + 2], x[8 * S + 3]); p.z = pk2(x[8 * S + 4], x[8 * S + 5]); p.w = pk2(x[8 * S + 6], x[8 * S + 7]); return __builtin_bit_cast(bf16x8, p); }
#ifndef ATT_SETPRIO
#define ATT_SETPRIO 1
#endif
#if ATT_SETPRIO
#define ATT_PRIO(p) __builtin_amdgcn_s_setprio(p)
#else
#define ATT_PRIO(p)
#endif
#define ATT_MFMA(a, b, c) __builtin_amdgcn_mfma_f32_32x32x16_bf16((a), (b), (c), 0, 0, 0)

template <bool BF16OUT, int KVSRC> DI void attn_phase(LAS unsigned char* lds, const bf16_t* __restrict__ Qb, const bf16_t* __restrict__ Kb, const bf16_t* __restrict__ Vb, float* __restrict__ AO, bf16_t* __restrict__ AOB, int with_ctx, int wv_, const float* __restrict__ rope_tab = nullptr) {
    const int tid = otid(wv_), lane = tid & 63, wid = tid >> 6, r = lane & 31, h2 = lane >> 5, g1 = (lane >> 4) & 1, i16 = lane & 15;
    const int nlat = BATCH * MLA_HEADS * (SEQ / 256), nctx = with_ctx ? BATCH * MLA_HEADS * (CTX_LEN / 256) : 0;
    const int kq0 = tid, kq1 = 512 + tid; const bool has_k1 = tid < 256;
    const int kr0 = kq0 / 12, kc0 = kq0 % 12, kr1 = kq1 / 12, kc1 = kq1 % 12, vr = tid >> 3, vc = tid & 7;
    const unsigned kl0 = kr0 * KROWB + kc0 * 16, kl1 = kr1 * KROWB + kc1 * 16, vl = KT_BYTES + (vc >> 2) * 4096 + vr * 64 + (vc & 3) * 16;
    for (int u0 = opaque_bid(); u0 < nlat + nctx; u0 += gridDim.x) {
        int u = u0;
#if ATT_REMAP
        if (gridDim.x == 256 && u0 < nlat && (SEQ / 256) == 8) { const int c = u0 & 255, x = c & 7, j = c >> 3; u = (u0 & ~255) + 8 * (4 * x + (j >> 3)) + (j & 7); }
#endif
        int b, h, qrow0, nkeys;
        if (u < nlat) { const int qb = u % (SEQ / 256), bh = u / (SEQ / 256); b = bh / MLA_HEADS; h = bh % MLA_HEADS; qrow0 = NC_ + b * SEQ + qb * 256; nkeys = TT_; }
        else { const int v = u - nlat; const int qb = v % (CTX_LEN / 256), bh = v / (CTX_LEN / 256); b = bh / MLA_HEADS; h = bh % MLA_HEADS; qrow0 = b * CTX_LEN + qb * 256; nkeys = CTX_LEN; }
        const int nt = nkeys / 64;
        const bf16_t* qp = Qb + (size_t)(qrow0 + wid * 32 + r) * (MLA_HEADS * 96) + h * 96 + 8 * h2;
        bf16x8 qf[6];
#pragma unroll
        for (int s = 0; s < 6; ++s) qf[s] = *(const GAS bf16x8*)(qp + 16 * s);
        const bf16_t* kbase = Kb + (size_t)(b * MLA_HEADS + h) * TT_ * 96;
        const bf16_t* vbase = Vb + (size_t)(b * MLA_HEADS + h) * TT_ * 64;
#define ATT_LOAD_TO(TI, sk0, sk1, sv) do { if (KVSRC == 0) { const size_t ko = (size_t)(TI) * 64; \
            sk0 = *(const GAS u32x4*)(kbase + (ko + kr0) * 96 + kc0 * 8); if (has_k1) sk1 = *(const GAS u32x4*)(kbase + (ko + kr1) * 96 + kc1 * 8); sv = *(const GAS u32x4*)(vbase + (ko + vr) * 64 + vc * 8); } \
          else { const int t0_ = (TI) * 64; const size_t rb = t0_ < CTX_LEN ? (size_t)b * CTX_LEN + t0_ : (size_t)NC_ + (size_t)b * SEQ + (t0_ - CTX_LEN); \
            sk0 = kc0 < 8 ? *(const GAS u32x4*)(Kb + (rb + kr0) * (MLA_HEADS * 128) + h * 128 + kc0 * 8) : *(const GAS u32x4*)(Vb + (rb + kr0) * 32 + (kc0 - 8) * 8); \
            if (has_k1) sk1 = kc1 < 8 ? *(const GAS u32x4*)(Kb + (rb + kr1) * (MLA_HEADS * 128) + h * 128 + kc1 * 8) : *(const GAS u32x4*)(Vb + (rb + kr1) * 32 + (kc1 - 8) * 8); \
            sv = *(const GAS u32x4*)(Kb + (rb + vr) * (MLA_HEADS * 128) + h * 128 + 64 + vc * 8); } } while (0)
#define ATT_LOAD(TI) ATT_LOAD_TO(TI, sk0, sk1, sv)
        const bool do_rope = rope_tab != nullptr && u < nlat;
        f32x4 rt[2][4];
        if (do_rope) { const int spos = (qrow0 - NC_ + wid * 32 + r) % SEQ; const float* tb = rope_tab + (size_t)spos * 32;
#pragma unroll
            for (int f = 0; f < 2; ++f)
#pragma unroll
                for (int c = 0; c < 4; ++c) rt[f][c] = *(const GAS f32x4*)(tb + 16 * f + 4 * c); }
        u32x4 sk0, sk1 = (u32x4){0u, 0u, 0u, 0u}, sv, tk0, tk1 = (u32x4){0u, 0u, 0u, 0u}, tv;
        ATT_LOAD(0);
        if (nt > 1) { ATT_LOAD_TO(1, tk0, tk1, tv); }
        if (do_rope) {
#pragma unroll
            for (int f = 0; f < 2; ++f) { const u32x4 own = __builtin_bit_cast(u32x4, qf[4 + f]); u32x4 oth;
                oth.x = __shfl_xor(own.x, 32); oth.y = __shfl_xor(own.y, 32); oth.z = __shfl_xor(own.z, 32); oth.w = __shfl_xor(own.w, 32);
                const f32x4 c0 = rt[f][0], c1 = rt[f][1], s0 = rt[f][2], s1 = rt[f][3];
                const float sgn = h2 ? 1.f : -1.f;
                const float x[8] = {bf_lo(own.x), bf_hi(own.x), bf_lo(own.y), bf_hi(own.y), bf_lo(own.z), bf_hi(own.z), bf_lo(own.w), bf_hi(own.w)};
                const float y[8] = {bf_lo(oth.x), bf_hi(oth.x), bf_lo(oth.y), bf_hi(oth.y), bf_lo(oth.z), bf_hi(oth.z), bf_lo(oth.w), bf_hi(oth.w)};
                const float cs[8] = {c0[0], c0[1], c0[2], c0[3], c1[0], c1[1], c1[2], c1[3]}, sn[8] = {s0[0], s0[1], s0[2], s0[3], s1[0], s1[1], s1[2], s1[3]};
                u32x4 w; w.x = pk2(x[0] * cs[0] + sgn * y[0] * sn[0], x[1] * cs[1] + sgn * y[1] * sn[1]); w.y = pk2(x[2] * cs[2] + sgn * y[2] * sn[2], x[3] * cs[3] + sgn * y[3] * sn[3]);
                w.z = pk2(x[4] * cs[4] + sgn * y[4] * sn[4], x[5] * cs[5] + sgn * y[5] * sn[5]); w.w = pk2(x[6] * cs[6] + sgn * y[6] * sn[6], x[7] * cs[7] + sgn * y[7] * sn[7]);
                qf[4 + f] = __builtin_bit_cast(bf16x8, w); } }
#define ATT_QK(S0, S1, BUFP) do { _Pragma("unroll") for (int i = 0; i < 16; ++i) { S0[i] = 0.f; S1[i] = 0.f; } \
            _Pragma("unroll") for (int s = 0; s < 6; ++s) { const bf16x8 k0 = *(const LAS bf16x8*)((BUFP) + r * KROWB + 32 * s + 16 * h2); const bf16x8 k1 = *(const LAS bf16x8*)((BUFP) + (32 + r) * KROWB + 32 * s + 16 * h2); \
                S0 = ATT_MFMA(k0, qf[s], S0); S1 = ATT_MFMA(k1, qf[s], S1); } } while (0)
#define ATT_STORE_STAGE(NB) do { *(LAS u32x4*)((NB) + kl0) = sk0; if (has_k1) *(LAS u32x4*)((NB) + kl1) = sk1; *(LAS u32x4*)((NB) + vl) = sv; } while (0)
        ATT_STORE_STAGE(lds);
        if (nt > 1) { *(LAS u32x4*)(lds + BUF + kl0) = tk0; if (has_k1) *(LAS u32x4*)(lds + BUF + kl1) = tk1; *(LAS u32x4*)(lds + BUF + vl) = tv; }
        __syncthreads();
        f32x16 o0, o1, s0, s1;
#pragma unroll
        for (int i = 0; i < 16; ++i) { o0[i] = 0.f; o1[i] = 0.f; }
        ATT_QK(s0, s1, lds);
        float m = -1e30f, l = 0.f;
        int st_cur = 0;
        for (int t = 0; t < nt; ++t) {
            const int st_nxt = st_cur == 2 ? 0 : st_cur + 1, st_nn = st_nxt == 2 ? 0 : st_nxt + 1;
            LAS unsigned char* buf = lds + st_cur * BUF;
            if (t + 2 < nt) { ATT_LOAD(t + 2); }
            f32x16 n0, n1;
            ATT_QK(n0, n1, lds + st_nxt * BUF);
            float mt = __builtin_fmaxf(s0[0], s1[0]);
#pragma unroll
            for (int i = 1; i < 16; ++i) mt = __builtin_fmaxf(__builtin_fmaxf(mt, s0[i]), s1[i]);
            { float ma = mt, mb = mt; asm volatile("s_nop 1\n\tv_permlane32_swap_b32 %0, %1" : "+v"(ma), "+v"(mb)); mt = fmaxf(ma, mb); }
            if (__any(mt > m + 8.f)) { const float mnew = fmaxf(m, mt), alpha = __builtin_amdgcn_exp2f(m - mnew); m = mnew; l *= alpha;
#pragma unroll
                for (int i = 0; i < 16; ++i) { o0[i] *= alpha; o1[i] *= alpha; } }
            float ls = 0.f;
#pragma unroll
            for (int i = 0; i < 16; ++i) { s0[i] = __builtin_amdgcn_exp2f(s0[i] - m); s1[i] = __builtin_amdgcn_exp2f(s1[i] - m); ls += s0[i] + s1[i]; }
            l += ls;
            LAS unsigned char* vb = buf + KT_BYTES + (4 * h2 + (i16 >> 2)) * 64 + 32 * g1 + 8 * (i16 & 3);
#define ATT_PV(PS, SB, S2) do { const bf16x8 pb = pack8<S2>(PS); \
            { const s16x4 lo = __builtin_amdgcn_ds_read_tr16_b64_v4i16((LAS s16x4*)(vb + (32 * SB + 16 * S2) * 64)), hi = __builtin_amdgcn_ds_read_tr16_b64_v4i16((LAS s16x4*)(vb + (32 * SB + 16 * S2 + 8) * 64)); \
              o0 = ATT_MFMA(__builtin_shufflevector(lo, hi, 0, 1, 2, 3, 4, 5, 6, 7), pb, o0); } \
            { const s16x4 lo = __builtin_amdgcn_ds_read_tr16_b64_v4i16((LAS s16x4*)(vb + 4096 + (32 * SB + 16 * S2) * 64)), hi = __builtin_amdgcn_ds_read_tr16_b64_v4i16((LAS s16x4*)(vb + 4096 + (32 * SB + 16 * S2 + 8) * 64)); \
              o1 = ATT_MFMA(__builtin_shufflevector(lo, hi, 0, 1, 2, 3, 4, 5, 6, 7), pb, o1); } } while (0)
            ATT_PRIO(1); ATT_PV(s0, 0, 0); ATT_PV(s0, 0, 1); ATT_PV(s1, 1, 0); ATT_PV(s1, 1, 1); ATT_PRIO(0);
#undef ATT_PV
            if (t + 2 < nt) ATT_STORE_STAGE(lds + st_nn * BUF);
            __syncthreads();
            s0 = n0; s1 = n1;
            st_cur = st_nxt;
        }
#undef ATT_QK
#undef ATT_STORE_STAGE
        l += __shfl_xor(l, 32);
        const float il = 1.f / l;
        if (BF16OUT) { bf16_t* op = AOB + (size_t)(qrow0 + wid * 32 + r) * 1024 + h * 64 + 4 * h2;
#pragma unroll
            for (int g = 0; g < 4; ++g) {
                *(GAS u32x2*)(op + 8 * g) = (u32x2){pk2(o0[4 * g] * il, o0[4 * g + 1] * il), pk2(o0[4 * g + 2] * il, o0[4 * g + 3] * il)};
                *(GAS u32x2*)(op + 32 + 8 * g) = (u32x2){pk2(o1[4 * g] * il, o1[4 * g + 1] * il), pk2(o1[4 * g + 2] * il, o1[4 * g + 3] * il)}; }
        } else { float* op = AO + (size_t)(qrow0 + wid * 32 + r) * 1024 + h * 64 + 4 * h2;
#pragma unroll
            for (int g = 0; g < 4; ++g) {
                *(GAS f32x4*)(op + 8 * g) = (f32x4){o0[4 * g] * il, o0[4 * g + 1] * il, o0[4 * g + 2] * il, o0[4 * g + 3] * il};
                *(GAS f32x4*)(op + 32 + 8 * g) = (f32x4){o1[4 * g] * il, o1[4 * g + 1] * il, o1[4 * g + 2] * il, o1[4 * g + 3] * il}; } }
    }
}
#undef ATT_LOAD
#undef ATT_LOAD_TO
}

namespace tl {
DI float wsum(float v) { v += __shfl_xor(v, 32); v += __shfl_xor(v, 16); v += __shfl_xor(v, 8); v += __shfl_xor(v, 4); v += __shfl_xor(v, 2); v += __shfl_xor(v, 1); return v; }
DI void ld16f(const float* p, int lane, float (&v)[16]) {
#pragma unroll
    for (int i = 0; i < 2; ++i) { const f32x4 a = *(const GAS f32x4*)(p + 512 * i + 8 * lane), b = *(const GAS f32x4*)(p + 512 * i + 8 * lane + 4);
        v[8 * i] = a[0]; v[8 * i + 1] = a[1]; v[8 * i + 2] = a[2]; v[8 * i + 3] = a[3]; v[8 * i + 4] = b[0]; v[8 * i + 5] = b[1]; v[8 * i + 6] = b[2]; v[8 * i + 7] = b[3]; } }
DI void st16f(float* p, int lane, const float (&v)[16]) {
#pragma unroll
    for (int i = 0; i < 2; ++i) { *(GAS f32x4*)(p + 512 * i + 8 * lane) = (f32x4){v[8 * i], v[8 * i + 1], v[8 * i + 2], v[8 * i + 3]}; *(GAS f32x4*)(p + 512 * i + 8 * lane + 4) = (f32x4){v[8 * i + 4], v[8 * i + 5], v[8 * i + 6], v[8 * i + 7]}; } }
DI void ld16b(const bf16_t* p, int lane, float (&v)[16]) {
#pragma unroll
    for (int i = 0; i < 2; ++i) { const u32x4 w = *(const GAS u32x4*)(p + 512 * i + 8 * lane);
        v[8 * i] = bf_lo(w.x); v[8 * i + 1] = bf_hi(w.x); v[8 * i + 2] = bf_lo(w.y); v[8 * i + 3] = bf_hi(w.y); v[8 * i + 4] = bf_lo(w.z); v[8 * i + 5] = bf_hi(w.z); v[8 * i + 6] = bf_lo(w.w); v[8 * i + 7] = bf_hi(w.w); } }
DI void st16b(bf16_t* p, int lane, const float (&v)[16]) {
#pragma unroll
    for (int i = 0; i < 2; ++i) { u32x4 w; w.x = att::pk2(v[8 * i], v[8 * i + 1]); w.y = att::pk2(v[8 * i + 2], v[8 * i + 3]); w.z = att::pk2(v[8 * i + 4], v[8 * i + 5]); w.w = att::pk2(v[8 * i + 6], v[8 * i + 7]);
        *(GAS u32x4*)(p + 512 * i + 8 * lane) = w; } }
typedef _Float16 f16x8 __attribute__((ext_vector_type(8)));
typedef float f32x8 __attribute__((ext_vector_type(8)));
DI void ld16h(const unsigned short* p, int lane, float (&v)[16]) {
#pragma unroll
    for (int i = 0; i < 2; ++i) { const f16x8 hv = *(const GAS f16x8*)(p + 512 * i + 8 * lane); const f32x8 f = __builtin_convertvector(hv, f32x8);
#pragma unroll
        for (int j = 0; j < 8; ++j) v[8 * i + j] = f[j]; } }
DI void st16h(unsigned short* p, int lane, const float (&v)[16]) {
#pragma unroll
    for (int i = 0; i < 2; ++i) { f32x8 f;
#pragma unroll
        for (int j = 0; j < 8; ++j) f[j] = v[8 * i + j];
        *(GAS f16x8*)(p + 512 * i + 8 * lane) = __builtin_convertvector(f, f16x8); } }
#define TL_ROWS(row, row_lo, nrows) const int rpw_ = ((nrows) + (int)gridDim.x - 1) / (int)gridDim.x, wg_ = opaque_bid(), tid_ = otid(wv_), lane = tid_ & 63, wid_ = tid_ >> 6; (void)lane; \
    for (int rr_ = wid_, row = (row_lo) + wg_ * rpw_ + wid_; rr_ < rpw_ && row < (row_lo) + (nrows); rr_ += 8, row += 8)

DI void init_h(const LAS NaiveCtx* Cp_, int wv_) {
    TL_ROWS(row, 0, NT_) { float h[16], m0[16], m1[16], u[16];
        ld16f(row < NC_ ? (*Cp_).ctx + (size_t)row * D_MODEL : (*Cp_).x + (size_t)(row - NC_) * D_MODEL, lane, h);
        const float* m = (*Cp_).MOD + (size_t)modrow(row) * N_MOD * D_MODEL; ld16f(m, lane, m0); ld16f(m + D_MODEL, lane, m1);
#pragma unroll
        for (int k = 0; k < 16; ++k) u[k] = h[k] * (1.f + m1[k]) + m0[k];
        st16h((*Cp_).HB + (size_t)row * D_MODEL, lane, h); st16b((*Cp_).UB + (size_t)row * D_MODEL, lane, u); }
}


DI void mod_phase(const LAS NaiveCtx* Cp_, LAS unsigned char* lds, int wv_) {
    constexpr int W = N_MOD * D_MODEL, NR = BATCH + 1, NCOLS = DEPTH * W;
    const int t = otid(wv_), wg = opaque_bid(), cpw = (NCOLS + (int)gridDim.x - 1) / (int)gridDim.x;
    LAS float* sl = (LAS float*)(lds + 72 * 1024);
    { constexpr int NV = NR * D_MODEL / PB_THREADS; float cv[NV]; const GAS float* cp = (const GAS float*)(*Cp_).c; const GAS float* cc = (const GAS float*)(*Cp_).c_ctx;
      static_assert(NR * D_MODEL % PB_THREADS == 0, "silu table");
#pragma unroll
      for (int j = 0; j < NV; ++j) { const int i = t + PB_THREADS * j, r = i / D_MODEL, k = i % D_MODEL; cv[j] = r < BATCH ? cp[(size_t)r * D_MODEL + k] : cc[k]; }
#pragma unroll
      for (int j = 0; j < NV; ++j) sl[t + PB_THREADS * j] = siluf_(cv[j]); }
    __syncthreads();
    const int col = wg * cpw + t;
    if (t < cpw && col < NCOLS) { const int l = col / W, j = col % W; const float* w = (*Cp_).mod_w + (size_t)l * D_MODEL * W + j;
        float acc[NR];
#pragma unroll
        for (int r = 0; r < NR; ++r) acc[r] = 0.f;
        for (int k = 0; k < D_MODEL; k += 4) { const GAS float* wg_ = (const GAS float*)w; const float w0 = wg_[(size_t)k * W], w1 = wg_[(size_t)(k + 1) * W], w2 = wg_[(size_t)(k + 2) * W], w3 = wg_[(size_t)(k + 3) * W];
#pragma unroll
            for (int r = 0; r < NR; ++r) { const f32x4 s = *(const LAS f32x4*)(sl + r * D_MODEL + k); acc[r] += s[0] * w0 + s[1] * w1 + s[2] * w2 + s[3] * w3; } }
        const float bj = (*Cp_).mod_b[(size_t)l * W + j];
#pragma unroll
        for (int r = 0; r < NR; ++r) (*Cp_).MOD[((size_t)l * NR + r) * W + j] = acc[r] + bj; }
    __syncthreads();
}

constexpr int WRT_STRIDE = 1028;
__shared__ int tl_lcnt[32], tl_wgbase[32], tl_offs[33], tl_tstart[33], tl_cnt[32];

DI void ln1_row_pre(const LAS NaiveCtx* Cp_, const float* MODp, const float (&g0)[16], const float (&b0)[16], int row, int lane, bool wr, float (&t)[16]) {
    const float* m = MODp + (size_t)modrow(row) * N_MOD * D_MODEL;
    float a[16], b[16];
    ld16h((*Cp_).HB + (size_t)row * D_MODEL, lane, t); ld16b((*Cp_).YOB + (size_t)row * D_MODEL, lane, a); ld16f(m + 2 * D_MODEL, lane, b);
    float s = 0.f;
#pragma unroll
    for (int k = 0; k < 16; ++k) { t[k] = ALPHA * t[k] + b[k] * a[k]; s += t[k]; }
    const float mean = wsum(s) * (1.f / D_MODEL); s = 0.f;
#pragma unroll
    for (int k = 0; k < 16; ++k) { t[k] -= mean; s += t[k] * t[k]; }
    const float rs = 1.f / sqrtf(wsum(s) * (1.f / D_MODEL) + 1e-5f);
    ld16f(m + 3 * D_MODEL, lane, a); ld16f(m + 4 * D_MODEL, lane, b);
#pragma unroll
    for (int k = 0; k < 16; ++k) t[k] = t[k] * rs * g0[k] + b0[k];
    if (wr) st16h((*Cp_).HB + (size_t)row * D_MODEL, lane, t);
#pragma unroll
    for (int k = 0; k < 16; ++k) t[k] = t[k] * (1.f + b[k]) + a[k];
    if (wr) st16b((*Cp_).UB + (size_t)row * D_MODEL, lane, t);
}
DI void ln1_row_post(const LAS NaiveCtx* Cp_, const float* brp, int row, int lane, bool wr, float (&p)[16]) {
#define TL_STAGE(N, BIT) { const bool up_ = (lane & BIT) != 0; _Pragma("unroll") for (int k = 0; k < N / 2; ++k) { const float send_ = up_ ? p[k] : p[k + N / 2], keep_ = up_ ? p[k + N / 2] : p[k]; p[k] = keep_ + __shfl_xor(send_, BIT); } }
        TL_STAGE(16, 16) TL_STAGE(8, 8) TL_STAGE(4, 4) TL_STAGE(2, 2)
#undef TL_STAGE
        const int e_me = (lane >> 1) & 31;
        const float lg = p[0] + __shfl_xor(p[0], 1) + brp[e_me];
        int rank = 0;
#pragma unroll
        for (int e2 = 0; e2 < 32; ++e2) { const float v = __builtin_bit_cast(float, __builtin_amdgcn_readlane(__builtin_bit_cast(int, lg), 2 * e2)); rank += (v > lg || (v == lg && e2 < e_me)) ? 1 : 0; }
        float vk[4]; int ek[4];
#pragma unroll
        for (int k = 0; k < 4; ++k) { const unsigned long long mk = __ballot(rank == k && (lane & 1) == 0); const int src = __builtin_amdgcn_readfirstlane((int)__builtin_ctzll(mk | (1ull << 63)));
            vk[k] = __builtin_bit_cast(float, __builtin_amdgcn_readlane(__builtin_bit_cast(int, lg), src)); ek[k] = src >> 1; }
        float wk[4], den = 0.f;
#pragma unroll
        for (int k = 0; k < 4; ++k) { wk[k] = expf(vk[k] - vk[0]); den += wk[k]; }
        if (wr && lane < 4) { const int e = lane == 0 ? ek[0] : lane == 1 ? ek[1] : lane == 2 ? ek[2] : ek[3]; const float g = (lane == 0 ? wk[0] : lane == 1 ? wk[1] : lane == 2 ? wk[2] : wk[3]) / den;
            const int r = atomicAdd(&tl_lcnt[e], 1);
            (*Cp_).TOPI[(size_t)row * TOP_K + lane] = e; (*Cp_).TOPG[(size_t)row * TOP_K + lane] = g; (*Cp_).SLOT[(size_t)row * TOP_K + lane] = r; }
}
DI void ln1_router(const LAS NaiveCtx* Cp_, LAS unsigned char* lds, long layer, int row_lo, int nrows, int wv_) {
    LAS float* wrt = (LAS float*)lds;
    { const int t = otid(wv_); const float* wrp = (*Cp_).moe_w_router + (size_t)layer * D_MODEL * N_EXPERTS;
      { const GAS f32x4* wrp4 = (const GAS f32x4*)wrp; constexpr int NV = D_MODEL * N_EXPERTS / 4 / PB_THREADS; f32x4 wv[NV];
#pragma unroll
        for (int j = 0; j < NV; ++j) wv[j] = wrp4[t + PB_THREADS * j];
#pragma unroll
        for (int j = 0; j < NV; ++j) { const int idx = 4 * (t + PB_THREADS * j);
#pragma unroll
            for (int c = 0; c < 4; ++c) wrt[((idx + c) & 31) * WRT_STRIDE + ((idx + c) >> 5)] = wv[j][c]; } }
      if (t < 32) tl_lcnt[t] = 0; }
    __syncthreads();
    const float* MODp = (*Cp_).MOD + (size_t)layer * (BATCH + 1) * N_MOD * D_MODEL;
    const float* lg0 = (*Cp_).ln_g + ((size_t)layer * 2) * D_MODEL; const float* lb0 = (*Cp_).ln_b + ((size_t)layer * 2) * D_MODEL;
    const float* brp = (*Cp_).moe_b_router + (size_t)layer * N_EXPERTS;
    { const int rpw_ = (nrows + (int)gridDim.x - 1) / (int)gridDim.x, wg_ = opaque_bid(), tid_ = otid(wv_), lane = tid_ & 63, wid_ = tid_ >> 6;
      float g0[16], b0[16]; ld16f(lg0, lane, g0); ld16f(lb0, lane, b0);
      for (int rr_ = wid_, row = row_lo + wg_ * rpw_ + wid_; rr_ < rpw_ && row < row_lo + nrows; rr_ += 16, row += 16) {
        const bool hasB = (rr_ + 8 < rpw_) && (row + 8 < row_lo + nrows); const int rowB = hasB ? row + 8 : row;
        float tA[16], tB[16];
        ln1_row_pre(Cp_, MODp, g0, b0, row, lane, true, tA); ln1_row_pre(Cp_, MODp, g0, b0, rowB, lane, hasB, tB);
        float pA[16], pB[16];
        const bool up5 = (lane & 32) != 0;
#pragma unroll
        for (int k = 0; k < 16; ++k) { float aA[2], aB[2];
#pragma unroll
            for (int hh = 0; hh < 2; ++hh) { const int e = k + 16 * hh; float accA = 0.f, accB = 0.f;
#pragma unroll
                for (int i = 0; i < 2; ++i) { const f32x4 w0 = *(const LAS f32x4*)(wrt + e * WRT_STRIDE + 512 * i + 8 * lane), w1 = *(const LAS f32x4*)(wrt + e * WRT_STRIDE + 512 * i + 8 * lane + 4);
                    accA += tA[8 * i] * w0[0] + tA[8 * i + 1] * w0[1] + tA[8 * i + 2] * w0[2] + tA[8 * i + 3] * w0[3] + tA[8 * i + 4] * w1[0] + tA[8 * i + 5] * w1[1] + tA[8 * i + 6] * w1[2] + tA[8 * i + 7] * w1[3];
                    accB += tB[8 * i] * w0[0] + tB[8 * i + 1] * w0[1] + tB[8 * i + 2] * w0[2] + tB[8 * i + 3] * w0[3] + tB[8 * i + 4] * w1[0] + tB[8 * i + 5] * w1[1] + tB[8 * i + 6] * w1[2] + tB[8 * i + 7] * w1[3]; }
                aA[hh] = accA; aB[hh] = accB; }
            { const float sendA = up5 ? aA[0] : aA[1], keepA = up5 ? aA[1] : aA[0]; pA[k] = keepA + __shfl_xor(sendA, 32);
              const float sendB = up5 ? aB[0] : aB[1], keepB = up5 ? aB[1] : aB[0]; pB[k] = keepB + __shfl_xor(sendB, 32); }
            __builtin_amdgcn_sched_barrier(0); }
        ln1_row_post(Cp_, brp, row, lane, true, pA); ln1_row_post(Cp_, brp, rowB, lane, hasB, pB);
      } }
    __syncthreads();
    { const int t = otid(wv_); if (t < 32) tl_wgbase[t] = atomicAdd((*Cp_).CNT + layer * 64 + t, tl_lcnt[t]); }
}

DI void slots_gather(const LAS NaiveCtx* Cp_, long layer, int row_lo, int nrows, int wv_) {
    { const int t = otid(wv_); if (t < N_EXPERTS) tl_cnt[t] = ld_cnt((*Cp_).CNT + layer * 64 + t); }
    __syncthreads();
    { const int t = otid(wv_); if (t == 0) { int off = 0; for (int e = 0; e < N_EXPERTS; ++e) { tl_offs[e] = off; tl_tstart[e] = off / MOE_PAD; off += (tl_cnt[e] + MOE_PAD - 1) / MOE_PAD * MOE_PAD; } tl_offs[N_EXPERTS] = off; tl_tstart[N_EXPERTS] = off / MOE_PAD; } }
    __syncthreads();
    { const int rpw_ = (nrows + (int)gridDim.x - 1) / (int)gridDim.x, base = row_lo + opaque_bid() * rpw_, hi = (base + rpw_ < row_lo + nrows) ? base + rpw_ : row_lo + nrows;
      const GAS int* topi = (const GAS int*)(*Cp_).TOPI; GAS int* slotp = (GAS int*)(*Cp_).SLOT; GAS int* tokof = (GAS int*)(*Cp_).TOKOF;
      for (int i = otid(wv_); i < (hi - base) * TOP_K; i += PB_THREADS) { const int row = base + i / TOP_K; const size_t idx = (size_t)base * TOP_K + i;
          const int e = topi[idx]; const int slot = tl_offs[e] + tl_wgbase[e] + slotp[idx]; slotp[idx] = slot;
          tokof[slot] = row; } }
    { const int wg = opaque_bid(), t = otid(wv_);
      if (wg < N_EXPERTS) { const int cnt = tl_cnt[wg], lo = tl_offs[wg] + cnt, hi = tl_offs[wg + 1]; for (int s = lo + t; s < hi; s += PB_THREADS) (*Cp_).TOKOF[s] = 0; } }
}

DI void cmb_issue(const LAS NaiveCtx* Cp_, int row, int lane, u32x4 (&o)[4][2], float (&g)[4], f16x8 (&h)[2]) {
    const GAS int* sp = (const GAS int*)((*Cp_).SLOT + (size_t)row * TOP_K); const GAS float* gp = (const GAS float*)((*Cp_).TOPG + (size_t)row * TOP_K);
    int sl[4];
#pragma unroll
    for (int q = 0; q < 4; ++q) { sl[q] = sp[q]; g[q] = gp[q]; }
#pragma unroll
    for (int q = 0; q < 4; ++q) { const GAS u32x4* p = (const GAS u32x4*)((*Cp_).OUT2B + (size_t)sl[q] * D_MODEL + 8 * lane); o[q][0] = p[0]; o[q][1] = p[64]; }
#pragma unroll
    for (int i = 0; i < 2; ++i) h[i] = *(const GAS f16x8*)((*Cp_).HB + (size_t)row * D_MODEL + 512 * i + 8 * lane);
}
DI void cmb_finish(const LAS NaiveCtx* Cp_, const float* MODp, const float (&g1)[16], const float (&b1)[16], bool last, int row, int lane, bool wr, const u32x4 (&o)[4][2], const float (&g)[4], const f16x8 (&h)[2]) {
    const float* m = MODp + (size_t)modrow(row) * N_MOD * D_MODEL;
    float f[16], t[16], a[16], b[16];
#pragma unroll
    for (int k = 0; k < 16; ++k) f[k] = 0.f;
#pragma unroll
    for (int q = 0; q < 4; ++q)
#pragma unroll
        for (int i = 0; i < 2; ++i) { const u32x4 w = o[q][i];
            f[8 * i] += g[q] * bf_lo(w.x); f[8 * i + 1] += g[q] * bf_hi(w.x); f[8 * i + 2] += g[q] * bf_lo(w.y); f[8 * i + 3] += g[q] * bf_hi(w.y);
            f[8 * i + 4] += g[q] * bf_lo(w.z); f[8 * i + 5] += g[q] * bf_hi(w.z); f[8 * i + 6] += g[q] * bf_lo(w.w); f[8 * i + 7] += g[q] * bf_hi(w.w); }
#pragma unroll
    for (int i = 0; i < 2; ++i) { const f32x8 hf = __builtin_convertvector(h[i], f32x8);
#pragma unroll
        for (int j = 0; j < 8; ++j) t[8 * i + j] = hf[j]; }
    ld16f(m + 5 * D_MODEL, lane, b);
    float s = 0.f;
#pragma unroll
    for (int k = 0; k < 16; ++k) { t[k] = ALPHA * t[k] + b[k] * f[k]; s += t[k]; }
    const float mean = wsum(s) * (1.f / D_MODEL); s = 0.f;
#pragma unroll
    for (int k = 0; k < 16; ++k) { t[k] -= mean; s += t[k] * t[k]; }
    const float rs = 1.f / sqrtf(wsum(s) * (1.f / D_MODEL) + 1e-5f);
#pragma unroll
    for (int k = 0; k < 16; ++k) t[k] = t[k] * rs * g1[k] + b1[k];
    if (!wr) return;
    if (last) { st16f((*Cp_).out + (size_t)(row - NC_) * D_MODEL, lane, t); }
    else { const float* mn = MODp + (size_t)(BATCH + 1) * N_MOD * D_MODEL + (size_t)modrow(row) * N_MOD * D_MODEL; ld16f(mn, lane, a); ld16f(mn + D_MODEL, lane, b);
        st16h((*Cp_).HB + (size_t)row * D_MODEL, lane, t);
#pragma unroll
        for (int k = 0; k < 16; ++k) t[k] = t[k] * (1.f + b[k]) + a[k];
        st16b((*Cp_).UB + (size_t)row * D_MODEL, lane, t); }
}
DI void combine_ln2(const LAS NaiveCtx* Cp_, long layer, int row_lo, int nrows, int wv_) {
    const float* MODp = (*Cp_).MOD + (size_t)layer * (BATCH + 1) * N_MOD * D_MODEL;
    const float* lg1 = (*Cp_).ln_g + ((size_t)layer * 2 + 1) * D_MODEL; const float* lb1 = (*Cp_).ln_b + ((size_t)layer * 2 + 1) * D_MODEL;
    const bool last = layer == DEPTH - 1;
    const int rpw_ = (nrows + (int)gridDim.x - 1) / (int)gridDim.x, wg_ = opaque_bid(), tid_ = otid(wv_), lane = tid_ & 63, wid_ = tid_ >> 6;
    float g1[16], b1[16]; ld16f(lg1, lane, g1); ld16f(lb1, lane, b1);
    for (int rr_ = wid_, row = row_lo + wg_ * rpw_ + wid_; rr_ < rpw_ && row < row_lo + nrows; rr_ += 16, row += 16) {
        const bool hasB = (rr_ + 8 < rpw_) && (row + 8 < row_lo + nrows); const int rowB = hasB ? row + 8 : row;
        u32x4 oA[4][2], oB[4][2]; float gA[4], gB[4]; f16x8 hA[2], hB[2];
        cmb_issue(Cp_, row, lane, oA, gA, hA); cmb_issue(Cp_, rowB, lane, oB, gB, hB);
        cmb_finish(Cp_, MODp, g1, b1, last, row, lane, true, oA, gA, hA); cmb_finish(Cp_, MODp, g1, b1, last, rowB, lane, hasB, oB, gB, hB);
    }
}
}

namespace tl {
DI u32x4 pack8f(const float (&v)[8]) { u32x4 w; w.x = att::pk2(v[0], v[1]); w.y = att::pk2(v[2], v[3]); w.z = att::pk2(v[4], v[5]); w.w = att::pk2(v[6], v[7]); return w; }
DI void ld8f(const float* p, float (&v)[8]) { const f32x4 a = *(const GAS f32x4*)p, b = *(const GAS f32x4*)(p + 4); v[0] = a[0]; v[1] = a[1]; v[2] = a[2]; v[3] = a[3]; v[4] = b[0]; v[5] = b[1]; v[6] = b[2]; v[7] = b[3]; }
DI void st8f(float* p, const float (&v)[8]) { *(GAS f32x4*)p = (f32x4){v[0], v[1], v[2], v[3]}; *(GAS f32x4*)(p + 4) = (f32x4){v[4], v[5], v[6], v[7]}; }
DI void up8b(const u32x4 w, float (&v)[8]) { v[0] = bf_lo(w.x); v[1] = bf_hi(w.x); v[2] = bf_lo(w.y); v[3] = bf_hi(w.y); v[4] = bf_lo(w.z); v[5] = bf_hi(w.z); v[6] = bf_lo(w.w); v[7] = bf_hi(w.w); }
DI void ld8b(const bf16_t* p, float (&v)[8]) { const u32x4 w = *(const GAS u32x4*)p; v[0] = bf_lo(w.x); v[1] = bf_hi(w.x); v[2] = bf_lo(w.y); v[3] = bf_hi(w.y); v[4] = bf_lo(w.z); v[5] = bf_hi(w.z); v[6] = bf_lo(w.w); v[7] = bf_hi(w.w); }
DI void shifted8(const float* Z, int ldz, int row, int c, bool has_p, bool has_n, const float* mu, float (&o)[8]) {
    float z[8], p[8], n[8], m[8]; ld8f(Z + (size_t)row * ldz + c, z); ld8f(mu + c, m);
    if (has_p) ld8f(Z + (size_t)(row - 1) * ldz + c, p); else {
#pragma unroll
        for (int j = 0; j < 8; ++j) p[j] = 0.f; }
    if (has_n) ld8f(Z + (size_t)(row + 1) * ldz + c, n); else {
#pragma unroll
        for (int j = 0; j < 8; ++j) n[j] = 0.f; }
#pragma unroll
    for (int j = 0; j < 8; ++j) o[j] = z[j] + m[j] * (0.5f * (p[j] + n[j]) - z[j]);
}
DI void shifted8b(const bf16_t* Z, int row, int c, bool has_p, bool has_n, const float* mu, float (&o)[8]) {
    float z[8], p[8], n[8], m[8]; ld8b(Z + (size_t)row * 4608 + c, z); ld8f(mu + c, m);
    if (has_p) ld8b(Z + (size_t)(row - 1) * 4608 + c, p); else {
#pragma unroll
        for (int j = 0; j < 8; ++j) p[j] = 0.f; }
    if (has_n) ld8b(Z + (size_t)(row + 1) * 4608 + c, n); else {
#pragma unroll
        for (int j = 0; j < 8; ++j) n[j] = 0.f; }
#pragma unroll
    for (int j = 0; j < 8; ++j) o[j] = z[j] + m[j] * (0.5f * (p[j] + n[j]) - z[j]);
}
#define TL_SEG(row, t, len) int t, len; if ((row) < NC_) { t = (row) % CTX_LEN; len = CTX_LEN; } else { t = ((row) - NC_) % SEQ; len = SEQ; }

DI void rw_tw(const LAS NaiveCtx* Cp_, long layer, int wv_) {
    const float* mu = (*Cp_).rw_mu + (size_t)(layer / 2) * RW_IN;
    TL_ROWS(row, 0, NT_) { if (lane < 48) { TL_SEG(row, t, len); float zs[8]; shifted8b((*Cp_).ZB, row, 1536 + 8 * lane, t > 0, t < len - 1, mu, zs);
#pragma unroll
            for (int j = 0; j < 8; ++j) zs[j] = lane < 16 ? ftanh(zs[j]) : (lane < 32 ? zs[j] : fsigmoid(zs[j]));
            *(GAS u32x4*)((*Cp_).TW + (size_t)row * 384 + 8 * lane) = pack8f(zs); } }
}

DI void rw_prep(const LAS NaiveCtx* Cp_, long layer, int wv_) {
    const long j2 = layer / 2;
    const float* mu = (*Cp_).rw_mu + (size_t)j2 * RW_IN;
    const float *w0 = (*Cp_).rw_w0 + (size_t)j2 * 1024, *a0 = (*Cp_).rw_a0 + (size_t)j2 * 1024, *kkp = (*Cp_).rw_k_k + (size_t)j2 * 512, *kap = (*Cp_).rw_k_a + (size_t)j2 * 512, *rkp = (*Cp_).rw_r_k + (size_t)j2 * 512;
    TL_ROWS(row, 0, NT_) { TL_SEG(row, t, len); const bool hp = t > 0, hn = t < len - 1; const int c0 = 8 * lane;
        float r[8], k[8], v[8], tmp[8], kk[8], g[8];
        const bf16_t* lo = (*Cp_).LOB + (size_t)row * 2560;
        const u32x4 lwl0 = *(const GAS u32x4*)(lo + c0), lwl1 = *(const GAS u32x4*)(lo + 512 + c0), lal0 = *(const GAS u32x4*)(lo + 1024 + c0), lal1 = *(const GAS u32x4*)(lo + 1536 + c0), lg = *(const GAS u32x4*)(lo + 2048 + c0);
        shifted8b((*Cp_).ZB, row, c0, hp, hn, mu, r); shifted8b((*Cp_).ZB, row, 512 + c0, hp, hn, mu, k); shifted8b((*Cp_).ZB, row, 1024 + c0, hp, hn, mu, v);
        ld8f(kkp + c0, tmp); float ss = 0.f;
#pragma unroll
        for (int j = 0; j < 8; ++j) { kk[j] = k[j] * tmp[j]; ss += kk[j] * kk[j]; }
        ss += __shfl_xor(ss, 1); ss += __shfl_xor(ss, 2); ss += __shfl_xor(ss, 4);
        const float inv = 1.f / sqrtf(fmaxf(ss, 1e-24f));
#pragma unroll
        for (int j = 0; j < 8; ++j) { kk[j] *= inv; tmp[j] = -kk[j]; }
        *(GAS u32x4*)((*Cp_).RBh + (size_t)row * 512 + c0) = pack8f(r); *(GAS u32x4*)((*Cp_).VBh + (size_t)row * 512 + c0) = pack8f(v); *(GAS u32x4*)((*Cp_).NKh + (size_t)row * 512 + c0) = pack8f(tmp);
        *(GAS u32x4*)((*Cp_).GBh + (size_t)row * 512 + c0) = lg; (void)g;
        float ka[8], rk[8], bon = 0.f; ld8f(kap + c0, ka); ld8f(rkp + c0, rk);
#pragma unroll
        for (int d = 0; d < 2; ++d) { float wl[8], al[8], wb[8], ab[8], dec[8], kd[8], bb[8];
            up8b(d ? lwl1 : lwl0, wl); up8b(d ? lal1 : lal0, al); ld8f(w0 + d * 512 + c0, wb); ld8f(a0 + d * 512 + c0, ab);
#pragma unroll
            for (int j = 0; j < 8; ++j) { const float wpre = wb[j] + wl[j]; dec[j] = -1.4426950408889634f * fexp(-fsoftplus(-wpre) - 0.5f);     const float a = fsigmoid(ab[j] + al[j]);
                kd[j] = k[j] * (1.f + (a - 1.f) * ka[j]); bb[j] = kk[j] * a; bon += r[j] * kd[j] * rk[j]; }
            const size_t o = ((size_t)d * NT_ + row) * 512 + c0; st8f((*Cp_).DEC + o, dec); *(GAS u32x4*)((*Cp_).KDh + o) = pack8f(kd); *(GAS u32x4*)((*Cp_).BBh + o) = pack8f(bb); }
        bon += __shfl_xor(bon, 1); bon += __shfl_xor(bon, 2); bon += __shfl_xor(bon, 4);
        if ((lane & 7) == 0) (*Cp_).BON[(size_t)row * 8 + (lane >> 3)] = bon;
    }
}

DI void even_post(const LAS NaiveCtx* Cp_, long layer, int wv_) {
    const long j2 = layer / 2;
    const float *gng = (*Cp_).rw_gn_g + (size_t)j2 * 512, *gnb = (*Cp_).rw_gn_b + (size_t)j2 * 512, *hgn = (*Cp_).hg_norm_g + (size_t)j2 * 512;
    TL_ROWS(row, 0, NT_) { const int c0 = 8 * lane;
        const u32x4 eo0 = *(const GAS u32x4*)((*Cp_).OBh + (size_t)row * 512 + c0), eo1 = *(const GAS u32x4*)((*Cp_).OBh + ((size_t)NT_ + row) * 512 + c0), egz = *(const GAS u32x4*)((*Cp_).ZB + (size_t)row * 4608 + RW_IN + 2048 + c0);
        { float y[8], y1[8], a[8], b[8], v[8], g[8], o[8];
          const u32x4 ry = *(const GAS u32x4*)((*Cp_).YBh + (size_t)row * 512 + c0), ry1 = *(const GAS u32x4*)((*Cp_).YBh + ((size_t)NT_ + row) * 512 + c0), rv = *(const GAS u32x4*)((*Cp_).VBh + (size_t)row * 512 + c0), rg = *(const GAS u32x4*)((*Cp_).GBh + (size_t)row * 512 + c0);
          const float bon = ((const GAS float*)(*Cp_).BON)[(size_t)row * 8 + (lane >> 3)]; ld8f(gng + c0, a); ld8f(gnb + c0, b);
          up8b(ry, y); up8b(ry1, y1);
          float s = 0.f;
#pragma unroll
          for (int j = 0; j < 8; ++j) { y[j] += y1[j]; s += y[j]; }
          s += __shfl_xor(s, 1); s += __shfl_xor(s, 2); s += __shfl_xor(s, 4); const float mean = s * (1.f / 64.f); s = 0.f;
#pragma unroll
          for (int j = 0; j < 8; ++j) { y[j] -= mean; s += y[j] * y[j]; }
          s += __shfl_xor(s, 1); s += __shfl_xor(s, 2); s += __shfl_xor(s, 4); const float rs = 1.f / sqrtf(s * (1.f / 64.f) + 64e-5f);
          up8b(rv, v); up8b(rg, g);
#pragma unroll
          for (int j = 0; j < 8; ++j) o[j] = (y[j] * rs * a[j] + b[j] + bon * v[j]) * g[j];
          *(GAS u32x4*)((*Cp_).YCATB + (size_t)row * 1024 + c0) = pack8f(o); }
        { float o[8], t0[8], a[8], gz[8]; up8b(eo0, o); up8b(eo1, t0);
#pragma unroll
          for (int j = 0; j < 8; ++j) o[j] += t0[j];
          float s = 0.f;
#pragma unroll
          for (int j = 0; j < 8; ++j) s += o[j] * o[j];
          s += __shfl_xor(s, 1); s += __shfl_xor(s, 2); s += __shfl_xor(s, 4); s += __shfl_xor(s, 8); const float rs = 1.f / sqrtf(s * (1.f / 128.f) + 1e-6f);
          ld8f(hgn + c0, a); up8b(egz, gz);
#pragma unroll
          for (int j = 0; j < 8; ++j) o[j] = o[j] * rs * a[j] * fsilu(gz[j]);
          *(GAS u32x4*)((*Cp_).YCATB + (size_t)row * 1024 + 512 + c0) = pack8f(o); }
    }
}

DI void mla_prep(const LAS NaiveCtx* Cp_, long layer, int wv_) {
    const long j2 = layer / 2; const float* qng = (*Cp_).mla_q_norm_g + (size_t)j2 * MLA_QR; const float* kvng = (*Cp_).mla_kv_norm_g + (size_t)j2 * MLA_KVR;
    TL_ROWS(row, 0, NT_) { const GAS bf16_t* z = (const GAS bf16_t*)(*Cp_).Z + (size_t)row * 512;
        const u32x2 qw = *(const GAS u32x2*)(z + 4 * lane); const f32x4 q = (f32x4){bf_lo(qw.x), bf_hi(qw.x), bf_lo(qw.y), bf_hi(qw.y)};
        const unsigned kvw = *(const GAS unsigned*)(z + 256 + 2 * lane); const float kv0 = bf_lo(kvw), kv1 = bf_hi(kvw); const float x = lane < 32 ? bf_lo((unsigned)z[384 + lane]) : 0.f;
        const float rsq = 1.f / sqrtf(wsum(q[0] * q[0] + q[1] * q[1] + q[2] * q[2] + q[3] * q[3]) * (1.f / MLA_QR) + 1e-6f);
        const f32x4 gq = *(const GAS f32x4*)(qng + 4 * lane);
        *(GAS u32x2*)((*Cp_).QNB + (size_t)row * 256 + 4 * lane) = (u32x2){att::pk2(q[0] * rsq * gq[0], q[1] * rsq * gq[1]), att::pk2(q[2] * rsq * gq[2], q[3] * rsq * gq[3])};
        const float rskv = 1.f / sqrtf(wsum(kv0 * kv0 + kv1 * kv1) * (1.f / MLA_KVR) + 1e-6f);
        *(GAS unsigned*)((*Cp_).KVNB + (size_t)row * 256 + 2 * lane) = att::pk2(kv0 * rskv * kvng[2 * lane], kv1 * rskv * kvng[2 * lane + 1]);
        *(GAS unsigned*)((*Cp_).KVNB + (size_t)row * 256 + 128 + 2 * lane) = 0u;
        const float partner = __shfl_xor(x, 8); float outv = x; int b, t;
        if (row >= NC_) { const int s = (row - NC_) % SEQ; b = (row - NC_) / SEQ; t = CTX_LEN + s; const float pos = (float)((lane & 16) ? (s % GRID_W) : (s / GRID_W));
            const float ang = pos * exp2f(-(float)(lane & 7) * 1.6609640474436812f); const float cs = cosf(ang), sn = sinf(ang); outv = (lane & 8) ? x * cs + partner * sn : x * cs - partner * sn; }
        else { b = row / CTX_LEN; t = row % CTX_LEN; }
        (void)b; (void)t; if (lane < 32) (*Cp_).KPEB[(size_t)row * 32 + lane] = f2bf(outv);
    }
}
DI void rope_table(const LAS NaiveCtx* Cp_, int wv_) {
    GRID_STRIDE_WAVES(i, (long)SEQ * 16) { const int s = (int)(i >> 4), q = (int)(i & 15); const float pos = (float)((q & 8) ? (s % GRID_W) : (s / GRID_W)); const float ang = pos * exp2f(-(float)(q & 7) * 1.6609640474436812f);
        (*Cp_).ROPE[(size_t)s * 32 + (q & 8) * 2 + (q & 7)] = cosf(ang); (*Cp_).ROPE[(size_t)s * 32 + (q & 8) * 2 + 8 + (q & 7)] = sinf(ang); }
}
DI void rope_q(const LAS NaiveCtx* Cp_, int wv_) {
    GRID_STRIDE_WAVES(i, (long)NL_ * MLA_HEADS) { const int h = (int)(i % MLA_HEADS); const long lr = i / MLA_HEADS; const int s = (int)(lr % SEQ);
        bf16_t* p = (*Cp_).QB + (size_t)(NC_ + lr) * (MLA_HEADS * 96) + h * 96 + 64; const float* tab = (*Cp_).ROPE + (size_t)s * 32;
        float r1[8], r2[8], c1[8], c2[8], cr[8], sr[8], cc[8], sc[8], o[8];
        ld8b(p, r1); ld8b(p + 8, r2); ld8b(p + 16, c1); ld8b(p + 24, c2); ld8f(tab, cr); ld8f(tab + 8, sr); ld8f(tab + 16, cc); ld8f(tab + 24, sc);
#pragma unroll
        for (int j = 0; j < 8; ++j) o[j] = r1[j] * cr[j] - r2[j] * sr[j];
        *(GAS u32x4*)p = pack8f(o);
#pragma unroll
        for (int j = 0; j < 8; ++j) o[j] = r2[j] * cr[j] + r1[j] * sr[j];
        *(GAS u32x4*)(p + 8) = pack8f(o);
#pragma unroll
        for (int j = 0; j < 8; ++j) o[j] = c1[j] * cc[j] - c2[j] * sc[j];
        *(GAS u32x4*)(p + 16) = pack8f(o);
#pragma unroll
        for (int j = 0; j < 8; ++j) o[j] = c2[j] * cc[j] + c1[j] * sc[j];
        *(GAS u32x4*)(p + 24) = pack8f(o); }
}
DI void lora_weights(const LAS NaiveCtx* Cp_, int wv_) {
    GRID_STRIDE_WAVES(i, (long)N_EVEN * 2560 * 384) { const int k = (int)(i % 384); const long t = i / 384; const int n = (int)(t % 2560), j = (int)(t / 2560); const int blk = n >> 9, c = n & 511; float v = 0.f;
        if (blk < 2) { if (k >= blk * 64 && k < blk * 64 + 64) v = (*Cp_).rw_w2[(((size_t)j * 2 + blk) * 64 + (k - blk * 64)) * 512 + c]; }
        else if (blk < 4) { const int d = blk - 2; if (k >= 128 + d * 64 && k < 128 + d * 64 + 64) v = (*Cp_).rw_a2[(((size_t)j * 2 + d) * 64 + (k - 128 - d * 64)) * 512 + c]; }
        else { if (k >= 256) v = (*Cp_).rw_g2[((size_t)j * 128 + (k - 256)) * 512 + c]; }
        (*Cp_).Wlora[i] = f2bf(v); }
}
}

namespace scan {
#ifndef SC_L32_PERM
#define SC_L32_PERM 1
#endif
#ifndef SC_L16_PERM
#define SC_L16_PERM 1
#endif
#ifndef SC_L8_DPP
#define SC_L8_DPP 1
#endif
#define SC_DPP(x, CTRL) __builtin_bit_cast(float, __builtin_amdgcn_update_dpp(0, __builtin_bit_cast(int, (x)), (CTRL), 0xF, 0xF, true))
DI float swap32_sum(float a, float b) { asm volatile("s_nop 1\n\tv_permlane32_swap_b32 %0, %1" : "+v"(a), "+v"(b)); return a + b; }
DI float swap16_sum(float a, float b) { asm volatile("s_nop 1\n\tv_permlane16_swap_b32 %0, %1" : "+v"(a), "+v"(b)); return a + b; }
DI float reduce8(const float (&x)[8], int lane) {
    float y0, y1, y2, y3, z0, z1, w;
#if SC_L32_PERM
    y0 = swap32_sum(x[0], x[4]); y1 = swap32_sum(x[1], x[5]); y2 = swap32_sum(x[2], x[6]); y3 = swap32_sum(x[3], x[7]);
#else
    { const bool up = (lane & 32) != 0;
      y0 = (up ? x[4] : x[0]) + __shfl_xor(up ? x[0] : x[4], 32); y1 = (up ? x[5] : x[1]) + __shfl_xor(up ? x[1] : x[5], 32);
      y2 = (up ? x[6] : x[2]) + __shfl_xor(up ? x[2] : x[6], 32); y3 = (up ? x[7] : x[3]) + __shfl_xor(up ? x[3] : x[7], 32); }
#endif
#if SC_L16_PERM
    z0 = swap16_sum(y0, y2); z1 = swap16_sum(y1, y3);
#else
    { const bool up = (lane & 16) != 0; z0 = (up ? y2 : y0) + __shfl_xor(up ? y0 : y2, 16); z1 = (up ? y3 : y1) + __shfl_xor(up ? y1 : y3, 16); }
#endif
    { const bool b3 = (lane & 8) != 0; const float keep = b3 ? z1 : z0, send = b3 ? z0 : z1;
#if SC_L8_DPP
      w = keep + SC_DPP(send, 0x128);
      w += SC_DPP(w, 0x141);
      w += SC_DPP(w, 0x4E);
      w += SC_DPP(w, 0xB1);
#else
      w = keep + __shfl_xor(send, 8); w += __shfl_xor(w, 4); w += __shfl_xor(w, 2); w += __shfl_xor(w, 1);
#endif
    }
    return w;
}
constexpr int TB = 32, STEP_F = 384, BUF_F = TB * STEP_F;

DI void rwkv_scan(const LAS NaiveCtx* Cp_, LAS unsigned char* lds, int wv_) {
    const int tid = otid(wv_), lane = tid & 63, wid = tid >> 6;
    LAS float* ldsf = (LAS float*)lds; LAS float* ybuf = ldsf + 2 * BUF_F;
    for (int chain = opaque_bid(); chain < 2 * BATCH * RW_HEADS; chain += gridDim.x) {
        const int d = chain / (BATCH * RW_HEADS), b = (chain / RW_HEADS) % BATCH, h = chain % RW_HEADS;
        const float* pA = (*Cp_).NKK + h * 64; const float* pW = (*Cp_).DEC + (size_t)d * NT_ * 512 + h * 64; const float* pB = (*Cp_).BB + (size_t)d * NT_ * 512 + h * 64;
        const float* pK = (*Cp_).KD + (size_t)d * NT_ * 512 + h * 64; const float* pR = (*Cp_).R + h * 64; const float* pV = (*Cp_).V + h * 64;
        float* pY = (*Cp_).Y + (size_t)d * NT_ * 512 + h * 64;
        float S[8];
#pragma unroll
        for (int j = 0; j < 8; ++j) S[j] = 0.f;
        f32x4 st[6];
#define SC_LOAD(T0) do { _Pragma("unroll") for (int q = 0; q < 6; ++q) { const int idx = tid + 512 * q, i = idx / 96, rem = idx % 96, arr = rem >> 4, part = rem & 15; \
            const size_t row = (size_t)tokrow(b, scan_pos(d, (T0) + i)); const float* src = arr == 0 ? pA : arr == 1 ? pW : arr == 2 ? pB : arr == 3 ? pK : arr == 4 ? pR : pV; \
            st[q] = *(const f32x4*)(src + row * 512 + part * 4); } } while (0)
#define SC_STORE(BUFI) do { _Pragma("unroll") for (int q = 0; q < 6; ++q) { const int idx = tid + 512 * q, i = idx / 96, rem = idx % 96; *(LAS f32x4*)(ldsf + (BUFI) * BUF_F + i * STEP_F + rem * 4) = st[q]; } } while (0)
        SC_LOAD(0); SC_STORE(0);
        __syncthreads();
        constexpr int NB = TT_ / TB;
        for (int blk = 0; blk < NB; ++blk) {
            if (blk + 1 < NB) SC_LOAD((blk + 1) * TB);
            const LAS float* buf = ldsf + (blk & 1) * BUF_F;
#pragma unroll 2
            for (int i = 0; i < TB; ++i) { const LAS float* sp = buf + i * STEP_F;
                const float a = sp[lane], w = sp[64 + lane], bb = sp[128 + lane], kd = sp[192 + lane], r = sp[256 + lane];
                const f32x4 v0 = *(const LAS f32x4*)(sp + 320 + 8 * wid), v1 = *(const LAS f32x4*)(sp + 324 + 8 * wid);
                float p[8];
#pragma unroll
                for (int j = 0; j < 8; ++j) p[j] = S[j] * a;
                const float wsa = reduce8(p, lane);
#pragma unroll
                for (int j = 0; j < 8; ++j) { const float sa = __builtin_bit_cast(float, __builtin_amdgcn_readlane(__builtin_bit_cast(int, wsa), 8 * j)); const float vv = j < 4 ? v0[j & 3] : v1[j & 3];
                    S[j] = S[j] * w + sa * bb + vv * kd; p[j] = S[j] * r; }
                const float wy = reduce8(p, lane);
                if ((lane & 7) == 0) ybuf[i * 64 + 8 * wid + (lane >> 3)] = wy; }
            __syncthreads();
            { const int i = tid >> 4, v4 = (tid & 15) * 4; const size_t row = (size_t)tokrow(b, scan_pos(d, blk * TB + i)); *(f32x4*)(pY + row * 512 + v4) = *(const LAS f32x4*)(ybuf + i * 64 + v4); }
            if (blk + 1 < NB) SC_STORE((blk + 1) & 1);
            __syncthreads();
        }
#undef SC_LOAD
#undef SC_STORE
    }
}
}

namespace hg {
typedef short s16x4 __attribute__((ext_vector_type(4)));
constexpr int RS = 272, RS2 = 40;
constexpr int OFF_QT = 0, OFF_KT = OFF_QT + 16 * RS, OFF_KH = OFF_KT + 16 * RS, OFF_VT = OFF_KH + 128 * RS2, OFF_ST = OFF_VT + 64 * RS2, OFF_P = OFF_ST + 2 * 64 * RS, OFF_GS = OFF_P + 512, OFF_SC = OFF_GS + 2048, OFF_V32 = OFF_SC + 4 * 16 * 80, HG_LDS = OFF_V32 + 64 * 80;
#define HG_MFMA16(a, b, c) __builtin_amdgcn_mfma_f32_16x16x16bf16_1k((a), (b), (c), 0, 0, 0)
#define HG_MFMA32(a, b, c) __builtin_amdgcn_mfma_f32_16x16x32_bf16((a), (b), (c), 0, 0, 0)
DI unsigned short bfr(float x) { return (unsigned short)(att::pk2(x, 0.f) & 0xffffu); }

DI void hgrn_scan(const LAS NaiveCtx* Cp_, LAS unsigned char* lds, long layer, int wv_) {
    const int tid = otid(wv_), lane = tid & 63, wid = tid >> 6, l15 = lane & 15, g = lane >> 4;
    const int k = tid & 127, tq = tid >> 7;
    LAS float* gsum = (LAS float*)(lds + OFF_GS); LAS float* p15 = (LAS float*)(lds + OFF_P);
    for (int unit = opaque_bid(); unit < 2 * BATCH * HG_HEADS * 2; unit += gridDim.x) {
        const int vh = unit & 1, h = (unit >> 1) % HG_HEADS, b = (unit / (2 * HG_HEADS)) % BATCH, d = unit / (2 * HG_HEADS * BATCH);
        const GAS bf16_t* pF = (const GAS bf16_t*)((*Cp_).ZB + RW_IN + 512 + d * 512 + h * 128 + k); const GAS bf16_t* pQ = (const GAS bf16_t*)((*Cp_).ZB + RW_IN + h * 128 + k);
        const GAS bf16_t* pV = (const GAS bf16_t*)((*Cp_).ZB + RW_IN + 1536 + h * 128 + vh * 64 + (tid & 15) * 4);
        float lower;
        { const long j2 = layer / 2; float mx = -1e30f;
#pragma unroll
          for (int qq = 0; qq < N_EVEN; ++qq) mx = fmaxf(mx, (*Cp_).hg_lb[((size_t)qq * 2 + d) * 512 + h * 128 + k]);
          float den = 0.f, num = 0.f;
#pragma unroll
          for (int qq = 0; qq < N_EVEN; ++qq) { const float e = fexp((*Cp_).hg_lb[((size_t)qq * 2 + d) * 512 + h * 128 + k] - mx); den += e; if (qq >= 1 && qq <= j2) num += e; }
          lower = num / den; }
        GAS bf16_t* pO = (GAS bf16_t*)((*Cp_).OBh + (size_t)d * NT_ * 512 + h * 128 + vh * 64);
        f32x4 acc[4];
#pragma unroll
        for (int n = 0; n < 4; ++n) acc[n] = (f32x4){0.f, 0.f, 0.f, 0.f};
        for (int i = tid; i < 64 * RS / 4; i += PB_THREADS) ((LAS unsigned*)(lds + OFF_ST))[i] = 0u;
        for (int i = tid; i < (4 * 16 * 80) / 4; i += PB_THREADS) ((LAS unsigned*)(lds + OFF_SC))[i] = 0u;
        unsigned fX[4][4], qX[4][4]; u32x2 vX[4];
        vX[0] = (u32x2){0u, 0u}; vX[1] = vX[0]; vX[2] = vX[0]; vX[3] = vX[0];
#define HG_ROWBASE(C0, rb) long rb; { const int i0_ = (C0) * 16; if (i0_ < CTX_LEN) rb = (long)b * CTX_LEN + (d ? CTX_LEN - 1 - i0_ : i0_); else rb = (long)NC_ + (long)b * SEQ + (d ? SEQ - 1 - (i0_ - CTX_LEN) : (i0_ - CTX_LEN)); }
#define HG_LOAD(C0, S) do { HG_ROWBASE(C0, rb_) const long sg_ = d ? -1 : 1; _Pragma("unroll") for (int i = 0; i < 4; ++i) { const long row = rb_ + sg_ * (4 * tq + i); fX[S][i] = pF[row * 4608]; qX[S][i] = pQ[row * 4608]; } \
            if (tid < 256) { const long row = rb_ + sg_ * (tid >> 4); vX[S] = *(const GAS u32x2*)(pV + row * 4608); } } while (0)
        HG_LOAD(0, 0); HG_LOAD(1, 1); HG_LOAD(2, 2); HG_LOAD(3, 3);
        constexpr int NCH = TT_ / 16;
        static_assert(NCH % 4 == 0, "chunks per trip");
        for (int c4 = 0; c4 < NCH; c4 += 4) {
            { const int c = c4 + 0;

            float f[4], kin[4], q[4], cum[4];
#pragma unroll
            for (int i = 0; i < 4; ++i) { const float sg = fsigmoid(bf_lo(fX[0][i])); f[i] = fmaxf(lower + (1.f - lower) * sg, 1e-30f); kin[i] = (1.f - lower) * (1.f - sg); q[i] = fsilu(bf_lo(qX[0][i])); }
            const f32x4 val = (f32x4){bf_lo(vX[0].x), bf_hi(vX[0].x), bf_lo(vX[0].y), bf_hi(vX[0].y)};
            cum[0] = flog2(f[0]); cum[1] = cum[0] + flog2(f[1]); cum[2] = cum[1] + flog2(f[2]); cum[3] = cum[2] + flog2(f[3]);
            gsum[tq * 128 + k] = cum[3];
            lds_barrier();
            { const float g0 = gsum[k], g1 = gsum[128 + k], g2 = gsum[256 + k], g3 = gsum[384 + k];
              const float base = tq == 0 ? 0.f : tq == 1 ? g0 : tq == 2 ? g0 + g1 : g0 + g1 + g2, tot = g0 + g1 + g2 + g3;
              float kh[4];
#pragma unroll
              for (int i = 0; i < 4; ++i) { const float cu = base + cum[i]; const int t = 4 * tq + i;
                  *(LAS unsigned short*)(lds + OFF_QT + t * RS + 2 * k) = bfr(q[i] * fexp2(cu));
                  *(LAS unsigned short*)(lds + OFF_KT + t * RS + 2 * k) = bfr(kin[i] * fexp2(fminf(-cu, 115.f)));
                  kh[i] = kin[i] * fexp2(tot - cu); }
              *(LAS u32x2*)(lds + OFF_KH + k * RS2 + 8 * tq) = (u32x2){att::pk2(kh[0], kh[1]), att::pk2(kh[2], kh[3])};
              if (tq == 0) p15[k] = fexp2(tot);
              if (tid < 256) { const int t = tid >> 4, v4 = (tid & 15) * 4;
#pragma unroll
                  for (int j = 0; j < 4; ++j) { const unsigned short hv = bfr(val[j]); *(LAS unsigned short*)(lds + OFF_VT + (v4 + j) * RS2 + 2 * t) = hv; } } }
            if (c + 4 < NCH) HG_LOAD(c + 4, 0);
            lds_barrier();
            const LAS unsigned char* stc = lds + OFF_ST + (c & 1) * 64 * RS; LAS unsigned char* stn = lds + OFF_ST + ((c + 1) & 1) * 64 * RS;
            if (wid < 4) {
                f32x4 sc = (f32x4){0.f, 0.f, 0.f, 0.f};
#pragma unroll
                for (int kk = 0; kk < 4; ++kk) { const bf16x8 a = *(const LAS bf16x8*)(lds + OFF_KT + l15 * RS + (32 * kk + 8 * g) * 2), bq = *(const LAS bf16x8*)(lds + OFF_QT + l15 * RS + (32 * kk + 8 * g) * 2); sc = HG_MFMA32(a, bq, sc); }
#pragma unroll
                for (int r = 0; r < 4; ++r) if (4 * g + r > l15) sc[r] = 0.f;
                const u32x2 pk = (u32x2){att::pk2(sc[0], sc[1]), att::pk2(sc[2], sc[3])};
                f32x4 o = (f32x4){0.f, 0.f, 0.f, 0.f};
                { LAS unsigned char* scw = lds + OFF_SC + wid * 16 * 80;
                  *(LAS u32x2*)(scw + l15 * 80 + 8 * g) = pk;
                  const bf16x8 sb = *(const LAS bf16x8*)(scw + l15 * 80 + 16 * g); bf16x8 va = (bf16x8){0, 0, 0, 0, 0, 0, 0, 0};
                  if (g < 2) { const LAS unsigned char* vp_ = lds + OFF_VT + (16 * wid + l15) * RS2 + 16 * g; const s16x4 lo_ = *(const LAS s16x4*)vp_, hi_ = *(const LAS s16x4*)(vp_ + 8); va = __builtin_shufflevector(lo_, hi_, 0, 1, 2, 3, 4, 5, 6, 7); }
                  o = HG_MFMA32(va, sb, o); }
#pragma unroll
                for (int kk = 0; kk < 4; ++kk) { const bf16x8 a = *(const LAS bf16x8*)(stc + (16 * wid + l15) * RS + (32 * kk + 8 * g) * 2), bq = *(const LAS bf16x8*)(lds + OFF_QT + l15 * RS + (32 * kk + 8 * g) * 2); o = HG_MFMA32(a, bq, o); }
                { HG_ROWBASE(c, rbo_) const long row = rbo_ + (d ? -l15 : l15); *(GAS u32x2*)(pO + row * 512 + 16 * wid + 4 * g) = (u32x2){att::pk2(o[0], o[1]), att::pk2(o[2], o[3])}; }
            }
            { const f32x4 pd = *(const LAS f32x4*)(p15 + 16 * wid + 4 * g); const s16x4 ka = *(const LAS s16x4*)(lds + OFF_KH + (16 * wid + l15) * RS2 + 8 * g);
#pragma unroll
              for (int n = 0; n < 4; ++n) { const s16x4 vb = *(const LAS s16x4*)(lds + OFF_VT + (16 * n + l15) * RS2 + 8 * g);
                  acc[n] = HG_MFMA16(ka, vb, acc[n] * pd);
                  *(LAS u32x2*)(stn + (16 * n + l15) * RS + (16 * wid + 4 * g) * 2) = (u32x2){att::pk2(acc[n][0], acc[n][1]), att::pk2(acc[n][2], acc[n][3])}; } }
                    }
            { const int c = c4 + 1;

            float f[4], kin[4], q[4], cum[4];
#pragma unroll
            for (int i = 0; i < 4; ++i) { const float sg = fsigmoid(bf_lo(fX[1][i])); f[i] = fmaxf(lower + (1.f - lower) * sg, 1e-30f); kin[i] = (1.f - lower) * (1.f - sg); q[i] = fsilu(bf_lo(qX[1][i])); }
            const f32x4 val = (f32x4){bf_lo(vX[1].x), bf_hi(vX[1].x), bf_lo(vX[1].y), bf_hi(vX[1].y)};
            cum[0] = flog2(f[0]); cum[1] = cum[0] + flog2(f[1]); cum[2] = cum[1] + flog2(f[2]); cum[3] = cum[2] + flog2(f[3]);
            gsum[tq * 128 + k] = cum[3];
            lds_barrier();
            { const float g0 = gsum[k], g1 = gsum[128 + k], g2 = gsum[256 + k], g3 = gsum[384 + k];
              const float base = tq == 0 ? 0.f : tq == 1 ? g0 : tq == 2 ? g0 + g1 : g0 + g1 + g2, tot = g0 + g1 + g2 + g3;
              float kh[4];
#pragma unroll
              for (int i = 0; i < 4; ++i) { const float cu = base + cum[i]; const int t = 4 * tq + i;
                  *(LAS unsigned short*)(lds + OFF_QT + t * RS + 2 * k) = bfr(q[i] * fexp2(cu));
                  *(LAS unsigned short*)(lds + OFF_KT + t * RS + 2 * k) = bfr(kin[i] * fexp2(fminf(-cu, 115.f)));
                  kh[i] = kin[i] * fexp2(tot - cu); }
              *(LAS u32x2*)(lds + OFF_KH + k * RS2 + 8 * tq) = (u32x2){att::pk2(kh[0], kh[1]), att::pk2(kh[2], kh[3])};
              if (tq == 0) p15[k] = fexp2(tot);
              if (tid < 256) { const int t = tid >> 4, v4 = (tid & 15) * 4;
#pragma unroll
                  for (int j = 0; j < 4; ++j) { const unsigned short hv = bfr(val[j]); *(LAS unsigned short*)(lds + OFF_VT + (v4 + j) * RS2 + 2 * t) = hv; } } }
            if (c + 4 < NCH) HG_LOAD(c + 4, 1);
            lds_barrier();
            const LAS unsigned char* stc = lds + OFF_ST + (c & 1) * 64 * RS; LAS unsigned char* stn = lds + OFF_ST + ((c + 1) & 1) * 64 * RS;
            if (wid < 4) {
                f32x4 sc = (f32x4){0.f, 0.f, 0.f, 0.f};
#pragma unroll
                for (int kk = 0; kk < 4; ++kk) { const bf16x8 a = *(const LAS bf16x8*)(lds + OFF_KT + l15 * RS + (32 * kk + 8 * g) * 2), bq = *(const LAS bf16x8*)(lds + OFF_QT + l15 * RS + (32 * kk + 8 * g) * 2); sc = HG_MFMA32(a, bq, sc); }
#pragma unroll
                for (int r = 0; r < 4; ++r) if (4 * g + r > l15) sc[r] = 0.f;
                const u32x2 pk = (u32x2){att::pk2(sc[0], sc[1]), att::pk2(sc[2], sc[3])};
                f32x4 o = (f32x4){0.f, 0.f, 0.f, 0.f};
                { LAS unsigned char* scw = lds + OFF_SC + wid * 16 * 80;
                  *(LAS u32x2*)(scw + l15 * 80 + 8 * g) = pk;
                  const bf16x8 sb = *(const LAS bf16x8*)(scw + l15 * 80 + 16 * g); bf16x8 va = (bf16x8){0, 0, 0, 0, 0, 0, 0, 0};
                  if (g < 2) { const LAS unsigned char* vp_ = lds + OFF_VT + (16 * wid + l15) * RS2 + 16 * g; const s16x4 lo_ = *(const LAS s16x4*)vp_, hi_ = *(const LAS s16x4*)(vp_ + 8); va = __builtin_shufflevector(lo_, hi_, 0, 1, 2, 3, 4, 5, 6, 7); }
                  o = HG_MFMA32(va, sb, o); }
#pragma unroll
                for (int kk = 0; kk < 4; ++kk) { const bf16x8 a = *(const LAS bf16x8*)(stc + (16 * wid + l15) * RS + (32 * kk + 8 * g) * 2), bq = *(const LAS bf16x8*)(lds + OFF_QT + l15 * RS + (32 * kk + 8 * g) * 2); o = HG_MFMA32(a, bq, o); }
                { HG_ROWBASE(c, rbo_) const long row = rbo_ + (d ? -l15 : l15); *(GAS u32x2*)(pO + row * 512 + 16 * wid + 4 * g) = (u32x2){att::pk2(o[0], o[1]), att::pk2(o[2], o[3])}; }
            }
            { const f32x4 pd = *(const LAS f32x4*)(p15 + 16 * wid + 4 * g); const s16x4 ka = *(const LAS s16x4*)(lds + OFF_KH + (16 * wid + l15) * RS2 + 8 * g);
#pragma unroll
              for (int n = 0; n < 4; ++n) { const s16x4 vb = *(const LAS s16x4*)(lds + OFF_VT + (16 * n + l15) * RS2 + 8 * g);
                  acc[n] = HG_MFMA16(ka, vb, acc[n] * pd);
                  *(LAS u32x2*)(stn + (16 * n + l15) * RS + (16 * wid + 4 * g) * 2) = (u32x2){att::pk2(acc[n][0], acc[n][1]), att::pk2(acc[n][2], acc[n][3])}; } }
                    }
            { const int c = c4 + 2;

            float f[4], kin[4], q[4], cum[4];
#pragma unroll
            for (int i = 0; i < 4; ++i) { const float sg = fsigmoid(bf_lo(fX[2][i])); f[i] = fmaxf(lower + (1.f - lower) * sg, 1e-30f); kin[i] = (1.f - lower) * (1.f - sg); q[i] = fsilu(bf_lo(qX[2][i])); }
            const f32x4 val = (f32x4){bf_lo(vX[2].x), bf_hi(vX[2].x), bf_lo(vX[2].y), bf_hi(vX[2].y)};
            cum[0] = flog2(f[0]); cum[1] = cum[0] + flog2(f[1]); cum[2] = cum[1] + flog2(f[2]); cum[3] = cum[2] + flog2(f[3]);
            gsum[tq * 128 + k] = cum[3];
            lds_barrier();
            { const float g0 = gsum[k], g1 = gsum[128 + k], g2 = gsum[256 + k], g3 = gsum[384 + k];
              const float base = tq == 0 ? 0.f : tq == 1 ? g0 : tq == 2 ? g0 + g1 : g0 + g1 + g2, tot = g0 + g1 + g2 + g3;
              float kh[4];
#pragma unroll
              for (int i = 0; i < 4; ++i) { const float cu = base + cum[i]; const int t = 4 * tq + i;
                  *(LAS unsigned short*)(lds + OFF_QT + t * RS + 2 * k) = bfr(q[i] * fexp2(cu));
                  *(LAS unsigned short*)(lds + OFF_KT + t * RS + 2 * k) = bfr(kin[i] * fexp2(fminf(-cu, 115.f)));
                  kh[i] = kin[i] * fexp2(tot - cu); }
              *(LAS u32x2*)(lds + OFF_KH + k * RS2 + 8 * tq) = (u32x2){att::pk2(kh[0], kh[1]), att::pk2(kh[2], kh[3])};
              if (tq == 0) p15[k] = fexp2(tot);
              if (tid < 256) { const int t = tid >> 4, v4 = (tid & 15) * 4;
#pragma unroll
                  for (int j = 0; j < 4; ++j) { const unsigned short hv = bfr(val[j]); *(LAS unsigned short*)(lds + OFF_VT + (v4 + j) * RS2 + 2 * t) = hv; } } }
            if (c + 4 < NCH) HG_LOAD(c + 4, 2);
            lds_barrier();
            const LAS unsigned char* stc = lds + OFF_ST + (c & 1) * 64 * RS; LAS unsigned char* stn = lds + OFF_ST + ((c + 1) & 1) * 64 * RS;
            if (wid < 4) {
                f32x4 sc = (f32x4){0.f, 0.f, 0.f, 0.f};
#pragma unroll
                for (int kk = 0; kk < 4; ++kk) { const bf16x8 a = *(const LAS bf16x8*)(lds + OFF_KT + l15 * RS + (32 * kk + 8 * g) * 2), bq = *(const LAS bf16x8*)(lds + OFF_QT + l15 * RS + (32 * kk + 8 * g) * 2); sc = HG_MFMA32(a, bq, sc); }
#pragma unroll
                for (int r = 0; r < 4; ++r) if (4 * g + r > l15) sc[r] = 0.f;
                const u32x2 pk = (u32x2){att::pk2(sc[0], sc[1]), att::pk2(sc[2], sc[3])};
                f32x4 o = (f32x4){0.f, 0.f, 0.f, 0.f};
                { LAS unsigned char* scw = lds + OFF_SC + wid * 16 * 80;
                  *(LAS u32x2*)(scw + l15 * 80 + 8 * g) = pk;
                  const bf16x8 sb = *(const LAS bf16x8*)(scw + l15 * 80 + 16 * g); bf16x8 va = (bf16x8){0, 0, 0, 0, 0, 0, 0, 0};
                  if (g < 2) { const LAS unsigned char* vp_ = lds + OFF_VT + (16 * wid + l15) * RS2 + 16 * g; const s16x4 lo_ = *(const LAS s16x4*)vp_, hi_ = *(const LAS s16x4*)(vp_ + 8); va = __builtin_shufflevector(lo_, hi_, 0, 1, 2, 3, 4, 5, 6, 7); }
                  o = HG_MFMA32(va, sb, o); }
#pragma unroll
                for (int kk = 0; kk < 4; ++kk) { const bf16x8 a = *(const LAS bf16x8*)(stc + (16 * wid + l15) * RS + (32 * kk + 8 * g) * 2), bq = *(const LAS bf16x8*)(lds + OFF_QT + l15 * RS + (32 * kk + 8 * g) * 2); o = HG_MFMA32(a, bq, o); }
                { HG_ROWBASE(c, rbo_) const long row = rbo_ + (d ? -l15 : l15); *(GAS u32x2*)(pO + row * 512 + 16 * wid + 4 * g) = (u32x2){att::pk2(o[0], o[1]), att::pk2(o[2], o[3])}; }
            }
            { const f32x4 pd = *(const LAS f32x4*)(p15 + 16 * wid + 4 * g); const s16x4 ka = *(const LAS s16x4*)(lds + OFF_KH + (16 * wid + l15) * RS2 + 8 * g);
#pragma unroll
              for (int n = 0; n < 4; ++n) { const s16x4 vb = *(const LAS s16x4*)(lds + OFF_VT + (16 * n + l15) * RS2 + 8 * g);
                  acc[n] = HG_MFMA16(ka, vb, acc[n] * pd);
                  *(LAS u32x2*)(stn + (16 * n + l15) * RS + (16 * wid + 4 * g) * 2) = (u32x2){att::pk2(acc[n][0], acc[n][1]), att::pk2(acc[n][2], acc[n][3])}; } }
                    }
            { const int c = c4 + 3;

            float f[4], kin[4], q[4], cum[4];
#pragma unroll
            for (int i = 0; i < 4; ++i) { const float sg = fsigmoid(bf_lo(fX[3][i])); f[i] = fmaxf(lower + (1.f - lower) * sg, 1e-30f); kin[i] = (1.f - lower) * (1.f - sg); q[i] = fsilu(bf_lo(qX[3][i])); }
            const f32x4 val = (f32x4){bf_lo(vX[3].x), bf_hi(vX[3].x), bf_lo(vX[3].y), bf_hi(vX[3].y)};
            cum[0] = flog2(f[0]); cum[1] = cum[0] + flog2(f[1]); cum[2] = cum[1] + flog2(f[2]); cum[3] = cum[2] + flog2(f[3]);
            gsum[tq * 128 + k] = cum[3];
            lds_barrier();
            { const float g0 = gsum[k], g1 = gsum[128 + k], g2 = gsum[256 + k], g3 = gsum[384 + k];
              const float base = tq == 0 ? 0.f : tq == 1 ? g0 : tq == 2 ? g0 + g1 : g0 + g1 + g2, tot = g0 + g1 + g2 + g3;
              float kh[4];
#pragma unroll
              for (int i = 0; i < 4; ++i) { const float cu = base + cum[i]; const int t = 4 * tq + i;
                  *(LAS unsigned short*)(lds + OFF_QT + t * RS + 2 * k) = bfr(q[i] * fexp2(cu));
                  *(LAS unsigned short*)(lds + OFF_KT + t * RS + 2 * k) = bfr(kin[i] * fexp2(fminf(-cu, 115.f)));
                  kh[i] = kin[i] * fexp2(tot - cu); }
              *(LAS u32x2*)(lds + OFF_KH + k * RS2 + 8 * tq) = (u32x2){att::pk2(kh[0], kh[1]), att::pk2(kh[2], kh[3])};
              if (tq == 0) p15[k] = fexp2(tot);
              if (tid < 256) { const int t = tid >> 4, v4 = (tid & 15) * 4;
#pragma unroll
                  for (int j = 0; j < 4; ++j) { const unsigned short hv = bfr(val[j]); *(LAS unsigned short*)(lds + OFF_VT + (v4 + j) * RS2 + 2 * t) = hv; } } }
            if (c + 4 < NCH) HG_LOAD(c + 4, 3);
            lds_barrier();
            const LAS unsigned char* stc = lds + OFF_ST + (c & 1) * 64 * RS; LAS unsigned char* stn = lds + OFF_ST + ((c + 1) & 1) * 64 * RS;
            if (wid < 4) {
                f32x4 sc = (f32x4){0.f, 0.f, 0.f, 0.f};
#pragma unroll
                for (int kk = 0; kk < 4; ++kk) { const bf16x8 a = *(const LAS bf16x8*)(lds + OFF_KT + l15 * RS + (32 * kk + 8 * g) * 2), bq = *(const LAS bf16x8*)(lds + OFF_QT + l15 * RS + (32 * kk + 8 * g) * 2); sc = HG_MFMA32(a, bq, sc); }
#pragma unroll
                for (int r = 0; r < 4; ++r) if (4 * g + r > l15) sc[r] = 0.f;
                const u32x2 pk = (u32x2){att::pk2(sc[0], sc[1]), att::pk2(sc[2], sc[3])};
                f32x4 o = (f32x4){0.f, 0.f, 0.f, 0.f};
                { LAS unsigned char* scw = lds + OFF_SC + wid * 16 * 80;
                  *(LAS u32x2*)(scw + l15 * 80 + 8 * g) = pk;
                  const bf16x8 sb = *(const LAS bf16x8*)(scw + l15 * 80 + 16 * g); bf16x8 va = (bf16x8){0, 0, 0, 0, 0, 0, 0, 0};
                  if (g < 2) { const LAS unsigned char* vp_ = lds + OFF_VT + (16 * wid + l15) * RS2 + 16 * g; const s16x4 lo_ = *(const LAS s16x4*)vp_, hi_ = *(const LAS s16x4*)(vp_ + 8); va = __builtin_shufflevector(lo_, hi_, 0, 1, 2, 3, 4, 5, 6, 7); }
                  o = HG_MFMA32(va, sb, o); }
#pragma unroll
                for (int kk = 0; kk < 4; ++kk) { const bf16x8 a = *(const LAS bf16x8*)(stc + (16 * wid + l15) * RS + (32 * kk + 8 * g) * 2), bq = *(const LAS bf16x8*)(lds + OFF_QT + l15 * RS + (32 * kk + 8 * g) * 2); o = HG_MFMA32(a, bq, o); }
                { HG_ROWBASE(c, rbo_) const long row = rbo_ + (d ? -l15 : l15); *(GAS u32x2*)(pO + row * 512 + 16 * wid + 4 * g) = (u32x2){att::pk2(o[0], o[1]), att::pk2(o[2], o[3])}; }
            }
            { const f32x4 pd = *(const LAS f32x4*)(p15 + 16 * wid + 4 * g); const s16x4 ka = *(const LAS s16x4*)(lds + OFF_KH + (16 * wid + l15) * RS2 + 8 * g);
#pragma unroll
              for (int n = 0; n < 4; ++n) { const s16x4 vb = *(const LAS s16x4*)(lds + OFF_VT + (16 * n + l15) * RS2 + 8 * g);
                  acc[n] = HG_MFMA16(ka, vb, acc[n] * pd);
                  *(LAS u32x2*)(stn + (16 * n + l15) * RS + (16 * wid + 4 * g) * 2) = (u32x2){att::pk2(acc[n][0], acc[n][1]), att::pk2(acc[n][2], acc[n][3])}; } }
                    }
        }
        lds_barrier();
#undef HG_LOAD
    }
}
}

namespace rwc {
constexpr int RS = 144, RS40 = 80;
constexpr int O_AT = 0, O_RT = 2304, O_BT = 4608, O_KT = 6912, O_BH = 9216, O_KH = 14336, O_VT = 19456, O_UT = 24576, O_HT = 29696, O_GAK = 48128, O_GRB = 49408, O_GRK = 50688,
              O_GAB = 51968, O_XS = 52992, O_P15 = 57088, O_GS = 57344, RW_LDS = 59392;
#define RW_MFMA(a, b, c) __builtin_amdgcn_mfma_f32_16x16x32_bf16((a), (b), (c), 0, 0, 0)
#define RW_FRAG(img, row, RSB, byteoff) (*(const LAS bf16x8*)(lds + (img) + (row) * (RSB) + (byteoff)))
DI unsigned short bfr(float x) { return (unsigned short)(att::pk2(x, 0.f) & 0xffffu); }

DI void rwkv_chunk_scan(const LAS NaiveCtx* Cp_, LAS unsigned char* lds, int wv_) {
    const int tid = otid(wv_), lane = tid & 63, wid = tid >> 6, l15 = lane & 15, g = lane >> 4;
    const int k = tid & 63, tq = tid >> 6;
    LAS float* gsum = (LAS float*)(lds + O_GS); LAS float* p15 = (LAS float*)(lds + O_P15); LAS float* gab = (LAS float*)(lds + O_GAB); LAS float* xs = (LAS float*)(lds + O_XS);
    for (int chain = opaque_bid(); chain < 2 * BATCH * RW_HEADS; chain += gridDim.x) {
        const int d = chain / (BATCH * RW_HEADS), b = (chain / RW_HEADS) % BATCH, h = chain % RW_HEADS;
        const GAS bf16_t* pA = (const GAS bf16_t*)((*Cp_).NKh + h * 64 + k); const GAS float* pW = (const GAS float*)((*Cp_).DEC + (size_t)d * NT_ * 512 + h * 64 + k); const GAS bf16_t* pB = (const GAS bf16_t*)((*Cp_).BBh + (size_t)d * NT_ * 512 + h * 64 + k);
        const GAS bf16_t* pK = (const GAS bf16_t*)((*Cp_).KDh + (size_t)d * NT_ * 512 + h * 64 + k); const GAS bf16_t* pR = (const GAS bf16_t*)((*Cp_).RBh + h * 64 + k); const GAS bf16_t* pV = (const GAS bf16_t*)((*Cp_).VBh + h * 64 + (tid & 31) * 2);
        GAS bf16_t* pY = (GAS bf16_t*)((*Cp_).YBh + (size_t)d * NT_ * 512 + h * 64);
        for (int i = tid; i < RW_LDS / 4; i += PB_THREADS) ((LAS unsigned*)lds)[i] = 0u;
        f32x4 acc[2];
        acc[0] = (f32x4){0.f, 0.f, 0.f, 0.f}; acc[1] = acc[0];
        float lwX[4][2]; unsigned aX[4][2], bX[4][2], kX[4][2], rX[4][2], vX[4];
#define RW_ROWBASE(C0, rb) long rb; { const int i0_ = (C0) * 16; if (i0_ < CTX_LEN) rb = (long)b * CTX_LEN + (d ? CTX_LEN - 1 - i0_ : i0_); else rb = (long)NC_ + (long)b * SEQ + (d ? SEQ - 1 - (i0_ - CTX_LEN) : (i0_ - CTX_LEN)); }
#define RW_LOAD(C0, S) do { RW_ROWBASE(C0, rb_) const long sg_ = d ? -1 : 1; _Pragma("unroll") for (int i = 0; i < 2; ++i) { const long row = rb_ + sg_ * (2 * tq + i); lwX[S][i] = pW[row * 512]; aX[S][i] = pA[row * 512]; bX[S][i] = pB[row * 512]; kX[S][i] = pK[row * 512]; rX[S][i] = pR[row * 512]; } \
            { const long row = rb_ + sg_ * (tid >> 5); vX[S] = *(const GAS unsigned*)(pV + row * 512); } } while (0)
        RW_LOAD(0, 0); RW_LOAD(1, 1); RW_LOAD(2, 2); RW_LOAD(3, 3);
        lds_barrier();
        constexpr int NCH = TT_ / 16;
        static_assert(NCH % 4 == 0, "chunks per trip");
        for (int c4 = 0; c4 < NCH; c4 += 4) {
            { const int c = c4 + 0;

            float lw[2], a[2], bb[2], kd[2], r[2];
#pragma unroll
            for (int i = 0; i < 2; ++i) { lw[i] = lwX[0][i]; a[i] = bf_lo(aX[0][i]); bb[i] = bf_lo(bX[0][i]); kd[i] = bf_lo(kX[0][i]); r[i] = bf_lo(rX[0][i]); }
            const float v0 = bf_lo(vX[0]), v1 = bf_hi(vX[0]);
            const float c0 = lw[0], c1 = lw[0] + lw[1];
            gsum[tq * 64 + k] = c1;
            lds_barrier();
            { float base = 0.f, tot = 0.f;
#pragma unroll
              for (int q = 0; q < 8; ++q) { const float gq = gsum[q * 64 + k]; tot += gq; base += q < tq ? gq : 0.f; }
              float bh[2], kh[2];
#pragma unroll
              for (int i = 0; i < 2; ++i) { const float cu = base + (i ? c1 : c0); const int t = 2 * tq + i; const float ep = fexp2(cu), em = fexp2(-cu), eh = fexp2(tot - cu);
                  *(LAS unsigned short*)(lds + O_AT + t * RS + 2 * k) = bfr(a[i] * fexp2(cu - lw[i]));
                  *(LAS unsigned short*)(lds + O_RT + t * RS + 2 * k) = bfr(r[i] * ep);
                  *(LAS unsigned short*)(lds + O_BT + t * RS + 2 * k) = bfr(bb[i] * em);
                  *(LAS unsigned short*)(lds + O_KT + t * RS + 2 * k) = bfr(kd[i] * em);
                  bh[i] = bb[i] * eh; kh[i] = kd[i] * eh; }
              *(LAS unsigned*)(lds + O_BH + k * RS40 + 4 * tq) = att::pk2(bh[0], bh[1]);
              *(LAS unsigned*)(lds + O_KH + k * RS40 + 4 * tq) = att::pk2(kh[0], kh[1]);
              if (tq == 0) p15[k] = fexp2(tot);
              { const int t = tid >> 5, v2 = (tid & 31) * 2; *(LAS unsigned short*)(lds + O_VT + v2 * RS40 + 2 * t) = bfr(v0); *(LAS unsigned short*)(lds + O_VT + (v2 + 1) * RS40 + 2 * t) = bfr(v1); } }
            if (c + 4 < NCH) RW_LOAD(c + 4, 0);
            lds_barrier();
            const int htc = O_HT + (c & 1) * 64 * RS, htn = O_HT + ((c + 1) & 1) * 64 * RS;
            if (wid < 4) { const int ia = wid < 2 ? O_AT : O_RT, ib = (wid & 1) ? O_KT : O_BT;
                f32x4 gm = (f32x4){0.f, 0.f, 0.f, 0.f};
#pragma unroll
                for (int kk = 0; kk < 2; ++kk) gm = RW_MFMA(RW_FRAG(ia, l15, RS, 64 * kk + 16 * g), RW_FRAG(ib, l15, RS, 64 * kk + 16 * g), gm);
#pragma unroll
                for (int rr = 0; rr < 4; ++rr) { const int t = 4 * g + rr; const bool keep = wid < 2 ? (l15 < t) : (l15 <= t); const float val = keep ? gm[rr] : 0.f;
                    if (wid == 0) gab[l15 * 16 + t] = val;
                    else *(LAS unsigned short*)(lds + (wid == 1 ? O_GAK : wid == 2 ? O_GRB : O_GRK) + t * RS40 + 2 * l15) = bfr(val); } }
            lds_barrier();
            if (wid < 4) { f32x4 x = (f32x4){0.f, 0.f, 0.f, 0.f};
#pragma unroll
                for (int kk = 0; kk < 2; ++kk) x = RW_MFMA(RW_FRAG(O_AT, l15, RS, 64 * kk + 16 * g), RW_FRAG(htc, 16 * wid + l15, RS, 64 * kk + 16 * g), x);
                x = RW_MFMA(RW_FRAG(O_GAK, l15, RS40, 16 * g), RW_FRAG(O_VT, 16 * wid + l15, RS40, 16 * g), x);
#pragma unroll
                for (int rr = 0; rr < 4; ++rr) xs[(4 * g + rr) * 64 + 16 * wid + l15] = x[rr]; }
            lds_barrier();
            if (wid == 0) { float u[16];
#pragma unroll
                for (int t = 0; t < 16; ++t) u[t] = xs[t * 64 + lane];
#pragma unroll
                for (int s = 0; s < 15; ++s) {
#pragma unroll
                    for (int q4 = (s + 1) / 4; q4 < 4; ++q4) { const f32x4 gc = *(const LAS f32x4*)(gab + s * 16 + 4 * q4);
#pragma unroll
                        for (int j = 0; j < 4; ++j) if (4 * q4 + j > s) u[4 * q4 + j] += gc[j] * u[s]; } }
                u32x4 w0, w1; w0.x = att::pk2(u[0], u[1]); w0.y = att::pk2(u[2], u[3]); w0.z = att::pk2(u[4], u[5]); w0.w = att::pk2(u[6], u[7]);
                w1.x = att::pk2(u[8], u[9]); w1.y = att::pk2(u[10], u[11]); w1.z = att::pk2(u[12], u[13]); w1.w = att::pk2(u[14], u[15]);
                *(LAS u32x4*)(lds + O_UT + lane * RS40) = w0; *(LAS u32x4*)(lds + O_UT + lane * RS40 + 16) = w1; }
            lds_barrier();
            if (wid < 4) { f32x4 y = (f32x4){0.f, 0.f, 0.f, 0.f};
#pragma unroll
                for (int kk = 0; kk < 2; ++kk) y = RW_MFMA(RW_FRAG(O_RT, l15, RS, 64 * kk + 16 * g), RW_FRAG(htc, 16 * wid + l15, RS, 64 * kk + 16 * g), y);
                y = RW_MFMA(RW_FRAG(O_GRB, l15, RS40, 16 * g), RW_FRAG(O_UT, 16 * wid + l15, RS40, 16 * g), y);
                y = RW_MFMA(RW_FRAG(O_GRK, l15, RS40, 16 * g), RW_FRAG(O_VT, 16 * wid + l15, RS40, 16 * g), y);
                { RW_ROWBASE(c, rby_) const long sgy_ = d ? -1 : 1;
#pragma unroll
                for (int rr = 0; rr < 4; ++rr) { const long row = rby_ + sgy_ * (4 * g + rr); pY[row * 512 + 16 * wid + l15] = bfr(y[rr]); } } }
            { const int kt = wid >> 1; const f32x4 pd = *(const LAS f32x4*)(p15 + 16 * kt + 4 * g);
              const bf16x8 fb = RW_FRAG(O_BH, 16 * kt + l15, RS40, 16 * g), fk = RW_FRAG(O_KH, 16 * kt + l15, RS40, 16 * g);
#pragma unroll
              for (int j = 0; j < 2; ++j) { const int vt = 2 * (wid & 1) + j;
                  acc[j] = RW_MFMA(fb, RW_FRAG(O_UT, 16 * vt + l15, RS40, 16 * g), acc[j] * pd);
                  acc[j] = RW_MFMA(fk, RW_FRAG(O_VT, 16 * vt + l15, RS40, 16 * g), acc[j]);
                  *(LAS u32x2*)(lds + htn + (16 * vt + l15) * RS + (16 * kt + 4 * g) * 2) = (u32x2){att::pk2(acc[j][0], acc[j][1]), att::pk2(acc[j][2], acc[j][3])}; } }
                    }
            { const int c = c4 + 1;

            float lw[2], a[2], bb[2], kd[2], r[2];
#pragma unroll
            for (int i = 0; i < 2; ++i) { lw[i] = lwX[1][i]; a[i] = bf_lo(aX[1][i]); bb[i] = bf_lo(bX[1][i]); kd[i] = bf_lo(kX[1][i]); r[i] = bf_lo(rX[1][i]); }
            const float v0 = bf_lo(vX[1]), v1 = bf_hi(vX[1]);
            const float c0 = lw[0], c1 = lw[0] + lw[1];
            gsum[tq * 64 + k] = c1;
            lds_barrier();
            { float base = 0.f, tot = 0.f;
#pragma unroll
              for (int q = 0; q < 8; ++q) { const float gq = gsum[q * 64 + k]; tot += gq; base += q < tq ? gq : 0.f; }
              float bh[2], kh[2];
#pragma unroll
              for (int i = 0; i < 2; ++i) { const float cu = base + (i ? c1 : c0); const int t = 2 * tq + i; const float ep = fexp2(cu), em = fexp2(-cu), eh = fexp2(tot - cu);
                  *(LAS unsigned short*)(lds + O_AT + t * RS + 2 * k) = bfr(a[i] * fexp2(cu - lw[i]));
                  *(LAS unsigned short*)(lds + O_RT + t * RS + 2 * k) = bfr(r[i] * ep);
                  *(LAS unsigned short*)(lds + O_BT + t * RS + 2 * k) = bfr(bb[i] * em);
                  *(LAS unsigned short*)(lds + O_KT + t * RS + 2 * k) = bfr(kd[i] * em);
                  bh[i] = bb[i] * eh; kh[i] = kd[i] * eh; }
              *(LAS unsigned*)(lds + O_BH + k * RS40 + 4 * tq) = att::pk2(bh[0], bh[1]);
              *(LAS unsigned*)(lds + O_KH + k * RS40 + 4 * tq) = att::pk2(kh[0], kh[1]);
              if (tq == 0) p15[k] = fexp2(tot);
              { const int t = tid >> 5, v2 = (tid & 31) * 2; *(LAS unsigned short*)(lds + O_VT + v2 * RS40 + 2 * t) = bfr(v0); *(LAS unsigned short*)(lds + O_VT + (v2 + 1) * RS40 + 2 * t) = bfr(v1); } }
            if (c + 4 < NCH) RW_LOAD(c + 4, 1);
            lds_barrier();
            const int htc = O_HT + (c & 1) * 64 * RS, htn = O_HT + ((c + 1) & 1) * 64 * RS;
            if (wid < 4) { const int ia = wid < 2 ? O_AT : O_RT, ib = (wid & 1) ? O_KT : O_BT;
                f32x4 gm = (f32x4){0.f, 0.f, 0.f, 0.f};
#pragma unroll
                for (int kk = 0; kk < 2; ++kk) gm = RW_MFMA(RW_FRAG(ia, l15, RS, 64 * kk + 16 * g), RW_FRAG(ib, l15, RS, 64 * kk + 16 * g), gm);
#pragma unroll
                for (int rr = 0; rr < 4; ++rr) { const int t = 4 * g + rr; const bool keep = wid < 2 ? (l15 < t) : (l15 <= t); const float val = keep ? gm[rr] : 0.f;
                    if (wid == 0) gab[l15 * 16 + t] = val;
                    else *(LAS unsigned short*)(lds + (wid == 1 ? O_GAK : wid == 2 ? O_GRB : O_GRK) + t * RS40 + 2 * l15) = bfr(val); } }
            lds_barrier();
            if (wid < 4) { f32x4 x = (f32x4){0.f, 0.f, 0.f, 0.f};
#pragma unroll
                for (int kk = 0; kk < 2; ++kk) x = RW_MFMA(RW_FRAG(O_AT, l15, RS, 64 * kk + 16 * g), RW_FRAG(htc, 16 * wid + l15, RS, 64 * kk + 16 * g), x);
                x = RW_MFMA(RW_FRAG(O_GAK, l15, RS40, 16 * g), RW_FRAG(O_VT, 16 * wid + l15, RS40, 16 * g), x);
#pragma unroll
                for (int rr = 0; rr < 4; ++rr) xs[(4 * g + rr) * 64 + 16 * wid + l15] = x[rr]; }
            lds_barrier();
            if (wid == 0) { float u[16];
#pragma unroll
                for (int t = 0; t < 16; ++t) u[t] = xs[t * 64 + lane];
#pragma unroll
                for (int s = 0; s < 15; ++s) {
#pragma unroll
                    for (int q4 = (s + 1) / 4; q4 < 4; ++q4) { const f32x4 gc = *(const LAS f32x4*)(gab + s * 16 + 4 * q4);
#pragma unroll
                        for (int j = 0; j < 4; ++j) if (4 * q4 + j > s) u[4 * q4 + j] += gc[j] * u[s]; } }
                u32x4 w0, w1; w0.x = att::pk2(u[0], u[1]); w0.y = att::pk2(u[2], u[3]); w0.z = att::pk2(u[4], u[5]); w0.w = att::pk2(u[6], u[7]);
                w1.x = att::pk2(u[8], u[9]); w1.y = att::pk2(u[10], u[11]); w1.z = att::pk2(u[12], u[13]); w1.w = att::pk2(u[14], u[15]);
                *(LAS u32x4*)(lds + O_UT + lane * RS40) = w0; *(LAS u32x4*)(lds + O_UT + lane * RS40 + 16) = w1; }
            lds_barrier();
            if (wid < 4) { f32x4 y = (f32x4){0.f, 0.f, 0.f, 0.f};
#pragma unroll
                for (int kk = 0; kk < 2; ++kk) y = RW_MFMA(RW_FRAG(O_RT, l15, RS, 64 * kk + 16 * g), RW_FRAG(htc, 16 * wid + l15, RS, 64 * kk + 16 * g), y);
                y = RW_MFMA(RW_FRAG(O_GRB, l15, RS40, 16 * g), RW_FRAG(O_UT, 16 * wid + l15, RS40, 16 * g), y);
                y = RW_MFMA(RW_FRAG(O_GRK, l15, RS40, 16 * g), RW_FRAG(O_VT, 16 * wid + l15, RS40, 16 * g), y);
                { RW_ROWBASE(c, rby_) const long sgy_ = d ? -1 : 1;
#pragma unroll
                for (int rr = 0; rr < 4; ++rr) { const long row = rby_ + sgy_ * (4 * g + rr); pY[row * 512 + 16 * wid + l15] = bfr(y[rr]); } } }
            { const int kt = wid >> 1; const f32x4 pd = *(const LAS f32x4*)(p15 + 16 * kt + 4 * g);
              const bf16x8 fb = RW_FRAG(O_BH, 16 * kt + l15, RS40, 16 * g), fk = RW_FRAG(O_KH, 16 * kt + l15, RS40, 16 * g);
#pragma unroll
              for (int j = 0; j < 2; ++j) { const int vt = 2 * (wid & 1) + j;
                  acc[j] = RW_MFMA(fb, RW_FRAG(O_UT, 16 * vt + l15, RS40, 16 * g), acc[j] * pd);
                  acc[j] = RW_MFMA(fk, RW_FRAG(O_VT, 16 * vt + l15, RS40, 16 * g), acc[j]);
                  *(LAS u32x2*)(lds + htn + (16 * vt + l15) * RS + (16 * kt + 4 * g) * 2) = (u32x2){att::pk2(acc[j][0], acc[j][1]), att::pk2(acc[j][2], acc[j][3])}; } }
                    }
            { const int c = c4 + 2;

            float lw[2], a[2], bb[2], kd[2], r[2];
#pragma unroll
            for (int i = 0; i < 2; ++i) { lw[i] = lwX[2][i]; a[i] = bf_lo(aX[2][i]); bb[i] = bf_lo(bX[2][i]); kd[i] = bf_lo(kX[2][i]); r[i] = bf_lo(rX[2][i]); }
            const float v0 = bf_lo(vX[2]), v1 = bf_hi(vX[2]);
            const float c0 = lw[0], c1 = lw[0] + lw[1];
            gsum[tq * 64 + k] = c1;
            lds_barrier();
            { float base = 0.f, tot = 0.f;
#pragma unroll
              for (int q = 0; q < 8; ++q) { const float gq = gsum[q * 64 + k]; tot += gq; base += q < tq ? gq : 0.f; }
              float bh[2], kh[2];
#pragma unroll
              for (int i = 0; i < 2; ++i) { const float cu = base + (i ? c1 : c0); const int t = 2 * tq + i; const float ep = fexp2(cu), em = fexp2(-cu), eh = fexp2(tot - cu);
                  *(LAS unsigned short*)(lds + O_AT + t * RS + 2 * k) = bfr(a[i] * fexp2(cu - lw[i]));
                  *(LAS unsigned short*)(lds + O_RT + t * RS + 2 * k) = bfr(r[i] * ep);
                  *(LAS unsigned short*)(lds + O_BT + t * RS + 2 * k) = bfr(bb[i] * em);
                  *(LAS unsigned short*)(lds + O_KT + t * RS + 2 * k) = bfr(kd[i] * em);
                  bh[i] = bb[i] * eh; kh[i] = kd[i] * eh; }
              *(LAS unsigned*)(lds + O_BH + k * RS40 + 4 * tq) = att::pk2(bh[0], bh[1]);
              *(LAS unsigned*)(lds + O_KH + k * RS40 + 4 * tq) = att::pk2(kh[0], kh[1]);
              if (tq == 0) p15[k] = fexp2(tot);
              { const int t = tid >> 5, v2 = (tid & 31) * 2; *(LAS unsigned short*)(lds + O_VT + v2 * RS40 + 2 * t) = bfr(v0); *(LAS unsigned short*)(lds + O_VT + (v2 + 1) * RS40 + 2 * t) = bfr(v1); } }
            if (c + 4 < NCH) RW_LOAD(c + 4, 2);
            lds_barrier();
            const int htc = O_HT + (c & 1) * 64 * RS, htn = O_HT + ((c + 1) & 1) * 64 * RS;
            if (wid < 4) { const int ia = wid < 2 ? O_AT : O_RT, ib = (wid & 1) ? O_KT : O_BT;
                f32x4 gm = (f32x4){0.f, 0.f, 0.f, 0.f};
#pragma unroll
                for (int kk = 0; kk < 2; ++kk) gm = RW_MFMA(RW_FRAG(ia, l15, RS, 64 * kk + 16 * g), RW_FRAG(ib, l15, RS, 64 * kk + 16 * g), gm);
#pragma unroll
                for (int rr = 0; rr < 4; ++rr) { const int t = 4 * g + rr; const bool keep = wid < 2 ? (l15 < t) : (l15 <= t); const float val = keep ? gm[rr] : 0.f;
                    if (wid == 0) gab[l15 * 16 + t] = val;
                    else *(LAS unsigned short*)(lds + (wid == 1 ? O_GAK : wid == 2 ? O_GRB : O_GRK) + t * RS40 + 2 * l15) = bfr(val); } }
            lds_barrier();
            if (wid < 4) { f32x4 x = (f32x4){0.f, 0.f, 0.f, 0.f};
#pragma unroll
                for (int kk = 0; kk < 2; ++kk) x = RW_MFMA(RW_FRAG(O_AT, l15, RS, 64 * kk + 16 * g), RW_FRAG(htc, 16 * wid + l15, RS, 64 * kk + 16 * g), x);
                x = RW_MFMA(RW_FRAG(O_GAK, l15, RS40, 16 * g), RW_FRAG(O_VT, 16 * wid + l15, RS40, 16 * g), x);
#pragma unroll
                for (int rr = 0; rr < 4; ++rr) xs[(4 * g + rr) * 64 + 16 * wid + l15] = x[rr]; }
            lds_barrier();
            if (wid == 0) { float u[16];
#pragma unroll
                for (int t = 0; t < 16; ++t) u[t] = xs[t * 64 + lane];
#pragma unroll
                for (int s = 0; s < 15; ++s) {
#pragma unroll
                    for (int q4 = (s + 1) / 4; q4 < 4; ++q4) { const f32x4 gc = *(const LAS f32x4*)(gab + s * 16 + 4 * q4);
#pragma unroll
                        for (int j = 0; j < 4; ++j) if (4 * q4 + j > s) u[4 * q4 + j] += gc[j] * u[s]; } }
                u32x4 w0, w1; w0.x = att::pk2(u[0], u[1]); w0.y = att::pk2(u[2], u[3]); w0.z = att::pk2(u[4], u[5]); w0.w = att::pk2(u[6], u[7]);
                w1.x = att::pk2(u[8], u[9]); w1.y = att::pk2(u[10], u[11]); w1.z = att::pk2(u[12], u[13]); w1.w = att::pk2(u[14], u[15]);
                *(LAS u32x4*)(lds + O_UT + lane * RS40) = w0; *(LAS u32x4*)(lds + O_UT + lane * RS40 + 16) = w1; }
            lds_barrier();
            if (wid < 4) { f32x4 y = (f32x4){0.f, 0.f, 0.f, 0.f};
#pragma unroll
                for (int kk = 0; kk < 2; ++kk) y = RW_MFMA(RW_FRAG(O_RT, l15, RS, 64 * kk + 16 * g), RW_FRAG(htc, 16 * wid + l15, RS, 64 * kk + 16 * g), y);
                y = RW_MFMA(RW_FRAG(O_GRB, l15, RS40, 16 * g), RW_FRAG(O_UT, 16 * wid + l15, RS40, 16 * g), y);
                y = RW_MFMA(RW_FRAG(O_GRK, l15, RS40, 16 * g), RW_FRAG(O_VT, 16 * wid + l15, RS40, 16 * g), y);
                { RW_ROWBASE(c, rby_) const long sgy_ = d ? -1 : 1;
#pragma unroll
                for (int rr = 0; rr < 4; ++rr) { const long row = rby_ + sgy_ * (4 * g + rr); pY[row * 512 + 16 * wid + l15] = bfr(y[rr]); } } }
            { const int kt = wid >> 1; const f32x4 pd = *(const LAS f32x4*)(p15 + 16 * kt + 4 * g);
              const bf16x8 fb = RW_FRAG(O_BH, 16 * kt + l15, RS40, 16 * g), fk = RW_FRAG(O_KH, 16 * kt + l15, RS40, 16 * g);
#pragma unroll
              for (int j = 0; j < 2; ++j) { const int vt = 2 * (wid & 1) + j;
                  acc[j] = RW_MFMA(fb, RW_FRAG(O_UT, 16 * vt + l15, RS40, 16 * g), acc[j] * pd);
                  acc[j] = RW_MFMA(fk, RW_FRAG(O_VT, 16 * vt + l15, RS40, 16 * g), acc[j]);
                  *(LAS u32x2*)(lds + htn + (16 * vt + l15) * RS + (16 * kt + 4 * g) * 2) = (u32x2){att::pk2(acc[j][0], acc[j][1]), att::pk2(acc[j][2], acc[j][3])}; } }
                    }
            { const int c = c4 + 3;

            float lw[2], a[2], bb[2], kd[2], r[2];
#pragma unroll
            for (int i = 0; i < 2; ++i) { lw[i] = lwX[3][i]; a[i] = bf_lo(aX[3][i]); bb[i] = bf_lo(bX[3][i]); kd[i] = bf_lo(kX[3][i]); r[i] = bf_lo(rX[3][i]); }
            const float v0 = bf_lo(vX[3]), v1 = bf_hi(vX[3]);
            const float c0 = lw[0], c1 = lw[0] + lw[1];
            gsum[tq * 64 + k] = c1;
            lds_barrier();
            { float base = 0.f, tot = 0.f;
#pragma unroll
              for (int q = 0; q < 8; ++q) { const float gq = gsum[q * 64 + k]; tot += gq; base += q < tq ? gq : 0.f; }
              float bh[2], kh[2];
#pragma unroll
              for (int i = 0; i < 2; ++i) { const float cu = base + (i ? c1 : c0); const int t = 2 * tq + i; const float ep = fexp2(cu), em = fexp2(-cu), eh = fexp2(tot - cu);
                  *(LAS unsigned short*)(lds + O_AT + t * RS + 2 * k) = bfr(a[i] * fexp2(cu - lw[i]));
                  *(LAS unsigned short*)(lds + O_RT + t * RS + 2 * k) = bfr(r[i] * ep);
                  *(LAS unsigned short*)(lds + O_BT + t * RS + 2 * k) = bfr(bb[i] * em);
                  *(LAS unsigned short*)(lds + O_KT + t * RS + 2 * k) = bfr(kd[i] * em);
                  bh[i] = bb[i] * eh; kh[i] = kd[i] * eh; }
              *(LAS unsigned*)(lds + O_BH + k * RS40 + 4 * tq) = att::pk2(bh[0], bh[1]);
              *(LAS unsigned*)(lds + O_KH + k * RS40 + 4 * tq) = att::pk2(kh[0], kh[1]);
              if (tq == 0) p15[k] = fexp2(tot);
              { const int t = tid >> 5, v2 = (tid & 31) * 2; *(LAS unsigned short*)(lds + O_VT + v2 * RS40 + 2 * t) = bfr(v0); *(LAS unsigned short*)(lds + O_VT + (v2 + 1) * RS40 + 2 * t) = bfr(v1); } }
            if (c + 4 < NCH) RW_LOAD(c + 4, 3);
            lds_barrier();
            const int htc = O_HT + (c & 1) * 64 * RS, htn = O_HT + ((c + 1) & 1) * 64 * RS;
            if (wid < 4) { const int ia = wid < 2 ? O_AT : O_RT, ib = (wid & 1) ? O_KT : O_BT;
                f32x4 gm = (f32x4){0.f, 0.f, 0.f, 0.f};
#pragma unroll
                for (int kk = 0; kk < 2; ++kk) gm = RW_MFMA(RW_FRAG(ia, l15, RS, 64 * kk + 16 * g), RW_FRAG(ib, l15, RS, 64 * kk + 16 * g), gm);
#pragma unroll
                for (int rr = 0; rr < 4; ++rr) { const int t = 4 * g + rr; const bool keep = wid < 2 ? (l15 < t) : (l15 <= t); const float val = keep ? gm[rr] : 0.f;
                    if (wid == 0) gab[l15 * 16 + t] = val;
                    else *(LAS unsigned short*)(lds + (wid == 1 ? O_GAK : wid == 2 ? O_GRB : O_GRK) + t * RS40 + 2 * l15) = bfr(val); } }
            lds_barrier();
            if (wid < 4) { f32x4 x = (f32x4){0.f, 0.f, 0.f, 0.f};
#pragma unroll
                for (int kk = 0; kk < 2; ++kk) x = RW_MFMA(RW_FRAG(O_AT, l15, RS, 64 * kk + 16 * g), RW_FRAG(htc, 16 * wid + l15, RS, 64 * kk + 16 * g), x);
                x = RW_MFMA(RW_FRAG(O_GAK, l15, RS40, 16 * g), RW_FRAG(O_VT, 16 * wid + l15, RS40, 16 * g), x);
#pragma unroll
                for (int rr = 0; rr < 4; ++rr) xs[(4 * g + rr) * 64 + 16 * wid + l15] = x[rr]; }
            lds_barrier();
            if (wid == 0) { float u[16];
#pragma unroll
                for (int t = 0; t < 16; ++t) u[t] = xs[t * 64 + lane];
#pragma unroll
                for (int s = 0; s < 15; ++s) {
#pragma unroll
                    for (int q4 = (s + 1) / 4; q4 < 4; ++q4) { const f32x4 gc = *(const LAS f32x4*)(gab + s * 16 + 4 * q4);
#pragma unroll
                        for (int j = 0; j < 4; ++j) if (4 * q4 + j > s) u[4 * q4 + j] += gc[j] * u[s]; } }
                u32x4 w0, w1; w0.x = att::pk2(u[0], u[1]); w0.y = att::pk2(u[2], u[3]); w0.z = att::pk2(u[4], u[5]); w0.w = att::pk2(u[6], u[7]);
                w1.x = att::pk2(u[8], u[9]); w1.y = att::pk2(u[10], u[11]); w1.z = att::pk2(u[12], u[13]); w1.w = att::pk2(u[14], u[15]);
                *(LAS u32x4*)(lds + O_UT + lane * RS40) = w0; *(LAS u32x4*)(lds + O_UT + lane * RS40 + 16) = w1; }
            lds_barrier();
            if (wid < 4) { f32x4 y = (f32x4){0.f, 0.f, 0.f, 0.f};
#pragma unroll
                for (int kk = 0; kk < 2; ++kk) y = RW_MFMA(RW_FRAG(O_RT, l15, RS, 64 * kk + 16 * g), RW_FRAG(htc, 16 * wid + l15, RS, 64 * kk + 16 * g), y);
                y = RW_MFMA(RW_FRAG(O_GRB, l15, RS40, 16 * g), RW_FRAG(O_UT, 16 * wid + l15, RS40, 16 * g), y);
                y = RW_MFMA(RW_FRAG(O_GRK, l15, RS40, 16 * g), RW_FRAG(O_VT, 16 * wid + l15, RS40, 16 * g), y);
                { RW_ROWBASE(c, rby_) const long sgy_ = d ? -1 : 1;
#pragma unroll
                for (int rr = 0; rr < 4; ++rr) { const long row = rby_ + sgy_ * (4 * g + rr); pY[row * 512 + 16 * wid + l15] = bfr(y[rr]); } } }
            { const int kt = wid >> 1; const f32x4 pd = *(const LAS f32x4*)(p15 + 16 * kt + 4 * g);
              const bf16x8 fb = RW_FRAG(O_BH, 16 * kt + l15, RS40, 16 * g), fk = RW_FRAG(O_KH, 16 * kt + l15, RS40, 16 * g);
#pragma unroll
              for (int j = 0; j < 2; ++j) { const int vt = 2 * (wid & 1) + j;
                  acc[j] = RW_MFMA(fb, RW_FRAG(O_UT, 16 * vt + l15, RS40, 16 * g), acc[j] * pd);
                  acc[j] = RW_MFMA(fk, RW_FRAG(O_VT, 16 * vt + l15, RS40, 16 * g), acc[j]);
                  *(LAS u32x2*)(lds + htn + (16 * vt + l15) * RS + (16 * kt + 4 * g) * 2) = (u32x2){att::pk2(acc[j][0], acc[j][1]), att::pk2(acc[j][2], acc[j][3])}; } }
                    }
        }
        lds_barrier();
#undef RW_LOAD
    }
}
}

#if defined(PERSISTENT)
#define DENSE_GEMM(Af, lda, Kreal, KP, WT, Wf, ldb, Cout, ldc, Mrows, Nvalid, NP) do { \
    conv_act((Af), (lda), (Kreal), C.ABF, (KP), (Mrows), wv_); grid_sync(bar); \
    { g8::DenseSched S_; S_.init(C.ABF, (WT), (Mrows), (NP), (KP), gridDim.x, opaque_bid()); g8::EpiF32 E_{(Cout), (ldc), (Nvalid)}; g8::gemm_phase<(KP), g8::EpiF32, g8::DenseSched>(lds, S_, E_, wv_); } \
    grid_sync(bar); } while (0)
#define DENSE_GEMM_UB(Af, lda, Kreal, KP, WT, Wf, ldb, Cout, ldc, Mrows, Nvalid, NP) do { \
    { g8::DenseSched S_; S_.init(C.UB, (WT), (Mrows), (NP), (KP), gridDim.x, opaque_bid()); g8::EpiF32 E_{(Cout), (ldc), (Nvalid)}; g8::gemm_phase<(KP), g8::EpiF32, g8::DenseSched>(lds, S_, E_, wv_); } \
    grid_sync(bar); } while (0)
#else
#define DENSE_GEMM_UB DENSE_GEMM
#define DENSE_GEMM(Af, lda, Kreal, KP, WT, Wf, ldb, Cout, ldc, Mrows, Nvalid, NP) ngemm((Af), (lda), nullptr, (Wf), 0, (ldb), nullptr, 0, (Cout), (ldc), (Mrows), (Nvalid), (Kreal), nullptr)
#endif
#ifdef PERSIST_C_MACRO
#define C (*Cp_)
#endif
#define MODL (C.MOD + (size_t)layer * (BATCH + 1) * N_MOD * D_MODEL)
FWD_QUAL void naive_prologue(FWD_SIG) {
    const int D = D_MODEL, NT = NT_, NC = NC_;
#if defined(PERSISTENT)
    tl::mod_phase(Cp_, lds, wv_);
    tl::rope_table(Cp_, wv_); tl::lora_weights(Cp_, wv_);
    conv_weight_b(lds, C.moe_w_gu, (size_t)D_MODEL * 2 * EXPERT_DIM, C.Wgu, (size_t)2 * EXPERT_DIM * D_MODEL, CV_PRO_LAYERS * N_EXPERTS, D_MODEL, 2 * EXPERT_DIM, 2 * EXPERT_DIM, D_MODEL, 2 * EXPERT_DIM, 1, wv_);
    conv_weight_b(lds, C.moe_w_down, (size_t)EXPERT_DIM * D_MODEL, C.Wdn, (size_t)D_MODEL * EXPERT_DIM, CV_PRO_LAYERS * N_EXPERTS, EXPERT_DIM, D_MODEL, D_MODEL, EXPERT_DIM, D_MODEL, 0, wv_);
    conv_weight_b(lds, C.ev_w_in, (size_t)D_MODEL * EVEN_IN, C.WinE, (size_t)4608 * 1024, N_EVEN, D_MODEL, EVEN_IN, EVEN_IN, 1024, 4608, 0, wv_);
    conv_weight_b(lds, C.ev_w_out, (size_t)1024 * D_MODEL, C.WoutE, (size_t)1024 * 1024, N_EVEN, 1024, D_MODEL, D_MODEL, 1024, 1024, 0, wv_);
    conv_weight_b(lds, C.od_w_in, (size_t)D_MODEL * MLA_IN, C.WinO, (size_t)512 * 1024, N_ODD, D_MODEL, MLA_IN, MLA_IN, 1024, 512, 0, wv_);
    conv_weight_b(lds, C.mla_w_qb, (size_t)MLA_QR * 1536, C.Wqb, (size_t)1536 * 256, N_ODD, MLA_QR, 1536, 1536, 256, 1536, 0, wv_);
    conv_weight_b(lds, C.mla_w_kvb, (size_t)MLA_KVR * 2048, C.Wkvb, (size_t)2048 * 256, N_ODD, MLA_KVR, 2048, 2048, 256, 2048, 0, wv_);
    conv_weight_b(lds, C.od_w_out, (size_t)1024 * D_MODEL, C.WoutO, (size_t)1024 * 1024, N_ODD, 1024, D_MODEL, D_MODEL, 1024, 1024, 0, wv_);
    grid_sync(bar);
#endif
#if !defined(PERSISTENT)
    NLAUNCH((long)NT * D, [=] HD(long i) { long row = i / D_MODEL; int d = (int)(i % D_MODEL); C.H[i] = row < NC_ ? C.ctx[row * D_MODEL + d] : C.x[(row - NC_) * D_MODEL + d]; });
#endif
#if !defined(PERSISTENT)
    NLAUNCH((long)DEPTH * (BATCH + 1) * N_MOD * D, [=] HD(long i) {
        const int W = N_MOD * D_MODEL; int j = (int)(i % W); long t = i / W; int r = (int)(t % (BATCH + 1)); int l = (int)(t / (BATCH + 1));
        const float* cv = r < BATCH ? C.c + (size_t)r * D_MODEL : C.c_ctx; const float* w = C.mod_w + (size_t)l * D_MODEL * W;
        float s = 0.f; for (int k = 0; k < D_MODEL; ++k) s += siluf_(cv[k]) * w[(size_t)k * W + j];
        C.MOD[i] = s + C.mod_b[(size_t)l * W + j]; });
#endif
#if defined(PERSISTENT)
    tl::init_h(Cp_, wv_); grid_sync(bar);
#endif
}
FWD_QUAL void naive_modu(FWD_SIG, long layer) {
#if !defined(PERSISTENT)
    const int D = D_MODEL, NT = NT_, NC = NC_; (void)D; (void)NT; (void)NC;
    const bool need_ctx = layer < DEPTH - 1; const long j2 = layer / 2; (void)need_ctx; (void)j2;
        NLAUNCH((long)NT * D, [=] HD(long i) { long row = i / D_MODEL; int d = (int)(i % D_MODEL); const float* m = MODL + (size_t)modrow((int)row) * N_MOD * D_MODEL; C.U[i] = C.H[i] * (1.f + m[D_MODEL + d]) + m[d]; });
#endif
}
FWD_QUAL void naive_even(FWD_SIG, long layer) {
    const int D = D_MODEL, NT = NT_, NC = NC_; (void)D; (void)NT; (void)NC;
    const bool need_ctx = layer < DEPTH - 1; const long j2 = layer / 2; (void)need_ctx; (void)j2;
            DENSE_GEMM_UB(C.U, D_MODEL, D_MODEL, 1024, C.WinE + (size_t)j2 * 4608 * 1024, C.ev_w_in + (size_t)j2 * D * EVEN_IN, EVEN_IN, C.Z, EVEN_IN, NT_, EVEN_IN, 4608);
#define mu (C.rw_mu + (size_t)j2 * RW_IN)
            NLAUNCH((long)NT * RW_IN, [=] HD(long i) { int row = (int)(i / RW_IN), c = (int)(i % RW_IN);
                int t, len; if (row < NC_) { t = row % CTX_LEN; len = CTX_LEN; } else { t = (row - NC_) % SEQ; len = SEQ; }
                float z = C.Z[(size_t)row * EVEN_IN + c]; float p = t > 0 ? C.Z[(size_t)(row - 1) * EVEN_IN + c] : 0.f; float n = t < len - 1 ? C.Z[(size_t)(row + 1) * EVEN_IN + c] : 0.f;
                C.ZS[i] = z + mu[c] * (0.5f * (p + n) - z); });
#define w0 (C.rw_w0 + (size_t)j2 * 2 * 512)
#define w2 (C.rw_w2 + (size_t)j2 * 2 * 64 * 512)
#define a0 (C.rw_a0 + (size_t)j2 * 2 * 512)
#define a2 (C.rw_a2 + (size_t)j2 * 2 * 64 * 512)
#define g2 (C.rw_g2 + (size_t)j2 * 128 * 512)
#define k_k (C.rw_k_k + (size_t)j2 * 512)
#define k_a (C.rw_k_a + (size_t)j2 * 512)
#define r_k (C.rw_r_k + (size_t)j2 * 512)
#define gn_g (C.rw_gn_g + (size_t)j2 * 512)
#define gn_b (C.rw_gn_b + (size_t)j2 * 512)
            NLAUNCH((long)NT * 512, [=] HD(long i) { int row = (int)(i / 512), c = (int)(i % 512); const float* zs = C.ZS + (size_t)row * RW_IN;
                float r = zs[c], k = zs[512 + c], v = zs[1024 + c];
                C.R[i] = r; C.V[i] = v; C.KKR[i] = k * k_k[c];
                float g = 0.f; for (int q = 0; q < 128; ++q) g += sigmoidf_(zs[1792 + q]) * g2[(size_t)q * 512 + c];
                C.G[i] = g;
                for (int d = 0; d < 2; ++d) {
                    float wl = 0.f, al = 0.f;
                    for (int q = 0; q < 64; ++q) { wl += tanhf(zs[1536 + d * 64 + q]) * w2[((size_t)d * 64 + q) * 512 + c]; al += zs[1664 + d * 64 + q] * a2[((size_t)d * 64 + q) * 512 + c]; }
                    float wpre = w0[d * 512 + c] + wl; float dec = expf(-expf(-softplusf_(-wpre) - 0.5f)); float a = sigmoidf_(a0[d * 512 + c] + al);
                    size_t o = ((size_t)d * NT_ + row) * 512 + c;
                    C.DEC[o] = dec; C.AG[o] = a; C.KD[o] = k * (1.f + (a - 1.f) * k_a[c]);
                } });
            NLAUNCH((long)NT * RW_HEADS, [=] HD(long i) { int row = (int)(i / RW_HEADS), h = (int)(i % RW_HEADS); size_t b0 = (size_t)row * 512 + h * 64;
                float ss = 0.f; for (int n = 0; n < 64; ++n) ss += C.KKR[b0 + n] * C.KKR[b0 + n];
                float inv = 1.f / sqrtf(fmaxf(ss, 1e-24f));
                for (int n = 0; n < 64; ++n) { float kk = C.KKR[b0 + n] * inv; C.NKK[b0 + n] = -kk; for (int d = 0; d < 2; ++d) { size_t o = ((size_t)d * NT_ + row) * 512 + h * 64 + n; C.BB[o] = kk * C.AG[o]; } } });
            NLAUNCH((long)2 * BATCH * RW_HEADS * 64, [=] HD(long i) { int v = (int)(i % 64); long t = i / 64; int h = (int)(t % RW_HEADS); t /= RW_HEADS; int b = (int)(t % BATCH); int d = (int)(t / BATCH);
                float S[64];
_Pragma("unroll")
                for (int k = 0; k < 64; ++k) S[k] = 0.f;
                for (int st = 0; st < TT_; ++st) { int row = tokrow(b, scan_pos(d, st)); size_t s0 = (size_t)row * 512 + h * 64, s1 = ((size_t)d * NT_ + row) * 512 + h * 64;
                    float sa = 0.f;
_Pragma("unroll")
                    for (int k = 0; k < 64; ++k) { sa += S[k] * C.NKK[s0 + k]; MEMFENCE_EVERY(k, 16); }
                    float vv = C.V[s0 + v], y = 0.f;
_Pragma("unroll")
                    for (int k = 0; k < 64; ++k) { S[k] = S[k] * C.DEC[s1 + k] + sa * C.BB[s1 + k] + vv * C.KD[s1 + k]; y += S[k] * C.R[s0 + k]; MEMFENCE_EVERY(k, 8); }
                    C.Y[s1 + v] = y; } });
#define lbp (C.hg_lb)
#define hgn (C.hg_norm_g + (size_t)j2 * 512)
            NLAUNCH((long)NT * 512, [=] HD(long i) { int row = (int)(i / 512), c = (int)(i % 512); const float* zb = C.Z + (size_t)row * EVEN_IN + RW_IN;
                C.HQ[i] = siluf_(zb[c]);
                for (int d = 0; d < 2; ++d) {
                    float mx = -1e30f; for (int q = 0; q < N_EVEN; ++q) mx = fmaxf(mx, lbp[((size_t)q * 2 + d) * 512 + c]);
                    float den = 0.f, num = 0.f; for (int q = 0; q < N_EVEN; ++q) { float e = expf(lbp[((size_t)q * 2 + d) * 512 + c] - mx); den += e; if (q >= 1 && q <= j2) num += e; }
                    float lower = num / den;
                    float sig = sigmoidf_(zb[512 + d * 512 + c]); float f = lower + (1.f - lower) * sig; f = fmaxf(f, 1e-30f);
                    size_t o = ((size_t)d * NT_ + row) * 512 + c; C.HF[o] = f; C.HK[o] = (1.f - lower) * (1.f - sig);
                } });
            NLAUNCH((long)2 * BATCH * HG_HEADS * 128 * 2, [=] HD(long i) { int kh = (int)(i & 1); int v = (int)((i >> 1) % 128); long t = (i >> 1) / 128; int h = (int)(t % HG_HEADS); t /= HG_HEADS; int b = (int)(t % BATCH); int d = (int)(t / BATCH);
                float S[64];
_Pragma("unroll")
                for (int k = 0; k < 64; ++k) S[k] = 0.f;
                for (int st = 0; st < TT_; ++st) { int row = tokrow(b, scan_pos(d, st)); size_t s0 = (size_t)row * 512 + h * 128 + kh * 64, s1 = ((size_t)d * NT_ + row) * 512 + h * 128 + kh * 64;
                    float val = C.Z[(size_t)row * EVEN_IN + RW_IN + 1536 + h * 128 + v], o = 0.f;
_Pragma("unroll")
                    for (int k = 0; k < 64; ++k) { S[k] = C.HF[s1 + k] * S[k] + C.HK[s1 + k] * val; o += S[k] * C.HQ[s0 + k]; MEMFENCE_EVERY(k, 16); }
                    C.OP[(((size_t)d * NT_ + row) * 512 + h * 128 + v) * 2 + kh] = o; } });
            NLAUNCH((long)NT * RW_HEADS, [=] HD(long i) { int row = (int)(i / RW_HEADS), h = (int)(i % RW_HEADS); size_t b0 = (size_t)row * 512 + h * 64, b1 = ((size_t)NT_ + row) * 512 + h * 64;
                float mu_ = 0.f; for (int n = 0; n < 64; ++n) mu_ += C.Y[b0 + n] + C.Y[b1 + n]; mu_ /= 64.f;
                float var = 0.f; for (int n = 0; n < 64; ++n) { float y = C.Y[b0 + n] + C.Y[b1 + n] - mu_; var += y * y; } var /= 64.f;
                float rs = 1.f / sqrtf(var + 64e-5f);
                float bon = 0.f; for (int n = 0; n < 64; ++n) bon += C.R[b0 + n] * (C.KD[b0 + n] + C.KD[b1 + n]) * r_k[h * 64 + n];
                for (int n = 0; n < 64; ++n) { int c = h * 64 + n; float y = (C.Y[b0 + n] + C.Y[b1 + n] - mu_) * rs * gn_g[c] + gn_b[c]; C.YCAT[(size_t)row * 1024 + c] = (y + bon * C.V[b0 + n]) * C.G[b0 + n]; } });
            NLAUNCH((long)NT * HG_HEADS, [=] HD(long i) { int row = (int)(i / HG_HEADS), h = (int)(i % HG_HEADS); size_t b0 = (size_t)row * 512 + h * 128, b1 = ((size_t)NT_ + row) * 512 + h * 128;
                float ss = 0.f; for (int n = 0; n < 128; ++n) { float o = C.OP[(b0 + n) * 2] + C.OP[(b0 + n) * 2 + 1] + C.OP[(b1 + n) * 2] + C.OP[(b1 + n) * 2 + 1]; ss += o * o; }
                float rs = 1.f / sqrtf(ss / 128.f + 1e-6f);
                for (int n = 0; n < 128; ++n) { int c = h * 128 + n; float o = (C.OP[(b0 + n) * 2] + C.OP[(b0 + n) * 2 + 1] + C.OP[(b1 + n) * 2] + C.OP[(b1 + n) * 2 + 1]) * rs * hgn[c]; C.YCAT[(size_t)row * 1024 + 512 + c] = o * siluf_(C.Z[(size_t)row * EVEN_IN + RW_IN + 2048 + c]); } });
            DENSE_GEMM(C.YCAT, 1024, 1024, 1024, C.WoutE + (size_t)j2 * 1024 * 1024, C.ev_w_out + (size_t)j2 * 1024 * D, D_MODEL, C.YO, D_MODEL, NT_, D_MODEL, 1024);
}
FWD_QUAL void naive_scans(FWD_SIG, long layer) {
    const long j2 = layer / 2; (void)j2;
            NLAUNCH((long)2 * BATCH * RW_HEADS * 64, [=] HD(long i) { int v = (int)(i % 64); long t = i / 64; int h = (int)(t % RW_HEADS); t /= RW_HEADS; int b = (int)(t % BATCH); int d = (int)(t / BATCH);
                float S[64];
_Pragma("unroll")
                for (int k = 0; k < 64; ++k) S[k] = 0.f;
                for (int st = 0; st < TT_; ++st) { int row = tokrow(b, scan_pos(d, st)); size_t s0 = (size_t)row * 512 + h * 64, s1 = ((size_t)d * NT_ + row) * 512 + h * 64;
                    float sa = 0.f;
_Pragma("unroll")
                    for (int k = 0; k < 64; ++k) { sa += S[k] * C.NKK[s0 + k]; MEMFENCE_EVERY(k, 16); }
                    float vv = C.V[s0 + v], y = 0.f;
_Pragma("unroll")
                    for (int k = 0; k < 64; ++k) { S[k] = S[k] * C.DEC[s1 + k] + sa * C.BB[s1 + k] + vv * C.KD[s1 + k]; y += S[k] * C.R[s0 + k]; MEMFENCE_EVERY(k, 8); }
                    C.Y[s1 + v] = y; } });
            NLAUNCH((long)2 * BATCH * HG_HEADS * 128 * 2, [=] HD(long i) { int kh = (int)(i & 1); int v = (int)((i >> 1) % 128); long t = (i >> 1) / 128; int h = (int)(t % HG_HEADS); t /= HG_HEADS; int b = (int)(t % BATCH); int d = (int)(t / BATCH);
                float S[64];
_Pragma("unroll")
                for (int k = 0; k < 64; ++k) S[k] = 0.f;
                for (int st = 0; st < TT_; ++st) { int row = tokrow(b, scan_pos(d, st)); size_t s0 = (size_t)row * 512 + h * 128 + kh * 64, s1 = ((size_t)d * NT_ + row) * 512 + h * 128 + kh * 64;
                    float val = C.Z[(size_t)row * EVEN_IN + RW_IN + 1536 + h * 128 + v], o = 0.f;
_Pragma("unroll")
                    for (int k = 0; k < 64; ++k) { S[k] = C.HF[s1 + k] * S[k] + C.HK[s1 + k] * val; o += S[k] * C.HQ[s0 + k]; MEMFENCE_EVERY(k, 16); }
                    C.OP[(((size_t)d * NT_ + row) * 512 + h * 128 + v) * 2 + kh] = o; } });
}
FWD_QUAL void naive_scan_hgrn(FWD_SIG, long layer) {
    const long j2 = layer / 2; (void)j2;
            NLAUNCH((long)2 * BATCH * HG_HEADS * 128 * 2, [=] HD(long i) { int kh = (int)(i & 1); int v = (int)((i >> 1) % 128); long t = (i >> 1) / 128; int h = (int)(t % HG_HEADS); t /= HG_HEADS; int b = (int)(t % BATCH); int d = (int)(t / BATCH);
                float S[64];
_Pragma("unroll")
                for (int k = 0; k < 64; ++k) S[k] = 0.f;
                for (int st = 0; st < TT_; ++st) { int row = tokrow(b, scan_pos(d, st)); size_t s0 = (size_t)row * 512 + h * 128 + kh * 64, s1 = ((size_t)d * NT_ + row) * 512 + h * 128 + kh * 64;
                    float val = C.Z[(size_t)row * EVEN_IN + RW_IN + 1536 + h * 128 + v], o = 0.f;
_Pragma("unroll")
                    for (int k = 0; k < 64; ++k) { S[k] = C.HF[s1 + k] * S[k] + C.HK[s1 + k] * val; o += S[k] * C.HQ[s0 + k]; MEMFENCE_EVERY(k, 16); }
                    C.OP[(((size_t)d * NT_ + row) * 512 + h * 128 + v) * 2 + kh] = o; } });
}
FWD_QUAL void naive_odd(FWD_SIG, long layer) {
    const int D = D_MODEL, NT = NT_, NC = NC_; (void)D; (void)NT; (void)NC;
    const bool need_ctx = layer < DEPTH - 1; const long j2 = layer / 2; (void)need_ctx; (void)j2;
            DENSE_GEMM_UB(C.U, D_MODEL, D_MODEL, 1024, C.WinO + (size_t)j2 * 512 * 1024, C.od_w_in + (size_t)j2 * D * MLA_IN, MLA_IN, C.Z, EVEN_IN, NT_, MLA_IN, 512);
#define qng (C.mla_q_norm_g + (size_t)j2 * MLA_QR)
#define kvng (C.mla_kv_norm_g + (size_t)j2 * MLA_KVR)
            NLAUNCH((long)NT, [=] HD(long i) { int row = (int)i; const float* z = C.Z + (size_t)row * EVEN_IN;
                float ss = 0.f; for (int k = 0; k < MLA_QR; ++k) ss += z[k] * z[k]; float rs = 1.f / sqrtf(ss / MLA_QR + 1e-6f);
                for (int k = 0; k < MLA_QR; ++k) C.QN[(size_t)row * MLA_QR + k] = z[k] * rs * qng[k];
                ss = 0.f; for (int k = 0; k < MLA_KVR; ++k) ss += z[MLA_QR + k] * z[MLA_QR + k]; rs = 1.f / sqrtf(ss / MLA_KVR + 1e-6f);
                for (int k = 0; k < MLA_KVR; ++k) C.KVN[(size_t)row * MLA_KVR + k] = z[MLA_QR + k] * rs * kvng[k];
                const float* kp = z + MLA_QR + MLA_KVR; float* o = C.KPE + (size_t)row * 32;
                if (row < NC_) { for (int k = 0; k < 32; ++k) o[k] = kp[k]; }
                else { int s = (row - NC_) % SEQ; float fr = (float)(s / GRID_W), fc = (float)(s % GRID_W);
                    for (int q = 0; q < 8; ++q) { float inv = powf(10000.f, -(float)(2 * q) / 16.f); float ar = fr * inv, ac = fc * inv; float cr = cosf(ar), sr = sinf(ar), cc = cosf(ac), sc = sinf(ac);
                        o[q] = kp[q] * cr - kp[8 + q] * sr; o[8 + q] = kp[8 + q] * cr + kp[q] * sr; o[16 + q] = kp[16 + q] * cc - kp[24 + q] * sc; o[24 + q] = kp[24 + q] * cc + kp[16 + q] * sc; } } });
            DENSE_GEMM(C.QN, MLA_QR, MLA_QR, 256, C.Wqb + (size_t)j2 * 1536 * 256, C.mla_w_qb + (size_t)j2 * MLA_QR * 1536, 1536, C.Q, 1536, NT_, 1536, 1536);
            DENSE_GEMM(C.KVN, MLA_KVR, MLA_KVR, 256, C.Wkvb + (size_t)j2 * 2048 * 256, C.mla_w_kvb + (size_t)j2 * MLA_KVR * 2048, 2048, C.KV, 2048, NT_, 2048, 2048);
            NLAUNCH((long)NL_ * MLA_HEADS * 8, [=] HD(long i) { int q = (int)(i % 8); long t = i / 8; int h = (int)(t % MLA_HEADS); int lr = (int)(t / MLA_HEADS); int s = lr % SEQ;
                float* p = C.Q + (size_t)(NC_ + lr) * 1536 + h * 96 + 64; float fr = (float)(s / GRID_W), fc = (float)(s % GRID_W);
                float inv = powf(10000.f, -(float)(2 * q) / 16.f); float ar = fr * inv, ac = fc * inv; float cr = cosf(ar), sr = sinf(ar), cc = cosf(ac), sc = sinf(ac);
                float r1 = p[q], r2 = p[8 + q], c1 = p[16 + q], c2 = p[24 + q];
                p[q] = r1 * cr - r2 * sr; p[8 + q] = r2 * cr + r1 * sr; p[16 + q] = c1 * cc - c2 * sc; p[24 + q] = c2 * cc + c1 * sc; });
#if defined(PERSISTENT)
            GRID_STRIDE_WAVES(i, (long)NT_ * (MLA_HEADS * 96 / 8)) { const long row = i / (MLA_HEADS * 96 / 8); const int c8 = (int)(i % (MLA_HEADS * 96 / 8)) * 8; const float* q = C.Q + row * 1536 + c8; const float sc = 0.14724445136f;
                u32x4 w; w.x = att::pk2(q[0] * sc, q[1] * sc); w.y = att::pk2(q[2] * sc, q[3] * sc); w.z = att::pk2(q[4] * sc, q[5] * sc); w.w = att::pk2(q[6] * sc, q[7] * sc); *(u32x4*)(C.QB + row * 1536 + c8) = w; }
            GRID_STRIDE_WAVES(i, (long)NT_ * MLA_HEADS * 20) { const int c8 = (int)(i % 20); const long rh = i / 20; const int h = (int)(rh % MLA_HEADS); const int row = (int)(rh / MLA_HEADS);
                int b, t; if (row < NC_) { b = row / CTX_LEN; t = row % CTX_LEN; } else { b = (row - NC_) / SEQ; t = CTX_LEN + (row - NC_) % SEQ; }
                const size_t kvrow = (size_t)(b * MLA_HEADS + h) * TT_ + t;
                const float* src = c8 < 8 ? C.KV + (size_t)row * 2048 + h * 128 + c8 * 8 : (c8 < 12 ? C.KPE + (size_t)row * 32 + (c8 - 8) * 8 : C.KV + (size_t)row * 2048 + h * 128 + 64 + (c8 - 12) * 8);
                u32x4 w; w.x = att::pk2(src[0], src[1]); w.y = att::pk2(src[2], src[3]); w.z = att::pk2(src[4], src[5]); w.w = att::pk2(src[6], src[7]);
                if (c8 < 12) *(u32x4*)(C.KB + kvrow * 96 + c8 * 8) = w; else *(u32x4*)(C.VB + kvrow * 64 + (c8 - 12) * 8) = w; }
            grid_sync(bar);
            att::attn_phase<false, 0>(lds, C.QB, C.KB, C.VB, C.AO, nullptr, need_ctx ? 1 : 0, wv_);
            grid_sync(bar);
#else
            const long row_lo = need_ctx ? 0 : NC;
            NLAUNCH((long)(NT - row_lo) * MLA_HEADS * 2, [=] HD(long i) { const int nrows_ = NT_ - (int)row_lo; int hv = (int)(i / nrows_); int row = (int)row_lo + (int)(i % nrows_); const int h = hv >> 1, vh = hv & 1;
                int b, nkeys; if (row < NC_) { b = row / CTX_LEN; nkeys = CTX_LEN; } else { b = (row - NC_) / SEQ; nkeys = TT_; }
                float q[96];
_Pragma("unroll")
                for (int k = 0; k < 96; ++k) q[k] = C.Q[(size_t)row * 1536 + h * 96 + k];
                float o[32];
_Pragma("unroll")
                for (int k = 0; k < 32; ++k) o[k] = 0.f;
                float m = -1e30f, l = 0.f; const float scale = 0.10206207261596577f;
                for (int t = 0; t < nkeys; ++t) { int kr = tokrow(b, t); const float* kn = C.KV + (size_t)kr * 2048 + h * 128; const float* kp = C.KPE + (size_t)kr * 32;
                    float s = 0.f;
_Pragma("unroll")
                    for (int k = 0; k < 64; ++k) { s += q[k] * kn[k]; MEMFENCE_EVERY(k, 16); }
_Pragma("unroll")
                    for (int k = 0; k < 32; ++k) { s += q[64 + k] * kp[k]; MEMFENCE_EVERY(k, 16); }
                    s *= scale; float mn = fmaxf(m, s); float corr = expf(m - mn), p = expf(s - mn); l = l * corr + p;
_Pragma("unroll")
                    for (int k = 0; k < 32; ++k) { o[k] = o[k] * corr + p * kn[64 + vh * 32 + k]; MEMFENCE_EVERY(k, 16); }
                    m = mn; }
                float il = 1.f / l;
_Pragma("unroll")
                for (int k = 0; k < 32; ++k) C.AO[(size_t)row * 1024 + h * 64 + vh * 32 + k] = o[k] * il; });
#endif
            DENSE_GEMM(C.AO, 1024, 1024, 1024, C.WoutO + (size_t)j2 * 1024 * 1024, C.od_w_out + (size_t)j2 * 1024 * D, D_MODEL, C.YO, D_MODEL, NT_, D_MODEL, 1024);
}
FWD_QUAL void naive_common(FWD_SIG, long layer) {
#if defined(PERSISTENT)
    {
        const int row_lo = layer < DEPTH - 1 ? 0 : NC_, nrows = NT_ - row_lo;
#if CV_BACKGROUND
        if (layer > 0) cv_catchup(Cp_, layer, wv_);
#endif
#if CV_TAIL && !CV_BACKGROUND
        if (layer > 0) cv_catch(Cp_, lds, layer, wv_);
#endif
        tl::ln1_router(Cp_, lds, layer, row_lo, nrows, wv_); grid_sync(bar);
        tl::slots_gather(Cp_, layer, row_lo, nrows, wv_); grid_sync(bar);
        RP(REP_MOE,
        { g8::MoeSched S_; S_.init(C.UB, C.Wgu + (size_t)layer * N_EXPERTS * 2 * EXPERT_DIM * D_MODEL, D_MODEL, 2 * EXPERT_DIM, N_EXPERTS, (const LAS int*)tl::tl_tstart, gridDim.x, moe_remap(opaque_bid(), gridDim.x, 2 * EXPERT_DIM / 256)); S_.gather = true; MOE_SET_CHUNK
          LAS int* gtab = (LAS int*)(lds + 131072);
          { const int t_ = otid(wv_); const GAS int* tok_ = (const GAS int*)C.TOKOF; int gv_[20];
            _Pragma("unroll") for (int i_ = 0; i_ < 20; ++i_) { const long L_ = S_.unit(i_); const int rt_ = (int)((L_ < 0 ? 0 : L_) / S_.NCT); gv_[i_] = (L_ >= 0 && t_ < 256) ? tok_[(size_t)rt_ * 256 + t_] : 0; }
            _Pragma("unroll") for (int i_ = 0; i_ < 20; ++i_) { const long L_ = S_.unit(i_); if (L_ >= 0 && t_ < 256) gtab[i_ * 256 + t_] = gv_[i_]; } }
          __syncthreads();
          g8::EpiSwiGLU E_{C.ACTB, C.moe_b_gu + (size_t)layer * N_EXPERTS * 2 * EXPERT_DIM, EXPERT_DIM}; g8::gemm_phase<D_MODEL, g8::EpiSwiGLU, g8::MoeSched, true>(lds, S_, E_, wv_, gtab, CV_CTX);
#if CV_TAIL && !CV_BACKGROUND
          if (layer < DEPTH - 1) cv_tail(Cp_, lds, S_, wv_);
#endif
          }
        grid_sync(bar);
        { g8::MoeSched S_; S_.init(C.ACTB, C.Wdn + (size_t)layer * N_EXPERTS * D_MODEL * EXPERT_DIM, EXPERT_DIM, D_MODEL, N_EXPERTS, (const LAS int*)tl::tl_tstart, gridDim.x, moe_remap(opaque_bid(), gridDim.x, D_MODEL / 256)); MOE_SET_CHUNK
          g8::EpiDownBf16 E_{C.OUT2B, D_MODEL, C.moe_b_down + (size_t)layer * N_EXPERTS * D_MODEL}; g8::gemm_phase<EXPERT_DIM, g8::EpiDownBf16, g8::MoeSched>(lds, S_, E_, wv_, nullptr, CV_CTX);
#if CV_TAIL && !CV_BACKGROUND
          if (layer < DEPTH - 1) cv_tail(Cp_, lds, S_, wv_);
#endif
          }
        grid_sync(bar);
        )
        tl::combine_ln2(Cp_, layer, row_lo, nrows, wv_); grid_sync(bar);
    }
#else

    const int D = D_MODEL, NT = NT_, NC = NC_; (void)D; (void)NT; (void)NC;
    const bool need_ctx = layer < DEPTH - 1; const long j2 = layer / 2; (void)need_ctx; (void)j2;
#define lng0 (C.ln_g + ((size_t)layer * 2 + 0) * D_MODEL)
#define lnb0 (C.ln_b + ((size_t)layer * 2 + 0) * D_MODEL)
#define lng1 (C.ln_g + ((size_t)layer * 2 + 1) * D_MODEL)
#define lnb1 (C.ln_b + ((size_t)layer * 2 + 1) * D_MODEL)
        const long row_lo = need_ctx ? 0 : NC;
        NLAUNCH((long)(NT - row_lo), [=] HD(long i) { int row = (int)row_lo + (int)i; const float* m = MODL + (size_t)modrow(row) * N_MOD * D_MODEL; float* h = C.H + (size_t)row * D_MODEL; const float* yo = C.YO + (size_t)row * D_MODEL;
            float mu_ = 0.f; for (int d = 0; d < D_MODEL; ++d) mu_ += ALPHA * h[d] + m[2 * D_MODEL + d] * yo[d]; mu_ /= D_MODEL;
            float var = 0.f; for (int d = 0; d < D_MODEL; ++d) { float t = ALPHA * h[d] + m[2 * D_MODEL + d] * yo[d] - mu_; var += t * t; } var /= D_MODEL;
            float rs = 1.f / sqrtf(var + 1e-5f);
            for (int d = 0; d < D_MODEL; ++d) { float t = (ALPHA * h[d] + m[2 * D_MODEL + d] * yo[d] - mu_) * rs * lng0[d] + lnb0[d]; h[d] = t; C.U[(size_t)row * D_MODEL + d] = t * (1.f + m[4 * D_MODEL + d]) + m[3 * D_MODEL + d]; } });
#define wr (C.moe_w_router + (size_t)layer * D_MODEL * N_EXPERTS)
#define br (C.moe_b_router + (size_t)layer * N_EXPERTS)
        NLAUNCH((long)(NT - row_lo) * N_EXPERTS, [=] HD(long i) { int e = (int)(i % N_EXPERTS); int row = (int)row_lo + (int)(i / N_EXPERTS); const float* u = C.U + (size_t)row * D_MODEL;
            float s = 0.f; for (int k = 0; k < D_MODEL; ++k) s += u[k] * wr[(size_t)k * N_EXPERTS + e]; C.LOGIT[(size_t)row * N_EXPERTS + e] = s + br[e]; });
#define CNTL (C.CNT + layer * 64)
#define CURL (C.CUR + layer * 64)
        NLAUNCH((long)(NT - row_lo), [=] HD(long i) { int row = (int)row_lo + (int)i; const float* lg = C.LOGIT + (size_t)row * N_EXPERTS; int idx[TOP_K]; float val[TOP_K];
            for (int k = 0; k < TOP_K; ++k) { int best = -1; float bv = -3.4e38f; for (int e = 0; e < N_EXPERTS; ++e) { bool used = false; for (int q = 0; q < k; ++q) used |= (idx[q] == e); if (!used && lg[e] > bv) { bv = lg[e]; best = e; } } idx[k] = best; val[k] = bv; }
            float den = 0.f; for (int k = 0; k < TOP_K; ++k) den += expf(val[k] - val[0]);
            for (int k = 0; k < TOP_K; ++k) { C.TOPI[(size_t)row * TOP_K + k] = idx[k]; C.TOPG[(size_t)row * TOP_K + k] = expf(val[k] - val[0]) / den;
#ifdef HOST_TEST
                CNTL[idx[k]]++;
#else
                atomicAdd(&CNTL[idx[k]], 1);
#endif
            } });
        NLAUNCH(1, [=] HD(long) { int off = 0; for (int e = 0; e < N_EXPERTS; ++e) { C.OFF[e] = off; const int cnt = ld_cnt(CNTL + e); int nt = (cnt + MOE_PAD - 1) / MOE_PAD * MOE_PAD; for (int t = 0; t < nt / 64; ++t) C.TILE_E[off / 64 + t] = (t * 64 < cnt) ? e : -1; off += nt; }
            for (int t = off / 64; t < NSLOT_ / 64; ++t) C.TILE_E[t] = -1; });
        NLAUNCH((long)NSLOT_, [=] HD(long i) { C.TOKOF[i] = -1; });
        NLAUNCH((long)(NT - row_lo) * TOP_K, [=] HD(long i) { int row = (int)row_lo + (int)(i / TOP_K); int k = (int)(i % TOP_K); int e = C.TOPI[(size_t)row * TOP_K + k];
#ifdef HOST_TEST
            int r = CURL[e]++;
#else
            int r = atomicAdd(&CURL[e], 1);
#endif
            int s = C.OFF[e] + r; C.SLOT[(size_t)row * TOP_K + k] = s; C.TOKOF[s] = row; });
#if defined(PERSISTENT)
        {
            __shared__ int tstart_s[40];
            if (otid(wv_) == 0) { int acc_t = 0; for (int e = 0; e < N_EXPERTS; ++e) { tstart_s[e] = acc_t; acc_t += (ld_cnt(CNTL + e) + MOE_PAD - 1) / MOE_PAD; } tstart_s[N_EXPERTS] = acc_t; }
            GRID_STRIDE_WAVES(i, (long)NSLOT_ * (D_MODEL / 8)) { const long sl = i / (D_MODEL / 8); const int c8 = (int)(i % (D_MODEL / 8)) * 8; const int tk = C.TOKOF[sl]; u32x4 w = (u32x4){0u, 0u, 0u, 0u};
                if (tk >= 0) { const float4 a = *(const float4*)(C.U + (size_t)tk * D_MODEL + c8), b = *(const float4*)(C.U + (size_t)tk * D_MODEL + c8 + 4);
                    w.x = cvt_pk_bf16(a.x, a.y); w.y = cvt_pk_bf16(a.z, a.w); w.z = cvt_pk_bf16(b.x, b.y); w.w = cvt_pk_bf16(b.z, b.w); }
                *(u32x4*)(C.XPB + sl * D_MODEL + c8) = w; }
            grid_sync(bar);
            { g8::MoeSched S_; S_.init(C.XPB, C.Wgu + (size_t)layer * N_EXPERTS * 2 * EXPERT_DIM * D_MODEL, D_MODEL, 2 * EXPERT_DIM, N_EXPERTS, (const LAS int*)tstart_s, gridDim.x, opaque_bid());
              g8::EpiSwiGLU E_{C.ACTB, C.moe_b_gu + (size_t)layer * N_EXPERTS * 2 * EXPERT_DIM, EXPERT_DIM}; g8::gemm_phase<D_MODEL, g8::EpiSwiGLU, g8::MoeSched>(lds, S_, E_, wv_); }
            grid_sync(bar);
            { g8::MoeSched S_; S_.init(C.ACTB, C.Wdn + (size_t)layer * N_EXPERTS * D_MODEL * EXPERT_DIM, EXPERT_DIM, D_MODEL, N_EXPERTS, (const LAS int*)tstart_s, gridDim.x, opaque_bid());
              g8::EpiDownF32 E_{C.OUT2, D_MODEL, C.moe_b_down + (size_t)layer * N_EXPERTS * D_MODEL}; g8::gemm_phase<EXPERT_DIM, g8::EpiDownF32, g8::MoeSched>(lds, S_, E_, wv_); }
            grid_sync(bar);
        }
#else
        const int F = EXPERT_DIM;
        ngemm(C.U, D, C.TOKOF, C.moe_w_gu + (size_t)layer * N_EXPERTS * D * 2 * F, (long)D * 2 * F, 2 * F, C.moe_b_gu + (size_t)layer * N_EXPERTS * 2 * F, 2 * F, C.H1, 2 * F, NSLOT_, 2 * F, D, C.TILE_E);
        NLAUNCH((long)NSLOT_ * F, [=] HD(long i) { long s = i / EXPERT_DIM; int j = (int)(i % EXPERT_DIM); if (C.TOKOF[s] < 0) { C.ACT[i] = 0.f; return; }
            float glu = fminf(C.H1[s * 2 * EXPERT_DIM + j], 7.f), lin = fminf(fmaxf(C.H1[s * 2 * EXPERT_DIM + EXPERT_DIM + j], -7.f), 7.f);
            C.ACT[i] = glu * sigmoidf_(1.702f * glu) * (lin + 1.f); });
        ngemm(C.ACT, F, nullptr, C.moe_w_down + (size_t)layer * N_EXPERTS * F * D, (long)F * D, D, C.moe_b_down + (size_t)layer * N_EXPERTS * D, D, C.OUT2, D, NSLOT_, D, F, C.TILE_E);
#endif
#define outp (C.out)
        const long last = (layer == DEPTH - 1);
        NLAUNCH((long)(NT - row_lo), [=] HD(long i) { int row = (int)row_lo + (int)i; const float* m = MODL + (size_t)modrow(row) * N_MOD * D_MODEL; float* h = C.H + (size_t)row * D_MODEL;
            const int* sl = C.SLOT + (size_t)row * TOP_K; const float* tg = C.TOPG + (size_t)row * TOP_K;
            float mu_ = 0.f; for (int d = 0; d < D_MODEL; ++d) { float f = 0.f; for (int k = 0; k < TOP_K; ++k) f += tg[k] * C.OUT2[(size_t)sl[k] * D_MODEL + d]; mu_ += ALPHA * h[d] + m[5 * D_MODEL + d] * f; } mu_ /= D_MODEL;
            float var = 0.f; for (int d = 0; d < D_MODEL; ++d) { float f = 0.f; for (int k = 0; k < TOP_K; ++k) f += tg[k] * C.OUT2[(size_t)sl[k] * D_MODEL + d]; float t = ALPHA * h[d] + m[5 * D_MODEL + d] * f - mu_; var += t * t; } var /= D_MODEL;
            float rs = 1.f / sqrtf(var + 1e-5f);
            for (int d = 0; d < D_MODEL; ++d) { float f = 0.f; for (int k = 0; k < TOP_K; ++k) f += tg[k] * C.OUT2[(size_t)sl[k] * D_MODEL + d]; float t = (ALPHA * h[d] + m[5 * D_MODEL + d] * f - mu_) * rs * lng1[d] + lnb1[d]; h[d] = t; if (last) outp[(size_t)(row - NC_) * D_MODEL + d] = t; } });
#endif
}


#if defined(PERSISTENT)
#define MG_DENSE(KP, EPI, Aptr, Wptr, Mrows, NP, ...) do { g8::DenseSched S_; S_.init((Aptr), (Wptr), (Mrows), (NP), (KP), gridDim.x, opaque_bid()); g8::EPI E_{__VA_ARGS__}; g8::gemm_phase<(KP), g8::EPI, g8::DenseSched>(lds, S_, E_, wv_, nullptr, CV_CTX); } while (0)
FWD_QUAL void mega_even(FWD_SIG, long layer) {
    const long j2 = layer / 2;
    RP(REP_DEN, MG_DENSE(1024, EpiBf16, C.UB, C.WinE + (size_t)j2 * 4608 * 1024, NT_, 4608, C.ZB, 4608, 1.f); grid_sync(bar);)
    RP(REP_TLE, tl::rw_tw(Cp_, layer, wv_); grid_sync(bar);)
    RP(REP_DEN, { g8::LoraSched S_; S_.init(C.TW, C.Wlora + (size_t)j2 * 2560 * 384, NT_, 2560, 384, gridDim.x, opaque_bid()); g8::EpiBf16 E_{C.LOB, 2560, 1.f}; g8::gemm_phase<256, g8::EpiBf16, g8::LoraSched, false, 384>(lds, S_, E_, wv_, nullptr, CV_CTX); } grid_sync(bar);)
    RP(REP_TLE, tl::rw_prep(Cp_, layer, wv_); grid_sync(bar);)
    RP(REP_RWS, rwc::rwkv_chunk_scan(Cp_, lds, wv_);)
    RP(REP_HGS, hg::hgrn_scan(Cp_, lds, layer, wv_); grid_sync(bar);)
    RP(REP_TLE, tl::even_post(Cp_, layer, wv_); grid_sync(bar);)
    RP(REP_DEN, MG_DENSE(1024, EpiBf16, C.YCATB, C.WoutE + (size_t)j2 * 1024 * 1024, NT_, 1024, C.YOB, D_MODEL, 1.f); grid_sync(bar);)
}
FWD_QUAL void mega_odd(FWD_SIG, long layer) {
    const long j2 = layer / 2; const bool need_ctx = layer < DEPTH - 1;
    RP(REP_DEN, MG_DENSE(1024, EpiBf16, C.UB, C.WinO + (size_t)j2 * 512 * 1024, NT_, 512, (bf16_t*)C.Z, 512, 1.f); grid_sync(bar);)
    RP(REP_TLE, tl::mla_prep(Cp_, layer, wv_); grid_sync(bar);)
    RP(REP_DEN, MG_DENSE(256, EpiBf16, C.QNB, C.Wqb + (size_t)j2 * 1536 * 256, NT_, 1536, C.QB, 1536, 0.14724445136f);)
    RP(REP_DEN, MG_DENSE(256, EpiBf16, C.KVNB, C.Wkvb + (size_t)j2 * 2048 * 256, NT_, 2048, C.KVB, 2048, 1.f); grid_sync(bar);)
    RP(REP_ATT, att::attn_phase<true, 1>(lds, C.QB, C.KVB, C.KPEB, nullptr, C.AOB, need_ctx ? 1 : 0, wv_, C.ROPE); grid_sync(bar);)
    RP(REP_DEN, MG_DENSE(1024, EpiBf16, C.AOB, C.WoutO + (size_t)j2 * 1024 * 1024, NT_, 1024, C.YOB, D_MODEL, 1.f); grid_sync(bar);)
}
#endif
FWD_QUAL void naive_forward(FWD_SIG) {
#if defined(PERSISTENT)
    RP(REP_PRO, naive_prologue(FWD_ARGS);)
#else
    naive_prologue(FWD_ARGS);
#endif
#if defined(PERSISTENT)
    mega_even(FWD_ARGS, 0); naive_common(FWD_ARGS, 0);
    mega_odd(FWD_ARGS, 1); naive_common(FWD_ARGS, 1);
    mega_even(FWD_ARGS, 2); naive_common(FWD_ARGS, 2);
    mega_odd(FWD_ARGS, 3); naive_common(FWD_ARGS, 3);
#else
    for (long p = 0; p < DEPTH / 2; ++p) {
        naive_modu(FWD_ARGS, 2 * p); naive_even(FWD_ARGS, 2 * p); naive_common(FWD_ARGS, 2 * p);
        naive_modu(FWD_ARGS, 2 * p + 1); naive_odd(FWD_ARGS, 2 * p + 1); naive_common(FWD_ARGS, 2 * p + 1);
    }
#endif
}

#undef MODL
#undef mu
#undef w0
#undef w2
#undef a0
#undef a2
#undef g2
#undef k_k
#undef k_a
#undef r_k
#undef gn_g
#undef gn_b
#undef lbp
#undef hgn
#undef qng
#undef kvng
#undef lng0
#undef lnb0
#undef lng1
#undef lnb1
#undef wr
#undef br
#undef CNTL
#undef CURL
#undef outp

#ifdef PERSIST_C_MACRO
#undef C
#endif
struct Params { NaiveCtx C; unsigned* bar; };
__global__ void __launch_bounds__(PB_THREADS, 2) mega_fwd(Params p) {
    extern __shared__ __attribute__((aligned(16))) unsigned char dyn_lds[];
    __shared__ NaiveCtx sC;
    __shared__ uint4 xb_words;
    typedef unsigned long long u64;
    const __attribute__((address_space(4))) u64* ka = (const __attribute__((address_space(4))) u64*)__builtin_amdgcn_kernarg_segment_ptr();
    constexpr int NW = (int)(sizeof(NaiveCtx) / 8);
    if (threadIdx.x < NW) ((LAS u64*)&sC)[threadIdx.x] = ka[threadIdx.x];
    if (threadIdx.x == 0) xb_words = make_uint4(0u, 0u, 0u, 0u);
    __syncthreads();
    unsigned* barp = (unsigned*)ka[NW];
    XcdBarrier bar = xcd_barrier_post(barp, (volatile LAS unsigned*)&xb_words);
    naive_forward((const LAS NaiveCtx*)&sC, bar, (LAS unsigned char*)dyn_lds, __builtin_amdgcn_readfirstlane(threadIdx.x >> 6));
}
extern "C" void kernel_launch(void* const* d_in, const int* in_sizes, int n_in, void* d_out, int out_size, void* d_ws, size_t ws_size, hipStream_t stream) {
    static int grid = 0;
    constexpr size_t kDynLds = 152 * 1024;
    if (grid == 0) {
        int dev = 0, cus = 0, per_cu = 0;
        hipGetDevice(&dev); hipDeviceGetAttribute(&cus, hipDeviceAttributeMultiprocessorCount, dev);
        hipFuncSetAttribute((const void*)mega_fwd, hipFuncAttributeMaxDynamicSharedMemorySize, (int)kDynLds);
        hipOccupancyMaxActiveBlocksPerMultiprocessor(&per_cu, (const void*)mega_fwd, PB_THREADS, kDynLds);
        if (per_cu < 1) { fprintf(stderr, "kernel_launch: occupancy query says %d blocks per CU\n", per_cu); grid = -1; return; }
        grid = cus;
    }
    if (grid < 0) return;
    Params p; memset(&p, 0, sizeof(p));
    const float** ip = (const float**)&p.C.x; for (int i = 0; i < 35; ++i) ip[i] = (const float*)d_in[i];
    p.C.out = (float*)d_out;
    const size_t ctl_bytes = 64 * 1024;
    p.bar = (unsigned*)d_ws;
    size_t need = ctl_bytes + mega_carve(p.C, (char*)d_ws + ctl_bytes);
    if (n_in != 35 || need > ws_size) { fprintf(stderr, "kernel_launch: n_in %d ws need %zu have %zu\n", n_in, need, ws_size); return; }
    hipMemsetAsync(d_ws, 0, ctl_bytes, stream);
    hipMemsetAsync(p.C.CNT, 0, 64 * DEPTH * 4 * 2 + 512, stream);
    hipLaunchKernelGGL(mega_fwd, dim3(grid), dim3(PB_THREADS), kDynLds, stream, p);
}
```

```cpp
#include <hip/hip_runtime.h>
#include <cstdio>
#include <cstring>
#include <cmath>
#define PERSISTENT 1

#define PB_THREADS 512
#define XB_TMO      128
#define XB_XCNT(j)  (256  + 64 * (j))
#define XB_XSUB(j)  (1280 + 64 * (j))
#define XB_XGEN(j)  (2304 + 64 * (j))
#define XB_TOP      3328
#define XB_TOPGEN   3392
#define XCD_BAR_WORDS 3456
#define XB_SPIN_CAP (1u << 22)
#define LAS __attribute__((address_space(3)))

__device__ __forceinline__ unsigned xb_ld(unsigned* p)              { return __hip_atomic_load(p, __ATOMIC_RELAXED, __HIP_MEMORY_SCOPE_AGENT); }
__device__ __forceinline__ unsigned xb_add(unsigned* p, unsigned v) { return __hip_atomic_fetch_add(p, v, __ATOMIC_RELAXED, __HIP_MEMORY_SCOPE_AGENT); }
__device__ __forceinline__ unsigned xb_xcc_id() { return (unsigned)__builtin_amdgcn_s_getreg((3 << 11) | 20) & 0xFu; }
#define XB_SPIN(cond, bar) do { unsigned _sp = 0; while (cond) { __builtin_amdgcn_s_sleep(1); \
    if ((++_sp & 255u) == 0u) { if (xb_ld(&(bar)[XB_TMO])) break; if (_sp > XB_SPIN_CAP) { atomicAdd(&(bar)[XB_TMO], 1u); break; } } } } while (0)

struct XcdBarrier {
    unsigned* bar; unsigned x;
    volatile LAS unsigned* st;
};

__device__ __forceinline__ XcdBarrier xcd_barrier_post(unsigned* bar, volatile LAS unsigned* st) {
    XcdBarrier b; b.bar = bar; b.x = xb_xcc_id(); b.st = st;
    if (threadIdx.x == 0) (void)xb_add(&bar[XB_XCNT(b.x)], 1u);
    return b;
}
__device__ __forceinline__ void xcd_barrier_complete(unsigned* bar, unsigned x, unsigned& nloc, unsigned& nx) {
    const unsigned G = gridDim.x * gridDim.y * gridDim.z;
    unsigned sum, cnt, mine, sp = 0u;
    for (;;) {
        sum = 0u; cnt = 0u; mine = 0u;
#pragma unroll
        for (unsigned j = 0; j < 16; ++j) { const unsigned c = xb_ld(&bar[XB_XCNT(j)]); sum += c; cnt += (c > 0u) ? 1u : 0u; mine = (j == x) ? c : mine; }
        if (sum == G) break;
        __builtin_amdgcn_s_sleep(1);
        if ((++sp & 255u) == 0u) { if (xb_ld(&bar[XB_TMO])) break; if (sp > XB_SPIN_CAP) { atomicAdd(&bar[XB_TMO], 1u); break; } }
    }
    nloc = mine > 0u ? mine : 1u; nx = cnt > 0u ? cnt : 1u;
}

__device__ __forceinline__ void xcd_barrier(const XcdBarrier& b) {
    asm volatile("s_waitcnt vmcnt(0)" ::: "memory");
    __syncthreads();
    if (threadIdx.x == 0) {
        unsigned* bar = b.bar;
        __builtin_amdgcn_s_waitcnt(0);
        unsigned nloc = b.st[0], nx = b.st[1];
        if (nloc == 0u) { xcd_barrier_complete(bar, b.x, nloc, nx); b.st[0] = nloc; b.st[1] = nx; }
        const unsigned old = xb_add(&bar[XB_XSUB(b.x)], 1u);
        const unsigned gen = old / nloc;
        if (old + 1u == (gen + 1u) * nloc) {
            __builtin_amdgcn_fence(__ATOMIC_RELEASE, "agent");
            asm volatile("s_waitcnt vmcnt(0)" ::: "memory");
            const unsigned og = xb_add(&bar[XB_TOP], 1u);
            const unsigned tg = og / nx;
            if (og + 1u == (tg + 1u) * nx) xb_add(&bar[XB_TOPGEN], 1u);
            else XB_SPIN(xb_ld(&bar[XB_TOPGEN]) == tg, bar);
            __builtin_amdgcn_fence(__ATOMIC_ACQUIRE, "agent");
            xb_add(&bar[XB_XGEN(b.x)], 1u);
            asm volatile("s_waitcnt vmcnt(0)" ::: "memory");
        } else {
            XB_SPIN(xb_ld(&bar[XB_XGEN(b.x)]) == gen, bar);
            __builtin_amdgcn_fence(__ATOMIC_ACQUIRE, "agent");
            asm volatile("s_waitcnt vmcnt(0)" ::: "memory");
        }
    }
    __syncthreads();
}
typedef unsigned short bf16_t;
typedef short bf16x8 __attribute__((ext_vector_type(8)));
typedef float f32x4 __attribute__((ext_vector_type(4)));
typedef unsigned u32x4 __attribute__((ext_vector_type(4)));
typedef unsigned u32x2 __attribute__((ext_vector_type(2)));
#define DI __device__ __forceinline__
#define GAS __attribute__((address_space(1)))
DI int opaque_bid() { int b = blockIdx.x; asm volatile("" : "+s"(b)); return b; }
DI int otid(int wv) { int l; asm volatile("v_mbcnt_lo_u32_b32 %0, -1, 0\n\tv_mbcnt_hi_u32_b32 %0, -1, %0" : "=v"(l) : "s"(wv)); return (wv << 6) | l; }
DI void grid_sync(const XcdBarrier& b) { XcdBarrier t = b; asm volatile("" : "+s"(t.bar), "+s"(t.x)); xcd_barrier(t); }
DI void lds_barrier() { asm volatile("s_waitcnt lgkmcnt(0)\n\ts_barrier" ::: "memory"); }
DI float fexp2(float x) { return __builtin_amdgcn_exp2f(x); }
DI float fexp(float x) { return __builtin_amdgcn_exp2f(x * 1.4426950408889634f); }
DI float flog2(float x) { return __builtin_amdgcn_logf(x); }
DI float flog(float x) { return __builtin_amdgcn_logf(x) * 0.6931471805599453f; }
DI float fsigmoid(float x) { return __builtin_amdgcn_rcpf(1.f + fexp(-x)); }
DI float fsilu(float x) { return x * fsigmoid(x); }
DI float ftanh(float x) { return 2.f * fsigmoid(2.f * x) - 1.f; }
DI float fsoftplus(float x) { return x > 20.f ? x : flog(1.f + fexp(x)); }
DI unsigned cvt_pk_bf16(float lo, float hi) { unsigned r; asm volatile("v_cvt_pk_bf16_f32 %0, %1, %2" : "=v"(r) : "v"(lo), "v"(hi)); return r; }
DI float bf_lo(unsigned w) { return __uint_as_float(w << 16); }
DI float bf_hi(unsigned w) { return __uint_as_float(w & 0xffff0000u); }
#ifndef REP_EPI
#define REP_EPI 1
#endif
struct NaiveCtx;
DI LAS int* cv_counter(const LAS NaiveCtx* Cp_);
DI bool cv_addr(const LAS NaiveCtx* Cp_, int T, int tid, const float*& sp, bf16_t*& dp, int& ld);
#ifndef CV_CARRY
#define CV_CARRY 1
#endif
#ifndef CV_NH
#define CV_NH 1
#endif
#define CV_LOADS(V, sp, ld) do { _Pragma("unroll") for (int i_ = 0; i_ < 4; ++i_) _Pragma("unroll") for (int h_ = 0; h_ < CV_NH; ++h_) V[i_][h_] = __builtin_nontemporal_load((const GAS f32x4*)((sp) + (size_t)i_ * (ld) + 4 * h_)); } while (0)
#define CV_STORES(V, dp) do { _Pragma("unroll") for (int j_ = 0; j_ < 4 * CV_NH; ++j_) { u32x2 w_; w_.x = cvt_pk_bf16(V[0][j_ >> 2][j_ & 3], V[1][j_ >> 2][j_ & 3]); w_.y = cvt_pk_bf16(V[2][j_ >> 2][j_ & 3], V[3][j_ >> 2][j_ & 3]); \
        *(GAS u32x2*)((dp) + (size_t)j_ * 1024) = w_; } } while (0)
namespace g8 {
constexpr int BM = 256, BK = 64, HALF = 128, HTB = HALF * BK * 2, STAGE_BYTES = 8 * HTB, NXCD = 8, WGM = 8;
__host__ __device__ __forceinline__ int lds_byte(int r, int c) { const int st = (r >> 4) * 2 + (c >> 5), rr = r & 15, cc = c & 31, ob = rr * 64 + cc * 2; return st * 1024 + (ob ^ (((ob >> 9) & 1) << 5)); }
__host__ __device__ __forceinline__ void stage_rc(int b, int& R, int& C) { const int st = b / 1024, sb = b % 1024, swz = sb ^ (((sb >> 9) & 1) << 5); R = (st >> 1) * 16 + swz / 64; C = (st & 1) * 32 + (swz % 64) / 2; }
__host__ __device__ __forceinline__ int perm32(int rho) { const int n = rho >> 4, i = rho & 15; return 8 * (i >> 2) + 4 * n + (i & 3); }
struct Unit { int pm, pn, e; };

struct DenseSched {
    const char* A; const char* Bt; size_t tstep; int nM, nN, nwg, G, c;
    DI void init(const bf16_t* A_, const bf16_t* Bt_, int M, int N, int K, int G_, int c_) { A = (const char*)A_; Bt = (const char*)Bt_; tstep = (size_t)BM * K * 2; nM = M / BM; nN = N / BM; nwg = nM * nN; G = G_; c = c_; }
    DI bool next(int i, Unit& u) const {
        const long L = (long)i * G + c; if (L >= nwg) return false;
        int wgid = (int)L; { const int q = nwg / NXCD, r = nwg % NXCD, xcd = wgid % NXCD, off = wgid / NXCD; wgid = (xcd < r ? xcd * (q + 1) : r * (q + 1) + (xcd - r) * q) + off; }
        const int nig = WGM * nN, gid = wgid / nig, fm = gid * WGM, gsz = (nM - fm) < WGM ? (nM - fm) : WGM;
        u.pm = fm + ((wgid % nig) % gsz); u.pn = (wgid % nig) / gsz; u.e = 0; return true;
    }
    DI const char* a(const Unit& u) const { return A + (size_t)u.pm * tstep; }
    DI const char* b(const Unit& u) const { return Bt + (size_t)u.pn * tstep; }
};

struct LoraSched : DenseSched {
    DI const char* a(const Unit& u) const { return A + (size_t)u.pm * tstep + (u.pn < 8 ? 0 : 256); }
    DI const char* b(const Unit& u) const { return Bt + (size_t)u.pn * tstep + (u.pn < 8 ? 0 : 256); }
};

struct EpiF32 {
    static constexpr bool PERM = false;
    float* C; int ldc; int ncols;
    DI void operator()(const f32x4 (&acc)[2][2][4][2], const Unit& u, int wr, int wc, int fr, int fq) const {
        const int row0 = u.pm * BM + wr * 64 + fr, col0 = u.pn * BM + wc * 32 + 4 * fq;
#pragma unroll
        for (int ai = 0; ai < 2; ++ai)
#pragma unroll
            for (int m = 0; m < 4; ++m) { float* rowp = C + (size_t)(row0 + ai * HALF + m * 16) * ldc + col0;
#pragma unroll
                for (int bj = 0; bj < 2; ++bj)
#pragma unroll
                    for (int n = 0; n < 2; ++n) if (col0 + bj * HALF + n * 16 < ncols) *(GAS f32x4*)(rowp + bj * HALF + n * 16) = acc[ai][bj][m][n]; }
    }
};


struct MoeSched {
    const char* A; const char* Bt; size_t tstep, bstride; const LAS int* tstart; int NCT, nE, nunits, G, c;
    DI void init(const bf16_t* A_, const bf16_t* Bt_, int K, int N, int nE_, const LAS int* tstart_, int G_, int c_) { A = (const char*)A_; Bt = (const char*)Bt_; tstep = (size_t)BM * K * 2; bstride = (size_t)N * K * 2; tstart = tstart_; NCT = N / BM; nE = nE_; nunits = tstart_[nE_] * NCT; G = G_; c = c_; }
    int cs = 0, cl = 0, jj = 0; bool chunk = false;
    DI void set_chunk(int craw) { if (G != 256) return; const int x = craw & 7, q = nunits / NXCD, r = nunits % NXCD; jj = craw >> 3; cs = x * q + (x < r ? x : r); cl = q + (x < r ? 1 : 0); chunk = true; }
    DI long unit(int i) const { if (chunk) { const int k = i * 32 + jj; return k < cl ? (long)cs + k : -1L; } const long L = (long)i * G + c; return L < nunits ? L : -1L; }
    DI bool next(int i, Unit& u) const {
        const long L = unit(i); if (L < 0) return false;
        const int rt = (int)(L / NCT); u.pm = rt; u.pn = (int)(L % NCT);
        const int ln_ = (int)__builtin_amdgcn_mbcnt_hi(~0u, __builtin_amdgcn_mbcnt_lo(~0u, 0u));
        const bool hit_ = (ln_ >= 1 && ln_ < nE) ? (tstart[ln_] <= rt) : false;
        u.e = (int)__builtin_popcountll(__ballot(hit_)); return true;
    }
    bool gather = false;
    DI const char* a(const Unit& u) const { return gather ? A : A + (size_t)u.pm * tstep; }
    DI const char* b(const Unit& u) const { return Bt + (size_t)u.e * bstride + (size_t)u.pn * tstep; }
};
struct EpiSwiGLU {
    static constexpr bool PERM = true;
    bf16_t* ACT; const float* bgu; int F;
    DI void operator()(const f32x4 (&acc)[2][2][4][2], const Unit& u, int wr, int wc, int fr, int fq) const {
        const int row0 = u.pm * BM + wr * 64 + fr, j0 = u.pn * HALF + wc * 32 + 8 * fq;
        const float* bp = bgu + (size_t)u.e * 2 * F + j0;
        f32x4 bg[2], bl[2];
#pragma unroll
        for (int n = 0; n < 2; ++n) { bg[n] = *(const GAS f32x4*)(bp + 4 * n); bl[n] = *(const GAS f32x4*)(bp + F + 4 * n); }
#pragma unroll
        for (int ai = 0; ai < 2; ++ai)
#pragma unroll
            for (int m = 0; m < 4; ++m) { float o[8];
#pragma unroll
                for (int n = 0; n < 2; ++n)
#pragma unroll
                    for (int j = 0; j < 4; j += 2) {
                        typedef float f32x2_ __attribute__((ext_vector_type(2)));
                        f32x2_ gl = (f32x2_){acc[ai][0][m][n][j], acc[ai][0][m][n][j + 1]} + (f32x2_){bg[n][j], bg[n][j + 1]};
                        f32x2_ li = (f32x2_){acc[ai][1][m][n][j], acc[ai][1][m][n][j + 1]} + (f32x2_){bl[n][j], bl[n][j + 1]};
                        gl = __builtin_elementwise_min(gl, (f32x2_){7.f, 7.f}); li = __builtin_elementwise_min(__builtin_elementwise_max(li, (f32x2_){-7.f, -7.f}), (f32x2_){7.f, 7.f});
                        const f32x2_ ex = gl * (f32x2_){-2.4554669595930156f, -2.4554669595930156f};
                        f32x2_ den; den.x = __builtin_amdgcn_exp2f(ex.x); den.y = __builtin_amdgcn_exp2f(ex.y); den = den + (f32x2_){1.f, 1.f};
                        f32x2_ sg; sg.x = __builtin_amdgcn_rcpf(den.x); sg.y = __builtin_amdgcn_rcpf(den.y);
                        const f32x2_ r2 = (gl * sg) * (li + (f32x2_){1.f, 1.f});
                        o[4 * n + j] = r2.x; o[4 * n + j + 1] = r2.y; }
                u32x4 w; w.x = cvt_pk_bf16(o[0], o[1]); w.y = cvt_pk_bf16(o[2], o[3]); w.z = cvt_pk_bf16(o[4], o[5]); w.w = cvt_pk_bf16(o[6], o[7]);
                *(GAS u32x4*)(ACT + (size_t)(row0 + ai * HALF + m * 16) * F + j0) = w; }
    }
};
struct EpiDownF32 {
    static constexpr bool PERM = false;
    float* C; int ldc; const float* bd;
    DI void operator()(const f32x4 (&acc)[2][2][4][2], const Unit& u, int wr, int wc, int fr, int fq) const {
        const int row0 = u.pm * BM + wr * 64 + fr, col0 = u.pn * BM + wc * 32 + 4 * fq;
        const float* bp = bd + (size_t)u.e * ldc + col0;
        f32x4 bv[2][2];
#pragma unroll
        for (int bj = 0; bj < 2; ++bj)
#pragma unroll
            for (int n = 0; n < 2; ++n) bv[bj][n] = *(const GAS f32x4*)(bp + bj * HALF + n * 16);
#pragma unroll
        for (int ai = 0; ai < 2; ++ai)
#pragma unroll
            for (int m = 0; m < 4; ++m) { float* rowp = C + (size_t)(row0 + ai * HALF + m * 16) * ldc + col0;
#pragma unroll
                for (int bj = 0; bj < 2; ++bj)
#pragma unroll
                    for (int n = 0; n < 2; ++n) *(GAS f32x4*)(rowp + bj * HALF + n * 16) = acc[ai][bj][m][n] + bv[bj][n]; }
    }
};
struct EpiDownBf16 {
    static constexpr bool PERM = true;
    bf16_t* O; int ldc; const float* bd;
    DI void operator()(const f32x4 (&acc)[2][2][4][2], const Unit& u, int wr, int wc, int fr, int fq) const {
        const int row0 = u.pm * BM + wr * 64 + fr, col0 = u.pn * BM + wc * 32 + 8 * fq;
        const float* bp = bd + (size_t)u.e * ldc + col0;
        f32x4 bv[2][2];
#pragma unroll
        for (int bj = 0; bj < 2; ++bj)
#pragma unroll
            for (int n = 0; n < 2; ++n) bv[bj][n] = *(const GAS f32x4*)(bp + bj * HALF + 4 * n);
#pragma unroll
        for (int ai = 0; ai < 2; ++ai)
#pragma unroll
            for (int m = 0; m < 4; ++m) { bf16_t* rowp = O + (size_t)(row0 + ai * HALF + m * 16) * ldc + col0;
#pragma unroll
                for (int bj = 0; bj < 2; ++bj) { const f32x4 v0 = acc[ai][bj][m][0] + bv[bj][0], v1 = acc[ai][bj][m][1] + bv[bj][1];
                    u32x4 w; w.x = cvt_pk_bf16(v0[0], v0[1]); w.y = cvt_pk_bf16(v0[2], v0[3]); w.z = cvt_pk_bf16(v1[0], v1[1]); w.w = cvt_pk_bf16(v1[2], v1[3]);
                    *(GAS u32x4*)(rowp + bj * HALF) = w; } }
    }
};
struct EpiBf16 {
    static constexpr bool PERM = true;
    bf16_t* O; int ldc; float scale;
    DI void operator()(const f32x4 (&acc)[2][2][4][2], const Unit& u, int wr, int wc, int fr, int fq) const {
        const int row0 = u.pm * BM + wr * 64 + fr, col0 = u.pn * BM + wc * 32 + 8 * fq;
#pragma unroll
        for (int ai = 0; ai < 2; ++ai)
#pragma unroll
            for (int m = 0; m < 4; ++m) { bf16_t* rowp = O + (size_t)(row0 + ai * HALF + m * 16) * ldc + col0;
#pragma unroll
                for (int bj = 0; bj < 2; ++bj) { const f32x4 v0 = acc[ai][bj][m][0] * scale, v1 = acc[ai][bj][m][1] * scale;
                    u32x4 w; w.x = cvt_pk_bf16(v0[0], v0[1]); w.y = cvt_pk_bf16(v0[2], v0[3]); w.z = cvt_pk_bf16(v1[0], v1[1]); w.w = cvt_pk_bf16(v1[2], v1[3]);
                    *(GAS u32x4*)(rowp + bj * HALF) = w; } }
    }
};

template <int K, class Epi, class Sched, bool GATHER = false, int LD = K>
DI void gemm_phase(LAS unsigned char* lds, const Sched& S, const Epi& E, int wv_, const LAS int* gtab = nullptr, const LAS NaiveCtx* cvC = nullptr) {
    const int tid = otid(wv_);
    int cvbase = 0;
    if (cvC) cvbase = __builtin_amdgcn_readfirstlane(*cv_counter(cvC));
    const int wid = __builtin_amdgcn_readfirstlane(tid >> 6), lane = tid & 63, wr = wid >> 2, wc = wid & 3, fr = lane & 15, fq = lane >> 4;
    constexpr int nt = K / BK;
    static_assert(K % 128 == 0 && K >= 256, "K");
    unsigned voffB[2], cvo[2][2], nvo[2][2];
#pragma unroll
    for (int i = 0; i < 2; ++i) { int R, C; stage_rc(tid * 16 + i * 8192, R, C); const int Rb = Epi::PERM ? ((R & ~31) + perm32(R & 31)) : R; voffB[i] = (unsigned)(Rb * LD + C) * 2u; }
#define PG8_CALC_VO(VO, UI) do { _Pragma("unroll") for (int h_ = 0; h_ < 2; ++h_) _Pragma("unroll") for (int i_ = 0; i_ < 2; ++i_) { int R_, C_; stage_rc(tid * 16 + i_ * 8192, R_, C_); \
        const int row_ = GATHER ? gtab[(UI) * 256 + h_ * HALF + R_] : h_ * HALF + R_; VO[h_][i_] = (unsigned)(row_ * LD + C_) * 2u; } } while (0)
    constexpr size_t kstep = (size_t)(BK * 2);
    constexpr size_t hstep = (size_t)HALF * LD * 2;
    const unsigned ldsw = (unsigned)wid * 1024u;
    const int aoff = lds_byte(wr * 64 + fr, fq * 8), boff = lds_byte(wc * 32 + fr, fq * 8);
#define PG8_SA(b, h) (((b) * 2 + (h)) * HTB)
#define PG8_SB(b, h) ((4 + (b) * 2 + (h)) * HTB)
#define PG8_STAGE(bufoff, gbase, voff) do { _Pragma("unroll") for (int _i = 0; _i < 2; ++_i) \
        __builtin_amdgcn_global_load_lds((const unsigned*)((const char*)(gbase) + (voff)[_i]), (LAS unsigned*)(lds + (bufoff) + ldsw + _i * 8192), 16, 0, 0); } while (0)
#define PG8_LDA(dst, b, h) do { _Pragma("unroll") for (int m = 0; m < 4; ++m) _Pragma("unroll") for (int k = 0; k < 2; ++k) dst[m][k] = *(const LAS bf16x8*)(lds + PG8_SA(b, h) + aoff + m * 2048 + k * 1024); } while (0)
#define PG8_LDB(dst, b, h) do { _Pragma("unroll") for (int n = 0; n < 2; ++n) _Pragma("unroll") for (int k = 0; k < 2; ++k) dst[n][k] = *(const LAS bf16x8*)(lds + PG8_SB(b, h) + boff + n * 2048 + k * 1024); } while (0)
#define PG8_MMA(ai, bj, At, Bt) do { __builtin_amdgcn_s_setprio(1); _Pragma("unroll") for (int m = 0; m < 4; ++m) _Pragma("unroll") for (int n = 0; n < 2; ++n) _Pragma("unroll") for (int k = 0; k < 2; ++k) \
        acc[ai][bj][m][n] = __builtin_amdgcn_mfma_f32_16x16x32_bf16(Bt[n][k], At[m][k], acc[ai][bj][m][n], 0, 0, 0); __builtin_amdgcn_s_setprio(0); } while (0)
#define PG8_WAIT_V(n) asm volatile("s_waitcnt vmcnt(" #n ")" ::: "memory")
#define PG8_WAIT_L(n) asm volatile("s_waitcnt lgkmcnt(" #n ")" ::: "memory")
#define PG8_BAR __builtin_amdgcn_s_barrier()
#define PG8_SCHED __builtin_amdgcn_sched_barrier(0)
    Unit cur, nxt; int ui = 0;
#if CV_CARRY
    f32x4 cvv[4][CV_NH]; bool cvon = false;
#endif
    if (!S.next(0, cur)) return;
    f32x4 acc[2][2][4][2];
#pragma unroll
    for (int a = 0; a < 2; ++a)
#pragma unroll
        for (int b = 0; b < 2; ++b)
#pragma unroll
            for (int m = 0; m < 4; ++m)
#pragma unroll
                for (int n = 0; n < 2; ++n) acc[a][b][m][n] = (f32x4){0.f, 0.f, 0.f, 0.f};
    bf16x8 At[4][2], B0[2][2], B1[2][2];
    const char* cA = S.a(cur); const char* cB = S.b(cur);
    PG8_CALC_VO(cvo, 0);
    PG8_STAGE(PG8_SB(0, 0), cB, voffB); PG8_STAGE(PG8_SB(0, 1), cB + hstep, voffB); PG8_STAGE(PG8_SA(0, 0), cA, cvo[0]); PG8_STAGE(PG8_SA(0, 1), cA, cvo[1]);
    if (wr == 1) PG8_BAR;
    PG8_WAIT_V(2); PG8_BAR;
    PG8_STAGE(PG8_SB(1, 0), cB + kstep, voffB); PG8_STAGE(PG8_SA(1, 0), cA + kstep, cvo[0]); PG8_STAGE(PG8_SB(1, 1), cB + hstep + kstep, voffB);
    PG8_WAIT_V(6); PG8_BAR;
    for (;;) {
        const bool has_next = S.next(ui + 1, nxt);
        const char* nA = has_next ? S.a(nxt) : cA; const char* nB = has_next ? S.b(nxt) : cB;
        if (has_next) PG8_CALC_VO(nvo, ui + 1); else { nvo[0][0] = cvo[0][0]; nvo[0][1] = cvo[0][1]; nvo[1][0] = cvo[1][0]; nvo[1][1] = cvo[1][1]; }
#pragma unroll 1
        for (int t = 0; t < nt; t += 2) {
            const bool last = (t == nt - 2);
            const char* a1 = cA + (size_t)(t + 1) * kstep;
            const char* a2 = last ? nA : cA + (size_t)(t + 2) * kstep; const char* b2 = last ? nB : cB + (size_t)(t + 2) * kstep;
            const char* a3 = a2 + kstep; const char* b3 = b2 + kstep;
            unsigned s0[2], s1[2]; s0[0] = last ? nvo[0][0] : cvo[0][0]; s0[1] = last ? nvo[0][1] : cvo[0][1]; s1[0] = last ? nvo[1][0] : cvo[1][0]; s1[1] = last ? nvo[1][1] : cvo[1][1];
            PG8_LDB(B0, 0, 0); PG8_LDB(B1, 0, 1); PG8_SCHED; PG8_LDA(At, 0, 0); PG8_STAGE(PG8_SA(1, 1), a1, cvo[1]);
            PG8_WAIT_V(8); PG8_WAIT_L(0); PG8_BAR; PG8_MMA(0, 0, At, B0); PG8_MMA(0, 1, At, B1); PG8_BAR; PG8_SCHED;
            PG8_LDA(At, 0, 1); PG8_STAGE(PG8_SB(0, 0), b2, voffB); PG8_STAGE(PG8_SB(0, 1), b2 + hstep, voffB); PG8_STAGE(PG8_SA(0, 0), a2, s0);
            PG8_WAIT_V(8); PG8_WAIT_L(0); PG8_BAR; PG8_MMA(1, 0, At, B0); PG8_MMA(1, 1, At, B1); PG8_BAR; PG8_SCHED;
            PG8_LDB(B0, 1, 0); PG8_LDB(B1, 1, 1); PG8_SCHED; PG8_LDA(At, 1, 0); PG8_STAGE(PG8_SA(0, 1), a2, s1);
            PG8_WAIT_V(8); PG8_WAIT_L(0); PG8_BAR; PG8_MMA(0, 0, At, B0); PG8_MMA(0, 1, At, B1); PG8_BAR; PG8_SCHED;
            PG8_LDA(At, 1, 1); PG8_STAGE(PG8_SB(1, 0), b3, voffB); PG8_STAGE(PG8_SB(1, 1), b3 + hstep, voffB); PG8_STAGE(PG8_SA(1, 0), a3, s0);
            PG8_WAIT_V(8); PG8_WAIT_L(0); PG8_BAR; PG8_MMA(1, 0, At, B0); PG8_MMA(1, 1, At, B1); PG8_BAR; PG8_SCHED;
        }
        if (wr == 0) PG8_BAR;
#if CV_CARRY
        if (cvC) { const float* cvs = nullptr; bf16_t* cvd = nullptr; int cvl = 0;
            if (cvon) { cv_addr(cvC, (cvbase + ui - 1) * S.G + S.c, otid(wv_), cvs, cvd, cvl); CV_STORES(cvv, cvd); }
            cvon = cv_addr(cvC, (cvbase + ui) * S.G + S.c, otid(wv_), cvs, cvd, cvl); if (cvon) CV_LOADS(cvv, cvs, cvl); }
#else
        f32x4 cvv[4][CV_NH]; const float* cvs = nullptr; bf16_t* cvd = nullptr; int cvl = 0; bool cvon = false;
        if (cvC) { cvon = cv_addr(cvC, (cvbase + ui) * S.G + S.c, otid(wv_), cvs, cvd, cvl); if (cvon) CV_LOADS(cvv, cvs, cvl); }
#endif
        { const int t2_ = otid(wv_), fr_ = t2_ & 15, fq_ = (t2_ & 63) >> 4;
          _Pragma("unroll") for (int re_ = 0; re_ < REP_EPI; ++re_) E(acc, cur, wr, wc, fr_, fq_); }
#if !CV_CARRY
        if (cvC) { if (cvon) CV_STORES(cvv, cvd); }
#endif
        if (!has_next) break;
#pragma unroll
        for (int a = 0; a < 2; ++a)
#pragma unroll
            for (int b = 0; b < 2; ++b)
#pragma unroll
                for (int m = 0; m < 4; ++m)
#pragma unroll
                    for (int n = 0; n < 2; ++n) acc[a][b][m][n] = (f32x4){0.f, 0.f, 0.f, 0.f};
        cur = nxt; cA = nA; cB = nB; ++ui; cvo[0][0] = nvo[0][0]; cvo[0][1] = nvo[0][1]; cvo[1][0] = nvo[1][0]; cvo[1][1] = nvo[1][1];
        if (wr == 1) PG8_BAR;
    }
#if CV_CARRY
    if (cvC) { if (cvon) { const float* cvs = nullptr; bf16_t* cvd = nullptr; int cvl = 0; cv_addr(cvC, (cvbase + ui) * S.G + S.c, otid(wv_), cvs, cvd, cvl); CV_STORES(cvv, cvd); } }
#endif
    PG8_WAIT_V(0);
    PG8_BAR;
    if (cvC) { if (otid(wv_) == 0) *cv_counter(cvC) = cvbase + ui + 1; }
#undef PG8_CALC_VO
#undef PG8_SA
#undef PG8_SB
#undef PG8_STAGE
#undef PG8_LDA
#undef PG8_LDB
#undef PG8_MMA
#undef PG8_WAIT_V
#undef PG8_WAIT_L
#undef PG8_BAR
#undef PG8_SCHED
}
}
#define GRID_STRIDE_WAVES(i_, n_) for (long tz_ = otid(wv_), i_ = ((long)(tz_ >> 6) * gridDim.x + opaque_bid()) * 64 + (tz_ & 63); i_ < (long)(n_); i_ += (long)gridDim.x * PB_THREADS)
DI bf16_t f2bf(float x) { return (bf16_t)(cvt_pk_bf16(x, 0.f) & 0xffffu); }

DI void conv_weight_r(LAS unsigned char* lds, const float* __restrict__ src, size_t sstride, bf16_t* __restrict__ dst, size_t dstride, int K, int N, int ldsrc, int Kpad, int Npad, int mode, int ti0, int G, int total, int wv_) {
    const int t = otid(wv_), nkt = Kpad / 64, nnt = Npad / 256, tpm = nkt * nnt;
    const int kk = t >> 6, c4 = (t & 63) * 4;
    float4 v[8];
#define CW_LOAD(TI) do { const int mat_ = (TI) / tpm, tile_ = (TI) % tpm, n0_ = (tile_ / nkt) * 256, k0_ = (tile_ % nkt) * 64; \
        const int sc_ = mode == 1 ? (c4 < 128 ? 0 : N / 2) + (n0_ / 256) * 128 + (c4 & 127) : n0_ + c4; const float* sp_ = src + (size_t)mat_ * sstride; \
        _Pragma("unroll") for (int i = 0; i < 8; ++i) { const int k_ = k0_ + 8 * kk + i; v[i] = make_float4(0.f, 0.f, 0.f, 0.f); \
            if (k_ < K && sc_ < N) { const f32x4 g_ = *(const GAS f32x4*)(sp_ + (size_t)k_ * ldsrc + sc_); v[i] = make_float4(g_[0], g_[1], g_[2], g_[3]); } } } while (0)
    int ti = ti0, par = 0;
    if (ti < total) CW_LOAD(ti);
    while (ti < total) {
        LAS bf16_t* Ts = (LAS bf16_t*)(lds + par * (256 * 72 * 2));
        const int mat = ti / tpm, tile = ti % tpm, n0 = (tile / nkt) * 256, k0 = (tile % nkt) * 64;
#define CW_COL(J, F) { u32x4 w_; w_.x = cvt_pk_bf16(v[0].F, v[1].F); w_.y = cvt_pk_bf16(v[2].F, v[3].F); w_.z = cvt_pk_bf16(v[4].F, v[5].F); w_.w = cvt_pk_bf16(v[6].F, v[7].F); *(LAS u32x4*)(Ts + (c4 + J) * 72 + 8 * kk) = w_; }
        CW_COL(0, x) CW_COL(1, y) CW_COL(2, z) CW_COL(3, w)
#undef CW_COL
        const int tn = ti + G;
        if (tn < total) CW_LOAD(tn);
        lds_barrier();
        bf16_t* dp = dst + (size_t)mat * dstride;
#pragma unroll
        for (int q0 = 0; q0 < 4; ++q0) { const int q = t + 512 * q0, n = q >> 3, k8 = (q & 7) * 8;
            const u32x4 w = *(const LAS u32x4*)(Ts + n * 72 + k8);
            *(GAS u32x4*)(dp + (size_t)(n0 + n) * Kpad + k0 + k8) = w; }
        ti = tn; par ^= 1;
    }
    __syncthreads();
#undef CW_LOAD
}
DI void conv_weight_b(LAS unsigned char* lds, const float* __restrict__ src, size_t sstride, bf16_t* __restrict__ dst, size_t dstride, int nmat, int K, int N, int ldsrc, int Kpad, int Npad, int mode, int wv_) {
    conv_weight_r(lds, src, sstride, dst, dstride, K, N, ldsrc, Kpad, Npad, mode, opaque_bid(), gridDim.x, (Kpad / 64) * (Npad / 256) * nmat, wv_);
}
DI void conv_act(const float* __restrict__ src, int lda, int K, bf16_t* __restrict__ dst, int Kpad, long M, int wv_) {
    const int cpr = Kpad / 8;
    GRID_STRIDE_WAVES(i, M * cpr) { const long row = i / cpr; const int c = (int)(i % cpr) * 8; u32x4 w = (u32x4){0u, 0u, 0u, 0u};
        if (c < K) { const f32x4 a_ = *(const GAS f32x4*)(src + row * lda + c), b_ = *(const GAS f32x4*)(src + row * lda + c + 4); const float4 a = make_float4(a_[0], a_[1], a_[2], a_[3]), b = make_float4(b_[0], b_[1], b_[2], b_[3]);
            w.x = cvt_pk_bf16(a.x, a.y); w.y = cvt_pk_bf16(a.z, a.w); w.z = cvt_pk_bf16(b.x, b.y); w.w = cvt_pk_bf16(b.z, b.w); }
        *(GAS u32x4*)(dst + row * Kpad + c) = w; }
}
#ifdef HOST_TEST
static int D_MODEL = 128, BATCH = 2, SEQ = 128, CTX_LEN = 64, N_EXPERTS = 8, EXPERT_DIM = 64;
#define HD
#else
constexpr int D_MODEL = 1024, BATCH = 16, SEQ = 2048, CTX_LEN = 256, N_EXPERTS = 32, EXPERT_DIM = 1024;
#ifdef PERSISTENT
#define HD __device__
#else
#define HD __host__ __device__
#endif
#endif
constexpr int DEPTH = 4, GRID_W = 64, N_MOD = 6;
constexpr int RW_HEADS = 8, RW_HD = 64, RW_DIM = 512, RW_DL = 64, RW_IL = 64, RW_GL = 128, RW_IN = 1920;
constexpr int HG_HEADS = 4, HG_KD = 128, HG_VD = 128, HG_DIM = 512, HG_VDIM = 512, HG_IN = 2560;
constexpr int EVEN_IN = 4480, EVEN_OUT = 1024;
constexpr int MLA_HEADS = 16, MLA_NOPE = 64, MLA_ROPE = 32, MLA_V = 64, MLA_QR = 256, MLA_KVR = 128, MLA_IN = 416, MLA_QK = 96;
constexpr int TOP_K = 4, N_EVEN = 2, N_ODD = 2;
constexpr int MOE_PAD = 256;
#define ALPHA 1.681792830507429f

#ifndef REP_MOE
#define REP_MOE 1
#endif
#ifndef REP_ATT
#define REP_ATT 1
#endif
#ifndef REP_RWS
#define REP_RWS 1
#endif
#ifndef REP_HGS
#define REP_HGS 1
#endif
#ifndef REP_DEN
#define REP_DEN 1
#endif
#ifndef REP_TLE
#define REP_TLE 1
#endif
#ifndef REP_PRO
#define REP_PRO 1
#endif
#ifndef CV_BACKGROUND
#define CV_BACKGROUND 0
#endif
#ifndef CV_TAIL
#define CV_TAIL 1
#endif
#ifndef CV_TAILN
#define CV_TAILN 10
#endif
#if CV_BACKGROUND
#define CV_PRO_LAYERS 1
#define CV_CTX Cp_
#elif CV_TAIL
#define CV_PRO_LAYERS 1
#define CV_CTX nullptr
#else
#define CV_PRO_LAYERS DEPTH
#define CV_CTX nullptr
#endif
#define RP(N, ...) _Pragma("unroll") for (int rep_ = 0; rep_ < (N); ++rep_) { __VA_ARGS__ }
#define NC_ (BATCH * CTX_LEN)
#define NL_ (BATCH * SEQ)
#define NT_ (NC_ + NL_)
#define TT_ (CTX_LEN + SEQ)
#define NSLOT_ (NT_ * TOP_K + N_EXPERTS * MOE_PAD)

#ifdef HOST_TEST
#define MEMFENCE_EVERY(k, n) do {} while (0)
#else
#define MEMFENCE_EVERY(k, n) do { if (((k) % (n)) == (n) - 1) asm volatile("" ::: "memory"); } while (0)
#endif
HD inline float sigmoidf_(float x) { return 1.f / (1.f + expf(-x)); }
HD inline float siluf_(float x) { return x / (1.f + expf(-x)); }
HD inline float softplusf_(float x) { return x > 20.f ? x : log1pf(expf(x)); }
HD inline int tokrow(int b, int t) { return t < CTX_LEN ? b * CTX_LEN + t : NC_ + b * SEQ + (t - CTX_LEN); }
HD inline int scan_pos(int d, int i) { return d == 0 ? i : (i < CTX_LEN ? CTX_LEN - 1 - i : CTX_LEN + (SEQ - 1 - (i - CTX_LEN))); }
#ifdef HOST_TEST
inline int ld_cnt(const int* p) { return *p; }
#else
__device__ inline int ld_cnt(const int* p) { return __hip_atomic_load(p, __ATOMIC_RELAXED, __HIP_MEMORY_SCOPE_AGENT); }
#endif
HD inline int modrow(int row) { return row < NC_ ? BATCH : (row - NC_) / SEQ; }

struct NaiveCtx {
    const float *x, *c, *ctx, *c_ctx, *mod_w, *mod_b, *ln_g, *ln_b, *ev_w_in, *rw_mu, *rw_w0, *rw_w2, *rw_a0, *rw_a2, *rw_g2, *rw_k_k, *rw_k_a, *rw_r_k,
        *rw_gn_g, *rw_gn_b, *hg_lb, *hg_norm_g, *ev_w_out, *od_w_in, *mla_q_norm_g, *mla_w_qb, *mla_kv_norm_g, *mla_w_kvb, *od_w_out, *moe_w_router,
        *moe_b_router, *moe_w_gu, *moe_b_gu, *moe_w_down, *moe_b_down;
    float* out;
    float *H, *MOD, *U, *Z, *ZS, *R, *V, *KKR, *NKK, *G, *DEC, *AG, *KD, *BB, *Y, *HQ, *HF, *HK, *OP, *YCAT, *YO;
    float *QN, *KVN, *KPE, *Q, *KV, *AO, *LOGIT, *TOPG, *H1, *ACT, *OUT2;
    int *TOPI, *CNT, *OFF, *CUR, *SLOT, *TOKOF, *TILE_E;
    unsigned short *WinE, *WoutE, *WinO, *Wqb, *Wkvb, *WoutO, *Wgu, *Wdn, *ABF, *XPB, *ACTB, *QB, *KB, *VB, *UB, *OUT2B, *TW, *LOB, *YCATB, *QNB, *KVNB, *AOB, *Wlora, *KVB, *KPEB, *ZB, *RBh, *VBh, *NKh, *GBh, *KDh, *BBh, *YOB, *HB, *YBh, *OBh;
    float *BON, *ROPE, *O;
    long cvn;
};
#if defined(PERSISTENT)
constexpr int CV_TN = 64 * CV_NH, CV_GU = (2 * EXPERT_DIM / CV_TN) * 8, CV_DN = (D_MODEL / CV_TN) * 8;
constexpr int CV_TPL = N_EXPERTS * (CV_GU + CV_DN);
DI LAS int* cv_counter(const LAS NaiveCtx* Cp_) { return (LAS int*)&Cp_->cvn; }
DI bool cv_addr(const LAS NaiveCtx* Cp_, int T, int tid, const float*& sp, bf16_t*& dp, int& ld) {
    if (T >= (DEPTH - 1) * CV_TPL) return false;
    const int layer = 1 + T / CV_TPL, r = T % CV_TPL;
    const int kb = (tid & 15) + 16 * ((tid >> 6) & 1), nb = ((tid >> 4) & 3) + 4 * (tid >> 7);
    if (r < N_EXPERTS * CV_GU) {
        const int mat = layer * N_EXPERTS + r / CV_GU, tile = r % CV_GU, n0 = (tile / 8) * CV_TN, k0 = (tile % 8) * 128;
        const int cb = ((n0 % 256) / 128) * EXPERT_DIM + (n0 / 256) * 128 + n0 % 128;
        sp = Cp_->moe_w_gu + (size_t)mat * ((size_t)D_MODEL * 2 * EXPERT_DIM) + (size_t)(k0 + kb * 4) * (2 * EXPERT_DIM) + cb + nb * (4 * CV_NH); ld = 2 * EXPERT_DIM;
        dp = Cp_->Wgu + (size_t)mat * ((size_t)2 * EXPERT_DIM * D_MODEL) + (size_t)(n0 + nb * (4 * CV_NH)) * D_MODEL + k0 + kb * 4;
    } else {
        const int r2 = r - N_EXPERTS * CV_GU, mat = layer * N_EXPERTS + r2 / CV_DN, tile = r2 % CV_DN, n0 = (tile / 8) * CV_TN, k0 = (tile % 8) * 128;
        sp = Cp_->moe_w_down + (size_t)mat * ((size_t)EXPERT_DIM * D_MODEL) + (size_t)(k0 + kb * 4) * D_MODEL + n0 + nb * (4 * CV_NH); ld = D_MODEL;
        dp = Cp_->Wdn + (size_t)mat * ((size_t)D_MODEL * EXPERT_DIM) + (size_t)(n0 + nb * (4 * CV_NH)) * EXPERT_DIM + k0 + kb * 4;
    }
    return true;
}
DI void cv_catchup(const LAS NaiveCtx* Cp_, long layer, int wv_) {
    const int G = gridDim.x, bid = opaque_bid();
    const int need = (int)((layer * CV_TPL + G - 1) / G);
    int j = __builtin_amdgcn_readfirstlane(*cv_counter(Cp_));
    if (j >= need) return;
    for (; j < need; ++j) { f32x4 v[4][CV_NH]; const float* sp = nullptr; bf16_t* dp = nullptr; int ld = 0;
        if (cv_addr(Cp_, j * G + bid, otid(wv_), sp, dp, ld)) { CV_LOADS(v, sp, ld); CV_STORES(v, dp); } }
    __syncthreads();
    if (otid(wv_) == 0) *cv_counter(Cp_) = j;
}
#endif
#if defined(PERSISTENT)
constexpr int CVT_GU = N_EXPERTS * 128, CVT_DN = N_EXPERTS * 64, CVT_L = CVT_GU + CVT_DN, CVT_TOT = (DEPTH - 1) * CVT_L;
DI void cv_range(const LAS NaiveCtx* Cp_, LAS unsigned char* lds, int a, int b, int step, int wv_) {
#pragma unroll 1
    for (int j = 0; j < 2 * (DEPTH - 1); ++j) { const int Lx = 1 + j / 2; const bool dn = (j & 1) != 0;
        const int base = CVT_L * (Lx - 1) + (dn ? CVT_GU : 0), lim = CVT_L * (Lx - 1) + (dn ? CVT_L : CVT_GU);
        const int v0 = a >= base ? a : a + ((base - a + step - 1) / step) * step, hi = b < lim ? b : lim;
        if (v0 < hi) { const int tb = (dn ? CVT_DN : CVT_GU) * Lx;
            conv_weight_r(lds, dn ? (*Cp_).moe_w_down : (*Cp_).moe_w_gu, (size_t)D_MODEL * (dn ? D_MODEL : 2 * EXPERT_DIM), dn ? (*Cp_).Wdn : (*Cp_).Wgu, (size_t)D_MODEL * (dn ? EXPERT_DIM : 2 * EXPERT_DIM),
                          1024, dn ? D_MODEL : 2 * EXPERT_DIM, dn ? D_MODEL : 2 * EXPERT_DIM, 1024, dn ? D_MODEL : 2 * EXPERT_DIM, dn ? 0 : 1, tb + (v0 - base), step, tb + (hi - base), wv_); } }
}
#ifndef MOE_REMAP
#define MOE_REMAP 2
#endif
#ifndef MOE_CHUNK
#define MOE_CHUNK 1
#endif
#if MOE_CHUNK
#define MOE_SET_CHUNK S_.set_chunk(opaque_bid());
#else
#define MOE_SET_CHUNK
#endif
DI int moe_remap(int c, int G, int nct) {
#if MOE_REMAP
    if (G == 256) { const int x = c & 7, j = c >> 3;
#if MOE_REMAP == 2
        if (nct == 8) return 8 * (4 * (j >> 2) + (x >> 1)) + 4 * (x & 1) + (j & 3);
        if (nct == 4) return 4 * (8 * (j >> 2) + x) + (j & 3); }
#elif MOE_REMAP == 3
        if (nct == 8) return 8 * (4 * (j >> 2) + (x >> 1)) + 4 * (x & 1) + (j & 3);
        if (nct == 4) return 4 * (4 * (j >> 1) + (x >> 1)) + 2 * (x & 1) + (j & 1); }
#else
        if (nct == 8) return 8 * (2 * (j >> 1) + (x >> 2)) + 2 * (x & 3) + (j & 1);
        if (nct == 4) return 4 * (4 * (j >> 1) + (x >> 1)) + 2 * (x & 1) + (j & 1); }
#endif
#endif
    return c;
}
DI void cv_tail(const LAS NaiveCtx* Cp_, LAS unsigned char* lds, const g8::MoeSched& S, int wv_) {
    int done = __builtin_amdgcn_readfirstlane(*cv_counter(Cp_));
    if (done >= CVT_TOT) return;
    int nidle = 0, mine = -1;
    if (S.chunk) { const int q = S.nunits / 8, r = S.nunits % 8, maxr = (q + (r ? 1 : 0) + 31) / 32, myx = opaque_bid() & 7;
#pragma unroll
        for (int x = 0; x < 8; ++x) { const int len = q + (x < r ? 1 : 0), rounds = (len + 31) / 32, busy = rounds < maxr ? 0 : len - 32 * (maxr - 1);
            if (x == myx && S.jj >= busy) mine = nidle + (S.jj - busy);
            nidle += 32 - busy; } }
    else { const int G = gridDim.x, r = S.nunits % G; if (r != 0) { nidle = G - r; if (S.c >= r) mine = S.c - r; } }
    if (nidle == 0) return;
    if (mine >= 0) { const int a = done + mine * CV_TAILN, b = a + CV_TAILN < CVT_TOT ? a + CV_TAILN : CVT_TOT; if (a < b) cv_range(Cp_, lds, a, b, 1, wv_); }
    done += nidle * CV_TAILN; if (done > CVT_TOT) done = CVT_TOT;
    __syncthreads();
    if (otid(wv_) == 0) *cv_counter(Cp_) = done;
}
DI void cv_catch(const LAS NaiveCtx* Cp_, LAS unsigned char* lds, long layer, int wv_) {
    const int G = gridDim.x, c = opaque_bid(), need = CVT_L * (int)layer;
    const int done = __builtin_amdgcn_readfirstlane(*cv_counter(Cp_));
    if (done >= need) return;
    cv_range(Cp_, lds, done + c, need, G, wv_);
    __syncthreads();
    if (otid(wv_) == 0) *cv_counter(Cp_) = need;
}
#endif


struct NaiveWs { size_t total; };
static size_t naive_carve(NaiveCtx& C, char* base) {
    size_t off = 0;
    auto take = [&](size_t nfl) { size_t o = off; off += ((nfl * 4 + 255) / 256) * 256; return base ? (float*)(base + o) : (float*)nullptr; };
    const size_t NT = NT_, NS = NSLOT_;
    C.H = take(NT * D_MODEL); C.MOD = take((size_t)DEPTH * (BATCH + 1) * N_MOD * D_MODEL); C.YO = take(NT * D_MODEL);
#if defined(PERSISTENT)
    C.U = nullptr;
#else
    C.U = take(NT * D_MODEL);
#endif
    C.LOGIT = take(NT * N_EXPERTS); C.TOPG = take(NT * TOP_K);
    C.TOPI = (int*)take(NT * TOP_K); C.CNT = (int*)take(64 * DEPTH); C.CUR = (int*)take(64 * DEPTH); C.OFF = (int*)take(64); C.SLOT = (int*)take(NT * TOP_K); C.TOKOF = (int*)take(NS);
    C.TILE_E = (int*)take(NS / 64 + 64);
    C.WinE = (unsigned short*)take((size_t)N_EVEN * 4608 * D_MODEL / 2); C.WoutE = (unsigned short*)take((size_t)N_EVEN * D_MODEL * 1024 / 2); C.WinO = (unsigned short*)take((size_t)N_ODD * 512 * D_MODEL / 2);
    C.Wqb = (unsigned short*)take((size_t)N_ODD * 1536 * 256 / 2); C.Wkvb = (unsigned short*)take((size_t)N_ODD * 2048 * 256 / 2); C.WoutO = (unsigned short*)take((size_t)N_ODD * D_MODEL * 1024 / 2);
    C.Wgu = (unsigned short*)take((size_t)DEPTH * N_EXPERTS * 2 * EXPERT_DIM * D_MODEL / 2); C.Wdn = (unsigned short*)take((size_t)DEPTH * N_EXPERTS * D_MODEL * EXPERT_DIM / 2);
    C.ABF = (unsigned short*)take((size_t)NT * 1024 / 2); C.UB = (unsigned short*)take((size_t)NT * 1024 / 2);
    const size_t ubase = off; size_t umax = off;
    C.Z = take(NT * EVEN_IN); C.ZS = take(NT * RW_IN);
    C.R = take(NT * 512); C.V = take(NT * 512); C.KKR = take(NT * 512); C.NKK = take(NT * 512); C.G = take(NT * 512);
    C.DEC = take(2 * NT * 512); C.AG = take(2 * NT * 512); C.KD = take(2 * NT * 512); C.BB = take(2 * NT * 512); C.Y = take(2 * NT * 512);
    C.HQ = take(NT * 512); C.HF = take(2 * NT * 512); C.HK = take(2 * NT * 512); C.OP = take(4 * NT * 512);
    C.YCAT = take(NT * 1024);
    umax = off > umax ? off : umax; off = ubase;
    (void)take(NT * EVEN_IN);
    C.QN = take(NT * MLA_QR); C.KVN = take(NT * MLA_KVR); C.KPE = take(NT * MLA_ROPE); C.Q = take(NT * MLA_HEADS * MLA_QK); C.KV = take(NT * MLA_HEADS * 128);
    C.AO = take(NT * 1024);
    C.QB = (unsigned short*)take(NT * MLA_HEADS * 96 / 2); C.KB = (unsigned short*)take((size_t)BATCH * MLA_HEADS * TT_ * 96 / 2); C.VB = (unsigned short*)take((size_t)BATCH * MLA_HEADS * TT_ * 64 / 2);
    umax = off > umax ? off : umax; off = ubase;
    C.H1 = take(NS * 2 * EXPERT_DIM); C.ACT = take(NS * EXPERT_DIM); C.OUT2 = take(NS * D_MODEL);
    C.OUT2B = (unsigned short*)C.OUT2; C.XPB = (unsigned short*)C.H1; C.ACTB = (unsigned short*)(C.H1 ? C.H1 + NS * EXPERT_DIM / 2 + 64 : C.H1);
    umax = off > umax ? off : umax; off = umax;
    return off;
}


#if defined(PERSISTENT)
static size_t mega_carve(NaiveCtx& C, char* base) {
    size_t off = 0;
    auto takeb = [&](size_t nbytes) { size_t o = off; off += ((nbytes + 255) / 256) * 256; return base ? (void*)(base + o) : (void*)nullptr; };
    const size_t NT = NT_, NS = NSLOT_;
    C.HB = (unsigned short*)takeb(NT * D_MODEL * 2); C.H = nullptr; C.MOD = (float*)takeb((size_t)DEPTH * (BATCH + 1) * N_MOD * D_MODEL * 4); C.YOB = (unsigned short*)takeb(NT * D_MODEL * 2); C.YO = nullptr; C.UB = (unsigned short*)takeb(NT * D_MODEL * 2);
    C.TOPG = (float*)takeb(NT * TOP_K * 4); C.TOPI = (int*)takeb(NT * TOP_K * 4); C.SLOT = (int*)takeb(NT * TOP_K * 4); C.CNT = (int*)takeb(64 * DEPTH * 4); C.CUR = (int*)takeb(64 * DEPTH * 4); C.TOKOF = (int*)takeb(NS * 4);
    C.ROPE = (float*)takeb((size_t)SEQ * 32 * 4);
    C.WinE = (unsigned short*)takeb((size_t)N_EVEN * 4608 * D_MODEL * 2); C.WoutE = (unsigned short*)takeb((size_t)N_EVEN * D_MODEL * 1024 * 2); C.WinO = (unsigned short*)takeb((size_t)N_ODD * 512 * D_MODEL * 2);
    C.Wqb = (unsigned short*)takeb((size_t)N_ODD * 1536 * 256 * 2); C.Wkvb = (unsigned short*)takeb((size_t)N_ODD * 2048 * 256 * 2); C.WoutO = (unsigned short*)takeb((size_t)N_ODD * D_MODEL * 1024 * 2);
    C.Wlora = (unsigned short*)takeb((size_t)N_EVEN * 2560 * 384 * 2);
    C.Wgu = (unsigned short*)takeb((size_t)DEPTH * N_EXPERTS * 2 * EXPERT_DIM * D_MODEL * 2); C.Wdn = (unsigned short*)takeb((size_t)DEPTH * N_EXPERTS * D_MODEL * EXPERT_DIM * 2);
    const size_t ubase = off; size_t umax = off;
    C.ZB = (unsigned short*)takeb(NT * 4608 * 2); C.Z = (float*)C.ZB; C.TW = (unsigned short*)takeb(NT * 384 * 2); C.LOB = (unsigned short*)takeb(NT * 2560 * 2);
    C.RBh = (unsigned short*)takeb(NT * 512 * 2); C.VBh = (unsigned short*)takeb(NT * 512 * 2); C.NKh = (unsigned short*)takeb(NT * 512 * 2); C.GBh = (unsigned short*)takeb(NT * 512 * 2);
    C.KDh = (unsigned short*)takeb(2 * NT * 512 * 2); C.BBh = (unsigned short*)takeb(2 * NT * 512 * 2); C.DEC = (float*)takeb(2 * NT * 512 * 4); C.YBh = (unsigned short*)takeb(2 * NT * 512 * 2); C.Y = nullptr;
    C.OBh = (unsigned short*)takeb(2 * NT * 512 * 2); C.O = nullptr; C.BON = (float*)takeb(NT * 8 * 4); C.YCATB = (unsigned short*)takeb(NT * 1024 * 2);
    umax = off > umax ? off : umax; off = ubase;
    (void)takeb(NT * 512 * 4); C.QNB = (unsigned short*)takeb(NT * 256 * 2); C.KVNB = (unsigned short*)takeb(NT * 256 * 2);
    C.QB = (unsigned short*)takeb(NT * MLA_HEADS * 96 * 2); C.KVB = (unsigned short*)takeb(NT * MLA_HEADS * 128 * 2); C.KPEB = (unsigned short*)takeb(NT * 32 * 2);
    C.AOB = (unsigned short*)takeb(NT * 1024 * 2);
    umax = off > umax ? off : umax; off = ubase;
    C.XPB = (unsigned short*)takeb(NS * D_MODEL * 2); C.ACTB = (unsigned short*)takeb(NS * EXPERT_DIM * 2); C.OUT2B = (unsigned short*)takeb(NS * D_MODEL * 2);
    umax = off > umax ? off : umax; off = umax;
    return off;
}
#endif
#if defined(HOST_TEST)
#define FWD_QUAL static
#define FWD_SIG NaiveCtx C
#define FWD_ARGS C
#define NLAUNCH(n, ...) do { auto f_ = __VA_ARGS__; for (long i_ = 0; i_ < (long)(n); ++i_) f_(i_); } while (0)
#elif defined(PERSISTENT)
#define FWD_QUAL __device__ __forceinline__
#define FWD_SIG const LAS NaiveCtx* Cp_, const XcdBarrier& bar, LAS unsigned char* lds, int wv_
#define FWD_ARGS Cp_, bar, lds, wv_
#define PERSIST_C_MACRO 1
#define NLAUNCH(n, ...) do { auto f_ = __VA_ARGS__; const long n_ = (long)(n); int tz_ = otid(wv_); \
    for (long i_ = ((long)(tz_ >> 6) * gridDim.x + opaque_bid()) * 64 + (tz_ & 63); i_ < n_; i_ += (long)gridDim.x * PB_THREADS) f_(i_); \
    grid_sync(bar); } while (0)
#else
#define FWD_QUAL static
#define FWD_SIG NaiveCtx C
#define FWD_ARGS C
template <class F> __global__ void __launch_bounds__(256) k_run(long n, F f) { for (long i = (long)blockIdx.x * 256 + threadIdx.x; i < n; i += (long)gridDim.x * 256) f(i); }
template <class F> static void nlaunch_(long n, F f, hipStream_t st) { long nb = (n + 255) / 256; if (nb > 65536) nb = 65536; if (nb < 1) nb = 1; hipLaunchKernelGGL(k_run<F>, dim3((unsigned)nb), dim3(256), 0, st, n, f); }
#define NLAUNCH(n, ...) nlaunch_((long)(n), __VA_ARGS__, g_stream)
static hipStream_t g_stream;
#endif

#ifdef HOST_TEST
static void ngemm(const float* A, int lda, const int* arow, const float* B, long bstride, int ldb, const float* bias, long biasstride, float* Cm, int ldc, int M, int N, int K, const int* tile_e) {
    for (int m = 0; m < M; ++m) {
        int e = 0; if (tile_e) { e = tile_e[m / 64]; if (e < 0) continue; }
        int ar = arow ? arow[m] : m; if (ar < 0) continue;
        const float* Bp = B + (size_t)e * bstride;
        for (int n = 0; n < N; ++n) { double s = bias ? bias[(size_t)e * biasstride + n] : 0.0; for (int k = 0; k < K; ++k) s += (double)A[(size_t)ar * lda + k] * Bp[(size_t)k * ldb + n]; Cm[(size_t)m * ldc + n] = (float)s; }
    }
}
#elif defined(PERSISTENT)
__device__ __forceinline__ void pgemm_(const float* A, int lda, const int* arow, const float* B, long bstride, int ldb, const float* bias, long biasstride, float* Cm, int ldc, int M, int N, int K, const int* tile_e, int wv_) {
    constexpr int NH = PB_THREADS / 256;
    __shared__ float As[NH][16][68], Bs[NH][16][68];
    const int tz_ = otid(wv_);
    const int half = tz_ >> 8, tid = tz_ & 255, tx = tid & 15, ty = tid >> 4;
    const int ntn = (N + 63) / 64, ntm = (M + 63) / 64, ntiles = ntn * ntm;
    const int ar_l = tid >> 2, ak = (tid & 3) * 4, bk = tid >> 4, bn = (tid & 15) * 4;
    for (int t0 = opaque_bid() * NH; t0 < ntiles; t0 += gridDim.x * NH) {
        const int tile = t0 + half; bool active = tile < ntiles; const int rt = active ? tile / ntn : 0, ct = active ? tile % ntn : 0;
        int e = 0; if (tile_e && active) { e = tile_e[rt]; if (e < 0) { active = false; e = 0; } }
        const float* Bp = B + (size_t)e * bstride;
        const int m0 = rt * 64, n0 = ct * 64;
        float acc[4][4];
_Pragma("unroll")
        for (int i = 0; i < 4; ++i)
_Pragma("unroll")
            for (int j = 0; j < 4; ++j) acc[i][j] = 0.f;
        int am = m0 + ar_l; int arr = -1; if (active && am < M) arr = arow ? arow[am] : am;
        for (int k0 = 0; k0 < K; k0 += 16) {
            float4 av = make_float4(0, 0, 0, 0); if (arr >= 0) av = *(const float4*)(A + (size_t)arr * lda + k0 + ak);
            As[half][ak + 0][ar_l] = av.x; As[half][ak + 1][ar_l] = av.y; As[half][ak + 2][ar_l] = av.z; As[half][ak + 3][ar_l] = av.w;
_Pragma("unroll")
            for (int j = 0; j < 4; ++j) { int n = n0 + bn + j; Bs[half][bk][bn + j] = (active && n < N) ? Bp[(size_t)(k0 + bk) * ldb + n] : 0.f; }
            __syncthreads();
_Pragma("unroll")
            for (int k = 0; k < 16; ++k) {
                float a[4], b[4];
_Pragma("unroll")
                for (int i = 0; i < 4; ++i) { a[i] = As[half][k][ty * 4 + i]; b[i] = Bs[half][k][tx * 4 + i]; }
_Pragma("unroll")
                for (int i = 0; i < 4; ++i)
_Pragma("unroll")
                    for (int j = 0; j < 4; ++j) acc[i][j] += a[i] * b[j];
            }
            __syncthreads();
        }
        if (active) {
_Pragma("unroll")
            for (int i = 0; i < 4; ++i) { int m = m0 + ty * 4 + i; if (m >= M) continue;
_Pragma("unroll")
                for (int j = 0; j < 4; ++j) { int n = n0 + tx * 4 + j; if (n < N) Cm[(size_t)m * ldc + n] = acc[i][j] + (bias ? bias[(size_t)e * biasstride + n] : 0.f); } }
        }
    }
}
#define ngemm(...) do { pgemm_(__VA_ARGS__, wv_); grid_sync(bar); } while (0)
#else
__global__ void __launch_bounds__(256) k_ngemm(const float* A, const int* arow, const float* B, const float* bias, float* Cm, const int* tile_e, long bstride, long biasstride, int lda, int ldb, int ldc, int M, int N, int K) {
    __shared__ float As[16][68], Bs[16][68];
    const int rt = blockIdx.y, ct = blockIdx.x, tid = threadIdx.x, tx = tid & 15, ty = tid >> 4;
    int e = 0; if (tile_e) { e = tile_e[rt]; if (e < 0) return; }
    const float* Bp = B + (size_t)e * bstride;
    const int m0 = rt * 64, n0 = ct * 64;
    float acc[4][4] = {};
    const int ar_l = tid >> 2, ak = (tid & 3) * 4; int am = m0 + ar_l; int arr = -1; if (am < M) arr = arow ? arow[am] : am;
    const int bk = tid >> 4, bn = (tid & 15) * 4;
    for (int k0 = 0; k0 < K; k0 += 16) {
        float4 av = make_float4(0, 0, 0, 0); if (arr >= 0) av = *(const float4*)(A + (size_t)arr * lda + k0 + ak);
        As[ak + 0][ar_l] = av.x; As[ak + 1][ar_l] = av.y; As[ak + 2][ar_l] = av.z; As[ak + 3][ar_l] = av.w;
        float bv[4]; for (int j = 0; j < 4; ++j) { int n = n0 + bn + j; bv[j] = n < N ? Bp[(size_t)(k0 + bk) * ldb + n] : 0.f; }
        Bs[bk][bn + 0] = bv[0]; Bs[bk][bn + 1] = bv[1]; Bs[bk][bn + 2] = bv[2]; Bs[bk][bn + 3] = bv[3];
        __syncthreads();
_Pragma("unroll")
        for (int k = 0; k < 16; ++k) {
            float a[4], b[4];
_Pragma("unroll")
            for (int i = 0; i < 4; ++i) { a[i] = As[k][ty * 4 + i]; b[i] = Bs[k][tx * 4 + i]; }
_Pragma("unroll")
            for (int i = 0; i < 4; ++i)
_Pragma("unroll")
                for (int j = 0; j < 4; ++j) acc[i][j] += a[i] * b[j];
        }
        __syncthreads();
    }
_Pragma("unroll")
    for (int i = 0; i < 4; ++i) { int m = m0 + ty * 4 + i; if (m >= M) continue;
_Pragma("unroll")
        for (int j = 0; j < 4; ++j) { int n = n0 + tx * 4 + j; if (n < N) Cm[(size_t)m * ldc + n] = acc[i][j] + (bias ? bias[(size_t)e * biasstride + n] : 0.f); } }
}
static void ngemm(const float* A, int lda, const int* arow, const float* B, long bstride, int ldb, const float* bias, long biasstride, float* Cm, int ldc, int M, int N, int K, const int* tile_e) {
    dim3 grid((N + 63) / 64, (M + 63) / 64);
    hipLaunchKernelGGL(k_ngemm, grid, dim3(256), 0, g_stream, A, arow, B, bias, Cm, tile_e, bstride, biasstride, lda, ldb, ldc, M, N, K);
}
#endif


#ifndef ATT_REMAP
#define ATT_REMAP 1
#endif
namespace att {
typedef float f32x16 __attribute__((ext_vector_type(16)));
typedef short s16x4 __attribute__((ext_vector_type(4)));
typedef __bf16 bf16x2_t __attribute__((ext_vector_type(2)));
typedef float f32x2_t __attribute__((ext_vector_type(2)));
constexpr int KROWB = 208, KT_BYTES = 64 * KROWB, VT_BYTES = 8192, BUF = KT_BYTES + VT_BYTES;
DI unsigned pk2(float a, float b) { f32x2_t f = {a, b}; return __builtin_bit_cast(unsigned, __builtin_convertvector(f, bf16x2_t)); }
template <int S> DI bf16x8 pack8(const f32x16& x) { u32x4 p; p.x = pk2(x[8 * S], x[8 * S + 1]); p.y = pk2(x[8 * S + 2], x[8 * S + 3]); p.z = pk2(x[8 * S + 4], x[8 * S + 5]); p.w = pk2(x[8 * S + 6], x[8 * S + 7]); return __builtin_bit_cast(bf16x8, p); }
#ifndef ATT_SETPRIO
#define ATT_SETPRIO 1
#endif
#if ATT_SETPRIO
#define ATT_PRIO(p) __builtin_amdgcn_s_setprio(p)
#else
#define ATT_PRIO(p)
#endif
#define ATT_MFMA(a, b, c) __builtin_amdgcn_mfma_f32_32x32x16_bf16((a), (b), (c), 0, 0, 0)

template <bool BF16OUT, int KVSRC> DI void attn_phase(LAS unsigned char* lds, const bf16_t* __restrict__ Qb, const bf16_t* __restrict__ Kb, const bf16_t* __restrict__ Vb, float* __restrict__ AO, bf16_t* __restrict__ AOB, int with_ctx, int wv_, const float* __restrict__ rope_tab = nullptr) {
    const int tid = otid(wv_), lane = tid & 63, wid = tid >> 6, r = lane & 31, h2 = lane >> 5, g1 = (lane >> 4) & 1, i16 = lane & 15;
    const int nlat = BATCH * MLA_HEADS * (SEQ / 256), nctx = with_ctx ? BATCH * MLA_HEADS * (CTX_LEN / 256) : 0;
    const int kq0 = tid, kq1 = 512 + tid; const bool has_k1 = tid < 256;
    const int kr0 = kq0 / 12, kc0 = kq0 % 12, kr1 = kq1 / 12, kc1 = kq1 % 12, vr = tid >> 3, vc = tid & 7;
    const unsigned kl0 = kr0 * KROWB + kc0 * 16, kl1 = kr1 * KROWB + kc1 * 16, vl = KT_BYTES + (vc >> 2) * 4096 + vr * 64 + (vc & 3) * 16;
    for (int u0 = opaque_bid(); u0 < nlat + nctx; u0 += gridDim.x) {
        int u = u0;
#if ATT_REMAP
        if (gridDim.x == 256 && u0 < nlat && (SEQ / 256) == 8) { const int c = u0 & 255, x = c & 7, j = c >> 3; u = (u0 & ~255) + 8 * (4 * x + (j >> 3)) + (j & 7); }
#endif
        int b, h, qrow0, nkeys;
        if (u < nlat) { const int qb = u % (SEQ / 256), bh = u / (SEQ / 256); b = bh / MLA_HEADS; h = bh % MLA_HEADS; qrow0 = NC_ + b * SEQ + qb * 256; nkeys = TT_; }
        else { const int v = u - nlat; const int qb = v % (CTX_LEN / 256), bh = v / (CTX_LEN / 256); b = bh / MLA_HEADS; h = bh % MLA_HEADS; qrow0 = b * CTX_LEN + qb * 256; nkeys = CTX_LEN; }
        const int nt = nkeys / 64;
        const bf16_t* qp = Qb + (size_t)(qrow0 + wid * 32 + r) * (MLA_HEADS * 96) + h * 96 + 8 * h2;
        bf16x8 qf[6];
#pragma unroll
        for (int s = 0; s < 6; ++s) qf[s] = *(const GAS bf16x8*)(qp + 16 * s);
        const bf16_t* kbase = Kb + (size_t)(b * MLA_HEADS + h) * TT_ * 96;
        const bf16_t* vbase = Vb + (size_t)(b * MLA_HEADS + h) * TT_ * 64;
#define ATT_LOAD_TO(TI, sk0, sk1, sv) do { if (KVSRC == 0) { const size_t ko = (size_t)(TI) * 64; \
            sk0 = *(const GAS u32x4*)(kbase + (ko + kr0) * 96 + kc0 * 8); if (has_k1) sk1 = *(const GAS u32x4*)(kbase + (ko + kr1) * 96 + kc1 * 8); sv = *(const GAS u32x4*)(vbase + (ko + vr) * 64 + vc * 8); } \
          else { const int t0_ = (TI) * 64; const size_t rb = t0_ < CTX_LEN ? (size_t)b * CTX_LEN + t0_ : (size_t)NC_ + (size_t)b * SEQ + (t0_ - CTX_LEN); \
            sk0 = kc0 < 8 ? *(const GAS u32x4*)(Kb + (rb + kr0) * (MLA_HEADS * 128) + h * 128 + kc0 * 8) : *(const GAS u32x4*)(Vb + (rb + kr0) * 32 + (kc0 - 8) * 8); \
            if (has_k1) sk1 = kc1 < 8 ? *(const GAS u32x4*)(Kb + (rb + kr1) * (MLA_HEADS * 128) + h * 128 + kc1 * 8) : *(const GAS u32x4*)(Vb + (rb + kr1) * 32 + (kc1 - 8) * 8); \
            sv = *(const GAS u32x4*)(Kb + (rb + vr) * (MLA_HEADS * 128) + h * 128 + 64 + vc * 8); } } while (0)
#define ATT_LOAD(TI) ATT_LOAD_TO(TI, sk0, sk1, sv)
        const bool do_rope = rope_tab != nullptr && u < nlat;
        f32x4 rt[2][4];
        if (do_rope) { const int spos = (qrow0 - NC_ + wid * 32 + r) % SEQ; const float* tb = rope_tab + (size_t)spos * 32;
#pragma unroll
            for (int f = 0; f < 2; ++f)
#pragma unroll
                for (int c = 0; c < 4; ++c) rt[f][c] = *(const GAS f32x4*)(tb + 16 * f + 4 * c); }
        u32x4 sk0, sk1 = (u32x4){0u, 0u, 0u, 0u}, sv, tk0, tk1 = (u32x4){0u, 0u, 0u, 0u}, tv;
        ATT_LOAD(0);
        if (nt > 1) { ATT_LOAD_TO(1, tk0, tk1, tv); }
        if (do_rope) {
#pragma unroll
            for (int f = 0; f < 2; ++f) { const u32x4 own = __builtin_bit_cast(u32x4, qf[4 + f]); u32x4 oth;
                oth.x = __shfl_xor(own.x, 32); oth.y = __shfl_xor(own.y, 32); oth.z = __shfl_xor(own.z, 32); oth.w = __shfl_xor(own.w, 32);
                const f32x4 c0 = rt[f][0], c1 = rt[f][1], s0 = rt[f][2], s1 = rt[f][3];
                const float sgn = h2 ? 1.f : -1.f;
                const float x[8] = {bf_lo(own.x), bf_hi(own.x), bf_lo(own.y), bf_hi(own.y), bf_lo(own.z), bf_hi(own.z), bf_lo(own.w), bf_hi(own.w)};
                const float y[8] = {bf_lo(oth.x), bf_hi(oth.x), bf_lo(oth.y), bf_hi(oth.y), bf_lo(oth.z), bf_hi(oth.z), bf_lo(oth.w), bf_hi(oth.w)};
                const float cs[8] = {c0[0], c0[1], c0[2], c0[3], c1[0], c1[1], c1[2], c1[3]}, sn[8] = {s0[0], s0[1], s0[2], s0[3], s1[0], s1[1], s1[2], s1[3]};
                u32x4 w; w.x = pk2(x[0] * cs[0] + sgn * y[0] * sn[0], x[1] * cs[1] + sgn * y[1] * sn[1]); w.y = pk2(x[2] * cs[2] + sgn * y[2] * sn[2], x[3] * cs[3] + sgn * y[3] * sn[3]);
                w.z = pk2(x[4] * cs[4] + sgn * y[4] * sn[4], x[5] * cs[5] + sgn * y[5] * sn[5]); w.w = pk2(x[6] * cs[6] + sgn * y[6] * sn[6], x[7] * cs[7] + sgn * y[7] * sn[7]);
                qf[4 + f] = __builtin_bit_cast(bf16x8, w); } }
#define ATT_QK(S0, S1, BUFP) do { _Pragma("unroll") for (int i = 0; i < 16; ++i) { S0[i] = 0.f; S1[i] = 0.f; } \
            _Pragma("unroll") for (int s = 0; s < 6; ++s) { const bf16x8 k0 = *(const LAS bf16x8*)((BUFP) + r * KROWB + 32 * s + 16 * h2); const bf16x8 k1 = *(const LAS bf16x8*)((BUFP) + (32 + r) * KROWB + 32 * s + 16 * h2); \
                S0 = ATT_MFMA(k0, qf[s], S0); S1 = ATT_MFMA(k1, qf[s], S1); } } while (0)
#define ATT_STORE_STAGE(NB) do { *(LAS u32x4*)((NB) + kl0) = sk0; if (has_k1) *(LAS u32x4*)((NB) + kl1) = sk1; *(LAS u32x4*)((NB) + vl) = sv; } while (0)
        ATT_STORE_STAGE(lds);
        if (nt > 1) { *(LAS u32x4*)(lds + BUF + kl0) = tk0; if (has_k1) *(LAS u32x4*)(lds + BUF + kl1) = tk1; *(LAS u32x4*)(lds + BUF + vl) = tv; }
        __syncthreads();
        f32x16 o0, o1, s0, s1;
#pragma unroll
        for (int i = 0; i < 16; ++i) { o0[i] = 0.f; o1[i] = 0.f; }
        ATT_QK(s0, s1, lds);
        float m = -1e30f, l = 0.f;
        int st_cur = 0;
        for (int t = 0; t < nt; ++t) {
            const int st_nxt = st_cur == 2 ? 0 : st_cur + 1, st_nn = st_nxt == 2 ? 0 : st_nxt + 1;
            LAS unsigned char* buf = lds + st_cur * BUF;
            if (t + 2 < nt) { ATT_LOAD(t + 2); }
            f32x16 n0, n1;
            ATT_QK(n0, n1, lds + st_nxt * BUF);
            float mt = __builtin_fmaxf(s0[0], s1[0]);
#pragma unroll
            for (int i = 1; i < 16; ++i) mt = __builtin_fmaxf(__builtin_fmaxf(mt, s0[i]), s1[i]);
            { float ma = mt, mb = mt; asm volatile("s_nop 1\n\tv_permlane32_swap_b32 %0, %1" : "+v"(ma), "+v"(mb)); mt = fmaxf(ma, mb); }
            if (__any(mt > m + 8.f)) { const float mnew = fmaxf(m, mt), alpha = __builtin_amdgcn_exp2f(m - mnew); m = mnew; l *= alpha;
#pragma unroll
                for (int i = 0; i < 16; ++i) { o0[i] *= alpha; o1[i] *= alpha; } }
            float ls = 0.f;
#pragma unroll
            for (int i = 0; i < 16; ++i) { s0[i] = __builtin_amdgcn_exp2f(s0[i] - m); s1[i] = __builtin_amdgcn_exp2f(s1[i] - m); ls += s0[i] + s1[i]; }
            l += ls;
            LAS unsigned char* vb = buf + KT_BYTES + (4 * h2 + (i16 >> 2)) * 64 + 32 * g1 + 8 * (i16 & 3);
#define ATT_PV(PS, SB, S2) do { const bf16x8 pb = pack8<S2>(PS); \
            { const s16x4 lo = __builtin_amdgcn_ds_read_tr16_b64_v4i16((LAS s16x4*)(vb + (32 * SB + 16 * S2) * 64)), hi = __builtin_amdgcn_ds_read_tr16_b64_v4i16((LAS s16x4*)(vb + (32 * SB + 16 * S2 + 8) * 64)); \
              o0 = ATT_MFMA(__builtin_shufflevector(lo, hi, 0, 1, 2, 3, 4, 5, 6, 7), pb, o0); } \
            { const s16x4 lo = __builtin_amdgcn_ds_read_tr16_b64_v4i16((LAS s16x4*)(vb + 4096 + (32 * SB + 16 * S2) * 64)), hi = __builtin_amdgcn_ds_read_tr16_b64_v4i16((LAS s16x4*)(vb + 4096 + (32 * SB + 16 * S2 + 8) * 64)); \
              o1 = ATT_MFMA(__builtin_shufflevector(lo, hi, 0, 1, 2, 3, 4, 5, 6, 7), pb, o1); } } while (0)
            ATT_PRIO(1); ATT_PV(s0, 0, 0); ATT_PV(s0, 0, 1); ATT_PV(s1, 1, 0); ATT_PV(s1, 1, 1); ATT_PRIO(0);
#undef ATT_PV
            if (t + 2 < nt) ATT_STORE_STAGE(lds + st_nn * BUF);
            __syncthreads();
            s0 = n0; s1 = n1;
            st_cur = st_nxt;
        }
#undef ATT_QK
#undef ATT_STORE_STAGE
        l += __shfl_xor(l, 32);
        const float il = 1.f / l;
        if (BF16OUT) { bf16_t* op = AOB + (size_t)(qrow0 + wid * 32 + r) * 1024 + h * 64 + 4 * h2;
#pragma unroll
            for (int g = 0; g < 4; ++g) {
                *(GAS u32x2*)(op + 8 * g) = (u32x2){pk2(o0[4 * g] * il, o0[4 * g + 1] * il), pk2(o0[4 * g + 2] * il, o0[4 * g + 3] * il)};
                *(GAS u32x2*)(op + 32 + 8 * g) = (u32x2){pk2(o1[4 * g] * il, o1[4 * g + 1] * il), pk2(o1[4 * g + 2] * il, o1[4 * g + 3] * il)}; }
        } else { float* op = AO + (size_t)(qrow0 + wid * 32 + r) * 1024 + h * 64 + 4 * h2;
#pragma unroll
            for (int g = 0; g < 4; ++g) {
                *(GAS f32x4*)(op + 8 * g) = (f32x4){o0[4 * g] * il, o0[4 * g + 1] * il, o0[4 * g + 2] * il, o0[4 * g + 3] * il};
                *(GAS f32x4*)(op + 32 + 8 * g) = (f32x4){o1[4 * g] * il, o1[4 * g + 1] * il, o1[4 * g + 2] * il, o1[4 * g + 3] * il}; } }
    }
}
#undef ATT_LOAD
#undef ATT_LOAD_TO
}

namespace tl {
DI float wsum(float v) { v += __shfl_xor(v, 32); v += __shfl_xor(v, 16); v += __shfl_xor(v, 8); v += __shfl_xor(v, 4); v += __shfl_xor(v, 2); v += __shfl_xor(v, 1); return v; }
DI void ld16f(const float* p, int lane, float (&v)[16]) {
#pragma unroll
    for (int i = 0; i < 2; ++i) { const f32x4 a = *(const GAS f32x4*)(p + 512 * i + 8 * lane), b = *(const GAS f32x4*)(p + 512 * i + 8 * lane + 4);
        v[8 * i] = a[0]; v[8 * i + 1] = a[1]; v[8 * i + 2] = a[2]; v[8 * i + 3] = a[3]; v[8 * i + 4] = b[0]; v[8 * i + 5] = b[1]; v[8 * i + 6] = b[2]; v[8 * i + 7] = b[3]; } }
DI void st16f(float* p, int lane, const float (&v)[16]) {
#pragma unroll
    for (int i = 0; i < 2; ++i) { *(GAS f32x4*)(p + 512 * i + 8 * lane) = (f32x4){v[8 * i], v[8 * i + 1], v[8 * i + 2], v[8 * i + 3]}; *(GAS f32x4*)(p + 512 * i + 8 * lane + 4) = (f32x4){v[8 * i + 4], v[8 * i + 5], v[8 * i + 6], v[8 * i + 7]}; } }
DI void ld16b(const bf16_t* p, int lane, float (&v)[16]) {
#pragma unroll
    for (int i = 0; i < 2; ++i) { const u32x4 w = *(const GAS u32x4*)(p + 512 * i + 8 * lane);
        v[8 * i] = bf_lo(w.x); v[8 * i + 1] = bf_hi(w.x); v[8 * i + 2] = bf_lo(w.y); v[8 * i + 3] = bf_hi(w.y); v[8 * i + 4] = bf_lo(w.z); v[8 * i + 5] = bf_hi(w.z); v[8 * i + 6] = bf_lo(w.w); v[8 * i + 7] = bf_hi(w.w); } }
DI void st16b(bf16_t* p, int lane, const float (&v)[16]) {
#pragma unroll
    for (int i = 0; i < 2; ++i) { u32x4 w; w.x = att::pk2(v[8 * i], v[8 * i + 1]); w.y = att::pk2(v[8 * i + 2], v[8 * i + 3]); w.z = att::pk2(v[8 * i + 4], v[8 * i + 5]); w.w = att::pk2(v[8 * i + 6], v[8 * i + 7]);
        *(GAS u32x4*)(p + 512 * i + 8 * lane) = w; } }
typedef _Float16 f16x8 __attribute__((ext_vector_type(8)));
typedef float f32x8 __attribute__((ext_vector_type(8)));
DI void ld16h(const unsigned short* p, int lane, float (&v)[16]) {
#pragma unroll
    for (int i = 0; i < 2; ++i) { const f16x8 hv = *(const GAS f16x8*)(p + 512 * i + 8 * lane); const f32x8 f = __builtin_convertvector(hv, f32x8);
#pragma unroll
        for (int j = 0; j < 8; ++j) v[8 * i + j] = f[j]; } }
DI void st16h(unsigned short* p, int lane, const float (&v)[16]) {
#pragma unroll
    for (int i = 0; i < 2; ++i) { f32x8 f;
#pragma unroll
        for (int j = 0; j < 8; ++j) f[j] = v[8 * i + j];
        *(GAS f16x8*)(p + 512 * i + 8 * lane) = __builtin_convertvector(f, f16x8); } }
#define TL_ROWS(row, row_lo, nrows) const int rpw_ = ((nrows) + (int)gridDim.x - 1) / (int)gridDim.x, wg_ = opaque_bid(), tid_ = otid(wv_), lane = tid_ & 63, wid_ = tid_ >> 6; (void)lane; \
    for (int rr_ = wid_, row = (row_lo) + wg_ * rpw_ + wid_; rr_ < rpw_ && row < (row_lo) + (nrows); rr_ += 8, row += 8)

DI void init_h(const LAS NaiveCtx* Cp_, int wv_) {
    TL_ROWS(row, 0, NT_) { float h[16], m0[16], m1[16], u[16];
        ld16f(row < NC_ ? (*Cp_).ctx + (size_t)row * D_MODEL : (*Cp_).x + (size_t)(row - NC_) * D_MODEL, lane, h);
        const float* m = (*Cp_).MOD + (size_t)modrow(row) * N_MOD * D_MODEL; ld16f(m, lane, m0); ld16f(m + D_MODEL, lane, m1);
#pragma unroll
        for (int k = 0; k < 16; ++k) u[k] = h[k] * (1.f + m1[k]) + m0[k];
        st16h((*Cp_).HB + (size_t)row * D_MODEL, lane, h); st16b((*Cp_).UB + (size_t)row * D_MODEL, lane, u); }
}


DI void mod_phase(const LAS NaiveCtx* Cp_, LAS unsigned char* lds, int wv_) {
    constexpr int W = N_MOD * D_MODEL, NR = BATCH + 1, NCOLS = DEPTH * W;
    const int t = otid(wv_), wg = opaque_bid(), cpw = (NCOLS + (int)gridDim.x - 1) / (int)gridDim.x;
    LAS float* sl = (LAS float*)(lds + 72 * 1024);
    { constexpr int NV = NR * D_MODEL / PB_THREADS; float cv[NV]; const GAS float* cp = (const GAS float*)(*Cp_).c; const GAS float* cc = (const GAS float*)(*Cp_).c_ctx;
      static_assert(NR * D_MODEL % PB_THREADS == 0, "silu table");
#pragma unroll
      for (int j = 0; j < NV; ++j) { const int i = t + PB_THREADS * j, r = i / D_MODEL, k = i % D_MODEL; cv[j] = r < BATCH ? cp[(size_t)r * D_MODEL + k] : cc[k]; }
#pragma unroll
      for (int j = 0; j < NV; ++j) sl[t + PB_THREADS * j] = siluf_(cv[j]); }
    __syncthreads();
    const int col = wg * cpw + t;
    if (t < cpw && col < NCOLS) { const int l = col / W, j = col % W; const float* w = (*Cp_).mod_w + (size_t)l * D_MODEL * W + j;
        float acc[NR];
#pragma unroll
        for (int r = 0; r < NR; ++r) acc[r] = 0.f;
        for (int k = 0; k < D_MODEL; k += 4) { const GAS float* wg_ = (const GAS float*)w; const float w0 = wg_[(size_t)k * W], w1 = wg_[(size_t)(k + 1) * W], w2 = wg_[(size_t)(k + 2) * W], w3 = wg_[(size_t)(k + 3) * W];
#pragma unroll
            for (int r = 0; r < NR; ++r) { const f32x4 s = *(const LAS f32x4*)(sl + r * D_MODEL + k); acc[r] += s[0] * w0 + s[1] * w1 + s[2] * w2 + s[3] * w3; } }
        const float bj = (*Cp_).mod_b[(size_t)l * W + j];
#pragma unroll
        for (int r = 0; r < NR; ++r) (*Cp_).MOD[((size_t)l * NR + r) * W + j] = acc[r] + bj; }
    __syncthreads();
}

constexpr int WRT_STRIDE = 1028;
__shared__ int tl_lcnt[32], tl_wgbase[32], tl_offs[33], tl_tstart[33], tl_cnt[32];

DI void ln1_row_pre(const LAS NaiveCtx* Cp_, const float* MODp, const float (&g0)[16], const float (&b0)[16], int row, int lane, bool wr, float (&t)[16]) {
    const float* m = MODp + (size_t)modrow(row) * N_MOD * D_MODEL;
    float a[16], b[16];
    ld16h((*Cp_).HB + (size_t)row * D_MODEL, lane, t); ld16b((*Cp_).YOB + (size_t)row * D_MODEL, lane, a); ld16f(m + 2 * D_MODEL, lane, b);
    float s = 0.f;
#pragma unroll
    for (int k = 0; k < 16; ++k) { t[k] = ALPHA * t[k] + b[k] * a[k]; s += t[k]; }
    const float mean = wsum(s) * (1.f / D_MODEL); s = 0.f;
#pragma unroll
    for (int k = 0; k < 16; ++k) { t[k] -= mean; s += t[k] * t[k]; }
    const float rs = 1.f / sqrtf(wsum(s) * (1.f / D_MODEL) + 1e-5f);
    ld16f(m + 3 * D_MODEL, lane, a); ld16f(m + 4 * D_MODEL, lane, b);
#pragma unroll
    for (int k = 0; k < 16; ++k) t[k] = t[k] * rs * g0[k] + b0[k];
    if (wr) st16h((*Cp_).HB + (size_t)row * D_MODEL, lane, t);
#pragma unroll
    for (int k = 0; k < 16; ++k) t[k] = t[k] * (1.f + b[k]) + a[k];
    if (wr) st16b((*Cp_).UB + (size_t)row * D_MODEL, lane, t);
}
DI void ln1_row_post(const LAS NaiveCtx* Cp_, const float* brp, int row, int lane, bool wr, float (&p)[16]) {
#define TL_STAGE(N, BIT) { const bool up_ = (lane & BIT) != 0; _Pragma("unroll") for (int k = 0; k < N / 2; ++k) { const float send_ = up_ ? p[k] : p[k + N / 2], keep_ = up_ ? p[k + N / 2] : p[k]; p[k] = keep_ + __shfl_xor(send_, BIT); } }
        TL_STAGE(16, 16) TL_STAGE(8, 8) TL_STAGE(4, 4) TL_STAGE(2, 2)
#undef TL_STAGE
        const int e_me = (lane >> 1) & 31;
        const float lg = p[0] + __shfl_xor(p[0], 1) + brp[e_me];
        int rank = 0;
#pragma unroll
        for (int e2 = 0; e2 < 32; ++e2) { const float v = __builtin_bit_cast(float, __builtin_amdgcn_readlane(__builtin_bit_cast(int, lg), 2 * e2)); rank += (v > lg || (v == lg && e2 < e_me)) ? 1 : 0; }
        float vk[4]; int ek[4];
#pragma unroll
        for (int k = 0; k < 4; ++k) { const unsigned long long mk = __ballot(rank == k && (lane & 1) == 0); const int src = __builtin_amdgcn_readfirstlane((int)__builtin_ctzll(mk | (1ull << 63)));
            vk[k] = __builtin_bit_cast(float, __builtin_amdgcn_readlane(__builtin_bit_cast(int, lg), src)); ek[k] = src >> 1; }
        float wk[4], den = 0.f;
#pragma unroll
        for (int k = 0; k < 4; ++k) { wk[k] = expf(vk[k] - vk[0]); den += wk[k]; }
        if (wr && lane < 4) { const int e = lane == 0 ? ek[0] : lane == 1 ? ek[1] : lane == 2 ? ek[2] : ek[3]; const float g = (lane == 0 ? wk[0] : lane == 1 ? wk[1] : lane == 2 ? wk[2] : wk[3]) / den;
            const int r = atomicAdd(&tl_lcnt[e], 1);
            (*Cp_).TOPI[(size_t)row * TOP_K + lane] = e; (*Cp_).TOPG[(size_t)row * TOP_K + lane] = g; (*Cp_).SLOT[(size_t)row * TOP_K + lane] = r; }
}
DI void ln1_router(const LAS NaiveCtx* Cp_, LAS unsigned char* lds, long layer, int row_lo, int nrows, int wv_) {
    LAS float* wrt = (LAS float*)lds;
    { const int t = otid(wv_); const float* wrp = (*Cp_).moe_w_router + (size_t)layer * D_MODEL * N_EXPERTS;
      { const GAS f32x4* wrp4 = (const GAS f32x4*)wrp; constexpr int NV = D_MODEL * N_EXPERTS / 4 / PB_THREADS; f32x4 wv[NV];
#pragma unroll
        for (int j = 0; j < NV; ++j) wv[j] = wrp4[t + PB_THREADS * j];
#pragma unroll
        for (int j = 0; j < NV; ++j) { const int idx = 4 * (t + PB_THREADS * j);
#pragma unroll
            for (int c = 0; c < 4; ++c) wrt[((idx + c) & 31) * WRT_STRIDE + ((idx + c) >> 5)] = wv[j][c]; } }
      if (t < 32) tl_lcnt[t] = 0; }
    __syncthreads();
    const float* MODp = (*Cp_).MOD + (size_t)layer * (BATCH + 1) * N_MOD * D_MODEL;
    const float* lg0 = (*Cp_).ln_g + ((size_t)layer * 2) * D_MODEL; const float* lb0 = (*Cp_).ln_b + ((size_t)layer * 2) * D_MODEL;
    const float* brp = (*Cp_).moe_b_router + (size_t)layer * N_EXPERTS;
    { const int rpw_ = (nrows + (int)gridDim.x - 1) / (int)gridDim.x, wg_ = opaque_bid(), tid_ = otid(wv_), lane = tid_ & 63, wid_ = tid_ >> 6;
      float g0[16], b0[16]; ld16f(lg0, lane, g0); ld16f(lb0, lane, b0);
      for (int rr_ = wid_, row = row_lo + wg_ * rpw_ + wid_; rr_ < rpw_ && row < row_lo + nrows; rr_ += 16, row += 16) {
        const bool hasB = (rr_ + 8 < rpw_) && (row + 8 < row_lo + nrows); const int rowB = hasB ? row + 8 : row;
        float tA[16], tB[16];
        ln1_row_pre(Cp_, MODp, g0, b0, row, lane, true, tA); ln1_row_pre(Cp_, MODp, g0, b0, rowB, lane, hasB, tB);
        float pA[16], pB[16];
        const bool up5 = (lane & 32) != 0;
#pragma unroll
        for (int k = 0; k < 16; ++k) { float aA[2], aB[2];
#pragma unroll
            for (int hh = 0; hh < 2; ++hh) { const int e = k + 16 * hh; float accA = 0.f, accB = 0.f;
#pragma unroll
                for (int i = 0; i < 2; ++i) { const f32x4 w0 = *(const LAS f32x4*)(wrt + e * WRT_STRIDE + 512 * i + 8 * lane), w1 = *(const LAS f32x4*)(wrt + e * WRT_STRIDE + 512 * i + 8 * lane + 4);
                    accA += tA[8 * i] * w0[0] + tA[8 * i + 1] * w0[1] + tA[8 * i + 2] * w0[2] + tA[8 * i + 3] * w0[3] + tA[8 * i + 4] * w1[0] + tA[8 * i + 5] * w1[1] + tA[8 * i + 6] * w1[2] + tA[8 * i + 7] * w1[3];
                    accB += tB[8 * i] * w0[0] + tB[8 * i + 1] * w0[1] + tB[8 * i + 2] * w0[2] + tB[8 * i + 3] * w0[3] + tB[8 * i + 4] * w1[0] + tB[8 * i + 5] * w1[1] + tB[8 * i + 6] * w1[2] + tB[8 * i + 7] * w1[3]; }
                aA[hh] = accA; aB[hh] = accB; }
            { const float sendA = up5 ? aA[0] : aA[1], keepA = up5 ? aA[1] : aA[0]; pA[k] = keepA + __shfl_xor(sendA, 32);
              const float sendB = up5 ? aB[0] : aB[1], keepB = up5 ? aB[1] : aB[0]; pB[k] = keepB + __shfl_xor(sendB, 32); }
            __builtin_amdgcn_sched_barrier(0); }
        ln1_row_post(Cp_, brp, row, lane, true, pA); ln1_row_post(Cp_, brp, rowB, lane, hasB, pB);
      } }
    __syncthreads();
    { const int t = otid(wv_); if (t < 32) tl_wgbase[t] = atomicAdd((*Cp_).CNT + layer * 64 + t, tl_lcnt[t]); }
}

DI void slots_gather(const LAS NaiveCtx* Cp_, long layer, int row_lo, int nrows, int wv_) {
    { const int t = otid(wv_); if (t < N_EXPERTS) tl_cnt[t] = ld_cnt((*Cp_).CNT + layer * 64 + t); }
    __syncthreads();
    { const int t = otid(wv_); if (t == 0) { int off = 0; for (int e = 0; e < N_EXPERTS; ++e) { tl_offs[e] = off; tl_tstart[e] = off / MOE_PAD; off += (tl_cnt[e] + MOE_PAD - 1) / MOE_PAD * MOE_PAD; } tl_offs[N_EXPERTS] = off; tl_tstart[N_EXPERTS] = off / MOE_PAD; } }
    __syncthreads();
    { const int rpw_ = (nrows + (int)gridDim.x - 1) / (int)gridDim.x, base = row_lo + opaque_bid() * rpw_, hi = (base + rpw_ < row_lo + nrows) ? base + rpw_ : row_lo + nrows;
      const GAS int* topi = (const GAS int*)(*Cp_).TOPI; GAS int* slotp = (GAS int*)(*Cp_).SLOT; GAS int* tokof = (GAS int*)(*Cp_).TOKOF;
      for (int i = otid(wv_); i < (hi - base) * TOP_K; i += PB_THREADS) { const int row = base + i / TOP_K; const size_t idx = (size_t)base * TOP_K + i;
          const int e = topi[idx]; const int slot = tl_offs[e] + tl_wgbase[e] + slotp[idx]; slotp[idx] = slot;
          tokof[slot] = row; } }
    { const int wg = opaque_bid(), t = otid(wv_);
      if (wg < N_EXPERTS) { const int cnt = tl_cnt[wg], lo = tl_offs[wg] + cnt, hi = tl_offs[wg + 1]; for (int s = lo + t; s < hi; s += PB_THREADS) (*Cp_).TOKOF[s] = 0; } }
}

DI void cmb_issue(const LAS NaiveCtx* Cp_, int row, int lane, u32x4 (&o)[4][2], float (&g)[4], f16x8 (&h)[2]) {
    const GAS int* sp = (const GAS int*)((*Cp_).SLOT + (size_t)row * TOP_K); const GAS float* gp = (const GAS float*)((*Cp_).TOPG + (size_t)row * TOP_K);
    int sl[4];
#pragma unroll
    for (int q = 0; q < 4; ++q) { sl[q] = sp[q]; g[q] = gp[q]; }
#pragma unroll
    for (int q = 0; q < 4; ++q) { const GAS u32x4* p = (const GAS u32x4*)((*Cp_).OUT2B + (size_t)sl[q] * D_MODEL + 8 * lane); o[q][0] = p[0]; o[q][1] = p[64]; }
#pragma unroll
    for (int i = 0; i < 2; ++i) h[i] = *(const GAS f16x8*)((*Cp_).HB + (size_t)row * D_MODEL + 512 * i + 8 * lane);
}
DI void cmb_finish(const LAS NaiveCtx* Cp_, const float* MODp, const float (&g1)[16], const float (&b1)[16], bool last, int row, int lane, bool wr, const u32x4 (&o)[4][2], const float (&g)[4], const f16x8 (&h)[2]) {
    const float* m = MODp + (size_t)modrow(row) * N_MOD * D_MODEL;
    float f[16], t[16], a[16], b[16];
#pragma unroll
    for (int k = 0; k < 16; ++k) f[k] = 0.f;
#pragma unroll
    for (int q = 0; q < 4; ++q)
#pragma unroll
        for (int i = 0; i < 2; ++i) { const u32x4 w = o[q][i];
            f[8 * i] += g[q] * bf_lo(w.x); f[8 * i + 1] += g[q] * bf_hi(w.x); f[8 * i + 2] += g[q] * bf_lo(w.y); f[8 * i + 3] += g[q] * bf_hi(w.y);
            f[8 * i + 4] += g[q] * bf_lo(w.z); f[8 * i + 5] += g[q] * bf_hi(w.z); f[8 * i + 6] += g[q] * bf_lo(w.w); f[8 * i + 7] += g[q] * bf_hi(w.w); }
#pragma unroll
    for (int i = 0; i < 2; ++i) { const f32x8 hf = __builtin_convertvector(h[i], f32x8);
#pragma unroll
        for (int j = 0; j < 8; ++j) t[8 * i + j] = hf[j]; }
    ld16f(m + 5 * D_MODEL, lane, b);
    float s = 0.f;
#pragma unroll
    for (int k = 0; k < 16; ++k) { t[k] = ALPHA * t[k] + b[k] * f[k]; s += t[k]; }
    const float mean = wsum(s) * (1.f / D_MODEL); s = 0.f;
#pragma unroll
    for (int k = 0; k < 16; ++k) { t[k] -= mean; s += t[k] * t[k]; }
    const float rs = 1.f / sqrtf(wsum(s) * (1.f / D_MODEL) + 1e-5f);
#pragma unroll
    for (int k = 0; k < 16; ++k) t[k] = t[k] * rs * g1[k] + b1[k];
    if (!wr) return;
    if (last) { st16f((*Cp_).out + (size_t)(row - NC_) * D_MODEL, lane, t); }
    else { const float* mn = MODp + (size_t)(BATCH + 1) * N_MOD * D_MODEL + (size_t)modrow(row) * N_MOD * D_MODEL; ld16f(mn, lane, a); ld16f(mn + D_MODEL, lane, b);
        st16h((*Cp_).HB + (size_t)row * D_MODEL, lane, t);
#pragma unroll
        for (int k = 0; k < 16; ++k) t[k] = t[k] * (1.f + b[k]) + a[k];
        st16b((*Cp_).UB + (size_t)row * D_MODEL, lane, t); }
}
DI void combine_ln2(const LAS NaiveCtx* Cp_, long layer, int row_lo, int nrows, int wv_) {
    const float* MODp = (*Cp_).MOD + (size_t)layer * (BATCH + 1) * N_MOD * D_MODEL;
    const float* lg1 = (*Cp_).ln_g + ((size_t)layer * 2 + 1) * D_MODEL; const float* lb1 = (*Cp_).ln_b + ((size_t)layer * 2 + 1) * D_MODEL;
    const bool last = layer == DEPTH - 1;
    const int rpw_ = (nrows + (int)gridDim.x - 1) / (int)gridDim.x, wg_ = opaque_bid(), tid_ = otid(wv_), lane = tid_ & 63, wid_ = tid_ >> 6;
    float g1[16], b1[16]; ld16f(lg1, lane, g1); ld16f(lb1, lane, b1);
    for (int rr_ = wid_, row = row_lo + wg_ * rpw_ + wid_; rr_ < rpw_ && row < row_lo + nrows; rr_ += 16, row += 16) {
        const bool hasB = (rr_ + 8 < rpw_) && (row + 8 < row_lo + nrows); const int rowB = hasB ? row + 8 : row;
        u32x4 oA[4][2], oB[4][2]; float gA[4], gB[4]; f16x8 hA[2], hB[2];
        cmb_issue(Cp_, row, lane, oA, gA, hA); cmb_issue(Cp_, rowB, lane, oB, gB, hB);
        cmb_finish(Cp_, MODp, g1, b1, last, row, lane, true, oA, gA, hA); cmb_finish(Cp_, MODp, g1, b1, last, rowB, lane, hasB, oB, gB, hB);
    }
}
}

namespace tl {
DI u32x4 pack8f(const float (&v)[8]) { u32x4 w; w.x = att::pk2(v[0], v[1]); w.y = att::pk2(v[2], v[3]); w.z = att::pk2(v[4], v[5]); w.w = att::pk2(v[6], v[7]); return w; }
DI void ld8f(const float* p, float (&v)[8]) { const f32x4 a = *(const GAS f32x4*)p, b = *(const GAS f32x4*)(p + 4); v[0] = a[0]; v[1] = a[1]; v[2] = a[2]; v[3] = a[3]; v[4] = b[0]; v[5] = b[1]; v[6] = b[2]; v[7] = b[3]; }
DI void st8f(float* p, const float (&v)[8]) { *(GAS f32x4*)p = (f32x4){v[0], v[1], v[2], v[3]}; *(GAS f32x4*)(p + 4) = (f32x4){v[4], v[5], v[6], v[7]}; }
DI void up8b(const u32x4 w, float (&v)[8]) { v[0] = bf_lo(w.x); v[1] = bf_hi(w.x); v[2] = bf_lo(w.y); v[3] = bf_hi(w.y); v[4] = bf_lo(w.z); v[5] = bf_hi(w.z); v[6] = bf_lo(w.w); v[7] = bf_hi(w.w); }
DI void ld8b(const bf16_t* p, float (&v)[8]) { const u32x4 w = *(const GAS u32x4*)p; v[0] = bf_lo(w.x); v[1] = bf_hi(w.x); v[2] = bf_lo(w.y); v[3] = bf_hi(w.y); v[4] = bf_lo(w.z); v[5] = bf_hi(w.z); v[6] = bf_lo(w.w); v[7] = bf_hi(w.w); }
DI void shifted8(const float* Z, int ldz, int row, int c, bool has_p, bool has_n, const float* mu, float (&o)[8]) {
    float z[8], p[8], n[8], m[8]; ld8f(Z + (size_t)row * ldz + c, z); ld8f(mu + c, m);
    if (has_p) ld8f(Z + (size_t)(row - 1) * ldz + c, p); else {
#pragma unroll
        for (int j = 0; j < 8; ++j) p[j] = 0.f; }
    if (has_n) ld8f(Z + (size_t)(row + 1) * ldz + c, n); else {
#pragma unroll
        for (int j = 0; j < 8; ++j) n[j] = 0.f; }
#pragma unroll
    for (int j = 0; j < 8; ++j) o[j] = z[j] + m[j] * (0.5f * (p[j] + n[j]) - z[j]);
}
DI void shifted8b(const bf16_t* Z, int row, int c, bool has_p, bool has_n, const float* mu, float (&o)[8]) {
    float z[8], p[8], n[8], m[8]; ld8b(Z + (size_t)row * 4608 + c, z); ld8f(mu + c, m);
    if (has_p) ld8b(Z + (size_t)(row - 1) * 4608 + c, p); else {
#pragma unroll
        for (int j = 0; j < 8; ++j) p[j] = 0.f; }
    if (has_n) ld8b(Z + (size_t)(row + 1) * 4608 + c, n); else {
#pragma unroll
        for (int j = 0; j < 8; ++j) n[j] = 0.f; }
#pragma unroll
    for (int j = 0; j < 8; ++j) o[j] = z[j] + m[j] * (0.5f * (p[j] + n[j]) - z[j]);
}
#define TL_SEG(row, t, len) int t, len; if ((row) < NC_) { t = (row) % CTX_LEN; len = CTX_LEN; } else { t = ((row) - NC_) % SEQ; len = SEQ; }

DI void rw_tw(const LAS NaiveCtx* Cp_, long layer, int wv_) {
    const float* mu = (*Cp_).rw_mu + (size_t)(layer / 2) * RW_IN;
    TL_ROWS(row, 0, NT_) { if (lane < 48) { TL_SEG(row, t, len); float zs[8]; shifted8b((*Cp_).ZB, row, 1536 + 8 * lane, t > 0, t < len - 1, mu, zs);
#pragma unroll
            for (int j = 0; j < 8; ++j) zs[j] = lane < 16 ? ftanh(zs[j]) : (lane < 32 ? zs[j] : fsigmoid(zs[j]));
            *(GAS u32x4*)((*Cp_).TW + (size_t)row * 384 + 8 * lane) = pack8f(zs); } }
}

DI void rw_prep(const LAS NaiveCtx* Cp_, long layer, int wv_) {
    const long j2 = layer / 2;
    const float* mu = (*Cp_).rw_mu + (size_t)j2 * RW_IN;
    const float *w0 = (*Cp_).rw_w0 + (size_t)j2 * 1024, *a0 = (*Cp_).rw_a0 + (size_t)j2 * 1024, *kkp = (*Cp_).rw_k_k + (size_t)j2 * 512, *kap = (*Cp_).rw_k_a + (size_t)j2 * 512, *rkp = (*Cp_).rw_r_k + (size_t)j2 * 512;
    TL_ROWS(row, 0, NT_) { TL_SEG(row, t, len); const bool hp = t > 0, hn = t < len - 1; const int c0 = 8 * lane;
        float r[8], k[8], v[8], tmp[8], kk[8], g[8];
        const bf16_t* lo = (*Cp_).LOB + (size_t)row * 2560;
        const u32x4 lwl0 = *(const GAS u32x4*)(lo + c0), lwl1 = *(const GAS u32x4*)(lo + 512 + c0), lal0 = *(const GAS u32x4*)(lo + 1024 + c0), lal1 = *(const GAS u32x4*)(lo + 1536 + c0), lg = *(const GAS u32x4*)(lo + 2048 + c0);
        shifted8b((*Cp_).ZB, row, c0, hp, hn, mu, r); shifted8b((*Cp_).ZB, row, 512 + c0, hp, hn, mu, k); shifted8b((*Cp_).ZB, row, 1024 + c0, hp, hn, mu, v);
        ld8f(kkp + c0, tmp); float ss = 0.f;
#pragma unroll
        for (int j = 0; j < 8; ++j) { kk[j] = k[j] * tmp[j]; ss += kk[j] * kk[j]; }
        ss += __shfl_xor(ss, 1); ss += __shfl_xor(ss, 2); ss += __shfl_xor(ss, 4);
        const float inv = 1.f / sqrtf(fmaxf(ss, 1e-24f));
#pragma unroll
        for (int j = 0; j < 8; ++j) { kk[j] *= inv; tmp[j] = -kk[j]; }
        *(GAS u32x4*)((*Cp_).RBh + (size_t)row * 512 + c0) = pack8f(r); *(GAS u32x4*)((*Cp_).VBh + (size_t)row * 512 + c0) = pack8f(v); *(GAS u32x4*)((*Cp_).NKh + (size_t)row * 512 + c0) = pack8f(tmp);
        *(GAS u32x4*)((*Cp_).GBh + (size_t)row * 512 + c0) = lg; (void)g;
        float ka[8], rk[8], bon = 0.f; ld8f(kap + c0, ka); ld8f(rkp + c0, rk);
#pragma unroll
        for (int d = 0; d < 2; ++d) { float wl[8], al[8], wb[8], ab[8], dec[8], kd[8], bb[8];
            up8b(d ? lwl1 : lwl0, wl); up8b(d ? lal1 : lal0, al); ld8f(w0 + d * 512 + c0, wb); ld8f(a0 + d * 512 + c0, ab);
#pragma unroll
            for (int j = 0; j < 8; ++j) { const float wpre = wb[j] + wl[j]; dec[j] = -1.4426950408889634f * fexp(-fsoftplus(-wpre) - 0.5f);     const float a = fsigmoid(ab[j] + al[j]);
                kd[j] = k[j] * (1.f + (a - 1.f) * ka[j]); bb[j] = kk[j] * a; bon += r[j] * kd[j] * rk[j]; }
            const size_t o = ((size_t)d * NT_ + row) * 512 + c0; st8f((*Cp_).DEC + o, dec); *(GAS u32x4*)((*Cp_).KDh + o) = pack8f(kd); *(GAS u32x4*)((*Cp_).BBh + o) = pack8f(bb); }
        bon += __shfl_xor(bon, 1); bon += __shfl_xor(bon, 2); bon += __shfl_xor(bon, 4);
        if ((lane & 7) == 0) (*Cp_).BON[(size_t)row * 8 + (lane >> 3)] = bon;
    }
}

DI void even_post(const LAS NaiveCtx* Cp_, long layer, int wv_) {
    const long j2 = layer / 2;
    const float *gng = (*Cp_).rw_gn_g + (size_t)j2 * 512, *gnb = (*Cp_).rw_gn_b + (size_t)j2 * 512, *hgn = (*Cp_).hg_norm_g + (size_t)j2 * 512;
    TL_ROWS(row, 0, NT_) { const int c0 = 8 * lane;
        const u32x4 eo0 = *(const GAS u32x4*)((*Cp_).OBh + (size_t)row * 512 + c0), eo1 = *(const GAS u32x4*)((*Cp_).OBh + ((size_t)NT_ + row) * 512 + c0), egz = *(const GAS u32x4*)((*Cp_).ZB + (size_t)row * 4608 + RW_IN + 2048 + c0);
        { float y[8], y1[8], a[8], b[8], v[8], g[8], o[8];
          const u32x4 ry = *(const GAS u32x4*)((*Cp_).YBh + (size_t)row * 512 + c0), ry1 = *(const GAS u32x4*)((*Cp_).YBh + ((size_t)NT_ + row) * 512 + c0), rv = *(const GAS u32x4*)((*Cp_).VBh + (size_t)row * 512 + c0), rg = *(const GAS u32x4*)((*Cp_).GBh + (size_t)row * 512 + c0);
          const float bon = ((const GAS float*)(*Cp_).BON)[(size_t)row * 8 + (lane >> 3)]; ld8f(gng + c0, a); ld8f(gnb + c0, b);
          up8b(ry, y); up8b(ry1, y1);
          float s = 0.f;
#pragma unroll
          for (int j = 0; j < 8; ++j) { y[j] += y1[j]; s += y[j]; }
          s += __shfl_xor(s, 1); s += __shfl_xor(s, 2); s += __shfl_xor(s, 4); const float mean = s * (1.f / 64.f); s = 0.f;
#pragma unroll
          for (int j = 0; j < 8; ++j) { y[j] -= mean; s += y[j] * y[j]; }
          s += __shfl_xor(s, 1); s += __shfl_xor(s, 2); s += __shfl_xor(s, 4); const float rs = 1.f / sqrtf(s * (1.f / 64.f) + 64e-5f);
          up8b(rv, v); up8b(rg, g);
#pragma unroll
          for (int j = 0; j < 8; ++j) o[j] = (y[j] * rs * a[j] + b[j] + bon * v[j]) * g[j];
          *(GAS u32x4*)((*Cp_).YCATB + (size_t)row * 1024 + c0) = pack8f(o); }
        { float o[8], t0[8], a[8], gz[8]; up8b(eo0, o); up8b(eo1, t0);
#pragma unroll
          for (int j = 0; j < 8; ++j) o[j] += t0[j];
          float s = 0.f;
#pragma unroll
          for (int j = 0; j < 8; ++j) s += o[j] * o[j];
          s += __shfl_xor(s, 1); s += __shfl_xor(s, 2); s += __shfl_xor(s, 4); s += __shfl_xor(s, 8); const float rs = 1.f / sqrtf(s * (1.f / 128.f) + 1e-6f);
          ld8f(hgn + c0, a); up8b(egz, gz);
#pragma unroll
          for (int j = 0; j < 8; ++j) o[j] = o[j] * rs * a[j] * fsilu(gz[j]);
          *(GAS u32x4*)((*Cp_).YCATB + (size_t)row * 1024 + 512 + c0) = pack8f(o); }
    }
}

DI void mla_prep(const LAS NaiveCtx* Cp_, long layer, int wv_) {
    const long j2 = layer / 2; const float* qng = (*Cp_).mla_q_norm_g + (size_t)j2 * MLA_QR; const float* kvng = (*Cp_).mla_kv_norm_g + (size_t)j2 * MLA_KVR;
    TL_ROWS(row, 0, NT_) { const GAS bf16_t* z = (const GAS bf16_t*)(*Cp_).Z + (size_t)row * 512;
        const u32x2 qw = *(const GAS u32x2*)(z + 4 * lane); const f32x4 q = (f32x4){bf_lo(qw.x), bf_hi(qw.x), bf_lo(qw.y), bf_hi(qw.y)};
        const unsigned kvw = *(const GAS unsigned*)(z + 256 + 2 * lane); const float kv0 = bf_lo(kvw), kv1 = bf_hi(kvw); const float x = lane < 32 ? bf_lo((unsigned)z[384 + lane]) : 0.f;
        const float rsq = 1.f / sqrtf(wsum(q[0] * q[0] + q[1] * q[1] + q[2] * q[2] + q[3] * q[3]) * (1.f / MLA_QR) + 1e-6f);
        const f32x4 gq = *(const GAS f32x4*)(qng + 4 * lane);
        *(GAS u32x2*)((*Cp_).QNB + (size_t)row * 256 + 4 * lane) = (u32x2){att::pk2(q[0] * rsq * gq[0], q[1] * rsq * gq[1]), att::pk2(q[2] * rsq * gq[2], q[3] * rsq * gq[3])};
        const float rskv = 1.f / sqrtf(wsum(kv0 * kv0 + kv1 * kv1) * (1.f / MLA_KVR) + 1e-6f);
        *(GAS unsigned*)((*Cp_).KVNB + (size_t)row * 256 + 2 * lane) = att::pk2(kv0 * rskv * kvng[2 * lane], kv1 * rskv * kvng[2 * lane + 1]);
        *(GAS unsigned*)((*Cp_).KVNB + (size_t)row * 256 + 128 + 2 * lane) = 0u;
        const float partner = __shfl_xor(x, 8); float outv = x; int b, t;
        if (row >= NC_) { const int s = (row - NC_) % SEQ; b = (row - NC_) / SEQ; t = CTX_LEN + s; const float pos = (float)((lane & 16) ? (s % GRID_W) : (s / GRID_W));
            const float ang = pos * exp2f(-(float)(lane & 7) * 1.6609640474436812f); const float cs = cosf(ang), sn = sinf(ang); outv = (lane & 8) ? x * cs + partner * sn : x * cs - partner * sn; }
        else { b = row / CTX_LEN; t = row % CTX_LEN; }
        (void)b; (void)t; if (lane < 32) (*Cp_).KPEB[(size_t)row * 32 + lane] = f2bf(outv);
    }
}
DI void rope_table(const LAS NaiveCtx* Cp_, int wv_) {
    GRID_STRIDE_WAVES(i, (long)SEQ * 16) { const int s = (int)(i >> 4), q = (int)(i & 15); const float pos = (float)((q & 8) ? (s % GRID_W) : (s / GRID_W)); const float ang = pos * exp2f(-(float)(q & 7) * 1.6609640474436812f);
        (*Cp_).ROPE[(size_t)s * 32 + (q & 8) * 2 + (q & 7)] = cosf(ang); (*Cp_).ROPE[(size_t)s * 32 + (q & 8) * 2 + 8 + (q & 7)] = sinf(ang); }
}
DI void rope_q(const LAS NaiveCtx* Cp_, int wv_) {
    GRID_STRIDE_WAVES(i, (long)NL_ * MLA_HEADS) { const int h = (int)(i % MLA_HEADS); const long lr = i / MLA_HEADS; const int s = (int)(lr % SEQ);
        bf16_t* p = (*Cp_).QB + (size_t)(NC_ + lr) * (MLA_HEADS * 96) + h * 96 + 64; const float* tab = (*Cp_).ROPE + (size_t)s * 32;
        float r1[8], r2[8], c1[8], c2[8], cr[8], sr[8], cc[8], sc[8], o[8];
        ld8b(p, r1); ld8b(p + 8, r2); ld8b(p + 16, c1); ld8b(p + 24, c2); ld8f(tab, cr); ld8f(tab + 8, sr); ld8f(tab + 16, cc); ld8f(tab + 24, sc);
#pragma unroll
        for (int j = 0; j < 8; ++j) o[j] = r1[j] * cr[j] - r2[j] * sr[j];
        *(GAS u32x4*)p = pack8f(o);
#pragma unroll
        for (int j = 0; j < 8; ++j) o[j] = r2[j] * cr[j] + r1[j] * sr[j];
        *(GAS u32x4*)(p + 8) = pack8f(o);
#pragma unroll
        for (int j = 0; j < 8; ++j) o[j] = c1[j] * cc[j] - c2[j] * sc[j];
        *(GAS u32x4*)(p + 16) = pack8f(o);
#pragma unroll
        for (int j = 0; j < 8; ++j) o[j] = c2[j] * cc[j] + c1[j] * sc[j];
        *(GAS u32x4*)(p + 24) = pack8f(o); }
}
DI void lora_weights(const LAS NaiveCtx* Cp_, int wv_) {
    GRID_STRIDE_WAVES(i, (long)N_EVEN * 2560 * 384) { const int k = (int)(i % 384); const long t = i / 384; const int n = (int)(t % 2560), j = (int)(t / 2560); const int blk = n >> 9, c = n & 511; float v = 0.f;
        if (blk < 2) { if (k >= blk * 64 && k < blk * 64 + 64) v = (*Cp_).rw_w2[(((size_t)j * 2 + blk) * 64 + (k - blk * 64)) * 512 + c]; }
        else if (blk < 4) { const int d = blk - 2; if (k >= 128 + d * 64 && k < 128 + d * 64 + 64) v = (*Cp_).rw_a2[(((size_t)j * 2 + d) * 64 + (k - 128 - d * 64)) * 512 + c]; }
        else { if (k >= 256) v = (*Cp_).rw_g2[((size_t)j * 128 + (k - 256)) * 512 + c]; }
        (*Cp_).Wlora[i] = f2bf(v); }
}
}

namespace scan {
#ifndef SC_L32_PERM
#define SC_L32_PERM 1
#endif
#ifndef SC_L16_PERM
#define SC_L16_PERM 1
#endif
#ifndef SC_L8_DPP
#define SC_L8_DPP 1
#endif
#define SC_DPP(x, CTRL) __builtin_bit_cast(float, __builtin_amdgcn_update_dpp(0, __builtin_bit_cast(int, (x)), (CTRL), 0xF, 0xF, true))
DI float swap32_sum(float a, float b) { asm volatile("s_nop 1\n\tv_permlane32_swap_b32 %0, %1" : "+v"(a), "+v"(b)); return a + b; }
DI float swap16_sum(float a, float b) { asm volatile("s_nop 1\n\tv_permlane16_swap_b32 %0, %1" : "+v"(a), "+v"(b)); return a + b; }
DI float reduce8(const float (&x)[8], int lane) {
    float y0, y1, y2, y3, z0, z1, w;
#if SC_L32_PERM
    y0 = swap32_sum(x[0], x[4]); y1 = swap32_sum(x[1], x[5]); y2 = swap32_sum(x[2], x[6]); y3 = swap32_sum(x[3], x[7]);
#else
    { const bool up = (lane & 32) != 0;
      y0 = (up ? x[4] : x[0]) + __shfl_xor(up ? x[0] : x[4], 32); y1 = (up ? x[5] : x[1]) + __shfl_xor(up ? x[1] : x[5], 32);
      y2 = (up ? x[6] : x[2]) + __shfl_xor(up ? x[2] : x[6], 32); y3 = (up ? x[7] : x[3]) + __shfl_xor(up ? x[3] : x[7], 32); }
#endif
#if SC_L16_PERM
    z0 = swap16_sum(y0, y2); z1 = swap16_sum(y1, y3);
#else
    { const bool up = (lane & 16) != 0; z0 = (up ? y2 : y0) + __shfl_xor(up ? y0 : y2, 16); z1 = (up ? y3 : y1) + __shfl_xor(up ? y1 : y3, 16); }
#endif
    { const bool b3 = (lane & 8) != 0; const float keep = b3 ? z1 : z0, send = b3 ? z0 : z1;
#if SC_L8_DPP
      w = keep + SC_DPP(send, 0x128);
      w += SC_DPP(w, 0x141);
      w += SC_DPP(w, 0x4E);
      w += SC_DPP(w, 0xB1);
#else
      w = keep + __shfl_xor(send, 8); w += __shfl_xor(w, 4); w += __shfl_xor(w, 2); w += __shfl_xor(w, 1);
#endif
    }
    return w;
}
constexpr int TB = 32, STEP_F = 384, BUF_F = TB * STEP_F;

DI void rwkv_scan(const LAS NaiveCtx* Cp_, LAS unsigned char* lds, int wv_) {
    const int tid = otid(wv_), lane = tid & 63, wid = tid >> 6;
    LAS float* ldsf = (LAS float*)lds; LAS float* ybuf = ldsf + 2 * BUF_F;
    for (int chain = opaque_bid(); chain < 2 * BATCH * RW_HEADS; chain += gridDim.x) {
        const int d = chain / (BATCH * RW_HEADS), b = (chain / RW_HEADS) % BATCH, h = chain % RW_HEADS;
        const float* pA = (*Cp_).NKK + h * 64; const float* pW = (*Cp_).DEC + (size_t)d * NT_ * 512 + h * 64; const float* pB = (*Cp_).BB + (size_t)d * NT_ * 512 + h * 64;
        const float* pK = (*Cp_).KD + (size_t)d * NT_ * 512 + h * 64; const float* pR = (*Cp_).R + h * 64; const float* pV = (*Cp_).V + h * 64;
        float* pY = (*Cp_).Y + (size_t)d * NT_ * 512 + h * 64;
        float S[8];
#pragma unroll
        for (int j = 0; j < 8; ++j) S[j] = 0.f;
        f32x4 st[6];
#define SC_LOAD(T0) do { _Pragma("unroll") for (int q = 0; q < 6; ++q) { const int idx = tid + 512 * q, i = idx / 96, rem = idx % 96, arr = rem >> 4, part = rem & 15; \
            const size_t row = (size_t)tokrow(b, scan_pos(d, (T0) + i)); const float* src = arr == 0 ? pA : arr == 1 ? pW : arr == 2 ? pB : arr == 3 ? pK : arr == 4 ? pR : pV; \
            st[q] = *(const f32x4*)(src + row * 512 + part * 4); } } while (0)
#define SC_STORE(BUFI) do { _Pragma("unroll") for (int q = 0; q < 6; ++q) { const int idx = tid + 512 * q, i = idx / 96, rem = idx % 96; *(LAS f32x4*)(ldsf + (BUFI) * BUF_F + i * STEP_F + rem * 4) = st[q]; } } while (0)
        SC_LOAD(0); SC_STORE(0);
        __syncthreads();
        constexpr int NB = TT_ / TB;
        for (int blk = 0; blk < NB; ++blk) {
            if (blk + 1 < NB) SC_LOAD((blk + 1) * TB);
            const LAS float* buf = ldsf + (blk & 1) * BUF_F;
#pragma unroll 2
            for (int i = 0; i < TB; ++i) { const LAS float* sp = buf + i * STEP_F;
                const float a = sp[lane], w = sp[64 + lane], bb = sp[128 + lane], kd = sp[192 + lane], r = sp[256 + lane];
                const f32x4 v0 = *(const LAS f32x4*)(sp + 320 + 8 * wid), v1 = *(const LAS f32x4*)(sp + 324 + 8 * wid);
                float p[8];
#pragma unroll
                for (int j = 0; j < 8; ++j) p[j] = S[j] * a;
                const float wsa = reduce8(p, lane);
#pragma unroll
                for (int j = 0; j < 8; ++j) { const float sa = __builtin_bit_cast(float, __builtin_amdgcn_readlane(__builtin_bit_cast(int, wsa), 8 * j)); const float vv = j < 4 ? v0[j & 3] : v1[j & 3];
                    S[j] = S[j] * w + sa * bb + vv * kd; p[j] = S[j] * r; }
                const float wy = reduce8(p, lane);
                if ((lane & 7) == 0) ybuf[i * 64 + 8 * wid + (lane >> 3)] = wy; }
            __syncthreads();
            { const int i = tid >> 4, v4 = (tid & 15) * 4; const size_t row = (size_t)tokrow(b, scan_pos(d, blk * TB + i)); *(f32x4*)(pY + row * 512 + v4) = *(const LAS f32x4*)(ybuf + i * 64 + v4); }
            if (blk + 1 < NB) SC_STORE((blk + 1) & 1);
            __syncthreads();
        }
#undef SC_LOAD
#undef SC_STORE
    }
}
}

namespace hg {
typedef short s16x4 __attribute__((ext_vector_type(4)));
constexpr int RS = 272, RS2 = 40;
constexpr int OFF_QT = 0, OFF_KT = OFF_QT + 16 * RS, OFF_KH = OFF_KT + 16 * RS, OFF_VT = OFF_KH + 128 * RS2, OFF_ST = OFF_VT + 64 * RS2, OFF_P = OFF_ST + 2 * 64 * RS, OFF_GS = OFF_P + 512, OFF_SC = OFF_GS + 2048, OFF_V32 = OFF_SC + 4 * 16 * 80, HG_LDS = OFF_V32 + 64 * 80;
#define HG_MFMA16(a, b, c) __builtin_amdgcn_mfma_f32_16x16x16bf16_1k((a), (b), (c), 0, 0, 0)
#define HG_MFMA32(a, b, c) __builtin_amdgcn_mfma_f32_16x16x32_bf16((a), (b), (c), 0, 0, 0)
DI unsigned short bfr(float x) { return (unsigned short)(att::pk2(x, 0.f) & 0xffffu); }

DI void hgrn_scan(const LAS NaiveCtx* Cp_, LAS unsigned char* lds, long layer, int wv_) {
    const int tid = otid(wv_), lane = tid & 63, wid = tid >> 6, l15 = lane & 15, g = lane >> 4;
    const int k = tid & 127, tq = tid >> 7;
    LAS float* gsum = (LAS float*)(lds + OFF_GS); LAS float* p15 = (LAS float*)(lds + OFF_P);
    for (int unit = opaque_bid(); unit < 2 * BATCH * HG_HEADS * 2; unit += gridDim.x) {
        const int vh = unit & 1, h = (unit >> 1) % HG_HEADS, b = (unit / (2 * HG_HEADS)) % BATCH, d = unit / (2 * HG_HEADS * BATCH);
        const GAS bf16_t* pF = (const GAS bf16_t*)((*Cp_).ZB + RW_IN + 512 + d * 512 + h * 128 + k); const GAS bf16_t* pQ = (const GAS bf16_t*)((*Cp_).ZB + RW_IN + h * 128 + k);
        const GAS bf16_t* pV = (const GAS bf16_t*)((*Cp_).ZB + RW_IN + 1536 + h * 128 + vh * 64 + (tid & 15) * 4);
        float lower;
        { const long j2 = layer / 2; float mx = -1e30f;
#pragma unroll
          for (int qq = 0; qq < N_EVEN; ++qq) mx = fmaxf(mx, (*Cp_).hg_lb[((size_t)qq * 2 + d) * 512 + h * 128 + k]);
          float den = 0.f, num = 0.f;
#pragma unroll
          for (int qq = 0; qq < N_EVEN; ++qq) { const float e = fexp((*Cp_).hg_lb[((size_t)qq * 2 + d) * 512 + h * 128 + k] - mx); den += e; if (qq >= 1 && qq <= j2) num += e; }
          lower = num / den; }
        GAS bf16_t* pO = (GAS bf16_t*)((*Cp_).OBh + (size_t)d * NT_ * 512 + h * 128 + vh * 64);
        f32x4 acc[4];
#pragma unroll
        for (int n = 0; n < 4; ++n) acc[n] = (f32x4){0.f, 0.f, 0.f, 0.f};
        for (int i = tid; i < 64 * RS / 4; i += PB_THREADS) ((LAS unsigned*)(lds + OFF_ST))[i] = 0u;
        for (int i = tid; i < (4 * 16 * 80) / 4; i += PB_THREADS) ((LAS unsigned*)(lds + OFF_SC))[i] = 0u;
        unsigned fX[4][4], qX[4][4]; u32x2 vX[4];
        vX[0] = (u32x2){0u, 0u}; vX[1] = vX[0]; vX[2] = vX[0]; vX[3] = vX[0];
#define HG_ROWBASE(C0, rb) long rb; { const int i0_ = (C0) * 16; if (i0_ < CTX_LEN) rb = (long)b * CTX_LEN + (d ? CTX_LEN - 1 - i0_ : i0_); else rb = (long)NC_ + (long)b * SEQ + (d ? SEQ - 1 - (i0_ - CTX_LEN) : (i0_ - CTX_LEN)); }
#define HG_LOAD(C0, S) do { HG_ROWBASE(C0, rb_) const long sg_ = d ? -1 : 1; _Pragma("unroll") for (int i = 0; i < 4; ++i) { const long row = rb_ + sg_ * (4 * tq + i); fX[S][i] = pF[row * 4608]; qX[S][i] = pQ[row * 4608]; } \
            if (tid < 256) { const long row = rb_ + sg_ * (tid >> 4); vX[S] = *(const GAS u32x2*)(pV + row * 4608); } } while (0)
        HG_LOAD(0, 0); HG_LOAD(1, 1); HG_LOAD(2, 2); HG_LOAD(3, 3);
        constexpr int NCH = TT_ / 16;
        static_assert(NCH % 4 == 0, "chunks per trip");
        for (int c4 = 0; c4 < NCH; c4 += 4) {
            { const int c = c4 + 0;

            float f[4], kin[4], q[4], cum[4];
#pragma unroll
            for (int i = 0; i < 4; ++i) { const float sg = fsigmoid(bf_lo(fX[0][i])); f[i] = fmaxf(lower + (1.f - lower) * sg, 1e-30f); kin[i] = (1.f - lower) * (1.f - sg); q[i] = fsilu(bf_lo(qX[0][i])); }
            const f32x4 val = (f32x4){bf_lo(vX[0].x), bf_hi(vX[0].x), bf_lo(vX[0].y), bf_hi(vX[0].y)};
            cum[0] = flog2(f[0]); cum[1] = cum[0] + flog2(f[1]); cum[2] = cum[1] + flog2(f[2]); cum[3] = cum[2] + flog2(f[3]);
            gsum[tq * 128 + k] = cum[3];
            lds_barrier();
            { const float g0 = gsum[k], g1 = gsum[128 + k], g2 = gsum[256 + k], g3 = gsum[384 + k];
              const float base = tq == 0 ? 0.f : tq == 1 ? g0 : tq == 2 ? g0 + g1 : g0 + g1 + g2, tot = g0 + g1 + g2 + g3;
              float kh[4];
#pragma unroll
              for (int i = 0; i < 4; ++i) { const float cu = base + cum[i]; const int t = 4 * tq + i;
                  *(LAS unsigned short*)(lds + OFF_QT + t * RS + 2 * k) = bfr(q[i] * fexp2(cu));
                  *(LAS unsigned short*)(lds + OFF_KT + t * RS + 2 * k) = bfr(kin[i] * fexp2(fminf(-cu, 115.f)));
                  kh[i] = kin[i] * fexp2(tot - cu); }
              *(LAS u32x2*)(lds + OFF_KH + k * RS2 + 8 * tq) = (u32x2){att::pk2(kh[0], kh[1]), att::pk2(kh[2], kh[3])};
              if (tq == 0) p15[k] = fexp2(tot);
              if (tid < 256) { const int t = tid >> 4, v4 = (tid & 15) * 4;
#pragma unroll
                  for (int j = 0; j < 4; ++j) { const unsigned short hv = bfr(val[j]); *(LAS unsigned short*)(lds + OFF_VT + (v4 + j) * RS2 + 2 * t) = hv; } } }
            if (c + 4 < NCH) HG_LOAD(c + 4, 0);
            lds_barrier();
            const LAS unsigned char* stc = lds + OFF_ST + (c & 1) * 64 * RS; LAS unsigned char* stn = lds + OFF_ST + ((c + 1) & 1) * 64 * RS;
            if (wid < 4) {
                f32x4 sc = (f32x4){0.f, 0.f, 0.f, 0.f};
#pragma unroll
                for (int kk = 0; kk < 4; ++kk) { const bf16x8 a = *(const LAS bf16x8*)(lds + OFF_KT + l15 * RS + (32 * kk + 8 * g) * 2), bq = *(const LAS bf16x8*)(lds + OFF_QT + l15 * RS + (32 * kk + 8 * g) * 2); sc = HG_MFMA32(a, bq, sc); }
#pragma unroll
                for (int r = 0; r < 4; ++r) if (4 * g + r > l15) sc[r] = 0.f;
                const u32x2 pk = (u32x2){att::pk2(sc[0], sc[1]), att::pk2(sc[2], sc[3])};
                f32x4 o = (f32x4){0.f, 0.f, 0.f, 0.f};
                { LAS unsigned char* scw = lds + OFF_SC + wid * 16 * 80;
                  *(LAS u32x2*)(scw + l15 * 80 + 8 * g) = pk;
                  const bf16x8 sb = *(const LAS bf16x8*)(scw + l15 * 80 + 16 * g); bf16x8 va = (bf16x8){0, 0, 0, 0, 0, 0, 0, 0};
                  if (g < 2) { const LAS unsigned char* vp_ = lds + OFF_VT + (16 * wid + l15) * RS2 + 16 * g; const s16x4 lo_ = *(const LAS s16x4*)vp_, hi_ = *(const LAS s16x4*)(vp_ + 8); va = __builtin_shufflevector(lo_, hi_, 0, 1, 2, 3, 4, 5, 6, 7); }
                  o = HG_MFMA32(va, sb, o); }
#pragma unroll
                for (int kk = 0; kk < 4; ++kk) { const bf16x8 a = *(const LAS bf16x8*)(stc + (16 * wid + l15) * RS + (32 * kk + 8 * g) * 2), bq = *(const LAS bf16x8*)(lds + OFF_QT + l15 * RS + (32 * kk + 8 * g) * 2); o = HG_MFMA32(a, bq, o); }
                { HG_ROWBASE(c, rbo_) const long row = rbo_ + (d ? -l15 : l15); *(GAS u32x2*)(pO + row * 512 + 16 * wid + 4 * g) = (u32x2){att::pk2(o[0], o[1]), att::pk2(o[2], o[3])}; }
            }
            { const f32x4 pd = *(const LAS f32x4*)(p15 + 16 * wid + 4 * g); const s16x4 ka = *(const LAS s16x4*)(lds + OFF_KH + (16 * wid + l15) * RS2 + 8 * g);
#pragma unroll
              for (int n = 0; n < 4; ++n) { const s16x4 vb = *(const LAS s16x4*)(lds + OFF_VT + (16 * n + l15) * RS2 + 8 * g);
                  acc[n] = HG_MFMA16(ka, vb, acc[n] * pd);
                  *(LAS u32x2*)(stn + (16 * n + l15) * RS + (16 * wid + 4 * g) * 2) = (u32x2){att::pk2(acc[n][0], acc[n][1]), att::pk2(acc[n][2], acc[n][3])}; } }
                    }
            { const int c = c4 + 1;

            float f[4], kin[4], q[4], cum[4];
#pragma unroll
            for (int i = 0; i < 4; ++i) { const float sg = fsigmoid(bf_lo(fX[1][i])); f[i] = fmaxf(lower + (1.f - lower) * sg, 1e-30f); kin[i] = (1.f - lower) * (1.f - sg); q[i] = fsilu(bf_lo(qX[1][i])); }
            const f32x4 val = (f32x4){bf_lo(vX[1].x), bf_hi(vX[1].x), bf_lo(vX[1].y), bf_hi(vX[1].y)};
            cum[0] = flog2(f[0]); cum[1] = cum[0] + flog2(f[1]); cum[2] = cum[1] + flog2(f[2]); cum[3] = cum[2] + flog2(f[3]);
            gsum[tq * 128 + k] = cum[3];
            lds_barrier();
            { const float g0 = gsum[k], g1 = gsum[128 + k], g2 = gsum[256 + k], g3 = gsum[384 + k];
              const float base = tq == 0 ? 0.f : tq == 1 ? g0 : tq == 2 ? g0 + g1 : g0 + g1 + g2, tot = g0 + g1 + g2 + g3;
              float kh[4];
#pragma unroll
              for (int i = 0; i < 4; ++i) { const float cu = base + cum[i]; const int t = 4 * tq + i;
                  *(LAS unsigned short*)(lds + OFF_QT + t * RS + 2 * k) = bfr(q[i] * fexp2(cu));
                  *(LAS unsigned short*)(lds + OFF_KT + t * RS + 2 * k) = bfr(kin[i] * fexp2(fminf(-cu, 115.f)));
                  kh[i] = kin[i] * fexp2(tot - cu); }
              *(LAS u32x2*)(lds + OFF_KH + k * RS2 + 8 * tq) = (u32x2){att::pk2(kh[0], kh[1]), att::pk2(kh[2], kh[3])};
              if (tq == 0) p15[k] = fexp2(tot);
              if (tid < 256) { const int t = tid >> 4, v4 = (tid & 15) * 4;
#pragma unroll
                  for (int j = 0; j < 4; ++j) { const unsigned short hv = bfr(val[j]); *(LAS unsigned short*)(lds + OFF_VT + (v4 + j) * RS2 + 2 * t) = hv; } } }
            if (c + 4 < NCH) HG_LOAD(c + 4, 1);
            lds_barrier();
            const LAS unsigned char* stc = lds + OFF_ST + (c & 1) * 64 * RS; LAS unsigned char* stn = lds + OFF_ST + ((c + 1) & 1) * 64 * RS;
            if (wid < 4) {
                f32x4 sc = (f32x4){0.f, 0.f, 0.f, 0.f};
#pragma unroll
                for (int kk = 0; kk < 4; ++kk) { const bf16x8 a = *(const LAS bf16x8*)(lds + OFF_KT + l15 * RS + (32 * kk + 8 * g) * 2), bq = *(const LAS bf16x8*)(lds + OFF_QT + l15 * RS + (32 * kk + 8 * g) * 2); sc = HG_MFMA32(a, bq, sc); }
#pragma unroll
                for (int r = 0; r < 4; ++r) if (4 * g + r > l15) sc[r] = 0.f;
                const u32x2 pk = (u32x2){att::pk2(sc[0], sc[1]), att::pk2(sc[2], sc[3])};
                f32x4 o = (f32x4){0.f, 0.f, 0.f, 0.f};
                { LAS unsigned char* scw = lds + OFF_SC + wid * 16 * 80;
                  *(LAS u32x2*)(scw + l15 * 80 + 8 * g) = pk;
                  const bf16x8 sb = *(const LAS bf16x8*)(scw + l15 * 80 + 16 * g); bf16x8 va = (bf16x8){0, 0, 0, 0, 0, 0, 0, 0};
                  if (g < 2) { const LAS unsigned char* vp_ = lds + OFF_VT + (16 * wid + l15) * RS2 + 16 * g; const s16x4 lo_ = *(const LAS s16x4*)vp_, hi_ = *(const LAS s16x4*)(vp_ + 8); va = __builtin_shufflevector(lo_, hi_, 0, 1, 2, 3, 4, 5, 6, 7); }
                  o = HG_MFMA32(va, sb, o); }
#pragma unroll
                for (int kk = 0; kk < 4; ++kk) { const bf16x8 a = *(const LAS bf16x8*)(stc + (16 * wid + l15) * RS + (32 * kk + 8 * g) * 2), bq = *(const LAS bf16x8*)(lds + OFF_QT + l15 * RS + (32 * kk + 8 * g) * 2); o = HG_MFMA32(a, bq, o); }
                { HG_ROWBASE(c, rbo_) const long row = rbo_ + (d ? -l15 : l15); *(GAS u32x2*)(pO + row * 512 + 16 * wid + 4 * g) = (u32x2){att::pk2(o[0], o[1]), att::pk2(o[2], o[3])}; }
            }
            { const f32x4 pd = *(const LAS f32x4*)(p15 + 16 * wid + 4 * g); const s16x4 ka = *(const LAS s16x4*)(lds + OFF_KH + (16 * wid + l15) * RS2 + 8 * g);
#pragma unroll
              for (int n = 0; n < 4; ++n) { const s16x4 vb = *(const LAS s16x4*)(lds + OFF_VT + (16 * n + l15) * RS2 + 8 * g);
                  acc[n] = HG_MFMA16(ka, vb, acc[n] * pd);
                  *(LAS u32x2*)(stn + (16 * n + l15) * RS + (16 * wid + 4 * g) * 2) = (u32x2){att::pk2(acc[n][0], acc[n][1]), att::pk2(acc[n][2], acc[n][3])}; } }
                    }
            { const int c = c4 + 2;

            float f[4], kin[4], q[4], cum[4];
#pragma unroll
            for (int i = 0; i < 4; ++i) { const float sg = fsigmoid(bf_lo(fX[2][i])); f[i] = fmaxf(lower + (1.f - lower) * sg, 1e-30f); kin[i] = (1.f - lower) * (1.f - sg); q[i] = fsilu(bf_lo(qX[2][i])); }
            const f32x4 val = (f32x4){bf_lo(vX[2].x), bf_hi(vX[2].x), bf_lo(vX[2].y), bf_hi(vX[2].y)};
            cum[0] = flog2(f[0]); cum[1] = cum[0] + flog2(f[1]); cum[2] = cum[1] + flog2(f[2]); cum[3] = cum[2] + flog2(f[3]);
            gsum[tq * 128 + k] = cum[3];
            lds_barrier();
            { const float g0 = gsum[k], g1 = gsum[128 + k], g2 = gsum[256 + k], g3 = gsum[384 + k];
              const float base = tq == 0 ? 0.f : tq == 1 ? g0 : tq == 2 ? g0 + g1 : g0 + g1 + g2, tot = g0 + g1 + g2 + g3;
              float kh[4];
#pragma unroll
              for (int i = 0; i < 4; ++i) { const float cu = base + cum[i]; const int t = 4 * tq + i;
                  *(LAS unsigned short*)(lds + OFF_QT + t * RS + 2 * k) = bfr(q[i] * fexp2(cu));
                  *(LAS unsigned short*)(lds + OFF_KT + t * RS + 2 * k) = bfr(kin[i] * fexp2(fminf(-cu, 115.f)));
                  kh[i] = kin[i] * fexp2(tot - cu); }
              *(LAS u32x2*)(lds + OFF_KH + k * RS2 + 8 * tq) = (u32x2){att::pk2(kh[0], kh[1]), att::pk2(kh[2], kh[3])};
              if (tq == 0) p15[k] = fexp2(tot);
              if (tid < 256) { const int t = tid >> 4, v4 = (tid & 15) * 4;
#pragma unroll
                  for (int j = 0; j < 4; ++j) { const unsigned short hv = bfr(val[j]); *(LAS unsigned short*)(lds + OFF_VT + (v4 + j) * RS2 + 2 * t) = hv; } } }
            if (c + 4 < NCH) HG_LOAD(c + 4, 2);
            lds_barrier();
            const LAS unsigned char* stc = lds + OFF_ST + (c & 1) * 64 * RS; LAS unsigned char* stn = lds + OFF_ST + ((c + 1) & 1) * 64 * RS;
            if (wid < 4) {
                f32x4 sc = (f32x4){0.f, 0.f, 0.f, 0.f};
#pragma unroll
                for (int kk = 0; kk < 4; ++kk) { const bf16x8 a = *(const LAS bf16x8*)(lds + OFF_KT + l15 * RS + (32 * kk + 8 * g) * 2), bq = *(const LAS bf16x8*)(lds + OFF_QT + l15 * RS + (32 * kk + 8 * g) * 2); sc = HG_MFMA32(a, bq, sc); }
#pragma unroll
                for (int r = 0; r < 4; ++r) if (4 * g + r > l15) sc[r] = 0.f;
                const u32x2 pk = (u32x2){att::pk2(sc[0], sc[1]), att::pk2(sc[2], sc[3])};
                f32x4 o = (f32x4){0.f, 0.f, 0.f, 0.f};
                { LAS unsigned char* scw = lds + OFF_SC + wid * 16 * 80;
                  *(LAS u32x2*)(scw + l15 * 80 + 8 * g) = pk;
                  const bf16x8 sb = *(const LAS bf16x8*)(scw + l15 * 80 + 16 * g); bf16x8 va = (bf16x8){0, 0, 0, 0, 0, 0, 0, 0};
                  if (g < 2) { const LAS unsigned char* vp_ = lds + OFF_VT + (16 * wid + l15) * RS2 + 16 * g; const s16x4 lo_ = *(const LAS s16x4*)vp_, hi_ = *(const LAS s16x4*)(vp_ + 8); va = __builtin_shufflevector(lo_, hi_, 0, 1, 2, 3, 4, 5, 6, 7); }
                  o = HG_MFMA32(va, sb, o); }
#pragma unroll
                for (int kk = 0; kk < 4; ++kk) { const bf16x8 a = *(const LAS bf16x8*)(stc + (16 * wid + l15) * RS + (32 * kk + 8 * g) * 2), bq = *(const LAS bf16x8*)(lds + OFF_QT + l15 * RS + (32 * kk + 8 * g) * 2); o = HG_MFMA32(a, bq, o); }
                { HG_ROWBASE(c, rbo_) const long row = rbo_ + (d ? -l15 : l15); *(GAS u32x2*)(pO + row * 512 + 16 * wid + 4 * g) = (u32x2){att::pk2(o[0], o[1]), att::pk2(o[2], o[3])}; }
            }
            { const f32x4 pd = *(const LAS f32x4*)(p15 + 16 * wid + 4 * g); const s16x4 ka = *(const LAS s16x4*)(lds + OFF_KH + (16 * wid + l15) * RS2 + 8 * g);
#pragma unroll
              for (int n = 0; n < 4; ++n) { const s16x4 vb = *(const LAS s16x4*)(lds + OFF_VT + (16 * n + l15) * RS2 + 8 * g);
                  acc[n] = HG_MFMA16(ka, vb, acc[n] * pd);
                  *(LAS u32x2*)(stn + (16 * n + l15) * RS + (16 * wid + 4 * g) * 2) = (u32x2){att::pk2(acc[n][0], acc[n][1]), att::pk2(acc[n][2], acc[n][3])}; } }
                    }
            { const int c = c4 + 3;

            float f[4], kin[4], q[4], cum[4];
#pragma unroll
            for (int i = 0; i < 4; ++i) { const float sg = fsigmoid(bf_lo(fX[3][i])); f[i] = fmaxf(lower + (1.f - lower) * sg, 1e-30f); kin[i] = (1.f - lower) * (1.f - sg); q[i] = fsilu(bf_lo(qX[3][i])); }
            const f32x4 val = (f32x4){bf_lo(vX[3].x), bf_hi(vX[3].x), bf_lo(vX[3].y), bf_hi(vX[3].y)};
            cum[0] = flog2(f[0]); cum[1] = cum[0] + flog2(f[1]); cum[2] = cum[1] + flog2(f[2]); cum[3] = cum[2] + flog2(f[3]);
            gsum[tq * 128 + k] = cum[3];
            lds_barrier();
            { const float g0 = gsum[k], g1 = gsum[128 + k], g2 = gsum[256 + k], g3 = gsum[384 + k];
              const float base = tq == 0 ? 0.f : tq == 1 ? g0 : tq == 2 ? g0 + g1 : g0 + g1 + g2, tot = g0 + g1 + g2 + g3;
              float kh[4];
#pragma unroll
              for (int i = 0; i < 4; ++i) { const float cu = base + cum[i]; const int t = 4 * tq + i;
                  *(LAS unsigned short*)(lds + OFF_QT + t * RS + 2 * k) = bfr(q[i] * fexp2(cu));
                  *(LAS unsigned short*)(lds + OFF_KT + t * RS + 2 * k) = bfr(kin[i] * fexp2(fminf(-cu, 115.f)));
                  kh[i] = kin[i] * fexp2(tot - cu); }
              *(LAS u32x2*)(lds + OFF_KH + k * RS2 + 8 * tq) = (u32x2){att::pk2(kh[0], kh[1]), att::pk2(kh[2], kh[3])};
              if (tq == 0) p15[k] = fexp2(tot);
              if (tid < 256) { const int t = tid >> 4, v4 = (tid & 15) * 4;
#pragma unroll
                  for (int j = 0; j < 4; ++j) { const unsigned short hv = bfr(val[j]); *(LAS unsigned short*)(lds + OFF_VT + (v4 + j) * RS2 + 2 * t) = hv; } } }
            if (c + 4 < NCH) HG_LOAD(c + 4, 3);
            lds_barrier();
            const LAS unsigned char* stc = lds + OFF_ST + (c & 1) * 64 * RS; LAS unsigned char* stn = lds + OFF_ST + ((c + 1) & 1) * 64 * RS;
            if (wid < 4) {
                f32x4 sc = (f32x4){0.f, 0.f, 0.f, 0.f};
#pragma unroll
                for (int kk = 0; kk < 4; ++kk) { const bf16x8 a = *(const LAS bf16x8*)(lds + OFF_KT + l15 * RS + (32 * kk + 8 * g) * 2), bq = *(const LAS bf16x8*)(lds + OFF_QT + l15 * RS + (32 * kk + 8 * g) * 2); sc = HG_MFMA32(a, bq, sc); }
#pragma unroll
                for (int r = 0; r < 4; ++r) if (4 * g + r > l15) sc[r] = 0.f;
                const u32x2 pk = (u32x2){att::pk2(sc[0], sc[1]), att::pk2(sc[2], sc[3])};
                f32x4 o = (f32x4){0.f, 0.f, 0.f, 0.f};
                { LAS unsigned char* scw = lds + OFF_SC + wid * 16 * 80;
                  *(LAS u32x2*)(scw + l15 * 80 + 8 * g) = pk;
                  const bf16x8 sb = *(const LAS bf16x8*)(scw + l15 * 80 + 16 * g); bf16x8 va = (bf16x8){0, 0, 0, 0, 0, 0, 0, 0};
                  if (g < 2) { const LAS unsigned char* vp_ = lds + OFF_VT + (16 * wid + l15) * RS2 + 16 * g; const s16x4 lo_ = *(const LAS s16x4*)vp_, hi_ = *(const LAS s16x4*)(vp_ + 8); va = __builtin_shufflevector(lo_, hi_, 0, 1, 2, 3, 4, 5, 6, 7); }
                  o = HG_MFMA32(va, sb, o); }
#pragma unroll
                for (int kk = 0; kk < 4; ++kk) { const bf16x8 a = *(const LAS bf16x8*)(stc + (16 * wid + l15) * RS + (32 * kk + 8 * g) * 2), bq = *(const LAS bf16x8*)(lds + OFF_QT + l15 * RS + (32 * kk + 8 * g) * 2); o = HG_MFMA32(a, bq, o); }
                { HG_ROWBASE(c, rbo_) const long row = rbo_ + (d ? -l15 : l15); *(GAS u32x2*)(pO + row * 512 + 16 * wid + 4 * g) = (u32x2){att::pk2(o[0], o[1]), att::pk2(o[2], o[3])}; }
            }
            { const f32x4 pd = *(const LAS f32x4*)(p15 + 16 * wid + 4 * g); const s16x4 ka = *(const LAS s16x4*)(lds + OFF_KH + (16 * wid + l15) * RS2 + 8 * g);
#pragma unroll
              for (int n = 0; n < 4; ++n) { const s16x4 vb = *(const LAS s16x4*)(lds + OFF_VT + (16 * n + l15) * RS2 + 8 * g);
                  acc[n] = HG_MFMA16(ka, vb, acc[n] * pd);
                  *(LAS u32x2*)(stn + (16 * n + l15) * RS + (16 * wid + 4 * g) * 2) = (u32x2){att::pk2(acc[n][0], acc[n][1]), att::pk2(acc[n][2], acc[n][3])}; } }
                    }
        }
        lds_barrier();
#undef HG_LOAD
    }
}
}

namespace rwc {
constexpr int RS = 144, RS40 = 80;
constexpr int O_AT = 0, O_RT = 2304, O_BT = 4608, O_KT = 6912, O_BH = 9216, O_KH = 14336, O_VT = 19456, O_UT = 24576, O_HT = 29696, O_GAK = 48128, O_GRB = 49408, O_GRK = 50688,
              O_GAB = 51968, O_XS = 52992, O_P15 = 57088, O_GS = 57344, RW_LDS = 59392;
#define RW_MFMA(a, b, c) __builtin_amdgcn_mfma_f32_16x16x32_bf16((a), (b), (c), 0, 0, 0)
#define RW_FRAG(img, row, RSB, byteoff) (*(const LAS bf16x8*)(lds + (img) + (row) * (RSB) + (byteoff)))
DI unsigned short bfr(float x) { return (unsigned short)(att::pk2(x, 0.f) & 0xffffu); }

DI void rwkv_chunk_scan(const LAS NaiveCtx* Cp_, LAS unsigned char* lds, int wv_) {
    const int tid = otid(wv_), lane = tid & 63, wid = tid >> 6, l15 = lane & 15, g = lane >> 4;
    const int k = tid & 63, tq = tid >> 6;
    LAS float* gsum = (LAS float*)(lds + O_GS); LAS float* p15 = (LAS float*)(lds + O_P15); LAS float* gab = (LAS float*)(lds + O_GAB); LAS float* xs = (LAS float*)(lds + O_XS);
    for (int chain = opaque_bid(); chain < 2 * BATCH * RW_HEADS; chain += gridDim.x) {
        const int d = chain / (BATCH * RW_HEADS), b = (chain / RW_HEADS) % BATCH, h = chain % RW_HEADS;
        const GAS bf16_t* pA = (const GAS bf16_t*)((*Cp_).NKh + h * 64 + k); const GAS float* pW = (const GAS float*)((*Cp_).DEC + (size_t)d * NT_ * 512 + h * 64 + k); const GAS bf16_t* pB = (const GAS bf16_t*)((*Cp_).BBh + (size_t)d * NT_ * 512 + h * 64 + k);
        const GAS bf16_t* pK = (const GAS bf16_t*)((*Cp_).KDh + (size_t)d * NT_ * 512 + h * 64 + k); const GAS bf16_t* pR = (const GAS bf16_t*)((*Cp_).RBh + h * 64 + k); const GAS bf16_t* pV = (const GAS bf16_t*)((*Cp_).VBh + h * 64 + (tid & 31) * 2);
        GAS bf16_t* pY = (GAS bf16_t*)((*Cp_).YBh + (size_t)d * NT_ * 512 + h * 64);
        for (int i = tid; i < RW_LDS / 4; i += PB_THREADS) ((LAS unsigned*)lds)[i] = 0u;
        f32x4 acc[2];
        acc[0] = (f32x4){0.f, 0.f, 0.f, 0.f}; acc[1] = acc[0];
        float lwX[4][2]; unsigned aX[4][2], bX[4][2], kX[4][2], rX[4][2], vX[4];
#define RW_ROWBASE(C0, rb) long rb; { const int i0_ = (C0) * 16; if (i0_ < CTX_LEN) rb = (long)b * CTX_LEN + (d ? CTX_LEN - 1 - i0_ : i0_); else rb = (long)NC_ + (long)b * SEQ + (d ? SEQ - 1 - (i0_ - CTX_LEN) : (i0_ - CTX_LEN)); }
#define RW_LOAD(C0, S) do { RW_ROWBASE(C0, rb_) const long sg_ = d ? -1 : 1; _Pragma("unroll") for (int i = 0; i < 2; ++i) { const long row = rb_ + sg_ * (2 * tq + i); lwX[S][i] = pW[row * 512]; aX[S][i] = pA[row * 512]; bX[S][i] = pB[row * 512]; kX[S][i] = pK[row * 512]; rX[S][i] = pR[row * 512]; } \
            { const long row = rb_ + sg_ * (tid >> 5); vX[S] = *(const GAS unsigned*)(pV + row * 512); } } while (0)
        RW_LOAD(0, 0); RW_LOAD(1, 1); RW_LOAD(2, 2); RW_LOAD(3, 3);
        lds_barrier();
        constexpr int NCH = TT_ / 16;
        static_assert(NCH % 4 == 0, "chunks per trip");
        for (int c4 = 0; c4 < NCH; c4 += 4) {
            { const int c = c4 + 0;

            float lw[2], a[2], bb[2], kd[2], r[2];
#pragma unroll
            for (int i = 0; i < 2; ++i) { lw[i] = lwX[0][i]; a[i] = bf_lo(aX[0][i]); bb[i] = bf_lo(bX[0][i]); kd[i] = bf_lo(kX[0][i]); r[i] = bf_lo(rX[0][i]); }
            const float v0 = bf_lo(vX[0]), v1 = bf_hi(vX[0]);
            const float c0 = lw[0], c1 = lw[0] + lw[1];
            gsum[tq * 64 + k] = c1;
            lds_barrier();
            { float base = 0.f, tot = 0.f;
#pragma unroll
              for (int q = 0; q < 8; ++q) { const float gq = gsum[q * 64 + k]; tot += gq; base += q < tq ? gq : 0.f; }
              float bh[2], kh[2];
#pragma unroll
              for (int i = 0; i < 2; ++i) { const float cu = base + (i ? c1 : c0); const int t = 2 * tq + i; const float ep = fexp2(cu), em = fexp2(-cu), eh = fexp2(tot - cu);
                  *(LAS unsigned short*)(lds + O_AT + t * RS + 2 * k) = bfr(a[i] * fexp2(cu - lw[i]));
                  *(LAS unsigned short*)(lds + O_RT + t * RS + 2 * k) = bfr(r[i] * ep);
                  *(LAS unsigned short*)(lds + O_BT + t * RS + 2 * k) = bfr(bb[i] * em);
                  *(LAS unsigned short*)(lds + O_KT + t * RS + 2 * k) = bfr(kd[i] * em);
                  bh[i] = bb[i] * eh; kh[i] = kd[i] * eh; }
              *(LAS unsigned*)(lds + O_BH + k * RS40 + 4 * tq) = att::pk2(bh[0], bh[1]);
              *(LAS unsigned*)(lds + O_KH + k * RS40 + 4 * tq) = att::pk2(kh[0], kh[1]);
              if (tq == 0) p15[k] = fexp2(tot);
              { const int t = tid >> 5, v2 = (tid & 31) * 2; *(LAS unsigned short*)(lds + O_VT + v2 * RS40 + 2 * t) = bfr(v0); *(LAS unsigned short*)(lds + O_VT + (v2 + 1) * RS40 + 2 * t) = bfr(v1); } }
            if (c + 4 < NCH) RW_LOAD(c + 4, 0);
            lds_barrier();
            const int htc = O_HT + (c & 1) * 64 * RS, htn = O_HT + ((c + 1) & 1) * 64 * RS;
            if (wid < 4) { const int ia = wid < 2 ? O_AT : O_RT, ib = (wid & 1) ? O_KT : O_BT;
                f32x4 gm = (f32x4){0.f, 0.f, 0.f, 0.f};
#pragma unroll
                for (int kk = 0; kk < 2; ++kk) gm = RW_MFMA(RW_FRAG(ia, l15, RS, 64 * kk + 16 * g), RW_FRAG(ib, l15, RS, 64 * kk + 16 * g), gm);
#pragma unroll
                for (int rr = 0; rr < 4; ++rr) { const int t = 4 * g + rr; const bool keep = wid < 2 ? (l15 < t) : (l15 <= t); const float val = keep ? gm[rr] : 0.f;
                    if (wid == 0) gab[l15 * 16 + t] = val;
                    else *(LAS unsigned short*)(lds + (wid == 1 ? O_GAK : wid == 2 ? O_GRB : O_GRK) + t * RS40 + 2 * l15) = bfr(val); } }
            lds_barrier();
            if (wid < 4) { f32x4 x = (f32x4){0.f, 0.f, 0.f, 0.f};
#pragma unroll
                for (int kk = 0; kk < 2; ++kk) x = RW_MFMA(RW_FRAG(O_AT, l15, RS, 64 * kk + 16 * g), RW_FRAG(htc, 16 * wid + l15, RS, 64 * kk + 16 * g), x);
                x = RW_MFMA(RW_FRAG(O_GAK, l15, RS40, 16 * g), RW_FRAG(O_VT, 16 * wid + l15, RS40, 16 * g), x);
#pragma unroll
                for (int rr = 0; rr < 4; ++rr) xs[(4 * g + rr) * 64 + 16 * wid + l15] = x[rr]; }
            lds_barrier();
            if (wid == 0) { float u[16];
#pragma unroll
                for (int t = 0; t < 16; ++t) u[t] = xs[t * 64 + lane];
#pragma unroll
                for (int s = 0; s < 15; ++s) {
#pragma unroll
                    for (int q4 = (s + 1) / 4; q4 < 4; ++q4) { const f32x4 gc = *(const LAS f32x4*)(gab + s * 16 + 4 * q4);
#pragma unroll
                        for (int j = 0; j < 4; ++j) if (4 * q4 + j > s) u[4 * q4 + j] += gc[j] * u[s]; } }
                u32x4 w0, w1; w0.x = att::pk2(u[0], u[1]); w0.y = att::pk2(u[2], u[3]); w0.z = att::pk2(u[4], u[5]); w0.w = att::pk2(u[6], u[7]);
                w1.x = att::pk2(u[8], u[9]); w1.y = att::pk2(u[10], u[11]); w1.z = att::pk2(u[12], u[13]); w1.w = att::pk2(u[14], u[15]);
                *(LAS u32x4*)(lds + O_UT + lane * RS40) = w0; *(LAS u32x4*)(lds + O_UT + lane * RS40 + 16) = w1; }
            lds_barrier();
            if (wid < 4) { f32x4 y = (f32x4){0.f, 0.f, 0.f, 0.f};
#pragma unroll
                for (int kk = 0; kk < 2; ++kk) y = RW_MFMA(RW_FRAG(O_RT, l15, RS, 64 * kk + 16 * g), RW_FRAG(htc, 16 * wid + l15, RS, 64 * kk + 16 * g), y);
                y = RW_MFMA(RW_FRAG(O_GRB, l15, RS40, 16 * g), RW_FRAG(O_UT, 16 * wid + l15, RS40, 16 * g), y);
                y = RW_MFMA(RW_FRAG(O_GRK, l15, RS40, 16 * g), RW_FRAG(O_VT, 16 * wid + l15, RS40, 16 * g), y);
                { RW_ROWBASE(c, rby_) const long sgy_ = d ? -1 : 1;
#pragma unroll
                for (int rr = 0; rr < 4; ++rr) { const long row = rby_ + sgy_ * (4 * g + rr); pY[row * 512 + 16 * wid + l15] = bfr(y[rr]); } } }
            { const int kt = wid >> 1; const f32x4 pd = *(const LAS f32x4*)(p15 + 16 * kt + 4 * g);
              const bf16x8 fb = RW_FRAG(O_BH, 16 * kt + l15, RS40, 16 * g), fk = RW_FRAG(O_KH, 16 * kt + l15, RS40, 16 * g);
#pragma unroll
              for (int j = 0; j < 2; ++j) { const int vt = 2 * (wid & 1) + j;
                  acc[j] = RW_MFMA(fb, RW_FRAG(O_UT, 16 * vt + l15, RS40, 16 * g), acc[j] * pd);
                  acc[j] = RW_MFMA(fk, RW_FRAG(O_VT, 16 * vt + l15, RS40, 16 * g), acc[j]);
                  *(LAS u32x2*)(lds + htn + (16 * vt + l15) * RS + (16 * kt + 4 * g) * 2) = (u32x2){att::pk2(acc[j][0], acc[j][1]), att::pk2(acc[j][2], acc[j][3])}; } }
                    }
            { const int c = c4 + 1;

            float lw[2], a[2], bb[2], kd[2], r[2];
#pragma unroll
            for (int i = 0; i < 2; ++i) { lw[i] = lwX[1][i]; a[i] = bf_lo(aX[1][i]); bb[i] = bf_lo(bX[1][i]); kd[i] = bf_lo(kX[1][i]); r[i] = bf_lo(rX[1][i]); }
            const float v0 = bf_lo(vX[1]), v1 = bf_hi(vX[1]);
            const float c0 = lw[0], c1 = lw[0] + lw[1];
            gsum[tq * 64 + k] = c1;
            lds_barrier();
            { float base = 0.f, tot = 0.f;
#pragma unroll
              for (int q = 0; q < 8; ++q) { const float gq = gsum[q * 64 + k]; tot += gq; base += q < tq ? gq : 0.f; }
              float bh[2], kh[2];
#pragma unroll
              for (int i = 0; i < 2; ++i) { const float cu = base + (i ? c1 : c0); const int t = 2 * tq + i; const float ep = fexp2(cu), em = fexp2(-cu), eh = fexp2(tot - cu);
                  *(LAS unsigned short*)(lds + O_AT + t * RS + 2 * k) = bfr(a[i] * fexp2(cu - lw[i]));
                  *(LAS unsigned short*)(lds + O_RT + t * RS + 2 * k) = bfr(r[i] * ep);
                  *(LAS unsigned short*)(lds + O_BT + t * RS + 2 * k) = bfr(bb[i] * em);
                  *(LAS unsigned short*)(lds + O_KT + t * RS + 2 * k) = bfr(kd[i] * em);
                  bh[i] = bb[i] * eh; kh[i] = kd[i] * eh; }
              *(LAS unsigned*)(lds + O_BH + k * RS40 + 4 * tq) = att::pk2(bh[0], bh[1]);
              *(LAS unsigned*)(lds + O_KH + k * RS40 + 4 * tq) = att::pk2(kh[0], kh[1]);
              if (tq == 0) p15[k] = fexp2(tot);
              { const int t = tid >> 5, v2 = (tid & 31) * 2; *(LAS unsigned short*)(lds + O_VT + v2 * RS40 + 2 * t) = bfr(v0); *(LAS unsigned short*)(lds + O_VT + (v2 + 1) * RS40 + 2 * t) = bfr(v1); } }
            if (c + 4 < NCH) RW_LOAD(c + 4, 1);
            lds_barrier();
            const int htc = O_HT + (c & 1) * 64 * RS, htn = O_HT + ((c + 1) & 1) * 64 * RS;
            if (wid < 4) { const int ia = wid < 2 ? O_AT : O_RT, ib = (wid & 1) ? O_KT : O_BT;
                f32x4 gm = (f32x4){0.f, 0.f, 0.f, 0.f};
#pragma unroll
                for (int kk = 0; kk < 2; ++kk) gm = RW_MFMA(RW_FRAG(ia, l15, RS, 64 * kk + 16 * g), RW_FRAG(ib, l15, RS, 64 * kk + 16 * g), gm);
#pragma unroll
                for (int rr = 0; rr < 4; ++rr) { const int t = 4 * g + rr; const bool keep = wid < 2 ? (l15 < t) : (l15 <= t); const float val = keep ? gm[rr] : 0.f;
                    if (wid == 0) gab[l15 * 16 + t] = val;
                    else *(LAS unsigned short*)(lds + (wid == 1 ? O_GAK : wid == 2 ? O_GRB : O_GRK) + t * RS40 + 2 * l15) = bfr(val); } }
            lds_barrier();
            if (wid < 4) { f32x4 x = (f32x4){0.f, 0.f, 0.f, 0.f};
#pragma unroll
                for (int kk = 0; kk < 2; ++kk) x = RW_MFMA(RW_FRAG(O_AT, l15, RS, 64 * kk + 16 * g), RW_FRAG(htc, 16 * wid + l15, RS, 64 * kk + 16 * g), x);
                x = RW_MFMA(RW_FRAG(O_GAK, l15, RS40, 16 * g), RW_FRAG(O_VT, 16 * wid + l15, RS40, 16 * g), x);
#pragma unroll
                for (int rr = 0; rr < 4; ++rr) xs[(4 * g + rr) * 64 + 16 * wid + l15] = x[rr]; }
            lds_barrier();
            if (wid == 0) { float u[16];
#pragma unroll
                for (int t = 0; t < 16; ++t) u[t] = xs[t * 64 + lane];
#pragma unroll
                for (int s = 0; s < 15; ++s) {
#pragma unroll
                    for (int q4 = (s + 1) / 4; q4 < 4; ++q4) { const f32x4 gc = *(const LAS f32x4*)(gab + s * 16 + 4 * q4);
#pragma unroll
                        for (int j = 0; j < 4; ++j) if (4 * q4 + j > s) u[4 * q4 + j] += gc[j] * u[s]; } }
                u32x4 w0, w1; w0.x = att::pk2(u[0], u[1]); w0.y = att::pk2(u[2], u[3]); w0.z = att::pk2(u[4], u[5]); w0.w = att::pk2(u[6], u[7]);
                w1.x = att::pk2(u[8], u[9]); w1.y = att::pk2(u[10], u[11]); w1.z = att::pk2(u[12], u[13]); w1.w = att::pk2(u[14], u[15]);
                *(LAS u32x4*)(lds + O_UT + lane * RS40) = w0; *(LAS u32x4*)(lds + O_UT + lane * RS40 + 16) = w1; }
            lds_barrier();
            if (wid < 4) { f32x4 y = (f32x4){0.f, 0.f, 0.f, 0.f};
#pragma unroll
                for (int kk = 0; kk < 2; ++kk) y = RW_MFMA(RW_FRAG(O_RT, l15, RS, 64 * kk + 16 * g), RW_FRAG(htc, 16 * wid + l15, RS, 64 * kk + 16 * g), y);
                y = RW_MFMA(RW_FRAG(O_GRB, l15, RS40, 16 * g), RW_FRAG(O_UT, 16 * wid + l15, RS40, 16 * g), y);
                y = RW_MFMA(RW_FRAG(O_GRK, l15, RS40, 16 * g), RW_FRAG(O_VT, 16 * wid + l15, RS40, 16 * g), y);
                { RW_ROWBASE(c, rby_) const long sgy_ = d ? -1 : 1;
#pragma unroll
                for (int rr = 0; rr < 4; ++rr) { const long row = rby_ + sgy_ * (4 * g + rr); pY[row * 512 + 16 * wid + l15] = bfr(y[rr]); } } }
            { const int kt = wid >> 1; const f32x4 pd = *(const LAS f32x4*)(p15 + 16 * kt + 4 * g);
              const bf16x8 fb = RW_FRAG(O_BH, 16 * kt + l15, RS40, 16 * g), fk = RW_FRAG(O_KH, 16 * kt + l15, RS40, 16 * g);
#pragma unroll
              for (int j = 0; j < 2; ++j) { const int vt = 2 * (wid & 1) + j;
                  acc[j] = RW_MFMA(fb, RW_FRAG(O_UT, 16 * vt + l15, RS40, 16 * g), acc[j] * pd);
                  acc[j] = RW_MFMA(fk, RW_FRAG(O_VT, 16 * vt + l15, RS40, 16 * g), acc[j]);
                  *(LAS u32x2*)(lds + htn + (16 * vt + l15) * RS + (16 * kt + 4 * g) * 2) = (u32x2){att::pk2(acc[j][0], acc[j][1]), att::pk2(acc[j][2], acc[j][3])}; } }
                    }
            { const int c = c4 + 2;

            float lw[2], a[2], bb[2], kd[2], r[2];
#pragma unroll
            for (int i = 0; i < 2; ++i) { lw[i] = lwX[2][i]; a[i] = bf_lo(aX[2][i]); bb[i] = bf_lo(bX[2][i]); kd[i] = bf_lo(kX[2][i]); r[i] = bf_lo(rX[2][i]); }
            const float v0 = bf_lo(vX[2]), v1 = bf_hi(vX[2]);
            const float c0 = lw[0], c1 = lw[0] + lw[1];
            gsum[tq * 64 + k] = c1;
            lds_barrier();
            { float base = 0.f, tot = 0.f;
#pragma unroll
              for (int q = 0; q < 8; ++q) { const float gq = gsum[q * 64 + k]; tot += gq; base += q < tq ? gq : 0.f; }
              float bh[2], kh[2];
#pragma unroll
              for (int i = 0; i < 2; ++i) { const float cu = base + (i ? c1 : c0); const int t = 2 * tq + i; const float ep = fexp2(cu), em = fexp2(-cu), eh = fexp2(tot - cu);
                  *(LAS unsigned short*)(lds + O_AT + t * RS + 2 * k) = bfr(a[i] * fexp2(cu - lw[i]));
                  *(LAS unsigned short*)(lds + O_RT + t * RS + 2 * k) = bfr(r[i] * ep);
                  *(LAS unsigned short*)(lds + O_BT + t * RS + 2 * k) = bfr(bb[i] * em);
                  *(LAS unsigned short*)(lds + O_KT + t * RS + 2 * k) = bfr(kd[i] * em);
                  bh[i] = bb[i] * eh; kh[i] = kd[i] * eh; }
              *(LAS unsigned*)(lds + O_BH + k * RS40 + 4 * tq) = att::pk2(bh[0], bh[1]);
              *(LAS unsigned*)(lds + O_KH + k * RS40 + 4 * tq) = att::pk2(kh[0], kh[1]);
              if (tq == 0) p15[k] = fexp2(tot);
              { const int t = tid >> 5, v2 = (tid & 31) * 2; *(LAS unsigned short*)(lds + O_VT + v2 * RS40 + 2 * t) = bfr(v0); *(LAS unsigned short*)(lds + O_VT + (v2 + 1) * RS40 + 2 * t) = bfr(v1); } }
            if (c + 4 < NCH) RW_LOAD(c + 4, 2);
            lds_barrier();
            const int htc = O_HT + (c & 1) * 64 * RS, htn = O_HT + ((c + 1) & 1) * 64 * RS;
            if (wid < 4) { const int ia = wid < 2 ? O_AT : O_RT, ib = (wid & 1) ? O_KT : O_BT;
                f32x4 gm = (f32x4){0.f, 0.f, 0.f, 0.f};
#pragma unroll
                for (int kk = 0; kk < 2; ++kk) gm = RW_MFMA(RW_FRAG(ia, l15, RS, 64 * kk + 16 * g), RW_FRAG(ib, l15, RS, 64 * kk + 16 * g), gm);
#pragma unroll
                for (int rr = 0; rr < 4; ++rr) { const int t = 4 * g + rr; const bool keep = wid < 2 ? (l15 < t) : (l15 <= t); const float val = keep ? gm[rr] : 0.f;
                    if (wid == 0) gab[l15 * 16 + t] = val;
                    else *(LAS unsigned short*)(lds + (wid == 1 ? O_GAK : wid == 2 ? O_GRB : O_GRK) + t * RS40 + 2 * l15) = bfr(val); } }
            lds_barrier();
            if (wid < 4) { f32x4 x = (f32x4){0.f, 0.f, 0.f, 0.f};
#pragma unroll
                for (int kk = 0; kk < 2; ++kk) x = RW_MFMA(RW_FRAG(O_AT, l15, RS, 64 * kk + 16 * g), RW_FRAG(htc, 16 * wid + l15, RS, 64 * kk + 16 * g), x);
                x = RW_MFMA(RW_FRAG(O_GAK, l15, RS40, 16 * g), RW_FRAG(O_VT, 16 * wid + l15, RS40, 16 * g), x);
#pragma unroll
                for (int rr = 0; rr < 4; ++rr) xs[(4 * g + rr) * 64 + 16 * wid + l15] = x[rr]; }
            lds_barrier();
            if (wid == 0) { float u[16];
#pragma unroll
                for (int t = 0; t < 16; ++t) u[t] = xs[t * 64 + lane];
#pragma unroll
                for (int s = 0; s < 15; ++s) {
#pragma unroll
                    for (int q4 = (s + 1) / 4; q4 < 4; ++q4) { const f32x4 gc = *(const LAS f32x4*)(gab + s * 16 + 4 * q4);
#pragma unroll
                        for (int j = 0; j < 4; ++j) if (4 * q4 + j > s) u[4 * q4 + j] += gc[j] * u[s]; } }
                u32x4 w0, w1; w0.x = att::pk2(u[0], u[1]); w0.y = att::pk2(u[2], u[3]); w0.z = att::pk2(u[4], u[5]); w0.w = att::pk2(u[6], u[7]);
                w1.x = att::pk2(u[8], u[9]); w1.y = att::pk2(u[10], u[11]); w1.z = att::pk2(u[12], u[13]); w1.w = att::pk2(u[14], u[15]);
                *(LAS u32x4*)(lds + O_UT + lane * RS40) = w0; *(LAS u32x4*)(lds + O_UT + lane * RS40 + 16) = w1; }
            lds_barrier();
            if (wid < 4) { f32x4 y = (f32x4){0.f, 0.f, 0.f, 0.f};
#pragma unroll
                for (int kk = 0; kk < 2; ++kk) y = RW_MFMA(RW_FRAG(O_RT, l15, RS, 64 * kk + 16 * g), RW_FRAG(htc, 16 * wid + l15, RS, 64 * kk + 16 * g), y);
                y = RW_MFMA(RW_FRAG(O_GRB, l15, RS40, 16 * g), RW_FRAG(O_UT, 16 * wid + l15, RS40, 16 * g), y);
                y = RW_MFMA(RW_FRAG(O_GRK, l15, RS40, 16 * g), RW_FRAG(O_VT, 16 * wid + l15, RS40, 16 * g), y);
                { RW_ROWBASE(c, rby_) const long sgy_ = d ? -1 : 1;
#pragma unroll
                for (int rr = 0; rr < 4; ++rr) { const long row = rby_ + sgy_ * (4 * g + rr); pY[row * 512 + 16 * wid + l15] = bfr(y[rr]); } } }
            { const int kt = wid >> 1; const f32x4 pd = *(const LAS f32x4*)(p15 + 16 * kt + 4 * g);
              const bf16x8 fb = RW_FRAG(O_BH, 16 * kt + l15, RS40, 16 * g), fk = RW_FRAG(O_KH, 16 * kt + l15, RS40, 16 * g);
#pragma unroll
              for (int j = 0; j < 2; ++j) { const int vt = 2 * (wid & 1) + j;
                  acc[j] = RW_MFMA(fb, RW_FRAG(O_UT, 16 * vt + l15, RS40, 16 * g), acc[j] * pd);
                  acc[j] = RW_MFMA(fk, RW_FRAG(O_VT, 16 * vt + l15, RS40, 16 * g), acc[j]);
                  *(LAS u32x2*)(lds + htn + (16 * vt + l15) * RS + (16 * kt + 4 * g) * 2) = (u32x2){att::pk2(acc[j][0], acc[j][1]), att::pk2(acc[j][2], acc[j][3])}; } }
                    }
            { const int c = c4 + 3;

            float lw[2], a[2], bb[2], kd[2], r[2];
#pragma unroll
            for (int i = 0; i < 2; ++i) { lw[i] = lwX[3][i]; a[i] = bf_lo(aX[3][i]); bb[i] = bf_lo(bX[3][i]); kd[i] = bf_lo(kX[3][i]); r[i] = bf_lo(rX[3][i]); }
            const float v0 = bf_lo(vX[3]), v1 = bf_hi(vX[3]);
            const float c0 = lw[0], c1 = lw[0] + lw[1];
            gsum[tq * 64 + k] = c1;
            lds_barrier();
            { float base = 0.f, tot = 0.f;
#pragma unroll
              for (int q = 0; q < 8; ++q) { const float gq = gsum[q * 64 + k]; tot += gq; base += q < tq ? gq : 0.f; }
              float bh[2], kh[2];
#pragma unroll
              for (int i = 0; i < 2; ++i) { const float cu = base + (i ? c1 : c0); const int t = 2 * tq + i; const float ep = fexp2(cu), em = fexp2(-cu), eh = fexp2(tot - cu);
                  *(LAS unsigned short*)(lds + O_AT + t * RS + 2 * k) = bfr(a[i] * fexp2(cu - lw[i]));
                  *(LAS unsigned short*)(lds + O_RT + t * RS + 2 * k) = bfr(r[i] * ep);
                  *(LAS unsigned short*)(lds + O_BT + t * RS + 2 * k) = bfr(bb[i] * em);
                  *(LAS unsigned short*)(lds + O_KT + t * RS + 2 * k) = bfr(kd[i] * em);
                  bh[i] = bb[i] * eh; kh[i] = kd[i] * eh; }
              *(LAS unsigned*)(lds + O_BH + k * RS40 + 4 * tq) = att::pk2(bh[0], bh[1]);
              *(LAS unsigned*)(lds + O_KH + k * RS40 + 4 * tq) = att::pk2(kh[0], kh[1]);
              if (tq == 0) p15[k] = fexp2(tot);
              { const int t = tid >> 5, v2 = (tid & 31) * 2; *(LAS unsigned short*)(lds + O_VT + v2 * RS40 + 2 * t) = bfr(v0); *(LAS unsigned short*)(lds + O_VT + (v2 + 1) * RS40 + 2 * t) = bfr(v1); } }
            if (c + 4 < NCH) RW_LOAD(c + 4, 3);
            lds_barrier();
            const int htc = O_HT + (c & 1) * 64 * RS, htn = O_HT + ((c + 1) & 1) * 64 * RS;
            if (wid < 4) { const int ia = wid < 2 ? O_AT : O_RT, ib = (wid & 1) ? O_KT : O_BT;
                f32x4 gm = (f32x4){0.f, 0.f, 0.f, 0.f};
#pragma unroll
                for (int kk = 0; kk < 2; ++kk) gm = RW_MFMA(RW_FRAG(ia, l15, RS, 64 * kk + 16 * g), RW_FRAG(ib, l15, RS, 64 * kk + 16 * g), gm);
#pragma unroll
                for (int rr = 0; rr < 4; ++rr) { const int t = 4 * g + rr; const bool keep = wid < 2 ? (l15 < t) : (l15 <= t); const float val = keep ? gm[rr] : 0.f;
                    if (wid == 0) gab[l15 * 16 + t] = val;
                    else *(LAS unsigned short*)(lds + (wid == 1 ? O_GAK : wid == 2 ? O_GRB : O_GRK) + t * RS40 + 2 * l15) = bfr(val); } }
            lds_barrier();
            if (wid < 4) { f32x4 x = (f32x4){0.f, 0.f, 0.f, 0.f};
#pragma unroll
                for (int kk = 0; kk < 2; ++kk) x = RW_MFMA(RW_FRAG(O_AT, l15, RS, 64 * kk + 16 * g), RW_FRAG(htc, 16 * wid + l15, RS, 64 * kk + 16 * g), x);
                x = RW_MFMA(RW_FRAG(O_GAK, l15, RS40, 16 * g), RW_FRAG(O_VT, 16 * wid + l15, RS40, 16 * g), x);
#pragma unroll
                for (int rr = 0; rr < 4; ++rr) xs[(4 * g + rr) * 64 + 16 * wid + l15] = x[rr]; }
            lds_barrier();
            if (wid == 0) { float u[16];
#pragma unroll
                for (int t = 0; t < 16; ++t) u[t] = xs[t * 64 + lane];
#pragma unroll
                for (int s = 0; s < 15; ++s) {
#pragma unroll
                    for (int q4 = (s + 1) / 4; q4 < 4; ++q4) { const f32x4 gc = *(const LAS f32x4*)(gab + s * 16 + 4 * q4);
#pragma unroll
                        for (int j = 0; j < 4; ++j) if (4 * q4 + j > s) u[4 * q4 + j] += gc[j] * u[s]; } }
                u32x4 w0, w1; w0.x = att::pk2(u[0], u[1]); w0.y = att::pk2(u[2], u[3]); w0.z = att::pk2(u[4], u[5]); w0.w = att::pk2(u[6], u[7]);
                w1.x = att::pk2(u[8], u[9]); w1.y = att::pk2(u[10], u[11]); w1.z = att::pk2(u[12], u[13]); w1.w = att::pk2(u[14], u[15]);
                *(LAS u32x4*)(lds + O_UT + lane * RS40) = w0; *(LAS u32x4*)(lds + O_UT + lane * RS40 + 16) = w1; }
            lds_barrier();
            if (wid < 4) { f32x4 y = (f32x4){0.f, 0.f, 0.f, 0.f};
#pragma unroll
                for (int kk = 0; kk < 2; ++kk) y = RW_MFMA(RW_FRAG(O_RT, l15, RS, 64 * kk + 16 * g), RW_FRAG(htc, 16 * wid + l15, RS, 64 * kk + 16 * g), y);
                y = RW_MFMA(RW_FRAG(O_GRB, l15, RS40, 16 * g), RW_FRAG(O_UT, 16 * wid + l15, RS40, 16 * g), y);
                y = RW_MFMA(RW_FRAG(O_GRK, l15, RS40, 16 * g), RW_FRAG(O_VT, 16 * wid + l15, RS40, 16 * g), y);
                { RW_ROWBASE(c, rby_) const long sgy_ = d ? -1 : 1;
#pragma unroll
                for (int rr = 0; rr < 4; ++rr) { const long row = rby_ + sgy_ * (4 * g + rr); pY[row * 512 + 16 * wid + l15] = bfr(y[rr]); } } }
            { const int kt = wid >> 1; const f32x4 pd = *(const LAS f32x4*)(p15 + 16 * kt + 4 * g);
              const bf16x8 fb = RW_FRAG(O_BH, 16 * kt + l15, RS40, 16 * g), fk = RW_FRAG(O_KH, 16 * kt + l15, RS40, 16 * g);
#pragma unroll
              for (int j = 0; j < 2; ++j) { const int vt = 2 * (wid & 1) + j;
                  acc[j] = RW_MFMA(fb, RW_FRAG(O_UT, 16 * vt + l15, RS40, 16 * g), acc[j] * pd);
                  acc[j] = RW_MFMA(fk, RW_FRAG(O_VT, 16 * vt + l15, RS40, 16 * g), acc[j]);
                  *(LAS u32x2*)(lds + htn + (16 * vt + l15) * RS + (16 * kt + 4 * g) * 2) = (u32x2){att::pk2(acc[j][0], acc[j][1]), att::pk2(acc[j][2], acc[j][3])}; } }
                    }
        }
        lds_barrier();
#undef RW_LOAD
    }
}
}

#if defined(PERSISTENT)
#define DENSE_GEMM(Af, lda, Kreal, KP, WT, Wf, ldb, Cout, ldc, Mrows, Nvalid, NP) do { \
    conv_act((Af), (lda), (Kreal), C.ABF, (KP), (Mrows), wv_); grid_sync(bar); \
    { g8::DenseSched S_; S_.init(C.ABF, (WT), (Mrows), (NP), (KP), gridDim.x, opaque_bid()); g8::EpiF32 E_{(Cout), (ldc), (Nvalid)}; g8::gemm_phase<(KP), g8::EpiF32, g8::DenseSched>(lds, S_, E_, wv_); } \
    grid_sync(bar); } while (0)
#define DENSE_GEMM_UB(Af, lda, Kreal, KP, WT, Wf, ldb, Cout, ldc, Mrows, Nvalid, NP) do { \
    { g8::DenseSched S_; S_.init(C.UB, (WT), (Mrows), (NP), (KP), gridDim.x, opaque_bid()); g8::EpiF32 E_{(Cout), (ldc), (Nvalid)}; g8::gemm_phase<(KP), g8::EpiF32, g8::DenseSched>(lds, S_, E_, wv_); } \
    grid_sync(bar); } while (0)
#else
#define DENSE_GEMM_UB DENSE_GEMM
#define DENSE_GEMM(Af, lda, Kreal, KP, WT, Wf, ldb, Cout, ldc, Mrows, Nvalid, NP) ngemm((Af), (lda), nullptr, (Wf), 0, (ldb), nullptr, 0, (Cout), (ldc), (Mrows), (Nvalid), (Kreal), nullptr)
#endif
#ifdef PERSIST_C_MACRO
#define C (*Cp_)
#endif
#define MODL (C.MOD + (size_t)layer * (BATCH + 1) * N_MOD * D_MODEL)
FWD_QUAL void naive_prologue(FWD_SIG) {
    const int D = D_MODEL, NT = NT_, NC = NC_;
#if defined(PERSISTENT)
    tl::mod_phase(Cp_, lds, wv_);
    tl::rope_table(Cp_, wv_); tl::lora_weights(Cp_, wv_);
    conv_weight_b(lds, C.moe_w_gu, (size_t)D_MODEL * 2 * EXPERT_DIM, C.Wgu, (size_t)2 * EXPERT_DIM * D_MODEL, CV_PRO_LAYERS * N_EXPERTS, D_MODEL, 2 * EXPERT_DIM, 2 * EXPERT_DIM, D_MODEL, 2 * EXPERT_DIM, 1, wv_);
    conv_weight_b(lds, C.moe_w_down, (size_t)EXPERT_DIM * D_MODEL, C.Wdn, (size_t)D_MODEL * EXPERT_DIM, CV_PRO_LAYERS * N_EXPERTS, EXPERT_DIM, D_MODEL, D_MODEL, EXPERT_DIM, D_MODEL, 0, wv_);
    conv_weight_b(lds, C.ev_w_in, (size_t)D_MODEL * EVEN_IN, C.WinE, (size_t)4608 * 1024, N_EVEN, D_MODEL, EVEN_IN, EVEN_IN, 1024, 4608, 0, wv_);
    conv_weight_b(lds, C.ev_w_out, (size_t)1024 * D_MODEL, C.WoutE, (size_t)1024 * 1024, N_EVEN, 1024, D_MODEL, D_MODEL, 1024, 1024, 0, wv_);
    conv_weight_b(lds, C.od_w_in, (size_t)D_MODEL * MLA_IN, C.WinO, (size_t)512 * 1024, N_ODD, D_MODEL, MLA_IN, MLA_IN, 1024, 512, 0, wv_);
    conv_weight_b(lds, C.mla_w_qb, (size_t)MLA_QR * 1536, C.Wqb, (size_t)1536 * 256, N_ODD, MLA_QR, 1536, 1536, 256, 1536, 0, wv_);
    conv_weight_b(lds, C.mla_w_kvb, (size_t)MLA_KVR * 2048, C.Wkvb, (size_t)2048 * 256, N_ODD, MLA_KVR, 2048, 2048, 256, 2048, 0, wv_);
    conv_weight_b(lds, C.od_w_out, (size_t)1024 * D_MODEL, C.WoutO, (size_t)1024 * 1024, N_ODD, 1024, D_MODEL, D_MODEL, 1024, 1024, 0, wv_);
    grid_sync(bar);
#endif
#if !defined(PERSISTENT)
    NLAUNCH((long)NT * D, [=] HD(long i) { long row = i / D_MODEL; int d = (int)(i % D_MODEL); C.H[i] = row < NC_ ? C.ctx[row * D_MODEL + d] : C.x[(row - NC_) * D_MODEL + d]; });
#endif
#if !defined(PERSISTENT)
    NLAUNCH((long)DEPTH * (BATCH + 1) * N_MOD * D, [=] HD(long i) {
        const int W = N_MOD * D_MODEL; int j = (int)(i % W); long t = i / W; int r = (int)(t % (BATCH + 1)); int l = (int)(t / (BATCH + 1));
        const float* cv = r < BATCH ? C.c + (size_t)r * D_MODEL : C.c_ctx; const float* w = C.mod_w + (size_t)l * D_MODEL * W;
        float s = 0.f; for (int k = 0; k < D_MODEL; ++k) s += siluf_(cv[k]) * w[(size_t)k * W + j];
        C.MOD[i] = s + C.mod_b[(size_t)l * W + j]; });
#endif
#if defined(PERSISTENT)
    tl::init_h(Cp_, wv_); grid_sync(bar);
#endif
}
FWD_QUAL void naive_modu(FWD_SIG, long layer) {
#if !defined(PERSISTENT)
    const int D = D_MODEL, NT = NT_, NC = NC_; (void)D; (void)NT; (void)NC;
    const bool need_ctx = layer < DEPTH - 1; const long j2 = layer / 2; (void)need_ctx; (void)j2;
        NLAUNCH((long)NT * D, [=] HD(long i) { long row = i / D_MODEL; int d = (int)(i % D_MODEL); const float* m = MODL + (size_t)modrow((int)row) * N_MOD * D_MODEL; C.U[i] = C.H[i] * (1.f + m[D_MODEL + d]) + m[d]; });
#endif
}
FWD_QUAL void naive_even(FWD_SIG, long layer) {
    const int D = D_MODEL, NT = NT_, NC = NC_; (void)D; (void)NT; (void)NC;
    const bool need_ctx = layer < DEPTH - 1; const long j2 = layer / 2; (void)need_ctx; (void)j2;
            DENSE_GEMM_UB(C.U, D_MODEL, D_MODEL, 1024, C.WinE + (size_t)j2 * 4608 * 1024, C.ev_w_in + (size_t)j2 * D * EVEN_IN, EVEN_IN, C.Z, EVEN_IN, NT_, EVEN_IN, 4608);
#define mu (C.rw_mu + (size_t)j2 * RW_IN)
            NLAUNCH((long)NT * RW_IN, [=] HD(long i) { int row = (int)(i / RW_IN), c = (int)(i % RW_IN);
                int t, len; if (row < NC_) { t = row % CTX_LEN; len = CTX_LEN; } else { t = (row - NC_) % SEQ; len = SEQ; }
                float z = C.Z[(size_t)row * EVEN_IN + c]; float p = t > 0 ? C.Z[(size_t)(row - 1) * EVEN_IN + c] : 0.f; float n = t < len - 1 ? C.Z[(size_t)(row + 1) * EVEN_IN + c] : 0.f;
                C.ZS[i] = z + mu[c] * (0.5f * (p + n) - z); });
#define w0 (C.rw_w0 + (size_t)j2 * 2 * 512)
#define w2 (C.rw_w2 + (size_t)j2 * 2 * 64 * 512)
#define a0 (C.rw_a0 + (size_t)j2 * 2 * 512)
#define a2 (C.rw_a2 + (size_t)j2 * 2 * 64 * 512)
#define g2 (C.rw_g2 + (size_t)j2 * 128 * 512)
#define k_k (C.rw_k_k + (size_t)j2 * 512)
#define k_a (C.rw_k_a + (size_t)j2 * 512)
#define r_k (C.rw_r_k + (size_t)j2 * 512)
#define gn_g (C.rw_gn_g + (size_t)j2 * 512)
#define gn_b (C.rw_gn_b + (size_t)j2 * 512)
            NLAUNCH((long)NT * 512, [=] HD(long i) { int row = (int)(i / 512), c = (int)(i % 512); const float* zs = C.ZS + (size_t)row * RW_IN;
                float r = zs[c], k = zs[512 + c], v = zs[1024 + c];
                C.R[i] = r; C.V[i] = v; C.KKR[i] = k * k_k[c];
                float g = 0.f; for (int q = 0; q < 128; ++q) g += sigmoidf_(zs[1792 + q]) * g2[(size_t)q * 512 + c];
                C.G[i] = g;
                for (int d = 0; d < 2; ++d) {
                    float wl = 0.f, al = 0.f;
                    for (int q = 0; q < 64; ++q) { wl += tanhf(zs[1536 + d * 64 + q]) * w2[((size_t)d * 64 + q) * 512 + c]; al += zs[1664 + d * 64 + q] * a2[((size_t)d * 64 + q) * 512 + c]; }
                    float wpre = w0[d * 512 + c] + wl; float dec = expf(-expf(-softplusf_(-wpre) - 0.5f)); float a = sigmoidf_(a0[d * 512 + c] + al);
                    size_t o = ((size_t)d * NT_ + row) * 512 + c;
                    C.DEC[o] = dec; C.AG[o] = a; C.KD[o] = k * (1.f + (a - 1.f) * k_a[c]);
                } });
            NLAUNCH((long)NT * RW_HEADS, [=] HD(long i) { int row = (int)(i / RW_HEADS), h = (int)(i % RW_HEADS); size_t b0 = (size_t)row * 512 + h * 64;
                float ss = 0.f; for (int n = 0; n < 64; ++n) ss += C.KKR[b0 + n] * C.KKR[b0 + n];
                float inv = 1.f / sqrtf(fmaxf(ss, 1e-24f));
                for (int n = 0; n < 64; ++n) { float kk = C.KKR[b0 + n] * inv; C.NKK[b0 + n] = -kk; for (int d = 0; d < 2; ++d) { size_t o = ((size_t)d * NT_ + row) * 512 + h * 64 + n; C.BB[o] = kk * C.AG[o]; } } });
            NLAUNCH((long)2 * BATCH * RW_HEADS * 64, [=] HD(long i) { int v = (int)(i % 64); long t = i / 64; int h = (int)(t % RW_HEADS); t /= RW_HEADS; int b = (int)(t % BATCH); int d = (int)(t / BATCH);
                float S[64];
_Pragma("unroll")
                for (int k = 0; k < 64; ++k) S[k] = 0.f;
                for (int st = 0; st < TT_; ++st) { int row = tokrow(b, scan_pos(d, st)); size_t s0 = (size_t)row * 512 + h * 64, s1 = ((size_t)d * NT_ + row) * 512 + h * 64;
                    float sa = 0.f;
_Pragma("unroll")
                    for (int k = 0; k < 64; ++k) { sa += S[k] * C.NKK[s0 + k]; MEMFENCE_EVERY(k, 16); }
                    float vv = C.V[s0 + v], y = 0.f;
_Pragma("unroll")
                    for (int k = 0; k < 64; ++k) { S[k] = S[k] * C.DEC[s1 + k] + sa * C.BB[s1 + k] + vv * C.KD[s1 + k]; y += S[k] * C.R[s0 + k]; MEMFENCE_EVERY(k, 8); }
                    C.Y[s1 + v] = y; } });
#define lbp (C.hg_lb)
#define hgn (C.hg_norm_g + (size_t)j2 * 512)
            NLAUNCH((long)NT * 512, [=] HD(long i) { int row = (int)(i / 512), c = (int)(i % 512); const float* zb = C.Z + (size_t)row * EVEN_IN + RW_IN;
                C.HQ[i] = siluf_(zb[c]);
                for (int d = 0; d < 2; ++d) {
                    float mx = -1e30f; for (int q = 0; q < N_EVEN; ++q) mx = fmaxf(mx, lbp[((size_t)q * 2 + d) * 512 + c]);
                    float den = 0.f, num = 0.f; for (int q = 0; q < N_EVEN; ++q) { float e = expf(lbp[((size_t)q * 2 + d) * 512 + c] - mx); den += e; if (q >= 1 && q <= j2) num += e; }
                    float lower = num / den;
                    float sig = sigmoidf_(zb[512 + d * 512 + c]); float f = lower + (1.f - lower) * sig; f = fmaxf(f, 1e-30f);
                    size_t o = ((size_t)d * NT_ + row) * 512 + c; C.HF[o] = f; C.HK[o] = (1.f - lower) * (1.f - sig);
                } });
            NLAUNCH((long)2 * BATCH * HG_HEADS * 128 * 2, [=] HD(long i) { int kh = (int)(i & 1); int v = (int)((i >> 1) % 128); long t = (i >> 1) / 128; int h = (int)(t % HG_HEADS); t /= HG_HEADS; int b = (int)(t % BATCH); int d = (int)(t / BATCH);
                float S[64];
_Pragma("unroll")
                for (int k = 0; k < 64; ++k) S[k] = 0.f;
                for (int st = 0; st < TT_; ++st) { int row = tokrow(b, scan_pos(d, st)); size_t s0 = (size_t)row * 512 + h * 128 + kh * 64, s1 = ((size_t)d * NT_ + row) * 512 + h * 128 + kh * 64;
                    float val = C.Z[(size_t)row * EVEN_IN + RW_IN + 1536 + h * 128 + v], o = 0.f;
_Pragma("unroll")
                    for (int k = 0; k < 64; ++k) { S[k] = C.HF[s1 + k] * S[k] + C.HK[s1 + k] * val; o += S[k] * C.HQ[s0 + k]; MEMFENCE_EVERY(k, 16); }
                    C.OP[(((size_t)d * NT_ + row) * 512 + h * 128 + v) * 2 + kh] = o; } });
            NLAUNCH((long)NT * RW_HEADS, [=] HD(long i) { int row = (int)(i / RW_HEADS), h = (int)(i % RW_HEADS); size_t b0 = (size_t)row * 512 + h * 64, b1 = ((size_t)NT_ + row) * 512 + h * 64;
                float mu_ = 0.f; for (int n = 0; n < 64; ++n) mu_ += C.Y[b0 + n] + C.Y[b1 + n]; mu_ /= 64.f;
                float var = 0.f; for (int n = 0; n < 64; ++n) { float y = C.Y[b0 + n] + C.Y[b1 + n] - mu_; var += y * y; } var /= 64.f;
                float rs = 1.f / sqrtf(var + 64e-5f);
                float bon = 0.f; for (int n = 0; n < 64; ++n) bon += C.R[b0 + n] * (C.KD[b0 + n] + C.KD[b1 + n]) * r_k[h * 64 + n];
                for (int n = 0; n < 64; ++n) { int c = h * 64 + n; float y = (C.Y[b0 + n] + C.Y[b1 + n] - mu_) * rs * gn_g[c] + gn_b[c]; C.YCAT[(size_t)row * 1024 + c] = (y + bon * C.V[b0 + n]) * C.G[b0 + n]; } });
            NLAUNCH((long)NT * HG_HEADS, [=] HD(long i) { int row = (int)(i / HG_HEADS), h = (int)(i % HG_HEADS); size_t b0 = (size_t)row * 512 + h * 128, b1 = ((size_t)NT_ + row) * 512 + h * 128;
                float ss = 0.f; for (int n = 0; n < 128; ++n) { float o = C.OP[(b0 + n) * 2] + C.OP[(b0 + n) * 2 + 1] + C.OP[(b1 + n) * 2] + C.OP[(b1 + n) * 2 + 1]; ss += o * o; }
                float rs = 1.f / sqrtf(ss / 128.f + 1e-6f);
                for (int n = 0; n < 128; ++n) { int c = h * 128 + n; float o = (C.OP[(b0 + n) * 2] + C.OP[(b0 + n) * 2 + 1] + C.OP[(b1 + n) * 2] + C.OP[(b1 + n) * 2 + 1]) * rs * hgn[c]; C.YCAT[(size_t)row * 1024 + 512 + c] = o * siluf_(C.Z[(size_t)row * EVEN_IN + RW_IN + 2048 + c]); } });
            DENSE_GEMM(C.YCAT, 1024, 1024, 1024, C.WoutE + (size_t)j2 * 1024 * 1024, C.ev_w_out + (size_t)j2 * 1024 * D, D_MODEL, C.YO, D_MODEL, NT_, D_MODEL, 1024);
}
FWD_QUAL void naive_scans(FWD_SIG, long layer) {
    const long j2 = layer / 2; (void)j2;
            NLAUNCH((long)2 * BATCH * RW_HEADS * 64, [=] HD(long i) { int v = (int)(i % 64); long t = i / 64; int h = (int)(t % RW_HEADS); t /= RW_HEADS; int b = (int)(t % BATCH); int d = (int)(t / BATCH);
                float S[64];
_Pragma("unroll")
                for (int k = 0; k < 64; ++k) S[k] = 0.f;
                for (int st = 0; st < TT_; ++st) { int row = tokrow(b, scan_pos(d, st)); size_t s0 = (size_t)row * 512 + h * 64, s1 = ((size_t)d * NT_ + row) * 512 + h * 64;
                    float sa = 0.f;
_Pragma("unroll")
                    for (int k = 0; k < 64; ++k) { sa += S[k] * C.NKK[s0 + k]; MEMFENCE_EVERY(k, 16); }
                    float vv = C.V[s0 + v], y = 0.f;
_Pragma("unroll")
                    for (int k = 0; k < 64; ++k) { S[k] = S[k] * C.DEC[s1 + k] + sa * C.BB[s1 + k] + vv * C.KD[s1 + k]; y += S[k] * C.R[s0 + k]; MEMFENCE_EVERY(k, 8); }
                    C.Y[s1 + v] = y; } });
            NLAUNCH((long)2 * BATCH * HG_HEADS * 128 * 2, [=] HD(long i) { int kh = (int)(i & 1); int v = (int)((i >> 1) % 128); long t = (i >> 1) / 128; int h = (int)(t % HG_HEADS); t /= HG_HEADS; int b = (int)(t % BATCH); int d = (int)(t / BATCH);
                float S[64];
_Pragma("unroll")
                for (int k = 0; k < 64; ++k) S[k] = 0.f;
                for (int st = 0; st < TT_; ++st) { int row = tokrow(b, scan_pos(d, st)); size_t s0 = (size_t)row * 512 + h * 128 + kh * 64, s1 = ((size_t)d * NT_ + row) * 512 + h * 128 + kh * 64;
                    float val = C.Z[(size_t)row * EVEN_IN + RW_IN + 1536 + h * 128 + v], o = 0.f;
_Pragma("unroll")
                    for (int k = 0; k < 64; ++k) { S[k] = C.HF[s1 + k] * S[k] + C.HK[s1 + k] * val; o += S[k] * C.HQ[s0 + k]; MEMFENCE_EVERY(k, 16); }
                    C.OP[(((size_t)d * NT_ + row) * 512 + h * 128 + v) * 2 + kh] = o; } });
}
FWD_QUAL void naive_scan_hgrn(FWD_SIG, long layer) {
    const long j2 = layer / 2; (void)j2;
            NLAUNCH((long)2 * BATCH * HG_HEADS * 128 * 2, [=] HD(long i) { int kh = (int)(i & 1); int v = (int)((i >> 1) % 128); long t = (i >> 1) / 128; int h = (int)(t % HG_HEADS); t /= HG_HEADS; int b = (int)(t % BATCH); int d = (int)(t / BATCH);
                float S[64];
_Pragma("unroll")
                for (int k = 0; k < 64; ++k) S[k] = 0.f;
                for (int st = 0; st < TT_; ++st) { int row = tokrow(b, scan_pos(d, st)); size_t s0 = (size_t)row * 512 + h * 128 + kh * 64, s1 = ((size_t)d * NT_ + row) * 512 + h * 128 + kh * 64;
                    float val = C.Z[(size_t)row * EVEN_IN + RW_IN + 1536 + h * 128 + v], o = 0.f;
_Pragma("unroll")
                    for (int k = 0; k < 64; ++k) { S[k] = C.HF[s1 + k] * S[k] + C.HK[s1 + k] * val; o += S[k] * C.HQ[s0 + k]; MEMFENCE_EVERY(k, 16); }
                    C.OP[(((size_t)d * NT_ + row) * 512 + h * 128 + v) * 2 + kh] = o; } });
}
FWD_QUAL void naive_odd(FWD_SIG, long layer) {
    const int D = D_MODEL, NT = NT_, NC = NC_; (void)D; (void)NT; (void)NC;
    const bool need_ctx = layer < DEPTH - 1; const long j2 = layer / 2; (void)need_ctx; (void)j2;
            DENSE_GEMM_UB(C.U, D_MODEL, D_MODEL, 1024, C.WinO + (size_t)j2 * 512 * 1024, C.od_w_in + (size_t)j2 * D * MLA_IN, MLA_IN, C.Z, EVEN_IN, NT_, MLA_IN, 512);
#define qng (C.mla_q_norm_g + (size_t)j2 * MLA_QR)
#define kvng (C.mla_kv_norm_g + (size_t)j2 * MLA_KVR)
            NLAUNCH((long)NT, [=] HD(long i) { int row = (int)i; const float* z = C.Z + (size_t)row * EVEN_IN;
                float ss = 0.f; for (int k = 0; k < MLA_QR; ++k) ss += z[k] * z[k]; float rs = 1.f / sqrtf(ss / MLA_QR + 1e-6f);
                for (int k = 0; k < MLA_QR; ++k) C.QN[(size_t)row * MLA_QR + k] = z[k] * rs * qng[k];
                ss = 0.f; for (int k = 0; k < MLA_KVR; ++k) ss += z[MLA_QR + k] * z[MLA_QR + k]; rs = 1.f / sqrtf(ss / MLA_KVR + 1e-6f);
                for (int k = 0; k < MLA_KVR; ++k) C.KVN[(size_t)row * MLA_KVR + k] = z[MLA_QR + k] * rs * kvng[k];
                const float* kp = z + MLA_QR + MLA_KVR; float* o = C.KPE + (size_t)row * 32;
                if (row < NC_) { for (int k = 0; k < 32; ++k) o[k] = kp[k]; }
                else { int s = (row - NC_) % SEQ; float fr = (float)(s / GRID_W), fc = (float)(s % GRID_W);
                    for (int q = 0; q < 8; ++q) { float inv = powf(10000.f, -(float)(2 * q) / 16.f); float ar = fr * inv, ac = fc * inv; float cr = cosf(ar), sr = sinf(ar), cc = cosf(ac), sc = sinf(ac);
                        o[q] = kp[q] * cr - kp[8 + q] * sr; o[8 + q] = kp[8 + q] * cr + kp[q] * sr; o[16 + q] = kp[16 + q] * cc - kp[24 + q] * sc; o[24 + q] = kp[24 + q] * cc + kp[16 + q] * sc; } } });
            DENSE_GEMM(C.QN, MLA_QR, MLA_QR, 256, C.Wqb + (size_t)j2 * 1536 * 256, C.mla_w_qb + (size_t)j2 * MLA_QR * 1536, 1536, C.Q, 1536, NT_, 1536, 1536);
            DENSE_GEMM(C.KVN, MLA_KVR, MLA_KVR, 256, C.Wkvb + (size_t)j2 * 2048 * 256, C.mla_w_kvb + (size_t)j2 * MLA_KVR * 2048, 2048, C.KV, 2048, NT_, 2048, 2048);
            NLAUNCH((long)NL_ * MLA_HEADS * 8, [=] HD(long i) { int q = (int)(i % 8); long t = i / 8; int h = (int)(t % MLA_HEADS); int lr = (int)(t / MLA_HEADS); int s = lr % SEQ;
                float* p = C.Q + (size_t)(NC_ + lr) * 1536 + h * 96 + 64; float fr = (float)(s / GRID_W), fc = (float)(s % GRID_W);
                float inv = powf(10000.f, -(float)(2 * q) / 16.f); float ar = fr * inv, ac = fc * inv; float cr = cosf(ar), sr = sinf(ar), cc = cosf(ac), sc = sinf(ac);
                float r1 = p[q], r2 = p[8 + q], c1 = p[16 + q], c2 = p[24 + q];
                p[q] = r1 * cr - r2 * sr; p[8 + q] = r2 * cr + r1 * sr; p[16 + q] = c1 * cc - c2 * sc; p[24 + q] = c2 * cc + c1 * sc; });
#if defined(PERSISTENT)
            GRID_STRIDE_WAVES(i, (long)NT_ * (MLA_HEADS * 96 / 8)) { const long row = i / (MLA_HEADS * 96 / 8); const int c8 = (int)(i % (MLA_HEADS * 96 / 8)) * 8; const float* q = C.Q + row * 1536 + c8; const float sc = 0.14724445136f;
                u32x4 w; w.x = att::pk2(q[0] * sc, q[1] * sc); w.y = att::pk2(q[2] * sc, q[3] * sc); w.z = att::pk2(q[4] * sc, q[5] * sc); w.w = att::pk2(q[6] * sc, q[7] * sc); *(u32x4*)(C.QB + row * 1536 + c8) = w; }
            GRID_STRIDE_WAVES(i, (long)NT_ * MLA_HEADS * 20) { const int c8 = (int)(i % 20); const long rh = i / 20; const int h = (int)(rh % MLA_HEADS); const int row = (int)(rh / MLA_HEADS);
                int b, t; if (row < NC_) { b = row / CTX_LEN; t = row % CTX_LEN; } else { b = (row - NC_) / SEQ; t = CTX_LEN + (row - NC_) % SEQ; }
                const size_t kvrow = (size_t)(b * MLA_HEADS + h) * TT_ + t;
                const float* src = c8 < 8 ? C.KV + (size_t)row * 2048 + h * 128 + c8 * 8 : (c8 < 12 ? C.KPE + (size_t)row * 32 + (c8 - 8) * 8 : C.KV + (size_t)row * 2048 + h * 128 + 64 + (c8 - 12) * 8);
                u32x4 w; w.x = att::pk2(src[0], src[1]); w.y = att::pk2(src[2], src[3]); w.z = att::pk2(src[4], src[5]); w.w = att::pk2(src[6], src[7]);
                if (c8 < 12) *(u32x4*)(C.KB + kvrow * 96 + c8 * 8) = w; else *(u32x4*)(C.VB + kvrow * 64 + (c8 - 12) * 8) = w; }
            grid_sync(bar);
            att::attn_phase<false, 0>(lds, C.QB, C.KB, C.VB, C.AO, nullptr, need_ctx ? 1 : 0, wv_);
            grid_sync(bar);
#else
            const long row_lo = need_ctx ? 0 : NC;
            NLAUNCH((long)(NT - row_lo) * MLA_HEADS * 2, [=] HD(long i) { const int nrows_ = NT_ - (int)row_lo; int hv = (int)(i / nrows_); int row = (int)row_lo + (int)(i % nrows_); const int h = hv >> 1, vh = hv & 1;
                int b, nkeys; if (row < NC_) { b = row / CTX_LEN; nkeys = CTX_LEN; } else { b = (row - NC_) / SEQ; nkeys = TT_; }
                float q[96];
_Pragma("unroll")
                for (int k = 0; k < 96; ++k) q[k] = C.Q[(size_t)row * 1536 + h * 96 + k];
                float o[32];
_Pragma("unroll")
                for (int k = 0; k < 32; ++k) o[k] = 0.f;
                float m = -1e30f, l = 0.f; const float scale = 0.10206207261596577f;
                for (int t = 0; t < nkeys; ++t) { int kr = tokrow(b, t); const float* kn = C.KV + (size_t)kr * 2048 + h * 128; const float* kp = C.KPE + (size_t)kr * 32;
                    float s = 0.f;
_Pragma("unroll")
                    for (int k = 0; k < 64; ++k) { s += q[k] * kn[k]; MEMFENCE_EVERY(k, 16); }
_Pragma("unroll")
                    for (int k = 0; k < 32; ++k) { s += q[64 + k] * kp[k]; MEMFENCE_EVERY(k, 16); }
                    s *= scale; float mn = fmaxf(m, s); float corr = expf(m - mn), p = expf(s - mn); l = l * corr + p;
_Pragma("unroll")
                    for (int k = 0; k < 32; ++k) { o[k] = o[k] * corr + p * kn[64 + vh * 32 + k]; MEMFENCE_EVERY(k, 16); }
                    m = mn; }
                float il = 1.f / l;
_Pragma("unroll")
                for (int k = 0; k < 32; ++k) C.AO[(size_t)row * 1024 + h * 64 + vh * 32 + k] = o[k] * il; });
#endif
            DENSE_GEMM(C.AO, 1024, 1024, 1024, C.WoutO + (size_t)j2 * 1024 * 1024, C.od_w_out + (size_t)j2 * 1024 * D, D_MODEL, C.YO, D_MODEL, NT_, D_MODEL, 1024);
}
FWD_QUAL void naive_common(FWD_SIG, long layer) {
#if defined(PERSISTENT)
    {
        const int row_lo = layer < DEPTH - 1 ? 0 : NC_, nrows = NT_ - row_lo;
#if CV_BACKGROUND
        if (layer > 0) cv_catchup(Cp_, layer, wv_);
#endif
#if CV_TAIL && !CV_BACKGROUND
        if (layer > 0) cv_catch(Cp_, lds, layer, wv_);
#endif
        tl::ln1_router(Cp_, lds, layer, row_lo, nrows, wv_); grid_sync(bar);
        tl::slots_gather(Cp_, layer, row_lo, nrows, wv_); grid_sync(bar);
        RP(REP_MOE,
        { g8::MoeSched S_; S_.init(C.UB, C.Wgu + (size_t)layer * N_EXPERTS * 2 * EXPERT_DIM * D_MODEL, D_MODEL, 2 * EXPERT_DIM, N_EXPERTS, (const LAS int*)tl::tl_tstart, gridDim.x, moe_remap(opaque_bid(), gridDim.x, 2 * EXPERT_DIM / 256)); S_.gather = true; MOE_SET_CHUNK
          LAS int* gtab = (LAS int*)(lds + 131072);
          { const int t_ = otid(wv_); const GAS int* tok_ = (const GAS int*)C.TOKOF; int gv_[20];
            _Pragma("unroll") for (int i_ = 0; i_ < 20; ++i_) { const long L_ = S_.unit(i_); const int rt_ = (int)((L_ < 0 ? 0 : L_) / S_.NCT); gv_[i_] = (L_ >= 0 && t_ < 256) ? tok_[(size_t)rt_ * 256 + t_] : 0; }
            _Pragma("unroll") for (int i_ = 0; i_ < 20; ++i_) { const long L_ = S_.unit(i_); if (L_ >= 0 && t_ < 256) gtab[i_ * 256 + t_] = gv_[i_]; } }
          __syncthreads();
          g8::EpiSwiGLU E_{C.ACTB, C.moe_b_gu + (size_t)layer * N_EXPERTS * 2 * EXPERT_DIM, EXPERT_DIM}; g8::gemm_phase<D_MODEL, g8::EpiSwiGLU, g8::MoeSched, true>(lds, S_, E_, wv_, gtab, CV_CTX);
#if CV_TAIL && !CV_BACKGROUND
          if (layer < DEPTH - 1) cv_tail(Cp_, lds, S_, wv_);
#endif
          }
        grid_sync(bar);
        { g8::MoeSched S_; S_.init(C.ACTB, C.Wdn + (size_t)layer * N_EXPERTS * D_MODEL * EXPERT_DIM, EXPERT_DIM, D_MODEL, N_EXPERTS, (const LAS int*)tl::tl_tstart, gridDim.x, moe_remap(opaque_bid(), gridDim.x, D_MODEL / 256)); MOE_SET_CHUNK
          g8::EpiDownBf16 E_{C.OUT2B, D_MODEL, C.moe_b_down + (size_t)layer * N_EXPERTS * D_MODEL}; g8::gemm_phase<EXPERT_DIM, g8::EpiDownBf16, g8::MoeSched>(lds, S_, E_, wv_, nullptr, CV_CTX);
#if CV_TAIL && !CV_BACKGROUND
          if (layer < DEPTH - 1) cv_tail(Cp_, lds, S_, wv_);
#endif
          }
        grid_sync(bar);
        )
        tl::combine_ln2(Cp_, layer, row_lo, nrows, wv_); grid_sync(bar);
    }
#else

    const int D = D_MODEL, NT = NT_, NC = NC_; (void)D; (void)NT; (void)NC;
    const bool need_ctx = layer < DEPTH - 1; const long j2 = layer / 2; (void)need_ctx; (void)j2;
#define lng0 (C.ln_g + ((size_t)layer * 2 + 0) * D_MODEL)
#define lnb0 (C.ln_b + ((size_t)layer * 2 + 0) * D_MODEL)
#define lng1 (C.ln_g + ((size_t)layer * 2 + 1) * D_MODEL)
#define lnb1 (C.ln_b + ((size_t)layer * 2 + 1) * D_MODEL)
        const long row_lo = need_ctx ? 0 : NC;
        NLAUNCH((long)(NT - row_lo), [=] HD(long i) { int row = (int)row_lo + (int)i; const float* m = MODL + (size_t)modrow(row) * N_MOD * D_MODEL; float* h = C.H + (size_t)row * D_MODEL; const float* yo = C.YO + (size_t)row * D_MODEL;
            float mu_ = 0.f; for (int d = 0; d < D_MODEL; ++d) mu_ += ALPHA * h[d] + m[2 * D_MODEL + d] * yo[d]; mu_ /= D_MODEL;
            float var = 0.f; for (int d = 0; d < D_MODEL; ++d) { float t = ALPHA * h[d] + m[2 * D_MODEL + d] * yo[d] - mu_; var += t * t; } var /= D_MODEL;
            float rs = 1.f / sqrtf(var + 1e-5f);
            for (int d = 0; d < D_MODEL; ++d) { float t = (ALPHA * h[d] + m[2 * D_MODEL + d] * yo[d] - mu_) * rs * lng0[d] + lnb0[d]; h[d] = t; C.U[(size_t)row * D_MODEL + d] = t * (1.f + m[4 * D_MODEL + d]) + m[3 * D_MODEL + d]; } });
#define wr (C.moe_w_router + (size_t)layer * D_MODEL * N_EXPERTS)
#define br (C.moe_b_router + (size_t)layer * N_EXPERTS)
        NLAUNCH((long)(NT - row_lo) * N_EXPERTS, [=] HD(long i) { int e = (int)(i % N_EXPERTS); int row = (int)row_lo + (int)(i / N_EXPERTS); const float* u = C.U + (size_t)row * D_MODEL;
            float s = 0.f; for (int k = 0; k < D_MODEL; ++k) s += u[k] * wr[(size_t)k * N_EXPERTS + e]; C.LOGIT[(size_t)row * N_EXPERTS + e] = s + br[e]; });
#define CNTL (C.CNT + layer * 64)
#define CURL (C.CUR + layer * 64)
        NLAUNCH((long)(NT - row_lo), [=] HD(long i) { int row = (int)row_lo + (int)i; const float* lg = C.LOGIT + (size_t)row * N_EXPERTS; int idx[TOP_K]; float val[TOP_K];
            for (int k = 0; k < TOP_K; ++k) { int best = -1; float bv = -3.4e38f; for (int e = 0; e < N_EXPERTS; ++e) { bool used = false; for (int q = 0; q < k; ++q) used |= (idx[q] == e); if (!used && lg[e] > bv) { bv = lg[e]; best = e; } } idx[k] = best; val[k] = bv; }
            float den = 0.f; for (int k = 0; k < TOP_K; ++k) den += expf(val[k] - val[0]);
            for (int k = 0; k < TOP_K; ++k) { C.TOPI[(size_t)row * TOP_K + k] = idx[k]; C.TOPG[(size_t)row * TOP_K + k] = expf(val[k] - val[0]) / den;
#ifdef HOST_TEST
                CNTL[idx[k]]++;
#else
                atomicAdd(&CNTL[idx[k]], 1);
#endif
            } });
        NLAUNCH(1, [=] HD(long) { int off = 0; for (int e = 0; e < N_EXPERTS; ++e) { C.OFF[e] = off; const int cnt = ld_cnt(CNTL + e); int nt = (cnt + MOE_PAD - 1) / MOE_PAD * MOE_PAD; for (int t = 0; t < nt / 64; ++t) C.TILE_E[off / 64 + t] = (t * 64 < cnt) ? e : -1; off += nt; }
            for (int t = off / 64; t < NSLOT_ / 64; ++t) C.TILE_E[t] = -1; });
        NLAUNCH((long)NSLOT_, [=] HD(long i) { C.TOKOF[i] = -1; });
        NLAUNCH((long)(NT - row_lo) * TOP_K, [=] HD(long i) { int row = (int)row_lo + (int)(i / TOP_K); int k = (int)(i % TOP_K); int e = C.TOPI[(size_t)row * TOP_K + k];
#ifdef HOST_TEST
            int r = CURL[e]++;
#else
            int r = atomicAdd(&CURL[e], 1);
#endif
            int s = C.OFF[e] + r; C.SLOT[(size_t)row * TOP_K + k] = s; C.TOKOF[s] = row; });
#if defined(PERSISTENT)
        {
            __shared__ int tstart_s[40];
            if (otid(wv_) == 0) { int acc_t = 0; for (int e = 0; e < N_EXPERTS; ++e) { tstart_s[e] = acc_t; acc_t += (ld_cnt(CNTL + e) + MOE_PAD - 1) / MOE_PAD; } tstart_s[N_EXPERTS] = acc_t; }
            GRID_STRIDE_WAVES(i, (long)NSLOT_ * (D_MODEL / 8)) { const long sl = i / (D_MODEL / 8); const int c8 = (int)(i % (D_MODEL / 8)) * 8; const int tk = C.TOKOF[sl]; u32x4 w = (u32x4){0u, 0u, 0u, 0u};
                if (tk >= 0) { const float4 a = *(const float4*)(C.U + (size_t)tk * D_MODEL + c8), b = *(const float4*)(C.U + (size_t)tk * D_MODEL + c8 + 4);
                    w.x = cvt_pk_bf16(a.x, a.y); w.y = cvt_pk_bf16(a.z, a.w); w.z = cvt_pk_bf16(b.x, b.y); w.w = cvt_pk_bf16(b.z, b.w); }
                *(u32x4*)(C.XPB + sl * D_MODEL + c8) = w; }
            grid_sync(bar);
            { g8::MoeSched S_; S_.init(C.XPB, C.Wgu + (size_t)layer * N_EXPERTS * 2 * EXPERT_DIM * D_MODEL, D_MODEL, 2 * EXPERT_DIM, N_EXPERTS, (const LAS int*)tstart_s, gridDim.x, opaque_bid());
              g8::EpiSwiGLU E_{C.ACTB, C.moe_b_gu + (size_t)layer * N_EXPERTS * 2 * EXPERT_DIM, EXPERT_DIM}; g8::gemm_phase<D_MODEL, g8::EpiSwiGLU, g8::MoeSched>(lds, S_, E_, wv_); }
            grid_sync(bar);
            { g8::MoeSched S_; S_.init(C.ACTB, C.Wdn + (size_t)layer * N_EXPERTS * D_MODEL * EXPERT_DIM, EXPERT_DIM, D_MODEL, N_EXPERTS, (const LAS int*)tstart_s, gridDim.x, opaque_bid());
              g8::EpiDownF32 E_{C.OUT2, D_MODEL, C.moe_b_down + (size_t)layer * N_EXPERTS * D_MODEL}; g8::gemm_phase<EXPERT_DIM, g8::EpiDownF32, g8::MoeSched>(lds, S_, E_, wv_); }
            grid_sync(bar);
        }
#else
        const int F = EXPERT_DIM;
        ngemm(C.U, D, C.TOKOF, C.moe_w_gu + (size_t)layer * N_EXPERTS * D * 2 * F, (long)D * 2 * F, 2 * F, C.moe_b_gu + (size_t)layer * N_EXPERTS * 2 * F, 2 * F, C.H1, 2 * F, NSLOT_, 2 * F, D, C.TILE_E);
        NLAUNCH((long)NSLOT_ * F, [=] HD(long i) { long s = i / EXPERT_DIM; int j = (int)(i % EXPERT_DIM); if (C.TOKOF[s] < 0) { C.ACT[i] = 0.f; return; }
            float glu = fminf(C.H1[s * 2 * EXPERT_DIM + j], 7.f), lin = fminf(fmaxf(C.H1[s * 2 * EXPERT_DIM + EXPERT_DIM + j], -7.f), 7.f);
            C.ACT[i] = glu * sigmoidf_(1.702f * glu) * (lin + 1.f); });
        ngemm(C.ACT, F, nullptr, C.moe_w_down + (size_t)layer * N_EXPERTS * F * D, (long)F * D, D, C.moe_b_down + (size_t)layer * N_EXPERTS * D, D, C.OUT2, D, NSLOT_, D, F, C.TILE_E);
#endif
#define outp (C.out)
        const long last = (layer == DEPTH - 1);
        NLAUNCH((long)(NT - row_lo), [=] HD(long i) { int row = (int)row_lo + (int)i; const float* m = MODL + (size_t)modrow(row) * N_MOD * D_MODEL; float* h = C.H + (size_t)row * D_MODEL;
            const int* sl = C.SLOT + (size_t)row * TOP_K; const float* tg = C.TOPG + (size_t)row * TOP_K;
            float mu_ = 0.f; for (int d = 0; d < D_MODEL; ++d) { float f = 0.f; for (int k = 0; k < TOP_K; ++k) f += tg[k] * C.OUT2[(size_t)sl[k] * D_MODEL + d]; mu_ += ALPHA * h[d] + m[5 * D_MODEL + d] * f; } mu_ /= D_MODEL;
            float var = 0.f; for (int d = 0; d < D_MODEL; ++d) { float f = 0.f; for (int k = 0; k < TOP_K; ++k) f += tg[k] * C.OUT2[(size_t)sl[k] * D_MODEL + d]; float t = ALPHA * h[d] + m[5 * D_MODEL + d] * f - mu_; var += t * t; } var /= D_MODEL;
            float rs = 1.f / sqrtf(var + 1e-5f);
            for (int d = 0; d < D_MODEL; ++d) { float f = 0.f; for (int k = 0; k < TOP_K; ++k) f += tg[k] * C.OUT2[(size_t)sl[k] * D_MODEL + d]; float t = (ALPHA * h[d] + m[5 * D_MODEL + d] * f - mu_) * rs * lng1[d] + lnb1[d]; h[d] = t; if (last) outp[(size_t)(row - NC_) * D_MODEL + d] = t; } });
#endif
}


#if defined(PERSISTENT)
#define MG_DENSE(KP, EPI, Aptr, Wptr, Mrows, NP, ...) do { g8::DenseSched S_; S_.init((Aptr), (Wptr), (Mrows), (NP), (KP), gridDim.x, opaque_bid()); g8::EPI E_{__VA_ARGS__}; g8::gemm_phase<(KP), g8::EPI, g8::DenseSched>(lds, S_, E_, wv_, nullptr, CV_CTX); } while (0)
FWD_QUAL void mega_even(FWD_SIG, long layer) {
    const long j2 = layer / 2;
    RP(REP_DEN, MG_DENSE(1024, EpiBf16, C.UB, C.WinE + (size_t)j2 * 4608 * 1024, NT_, 4608, C.ZB, 4608, 1.f); grid_sync(bar);)
    RP(REP_TLE, tl::rw_tw(Cp_, layer, wv_); grid_sync(bar);)
    RP(REP_DEN, { g8::LoraSched S_; S_.init(C.TW, C.Wlora + (size_t)j2 * 2560 * 384, NT_, 2560, 384, gridDim.x, opaque_bid()); g8::EpiBf16 E_{C.LOB, 2560, 1.f}; g8::gemm_phase<256, g8::EpiBf16, g8::LoraSched, false, 384>(lds, S_, E_, wv_, nullptr, CV_CTX); } grid_sync(bar);)
    RP(REP_TLE, tl::rw_prep(Cp_, layer, wv_); grid_sync(bar);)
    RP(REP_RWS, rwc::rwkv_chunk_scan(Cp_, lds, wv_);)
    RP(REP_HGS, hg::hgrn_scan(Cp_, lds, layer, wv_); grid_sync(bar);)
    RP(REP_TLE, tl::even_post(Cp_, layer, wv_); grid_sync(bar);)
    RP(REP_DEN, MG_DENSE(1024, EpiBf16, C.YCATB, C.WoutE + (size_t)j2 * 1024 * 1024, NT_, 1024, C.YOB, D_MODEL, 1.f); grid_sync(bar);)
}
FWD_QUAL void mega_odd(FWD_SIG, long layer) {
    const long j2 = layer / 2; const bool need_ctx = layer < DEPTH - 1;
    RP(REP_DEN, MG_DENSE(1024, EpiBf16, C.UB, C.WinO + (size_t)j2 * 512 * 1024, NT_, 512, (bf16_t*)C.Z, 512, 1.f); grid_sync(bar);)
    RP(REP_TLE, tl::mla_prep(Cp_, layer, wv_); grid_sync(bar);)
    const size_t r0 = need_ctx ? 0 : (size_t)NC_; const int mq = need_ctx ? NT_ : NT_ - NC_;
    RP(REP_DEN, MG_DENSE(256, EpiBf16, C.QNB + r0 * 256, C.Wqb + (size_t)j2 * 1536 * 256, mq, 1536, C.QB + r0 * 1536, 1536, 0.14724445136f);)
    RP(REP_DEN, MG_DENSE(256, EpiBf16, C.KVNB, C.Wkvb + (size_t)j2 * 2048 * 256, NT_, 2048, C.KVB, 2048, 1.f); grid_sync(bar);)
    RP(REP_ATT, att::attn_phase<true, 1>(lds, C.QB, C.KVB, C.KPEB, nullptr, C.AOB, need_ctx ? 1 : 0, wv_, C.ROPE); grid_sync(bar);)
    RP(REP_DEN, MG_DENSE(1024, EpiBf16, C.AOB + r0 * 1024, C.WoutO + (size_t)j2 * 1024 * 1024, mq, 1024, C.YOB + r0 * D_MODEL, D_MODEL, 1.f); grid_sync(bar);)
}
#endif
FWD_QUAL void naive_forward(FWD_SIG) {
#if defined(PERSISTENT)
    RP(REP_PRO, naive_prologue(FWD_ARGS);)
#else
    naive_prologue(FWD_ARGS);
#endif
#if defined(PERSISTENT)
    mega_even(FWD_ARGS, 0); naive_common(FWD_ARGS, 0);
    mega_odd(FWD_ARGS, 1); naive_common(FWD_ARGS, 1);
    mega_even(FWD_ARGS, 2); naive_common(FWD_ARGS, 2);
    mega_odd(FWD_ARGS, 3); naive_common(FWD_ARGS, 3);
#else
    for (long p = 0; p < DEPTH / 2; ++p) {
        naive_modu(FWD_ARGS, 2 * p); naive_even(FWD_ARGS, 2 * p); naive_common(FWD_ARGS, 2 * p);
        naive_modu(FWD_ARGS, 2 * p + 1); naive_odd(FWD_ARGS, 2 * p + 1); naive_common(FWD_ARGS, 2 * p + 1);
    }
#endif
}

#undef MODL
#undef mu
#undef w0
#undef w2
#undef a0
#undef a2
#undef g2
#undef k_k
#undef k_a
#undef r_k
#undef gn_g
#undef gn_b
#undef lbp
#undef hgn
#undef qng
#undef kvng
#undef lng0
#undef lnb0
#undef lng1
#undef lnb1
#undef wr
#undef br
#undef CNTL
#undef CURL
#undef outp

#ifdef PERSIST_C_MACRO
#undef C
#endif
struct Params { NaiveCtx C; unsigned* bar; };
__global__ void __launch_bounds__(PB_THREADS, 2) mega_fwd(Params p) {
    extern __shared__ __attribute__((aligned(16))) unsigned char dyn_lds[];
    __shared__ NaiveCtx sC;
    __shared__ uint4 xb_words;
    typedef unsigned long long u64;
    const __attribute__((address_space(4))) u64* ka = (const __attribute__((address_space(4))) u64*)__builtin_amdgcn_kernarg_segment_ptr();
    constexpr int NW = (int)(sizeof(NaiveCtx) / 8);
    if (threadIdx.x < NW) ((LAS u64*)&sC)[threadIdx.x] = ka[threadIdx.x];
    if (threadIdx.x == 0) xb_words = make_uint4(0u, 0u, 0u, 0u);
    __syncthreads();
    unsigned* barp = (unsigned*)ka[NW];
    XcdBarrier bar = xcd_barrier_post(barp, (volatile LAS unsigned*)&xb_words);
    naive_forward((const LAS NaiveCtx*)&sC, bar, (LAS unsigned char*)dyn_lds, __builtin_amdgcn_readfirstlane(threadIdx.x >> 6));
}
extern "C" void kernel_launch(void* const* d_in, const int* in_sizes, int n_in, void* d_out, int out_size, void* d_ws, size_t ws_size, hipStream_t stream) {
    static int grid = 0;
    constexpr size_t kDynLds = 152 * 1024;
    if (grid == 0) {
        int dev = 0, cus = 0, per_cu = 0;
        hipGetDevice(&dev); hipDeviceGetAttribute(&cus, hipDeviceAttributeMultiprocessorCount, dev);
        hipFuncSetAttribute((const void*)mega_fwd, hipFuncAttributeMaxDynamicSharedMemorySize, (int)kDynLds);
        hipOccupancyMaxActiveBlocksPerMultiprocessor(&per_cu, (const void*)mega_fwd, PB_THREADS, kDynLds);
        if (per_cu < 1) { fprintf(stderr, "kernel_launch: occupancy query says %d blocks per CU\n", per_cu); grid = -1; return; }
        grid = cus;
    }
    if (grid < 0) return;
    Params p; memset(&p, 0, sizeof(p));
    const float** ip = (const float**)&p.C.x; for (int i = 0; i < 35; ++i) ip[i] = (const float*)d_in[i];
    p.C.out = (float*)d_out;
    const size_t ctl_bytes = 64 * 1024;
    p.bar = (unsigned*)d_ws;
    size_t need = ctl_bytes + mega_carve(p.C, (char*)d_ws + ctl_bytes);
    if (n_in != 35 || need > ws_size) { fprintf(stderr, "kernel_launch: n_in %d ws need %zu have %zu\n", n_in, need, ws_size); return; }
    hipMemsetAsync(d_ws, 0, ctl_bytes, stream);
    hipMemsetAsync(p.C.CNT, 0, 64 * DEPTH * 4 * 2 + 512, stream);
    hipLaunchKernelGGL(mega_fwd, dim3(grid), dim3(PB_THREADS), kDynLds, stream, p);
}
```

```cpp
#include <hip/hip_runtime.h>
#include <cstdio>
#include <cstring>
#include <cmath>
#define PERSISTENT 1

#define PB_THREADS 512
#define XB_TMO      128
#define XB_XCNT(j)  (256  + 64 * (j))
#define XB_XSUB(j)  (1280 + 64 * (j))
#define XB_XGEN(j)  (2304 + 64 * (j))
#define XB_TOP      3328
#define XB_TOPGEN   3392
#define XCD_BAR_WORDS 3456
#define XB_SPIN_CAP (1u << 22)
#define LAS __attribute__((address_space(3)))

__device__ __forceinline__ unsigned xb_ld(unsigned* p)              { return __hip_atomic_load(p, __ATOMIC_RELAXED, __HIP_MEMORY_SCOPE_AGENT); }
__device__ __forceinline__ unsigned xb_add(unsigned* p, unsigned v) { return __hip_atomic_fetch_add(p, v, __ATOMIC_RELAXED, __HIP_MEMORY_SCOPE_AGENT); }
__device__ __forceinline__ unsigned xb_xcc_id() { return (unsigned)__builtin_amdgcn_s_getreg((3 << 11) | 20) & 0xFu; }
#define XB_SPIN(cond, bar) do { unsigned _sp = 0; while (cond) { __builtin_amdgcn_s_sleep(1); \
    if ((++_sp & 255u) == 0u) { if (xb_ld(&(bar)[XB_TMO])) break; if (_sp > XB_SPIN_CAP) { atomicAdd(&(bar)[XB_TMO], 1u); break; } } } } while (0)

struct XcdBarrier {
    unsigned* bar; unsigned x;
    volatile LAS unsigned* st;
};

__device__ __forceinline__ XcdBarrier xcd_barrier_post(unsigned* bar, volatile LAS unsigned* st) {
    XcdBarrier b; b.bar = bar; b.x = xb_xcc_id(); b.st = st;
    if (threadIdx.x == 0) (void)xb_add(&bar[XB_XCNT(b.x)], 1u);
    return b;
}
__device__ __forceinline__ void xcd_barrier_complete(unsigned* bar, unsigned x, unsigned& nloc, unsigned& nx) {
    const unsigned G = gridDim.x * gridDim.y * gridDim.z;
    unsigned sum, cnt, mine, sp = 0u;
    for (;;) {
        sum = 0u; cnt = 0u; mine = 0u;
#pragma unroll
        for (unsigned j = 0; j < 16; ++j) { const unsigned c = xb_ld(&bar[XB_XCNT(j)]); sum += c; cnt += (c > 0u) ? 1u : 0u; mine = (j == x) ? c : mine; }
        if (sum == G) break;
        __builtin_amdgcn_s_sleep(1);
        if ((++sp & 255u) == 0u) { if (xb_ld(&bar[XB_TMO])) break; if (sp > XB_SPIN_CAP) { atomicAdd(&bar[XB_TMO], 1u); break; } }
    }
    nloc = mine > 0u ? mine : 1u; nx = cnt > 0u ? cnt : 1u;
}

__device__ __forceinline__ void xcd_barrier(const XcdBarrier& b) {
    asm volatile("s_waitcnt vmcnt(0)" ::: "memory");
    __syncthreads();
    if (threadIdx.x == 0) {
        unsigned* bar = b.bar;
        __builtin_amdgcn_s_waitcnt(0);
        unsigned nloc = b.st[0], nx = b.st[1];
        if (nloc == 0u) { xcd_barrier_complete(bar, b.x, nloc, nx); b.st[0] = nloc; b.st[1] = nx; }
        const unsigned old = xb_add(&bar[XB_XSUB(b.x)], 1u);
        const unsigned gen = old / nloc;
        if (old + 1u == (gen + 1u) * nloc) {
            __builtin_amdgcn_fence(__ATOMIC_RELEASE, "agent");
            asm volatile("s_waitcnt vmcnt(0)" ::: "memory");
            const unsigned og = xb_add(&bar[XB_TOP], 1u);
            const unsigned tg = og / nx;
            if (og + 1u == (tg + 1u) * nx) xb_add(&bar[XB_TOPGEN], 1u);
            else XB_SPIN(xb_ld(&bar[XB_TOPGEN]) == tg, bar);
            __builtin_amdgcn_fence(__ATOMIC_ACQUIRE, "agent");
            xb_add(&bar[XB_XGEN(b.x)], 1u);
            asm volatile("s_waitcnt vmcnt(0)" ::: "memory");
        } else {
            XB_SPIN(xb_ld(&bar[XB_XGEN(b.x)]) == gen, bar);
            __builtin_amdgcn_fence(__ATOMIC_ACQUIRE, "agent");
            asm volatile("s_waitcnt vmcnt(0)" ::: "memory");
        }
    }
    __syncthreads();
}
typedef unsigned short bf16_t;
typedef short bf16x8 __attribute__((ext_vector_type(8)));
typedef float f32x4 __attribute__((ext_vector_type(4)));
typedef unsigned u32x4 __attribute__((ext_vector_type(4)));
typedef unsigned u32x2 __attribute__((ext_vector_type(2)));
#define DI __device__ __forceinline__
#define GAS __attribute__((address_space(1)))
DI int opaque_bid() { int b = blockIdx.x; asm volatile("" : "+s"(b)); return b; }
DI int otid(int wv) { int l; asm volatile("v_mbcnt_lo_u32_b32 %0, -1, 0\n\tv_mbcnt_hi_u32_b32 %0, -1, %0" : "=v"(l) : "s"(wv)); return (wv << 6) | l; }
DI void grid_sync(const XcdBarrier& b) { XcdBarrier t = b; asm volatile("" : "+s"(t.bar), "+s"(t.x)); xcd_barrier(t); }
DI void lds_barrier() { asm volatile("s_waitcnt lgkmcnt(0)\n\ts_barrier" ::: "memory"); }
DI float fexp2(float x) { return __builtin_amdgcn_exp2f(x); }
DI float fexp(float x) { return __builtin_amdgcn_exp2f(x * 1.4426950408889634f); }
DI float flog2(float x) { return __builtin_amdgcn_logf(x); }
DI float flog(float x) { return __builtin_amdgcn_logf(x) * 0.6931471805599453f; }
DI float fsigmoid(float x) { return __builtin_amdgcn_rcpf(1.f + fexp(-x)); }
DI float fsilu(float x) { return x * fsigmoid(x); }
DI float ftanh(float x) { return 2.f * fsigmoid(2.f * x) - 1.f; }
DI float fsoftplus(float x) { return x > 20.f ? x : flog(1.f + fexp(x)); }
DI unsigned cvt_pk_bf16(float lo, float hi) { unsigned r; asm volatile("v_cvt_pk_bf16_f32 %0, %1, %2" : "=v"(r) : "v"(lo), "v"(hi)); return r; }
DI float bf_lo(unsigned w) { return __uint_as_float(w << 16); }
DI float bf_hi(unsigned w) { return __uint_as_float(w & 0xffff0000u); }
#ifndef REP_EPI
#define REP_EPI 1
#endif
struct NaiveCtx;
DI LAS int* cv_counter(const LAS NaiveCtx* Cp_);
DI bool cv_addr(const LAS NaiveCtx* Cp_, int T, int tid, const float*& sp, bf16_t*& dp, int& ld);
#ifndef CV_CARRY
#define CV_CARRY 1
#endif
#ifndef CV_NH
#define CV_NH 1
#endif
#define CV_LOADS(V, sp, ld) do { _Pragma("unroll") for (int i_ = 0; i_ < 4; ++i_) _Pragma("unroll") for (int h_ = 0; h_ < CV_NH; ++h_) V[i_][h_] = __builtin_nontemporal_load((const GAS f32x4*)((sp) + (size_t)i_ * (ld) + 4 * h_)); } while (0)
#define CV_STORES(V, dp) do { _Pragma("unroll") for (int j_ = 0; j_ < 4 * CV_NH; ++j_) { u32x2 w_; w_.x = cvt_pk_bf16(V[0][j_ >> 2][j_ & 3], V[1][j_ >> 2][j_ & 3]); w_.y = cvt_pk_bf16(V[2][j_ >> 2][j_ & 3], V[3][j_ >> 2][j_ & 3]); \
        *(GAS u32x2*)((dp) + (size_t)j_ * 1024) = w_; } } while (0)
namespace g8 {
constexpr int BM = 256, BK = 64, HALF = 128, HTB = HALF * BK * 2, STAGE_BYTES = 8 * HTB, NXCD = 8, WGM = 8;
__host__ __device__ __forceinline__ int lds_byte(int r, int c) { const int st = (r >> 4) * 2 + (c >> 5), rr = r & 15, cc = c & 31, ob = rr * 64 + cc * 2; return st * 1024 + (ob ^ (((ob >> 9) & 1) << 5)); }
__host__ __device__ __forceinline__ void stage_rc(int b, int& R, int& C) { const int st = b / 1024, sb = b % 1024, swz = sb ^ (((sb >> 9) & 1) << 5); R = (st >> 1) * 16 + swz / 64; C = (st & 1) * 32 + (swz % 64) / 2; }
__host__ __device__ __forceinline__ int perm32(int rho) { const int n = rho >> 4, i = rho & 15; return 8 * (i >> 2) + 4 * n + (i & 3); }
struct Unit { int pm, pn, e; };

struct DenseSched {
    const char* A; const char* Bt; size_t tstep; int nM, nN, nwg, G, c;
    DI void init(const bf16_t* A_, const bf16_t* Bt_, int M, int N, int K, int G_, int c_) { A = (const char*)A_; Bt = (const char*)Bt_; tstep = (size_t)BM * K * 2; nM = M / BM; nN = N / BM; nwg = nM * nN; G = G_; c = c_; }
    DI bool next(int i, Unit& u) const {
        const long L = (long)i * G + c; if (L >= nwg) return false;
        int wgid = (int)L; { const int q = nwg / NXCD, r = nwg % NXCD, xcd = wgid % NXCD, off = wgid / NXCD; wgid = (xcd < r ? xcd * (q + 1) : r * (q + 1) + (xcd - r) * q) + off; }
        const int nig = WGM * nN, gid = wgid / nig, fm = gid * WGM, gsz = (nM - fm) < WGM ? (nM - fm) : WGM;
        u.pm = fm + ((wgid % nig) % gsz); u.pn = (wgid % nig) / gsz; u.e = 0; return true;
    }
    DI const char* a(const Unit& u) const { return A + (size_t)u.pm * tstep; }
    DI const char* b(const Unit& u) const { return Bt + (size_t)u.pn * tstep; }
};

struct LoraSched : DenseSched {
    DI const char* a(const Unit& u) const { return A + (size_t)u.pm * tstep + (u.pn < 8 ? 0 : 256); }
    DI const char* b(const Unit& u) const { return Bt + (size_t)u.pn * tstep + (u.pn < 8 ? 0 : 256); }
};

struct EpiF32 {
    static constexpr bool PERM = false;
    float* C; int ldc; int ncols;
    DI void operator()(const f32x4 (&acc)[2][2][4][2], const Unit& u, int wr, int wc, int fr, int fq) const {
        const int row0 = u.pm * BM + wr * 64 + fr, col0 = u.pn * BM + wc * 32 + 4 * fq;
#pragma unroll
        for (int ai = 0; ai < 2; ++ai)
#pragma unroll
            for (int m = 0; m < 4; ++m) { float* rowp = C + (size_t)(row0 + ai * HALF + m * 16) * ldc + col0;
#pragma unroll
                for (int bj = 0; bj < 2; ++bj)
#pragma unroll
                    for (int n = 0; n < 2; ++n) if (col0 + bj * HALF + n * 16 < ncols) *(GAS f32x4*)(rowp + bj * HALF + n * 16) = acc[ai][bj][m][n]; }
    }
};


struct MoeSched {
    const char* A; const char* Bt; size_t tstep, bstride; const LAS int* tstart; int NCT, nE, nunits, G, c;
    DI void init(const bf16_t* A_, const bf16_t* Bt_, int K, int N, int nE_, const LAS int* tstart_, int G_, int c_) { A = (const char*)A_; Bt = (const char*)Bt_; tstep = (size_t)BM * K * 2; bstride = (size_t)N * K * 2; tstart = tstart_; NCT = N / BM; nE = nE_; nunits = tstart_[nE_] * NCT; G = G_; c = c_; }
    int cs = 0, cl = 0, jj = 0; bool chunk = false;
    DI void set_chunk(int craw) { if (G != 256) return; const int x = craw & 7, q = nunits / NXCD, r = nunits % NXCD; jj = craw >> 3; cs = x * q + (x < r ? x : r); cl = q + (x < r ? 1 : 0); chunk = true; }
    DI long unit(int i) const { if (chunk) { const int k = i * 32 + jj; return k < cl ? (long)cs + k : -1L; } const long L = (long)i * G + c; return L < nunits ? L : -1L; }
    DI bool next(int i, Unit& u) const {
        const long L = unit(i); if (L < 0) return false;
        const int rt = (int)(L / NCT); u.pm = rt; u.pn = (int)(L % NCT);
        const int ln_ = (int)__builtin_amdgcn_mbcnt_hi(~0u, __builtin_amdgcn_mbcnt_lo(~0u, 0u));
        const bool hit_ = (ln_ >= 1 && ln_ < nE) ? (tstart[ln_] <= rt) : false;
        u.e = (int)__builtin_popcountll(__ballot(hit_)); return true;
    }
    bool gather = false;
    DI const char* a(const Unit& u) const { return gather ? A : A + (size_t)u.pm * tstep; }
    DI const char* b(const Unit& u) const { return Bt + (size_t)u.e * bstride + (size_t)u.pn * tstep; }
};
struct EpiSwiGLU {
    static constexpr bool PERM = true;
    bf16_t* ACT; const float* bgu; int F;
    DI void operator()(const f32x4 (&acc)[2][2][4][2], const Unit& u, int wr, int wc, int fr, int fq) const {
        const int row0 = u.pm * BM + wr * 64 + fr, j0 = u.pn * HALF + wc * 32 + 8 * fq;
        const float* bp = bgu + (size_t)u.e * 2 * F + j0;
        f32x4 bg[2], bl[2];
#pragma unroll
        for (int n = 0; n < 2; ++n) { bg[n] = *(const GAS f32x4*)(bp + 4 * n); bl[n] = *(const GAS f32x4*)(bp + F + 4 * n); }
#pragma unroll
        for (int ai = 0; ai < 2; ++ai)
#pragma unroll
            for (int m = 0; m < 4; ++m) { float o[8];
#pragma unroll
                for (int n = 0; n < 2; ++n)
#pragma unroll
                    for (int j = 0; j < 4; j += 2) {
                        typedef float f32x2_ __attribute__((ext_vector_type(2)));
                        f32x2_ gl = (f32x2_){acc[ai][0][m][n][j], acc[ai][0][m][n][j + 1]} + (f32x2_){bg[n][j], bg[n][j + 1]};
                        f32x2_ li = (f32x2_){acc[ai][1][m][n][j], acc[ai][1][m][n][j + 1]} + (f32x2_){bl[n][j], bl[n][j + 1]};
                        gl = __builtin_elementwise_min(gl, (f32x2_){7.f, 7.f}); li = __builtin_elementwise_min(__builtin_elementwise_max(li, (f32x2_){-7.f, -7.f}), (f32x2_){7.f, 7.f});
                        const f32x2_ ex = gl * (f32x2_){-2.4554669595930156f, -2.4554669595930156f};
                        f32x2_ den; den.x = __builtin_amdgcn_exp2f(ex.x); den.y = __builtin_amdgcn_exp2f(ex.y); den = den + (f32x2_){1.f, 1.f};
                        f32x2_ sg; sg.x = __builtin_amdgcn_rcpf(den.x); sg.y = __builtin_amdgcn_rcpf(den.y);
                        const f32x2_ r2 = (gl * sg) * (li + (f32x2_){1.f, 1.f});
                        o[4 * n + j] = r2.x; o[4 * n + j + 1] = r2.y; }
                u32x4 w; w.x = cvt_pk_bf16(o[0], o[1]); w.y = cvt_pk_bf16(o[2], o[3]); w.z = cvt_pk_bf16(o[4], o[5]); w.w = cvt_pk_bf16(o[6], o[7]);
                *(GAS u32x4*)(ACT + (size_t)(row0 + ai * HALF + m * 16) * F + j0) = w; }
    }
};
struct EpiDownF32 {
    static constexpr bool PERM = false;
    float* C; int ldc; const float* bd;
    DI void operator()(const f32x4 (&acc)[2][2][4][2], const Unit& u, int wr, int wc, int fr, int fq) const {
        const int row0 = u.pm * BM + wr * 64 + fr, col0 = u.pn * BM + wc * 32 + 4 * fq;
        const float* bp = bd + (size_t)u.e * ldc + col0;
        f32x4 bv[2][2];
#pragma unroll
        for (int bj = 0; bj < 2; ++bj)
#pragma unroll
            for (int n = 0; n < 2; ++n) bv[bj][n] = *(const GAS f32x4*)(bp + bj * HALF + n * 16);
#pragma unroll
        for (int ai = 0; ai < 2; ++ai)
#pragma unroll
            for (int m = 0; m < 4; ++m) { float* rowp = C + (size_t)(row0 + ai * HALF + m * 16) * ldc + col0;
#pragma unroll
                for (int bj = 0; bj < 2; ++bj)
#pragma unroll
                    for (int n = 0; n < 2; ++n) *(GAS f32x4*)(rowp + bj * HALF + n * 16) = acc[ai][bj][m][n] + bv[bj][n]; }
    }
};
struct EpiDownBf16 {
    static constexpr bool PERM = true;
    bf16_t* O; int ldc; const float* bd;
    DI void operator()(const f32x4 (&acc)[2][2][4][2], const Unit& u, int wr, int wc, int fr, int fq) const {
        const int row0 = u.pm * BM + wr * 64 + fr, col0 = u.pn * BM + wc * 32 + 8 * fq;
        const float* bp = bd + (size_t)u.e * ldc + col0;
        f32x4 bv[2][2];
#pragma unroll
        for (int bj = 0; bj < 2; ++bj)
#pragma unroll
            for (int n = 0; n < 2; ++n) bv[bj][n] = *(const GAS f32x4*)(bp + bj * HALF + 4 * n);
#pragma unroll
        for (int ai = 0; ai < 2; ++ai)
#pragma unroll
            for (int m = 0; m < 4; ++m) { bf16_t* rowp = O + (size_t)(row0 + ai * HALF + m * 16) * ldc + col0;
#pragma unroll
                for (int bj = 0; bj < 2; ++bj) { const f32x4 v0 = acc[ai][bj][m][0] + bv[bj][0], v1 = acc[ai][bj][m][1] + bv[bj][1];
                    u32x4 w; w.x = cvt_pk_bf16(v0[0], v0[1]); w.y = cvt_pk_bf16(v0[2], v0[3]); w.z = cvt_pk_bf16(v1[0], v1[1]); w.w = cvt_pk_bf16(v1[2], v1[3]);
                    *(GAS u32x4*)(rowp + bj * HALF) = w; } }
    }
};
struct EpiBf16 {
    static constexpr bool PERM = true;
    bf16_t* O; int ldc; float scale;
    DI void operator()(const f32x4 (&acc)[2][2][4][2], const Unit& u, int wr, int wc, int fr, int fq) const {
        const int row0 = u.pm * BM + wr * 64 + fr, col0 = u.pn * BM + wc * 32 + 8 * fq;
#pragma unroll
        for (int ai = 0; ai < 2; ++ai)
#pragma unroll
            for (int m = 0; m < 4; ++m) { bf16_t* rowp = O + (size_t)(row0 + ai * HALF + m * 16) * ldc + col0;
#pragma unroll
                for (int bj = 0; bj < 2; ++bj) { const f32x4 v0 = acc[ai][bj][m][0] * scale, v1 = acc[ai][bj][m][1] * scale;
                    u32x4 w; w.x = cvt_pk_bf16(v0[0], v0[1]); w.y = cvt_pk_bf16(v0[2], v0[3]); w.z = cvt_pk_bf16(v1[0], v1[1]); w.w = cvt_pk_bf16(v1[2], v1[3]);
                    *(GAS u32x4*)(rowp + bj * HALF) = w; } }
    }
};

template <int K, class Epi, class Sched, bool GATHER = false, int LD = K>
DI void gemm_phase(LAS unsigned char* lds, const Sched& S, const Epi& E, int wv_, const LAS int* gtab = nullptr, const LAS NaiveCtx* cvC = nullptr) {
    const int tid = otid(wv_);
    int cvbase = 0;
    if (cvC) cvbase = __builtin_amdgcn_readfirstlane(*cv_counter(cvC));
    const int wid = __builtin_amdgcn_readfirstlane(tid >> 6), lane = tid & 63, wr = wid >> 2, wc = wid & 3, fr = lane & 15, fq = lane >> 4;
    constexpr int nt = K / BK;
    static_assert(K % 128 == 0 && K >= 256, "K");
    unsigned voffB[2], cvo[2][2], nvo[2][2];
#pragma unroll
    for (int i = 0; i < 2; ++i) { int R, C; stage_rc(tid * 16 + i * 8192, R, C); const int Rb = Epi::PERM ? ((R & ~31) + perm32(R & 31)) : R; voffB[i] = (unsigned)(Rb * LD + C) * 2u; }
#define PG8_CALC_VO(VO, UI) do { _Pragma("unroll") for (int h_ = 0; h_ < 2; ++h_) _Pragma("unroll") for (int i_ = 0; i_ < 2; ++i_) { int R_, C_; stage_rc(tid * 16 + i_ * 8192, R_, C_); \
        const int row_ = GATHER ? gtab[(UI) * 256 + h_ * HALF + R_] : h_ * HALF + R_; VO[h_][i_] = (unsigned)(row_ * LD + C_) * 2u; } } while (0)
    constexpr size_t kstep = (size_t)(BK * 2);
    constexpr size_t hstep = (size_t)HALF * LD * 2;
    const unsigned ldsw = (unsigned)wid * 1024u;
    const int aoff = lds_byte(wr * 64 + fr, fq * 8), boff = lds_byte(wc * 32 + fr, fq * 8);
#define PG8_SA(b, h) (((b) * 2 + (h)) * HTB)
#define PG8_SB(b, h) ((4 + (b) * 2 + (h)) * HTB)
#define PG8_STAGE(bufoff, gbase, voff) do { _Pragma("unroll") for (int _i = 0; _i < 2; ++_i) \
        __builtin_amdgcn_global_load_lds((const unsigned*)((const char*)(gbase) + (voff)[_i]), (LAS unsigned*)(lds + (bufoff) + ldsw + _i * 8192), 16, 0, 0); } while (0)
#define PG8_LDA(dst, b, h) do { _Pragma("unroll") for (int m = 0; m < 4; ++m) _Pragma("unroll") for (int k = 0; k < 2; ++k) dst[m][k] = *(const LAS bf16x8*)(lds + PG8_SA(b, h) + aoff + m * 2048 + k * 1024); } while (0)
#define PG8_LDB(dst, b, h) do { _Pragma("unroll") for (int n = 0; n < 2; ++n) _Pragma("unroll") for (int k = 0; k < 2; ++k) dst[n][k] = *(const LAS bf16x8*)(lds + PG8_SB(b, h) + boff + n * 2048 + k * 1024); } while (0)
#define PG8_MMA(ai, bj, At, Bt) do { __builtin_amdgcn_s_setprio(1); _Pragma("unroll") for (int m = 0; m < 4; ++m) _Pragma("unroll") for (int n = 0; n < 2; ++n) _Pragma("unroll") for (int k = 0; k < 2; ++k) \
        acc[ai][bj][m][n] = __builtin_amdgcn_mfma_f32_16x16x32_bf16(Bt[n][k], At[m][k], acc[ai][bj][m][n], 0, 0, 0); __builtin_amdgcn_s_setprio(0); } while (0)
#define PG8_WAIT_V(n) asm volatile("s_waitcnt vmcnt(" #n ")" ::: "memory")
#define PG8_WAIT_L(n) asm volatile("s_waitcnt lgkmcnt(" #n ")" ::: "memory")
#define PG8_BAR __builtin_amdgcn_s_barrier()
#define PG8_SCHED __builtin_amdgcn_sched_barrier(0)
    Unit cur, nxt; int ui = 0;
#if CV_CARRY
    f32x4 cvv[4][CV_NH]; bool cvon = false;
#endif
    if (!S.next(0, cur)) return;
    f32x4 acc[2][2][4][2];
#pragma unroll
    for (int a = 0; a < 2; ++a)
#pragma unroll
        for (int b = 0; b < 2; ++b)
#pragma unroll
            for (int m = 0; m < 4; ++m)
#pragma unroll
                for (int n = 0; n < 2; ++n) acc[a][b][m][n] = (f32x4){0.f, 0.f, 0.f, 0.f};
    bf16x8 At[4][2], B0[2][2], B1[2][2];
    const char* cA = S.a(cur); const char* cB = S.b(cur);
    PG8_CALC_VO(cvo, 0);
    PG8_STAGE(PG8_SB(0, 0), cB, voffB); PG8_STAGE(PG8_SB(0, 1), cB + hstep, voffB); PG8_STAGE(PG8_SA(0, 0), cA, cvo[0]); PG8_STAGE(PG8_SA(0, 1), cA, cvo[1]);
    if (wr == 1) PG8_BAR;
    PG8_WAIT_V(2); PG8_BAR;
    PG8_STAGE(PG8_SB(1, 0), cB + kstep, voffB); PG8_STAGE(PG8_SA(1, 0), cA + kstep, cvo[0]); PG8_STAGE(PG8_SB(1, 1), cB + hstep + kstep, voffB);
    PG8_WAIT_V(6); PG8_BAR;
    for (;;) {
        const bool has_next = S.next(ui + 1, nxt);
        const char* nA = has_next ? S.a(nxt) : cA; const char* nB = has_next ? S.b(nxt) : cB;
        if (has_next) PG8_CALC_VO(nvo, ui + 1); else { nvo[0][0] = cvo[0][0]; nvo[0][1] = cvo[0][1]; nvo[1][0] = cvo[1][0]; nvo[1][1] = cvo[1][1]; }
#pragma unroll 1
        for (int t = 0; t < nt; t += 2) {
            const bool last = (t == nt - 2);
            const char* a1 = cA + (size_t)(t + 1) * kstep;
            const char* a2 = last ? nA : cA + (size_t)(t + 2) * kstep; const char* b2 = last ? nB : cB + (size_t)(t + 2) * kstep;
            const char* a3 = a2 + kstep; const char* b3 = b2 + kstep;
            unsigned s0[2], s1[2]; s0[0] = last ? nvo[0][0] : cvo[0][0]; s0[1] = last ? nvo[0][1] : cvo[0][1]; s1[0] = last ? nvo[1][0] : cvo[1][0]; s1[1] = last ? nvo[1][1] : cvo[1][1];
            PG8_LDB(B0, 0, 0); PG8_LDB(B1, 0, 1); PG8_SCHED; PG8_LDA(At, 0, 0); PG8_STAGE(PG8_SA(1, 1), a1, cvo[1]);
            PG8_WAIT_V(8); PG8_WAIT_L(0); PG8_BAR; PG8_MMA(0, 0, At, B0); PG8_MMA(0, 1, At, B1); PG8_BAR; PG8_SCHED;
            PG8_LDA(At, 0, 1); PG8_STAGE(PG8_SB(0, 0), b2, voffB); PG8_STAGE(PG8_SB(0, 1), b2 + hstep, voffB); PG8_STAGE(PG8_SA(0, 0), a2, s0);
            PG8_WAIT_V(8); PG8_WAIT_L(0); PG8_BAR; PG8_MMA(1, 0, At, B0); PG8_MMA(1, 1, At, B1); PG8_BAR; PG8_SCHED;
            PG8_LDB(B0, 1, 0); PG8_LDB(B1, 1, 1); PG8_SCHED; PG8_LDA(At, 1, 0); PG8_STAGE(PG8_SA(0, 1), a2, s1);
            PG8_WAIT_V(8); PG8_WAIT_L(0); PG8_BAR; PG8_MMA(0, 0, At, B0); PG8_MMA(0, 1, At, B1); PG8_BAR; PG8_SCHED;
            PG8_LDA(At, 1, 1); PG8_STAGE(PG8_SB(1, 0), b3, voffB); PG8_STAGE(PG8_SB(1, 1), b3 + hstep, voffB); PG8_STAGE(PG8_SA(1, 0), a3, s0);
            PG8_WAIT_V(8); PG8_WAIT_L(0); PG8_BAR; PG8_MMA(1, 0, At, B0); PG8_MMA(1, 1, At, B1); PG8_BAR; PG8_SCHED;
        }
        if (wr == 0) PG8_BAR;
#if CV_CARRY
        if (cvC) { const float* cvs = nullptr; bf16_t* cvd = nullptr; int cvl = 0;
            if (cvon) { cv_addr(cvC, (cvbase + ui - 1) * S.G + S.c, otid(wv_), cvs, cvd, cvl); CV_STORES(cvv, cvd); }
            cvon = cv_addr(cvC, (cvbase + ui) * S.G + S.c, otid(wv_), cvs, cvd, cvl); if (cvon) CV_LOADS(cvv, cvs, cvl); }
#else
        f32x4 cvv[4][CV_NH]; const float* cvs = nullptr; bf16_t* cvd = nullptr; int cvl = 0; bool cvon = false;
        if (cvC) { cvon = cv_addr(cvC, (cvbase + ui) * S.G + S.c, otid(wv_), cvs, cvd, cvl); if (cvon) CV_LOADS(cvv, cvs, cvl); }
#endif
        { const int t2_ = otid(wv_), fr_ = t2_ & 15, fq_ = (t2_ & 63) >> 4;
          _Pragma("unroll") for (int re_ = 0; re_ < REP_EPI; ++re_) E(acc, cur, wr, wc, fr_, fq_); }
#if !CV_CARRY
        if (cvC) { if (cvon) CV_STORES(cvv, cvd); }
#endif
        if (!has_next) break;
#pragma unroll
        for (int a = 0; a < 2; ++a)
#pragma unroll
            for (int b = 0; b < 2; ++b)
#pragma unroll
                for (int m = 0; m < 4; ++m)
#pragma unroll
                    for (int n = 0; n < 2; ++n) acc[a][b][m][n] = (f32x4){0.f, 0.f, 0.f, 0.f};
        cur = nxt; cA = nA; cB = nB; ++ui; cvo[0][0] = nvo[0][0]; cvo[0][1] = nvo[0][1]; cvo[1][0] = nvo[1][0]; cvo[1][1] = nvo[1][1];
        if (wr == 1) PG8_BAR;
    }
#if CV_CARRY
    if (cvC) { if (cvon) { const float* cvs = nullptr; bf16_t* cvd = nullptr; int cvl = 0; cv_addr(cvC, (cvbase + ui) * S.G + S.c, otid(wv_), cvs, cvd, cvl); CV_STORES(cvv, cvd); } }
#endif
    PG8_WAIT_V(0);
    PG8_BAR;
    if (cvC) { if (otid(wv_) == 0) *cv_counter(cvC) = cvbase + ui + 1; }
#undef PG8_CALC_VO
#undef PG8_SA
#undef PG8_SB
#undef PG8_STAGE
#undef PG8_LDA
#undef PG8_LDB
#undef PG8_MMA
#undef PG8_WAIT_V
#undef PG8_WAIT_L
#undef PG8_BAR
#undef PG8_SCHED
}
}
#define GRID_STRIDE_WAVES(i_, n_) for (long tz_ = otid(wv_), i_ = ((long)(tz_ >> 6) * gridDim.x + opaque_bid()) * 64 + (tz_ & 63); i_ < (long)(n_); i_ += (long)gridDim.x * PB_THREADS)
DI bf16_t f2bf(float x) { return (bf16_t)(cvt_pk_bf16(x, 0.f) & 0xffffu); }

DI void conv_weight_r(LAS unsigned char* lds, const float* __restrict__ src, size_t sstride, bf16_t* __restrict__ dst, size_t dstride, int K, int N, int ldsrc, int Kpad, int Npad, int mode, int ti0, int G, int total, int wv_) {
    const int t = otid(wv_), nkt = Kpad / 64, nnt = Npad / 256, tpm = nkt * nnt;
    const int kk = t >> 6, c4 = (t & 63) * 4;
    float4 v[8];
#define CW_LOAD(TI) do { const int mat_ = (TI) / tpm, tile_ = (TI) % tpm, n0_ = (tile_ / nkt) * 256, k0_ = (tile_ % nkt) * 64; \
        const int sc_ = mode == 1 ? (c4 < 128 ? 0 : N / 2) + (n0_ / 256) * 128 + (c4 & 127) : n0_ + c4; const float* sp_ = src + (size_t)mat_ * sstride; \
        _Pragma("unroll") for (int i = 0; i < 8; ++i) { const int k_ = k0_ + 8 * kk + i; v[i] = make_float4(0.f, 0.f, 0.f, 0.f); \
            if (k_ < K && sc_ < N) { const f32x4 g_ = *(const GAS f32x4*)(sp_ + (size_t)k_ * ldsrc + sc_); v[i] = make_float4(g_[0], g_[1], g_[2], g_[3]); } } } while (0)
    int ti = ti0, par = 0;
    if (ti < total) CW_LOAD(ti);
    while (ti < total) {
        LAS bf16_t* Ts = (LAS bf16_t*)(lds + par * (256 * 72 * 2));
        const int mat = ti / tpm, tile = ti % tpm, n0 = (tile / nkt) * 256, k0 = (tile % nkt) * 64;
#define CW_COL(J, F) { u32x4 w_; w_.x = cvt_pk_bf16(v[0].F, v[1].F); w_.y = cvt_pk_bf16(v[2].F, v[3].F); w_.z = cvt_pk_bf16(v[4].F, v[5].F); w_.w = cvt_pk_bf16(v[6].F, v[7].F); *(LAS u32x4*)(Ts + (c4 + J) * 72 + 8 * kk) = w_; }
        CW_COL(0, x) CW_COL(1, y) CW_COL(2, z) CW_COL(3, w)
#undef CW_COL
        const int tn = ti + G;
        if (tn < total) CW_LOAD(tn);
        lds_barrier();
        bf16_t* dp = dst + (size_t)mat * dstride;
#pragma unroll
        for (int q0 = 0; q0 < 4; ++q0) { const int q = t + 512 * q0, n = q >> 3, k8 = (q & 7) * 8;
            const u32x4 w = *(const LAS u32x4*)(Ts + n * 72 + k8);
            *(GAS u32x4*)(dp + (size_t)(n0 + n) * Kpad + k0 + k8) = w; }
        ti = tn; par ^= 1;
    }
    __syncthreads();
#undef CW_LOAD
}
DI void conv_weight_b(LAS unsigned char* lds, const float* __restrict__ src, size_t sstride, bf16_t* __restrict__ dst, size_t dstride, int nmat, int K, int N, int ldsrc, int Kpad, int Npad, int mode, int wv_) {
    conv_weight_r(lds, src, sstride, dst, dstride, K, N, ldsrc, Kpad, Npad, mode, opaque_bid(), gridDim.x, (Kpad / 64) * (Npad / 256) * nmat, wv_);
}
DI void conv_act(const float* __restrict__ src, int lda, int K, bf16_t* __restrict__ dst, int Kpad, long M, int wv_) {
    const int cpr = Kpad / 8;
    GRID_STRIDE_WAVES(i, M * cpr) { const long row = i / cpr; const int c = (int)(i % cpr) * 8; u32x4 w = (u32x4){0u, 0u, 0u, 0u};
        if (c < K) { const f32x4 a_ = *(const GAS f32x4*)(src + row * lda + c), b_ = *(const GAS f32x4*)(src + row * lda + c + 4); const float4 a = make_float4(a_[0], a_[1], a_[2], a_[3]), b = make_float4(b_[0], b_[1], b_[2], b_[3]);
            w.x = cvt_pk_bf16(a.x, a.y); w.y = cvt_pk_bf16(a.z, a.w); w.z = cvt_pk_bf16(b.x, b.y); w.w = cvt_pk_bf16(b.z, b.w); }
        *(GAS u32x4*)(dst + row * Kpad + c) = w; }
}
#ifdef HOST_TEST
static int D_MODEL = 128, BATCH = 2, SEQ = 128, CTX_LEN = 64, N_EXPERTS = 8, EXPERT_DIM = 64;
#define HD
#else
constexpr int D_MODEL = 1024, BATCH = 16, SEQ = 2048, CTX_LEN = 256, N_EXPERTS = 32, EXPERT_DIM = 1024;
#ifdef PERSISTENT
#define HD __device__
#else
#define HD __host__ __device__
#endif
#endif
constexpr int DEPTH = 4, GRID_W = 64, N_MOD = 6;
constexpr int RW_HEADS = 8, RW_HD = 64, RW_DIM = 512, RW_DL = 64, RW_IL = 64, RW_GL = 128, RW_IN = 1920;
constexpr int HG_HEADS = 4, HG_KD = 128, HG_VD = 128, HG_DIM = 512, HG_VDIM = 512, HG_IN = 2560;
constexpr int EVEN_IN = 4480, EVEN_OUT = 1024;
constexpr int MLA_HEADS = 16, MLA_NOPE = 64, MLA_ROPE = 32, MLA_V = 64, MLA_QR = 256, MLA_KVR = 128, MLA_IN = 416, MLA_QK = 96;
constexpr int TOP_K = 4, N_EVEN = 2, N_ODD = 2;
constexpr int MOE_PAD = 256;
#define ALPHA 1.681792830507429f

#ifndef REP_MOE
#define REP_MOE 1
#endif
#ifndef REP_ATT
#define REP_ATT 1
#endif
#ifndef REP_RWS
#define REP_RWS 1
#endif
#ifndef REP_HGS
#define REP_HGS 1
#endif
#ifndef REP_DEN
#define REP_DEN 1
#endif
#ifndef REP_TLE
#define REP_TLE 1
#endif
#ifndef REP_PRO
#define REP_PRO 1
#endif
#ifndef CV_BACKGROUND
#define CV_BACKGROUND 0
#endif
#ifndef CV_TAIL
#define CV_TAIL 1
#endif
#ifndef CV_TAILN
#define CV_TAILN 10
#endif
#if CV_BACKGROUND
#define CV_PRO_LAYERS 1
#define CV_CTX Cp_
#elif CV_TAIL
#define CV_PRO_LAYERS 1
#define CV_CTX nullptr
#else
#define CV_PRO_LAYERS DEPTH
#define CV_CTX nullptr
#endif
#define RP(N, ...) _Pragma("unroll") for (int rep_ = 0; rep_ < (N); ++rep_) { __VA_ARGS__ }
#define NC_ (BATCH * CTX_LEN)
#define NL_ (BATCH * SEQ)
#define NT_ (NC_ + NL_)
#define TT_ (CTX_LEN + SEQ)
#define NSLOT_ (NT_ * TOP_K + N_EXPERTS * MOE_PAD)

#ifdef HOST_TEST
#define MEMFENCE_EVERY(k, n) do {} while (0)
#else
#define MEMFENCE_EVERY(k, n) do { if (((k) % (n)) == (n) - 1) asm volatile("" ::: "memory"); } while (0)
#endif
HD inline float sigmoidf_(float x) { return 1.f / (1.f + expf(-x)); }
HD inline float siluf_(float x) { return x / (1.f + expf(-x)); }
HD inline float softplusf_(float x) { return x > 20.f ? x : log1pf(expf(x)); }
HD inline int tokrow(int b, int t) { return t < CTX_LEN ? b * CTX_LEN + t : NC_ + b * SEQ + (t - CTX_LEN); }
HD inline int scan_pos(int d, int i) { return d == 0 ? i : (i < CTX_LEN ? CTX_LEN - 1 - i : CTX_LEN + (SEQ - 1 - (i - CTX_LEN))); }
#ifdef HOST_TEST
inline int ld_cnt(const int* p) { return *p; }
#else
__device__ inline int ld_cnt(const int* p) { return __hip_atomic_load(p, __ATOMIC_RELAXED, __HIP_MEMORY_SCOPE_AGENT); }
#endif
HD inline int modrow(int row) { return row < NC_ ? BATCH : (row - NC_) / SEQ; }

struct NaiveCtx {
    const float *x, *c, *ctx, *c_ctx, *mod_w, *mod_b, *ln_g, *ln_b, *ev_w_in, *rw_mu, *rw_w0, *rw_w2, *rw_a0, *rw_a2, *rw_g2, *rw_k_k, *rw_k_a, *rw_r_k,
        *rw_gn_g, *rw_gn_b, *hg_lb, *hg_norm_g, *ev_w_out, *od_w_in, *mla_q_norm_g, *mla_w_qb, *mla_kv_norm_g, *mla_w_kvb, *od_w_out, *moe_w_router,
        *moe_b_router, *moe_w_gu, *moe_b_gu, *moe_w_down, *moe_b_down;
    float* out;
    float *H, *MOD, *U, *Z, *ZS, *R, *V, *KKR, *NKK, *G, *DEC, *AG, *KD, *BB, *Y, *HQ, *HF, *HK, *OP, *YCAT, *YO;
    float *QN, *KVN, *KPE, *Q, *KV, *AO, *LOGIT, *TOPG, *H1, *ACT, *OUT2;
    int *TOPI, *CNT, *OFF, *CUR, *SLOT, *TOKOF, *TILE_E;
    unsigned short *WinE, *WoutE, *WinO, *Wqb, *Wkvb, *WoutO, *Wgu, *Wdn, *ABF, *XPB, *ACTB, *QB, *KB, *VB, *UB, *OUT2B, *TW, *LOB, *YCATB, *QNB, *KVNB, *AOB, *Wlora, *KVB, *KPEB, *ZB, *RBh, *VBh, *NKh, *GBh, *KDh, *BBh, *YOB, *HB, *YBh, *OBh;
    float *BON, *ROPE, *O;
    long cvn;
};
#if defined(PERSISTENT)
constexpr int CV_TN = 64 * CV_NH, CV_GU = (2 * EXPERT_DIM / CV_TN) * 8, CV_DN = (D_MODEL / CV_TN) * 8;
constexpr int CV_TPL = N_EXPERTS * (CV_GU + CV_DN);
DI LAS int* cv_counter(const LAS NaiveCtx* Cp_) { return (LAS int*)&Cp_->cvn; }
DI bool cv_addr(const LAS NaiveCtx* Cp_, int T, int tid, const float*& sp, bf16_t*& dp, int& ld) {
    if (T >= (DEPTH - 1) * CV_TPL) return false;
    const int layer = 1 + T / CV_TPL, r = T % CV_TPL;
    const int kb = (tid & 15) + 16 * ((tid >> 6) & 1), nb = ((tid >> 4) & 3) + 4 * (tid >> 7);
    if (r < N_EXPERTS * CV_GU) {
        const int mat = layer * N_EXPERTS + r / CV_GU, tile = r % CV_GU, n0 = (tile / 8) * CV_TN, k0 = (tile % 8) * 128;
        const int cb = ((n0 % 256) / 128) * EXPERT_DIM + (n0 / 256) * 128 + n0 % 128;
        sp = Cp_->moe_w_gu + (size_t)mat * ((size_t)D_MODEL * 2 * EXPERT_DIM) + (size_t)(k0 + kb * 4) * (2 * EXPERT_DIM) + cb + nb * (4 * CV_NH); ld = 2 * EXPERT_DIM;
        dp = Cp_->Wgu + (size_t)mat * ((size_t)2 * EXPERT_DIM * D_MODEL) + (size_t)(n0 + nb * (4 * CV_NH)) * D_MODEL + k0 + kb * 4;
    } else {
        const int r2 = r - N_EXPERTS * CV_GU, mat = layer * N_EXPERTS + r2 / CV_DN, tile = r2 % CV_DN, n0 = (tile / 8) * CV_TN, k0 = (tile % 8) * 128;
        sp = Cp_->moe_w_down + (size_t)mat * ((size_t)EXPERT_DIM * D_MODEL) + (size_t)(k0 + kb * 4) * D_MODEL + n0 + nb * (4 * CV_NH); ld = D_MODEL;
        dp = Cp_->Wdn + (size_t)mat * ((size_t)D_MODEL * EXPERT_DIM) + (size_t)(n0 + nb * (4 * CV_NH)) * EXPERT_DIM + k0 + kb * 4;
    }
    return true;
}
DI void cv_catchup(const LAS NaiveCtx* Cp_, long layer, int wv_) {
    const int G = gridDim.x, bid = opaque_bid();
    const int need = (int)((layer * CV_TPL + G - 1) / G);
    int j = __builtin_amdgcn_readfirstlane(*cv_counter(Cp_));
    if (j >= need) return;
    for (; j < need; ++j) { f32x4 v[4][CV_NH]; const float* sp = nullptr; bf16_t* dp = nullptr; int ld = 0;
        if (cv_addr(Cp_, j * G + bid, otid(wv_), sp, dp, ld)) { CV_LOADS(v, sp, ld); CV_STORES(v, dp); } }
    __syncthreads();
    if (otid(wv_) == 0) *cv_counter(Cp_) = j;
}
#endif
#if defined(PERSISTENT)
constexpr int CVT_GU = N_EXPERTS * 128, CVT_DN = N_EXPERTS * 64, CVT_L = CVT_GU + CVT_DN, CVT_TOT = (DEPTH - 1) * CVT_L;
DI void cv_range(const LAS NaiveCtx* Cp_, LAS unsigned char* lds, int a, int b, int step, int wv_) {
#pragma unroll 1
    for (int j = 0; j < 2 * (DEPTH - 1); ++j) { const int Lx = 1 + j / 2; const bool dn = (j & 1) != 0;
        const int base = CVT_L * (Lx - 1) + (dn ? CVT_GU : 0), lim = CVT_L * (Lx - 1) + (dn ? CVT_L : CVT_GU);
        const int v0 = a >= base ? a : a + ((base - a + step - 1) / step) * step, hi = b < lim ? b : lim;
        if (v0 < hi) { const int tb = (dn ? CVT_DN : CVT_GU) * Lx;
            conv_weight_r(lds, dn ? (*Cp_).moe_w_down : (*Cp_).moe_w_gu, (size_t)D_MODEL * (dn ? D_MODEL : 2 * EXPERT_DIM), dn ? (*Cp_).Wdn : (*Cp_).Wgu, (size_t)D_MODEL * (dn ? EXPERT_DIM : 2 * EXPERT_DIM),
                          1024, dn ? D_MODEL : 2 * EXPERT_DIM, dn ? D_MODEL : 2 * EXPERT_DIM, 1024, dn ? D_MODEL : 2 * EXPERT_DIM, dn ? 0 : 1, tb + (v0 - base), step, tb + (hi - base), wv_); } }
}
#ifndef MOE_REMAP
#define MOE_REMAP 2
#endif
#ifndef MOE_CHUNK
#define MOE_CHUNK 1
#endif
#if MOE_CHUNK
#define MOE_SET_CHUNK S_.set_chunk(opaque_bid());
#else
#define MOE_SET_CHUNK
#endif
DI int moe_remap(int c, int G, int nct) {
#if MOE_REMAP
    if (G == 256) { const int x = c & 7, j = c >> 3;
#if MOE_REMAP == 2
        if (nct == 8) return 8 * (4 * (j >> 2) + (x >> 1)) + 4 * (x & 1) + (j & 3);
        if (nct == 4) return 4 * (8 * (j >> 2) + x) + (j & 3); }
#elif MOE_REMAP == 3
        if (nct == 8) return 8 * (4 * (j >> 2) + (x >> 1)) + 4 * (x & 1) + (j & 3);
        if (nct == 4) return 4 * (4 * (j >> 1) + (x >> 1)) + 2 * (x & 1) + (j & 1); }
#else
        if (nct == 8) return 8 * (2 * (j >> 1) + (x >> 2)) + 2 * (x & 3) + (j & 1);
        if (nct == 4) return 4 * (4 * (j >> 1) + (x >> 1)) + 2 * (x & 1) + (j & 1); }
#endif
#endif
    return c;
}
DI void cv_tail(const LAS NaiveCtx* Cp_, LAS unsigned char* lds, const g8::MoeSched& S, int wv_) {
    int done = __builtin_amdgcn_readfirstlane(*cv_counter(Cp_));
    if (done >= CVT_TOT) return;
    int nidle = 0, mine = -1;
    if (S.chunk) { const int q = S.nunits / 8, r = S.nunits % 8, maxr = (q + (r ? 1 : 0) + 31) / 32, myx = opaque_bid() & 7;
#pragma unroll
        for (int x = 0; x < 8; ++x) { const int len = q + (x < r ? 1 : 0), rounds = (len + 31) / 32, busy = rounds < maxr ? 0 : len - 32 * (maxr - 1);
            if (x == myx && S.jj >= busy) mine = nidle + (S.jj - busy);
            nidle += 32 - busy; } }
    else { const int G = gridDim.x, r = S.nunits % G; if (r != 0) { nidle = G - r; if (S.c >= r) mine = S.c - r; } }
    if (nidle == 0) return;
    if (mine >= 0) { const int a = done + mine * CV_TAILN, b = a + CV_TAILN < CVT_TOT ? a + CV_TAILN : CVT_TOT; if (a < b) cv_range(Cp_, lds, a, b, 1, wv_); }
    done += nidle * CV_TAILN; if (done > CVT_TOT) done = CVT_TOT;
    __syncthreads();
    if (otid(wv_) == 0) *cv_counter(Cp_) = done;
}
DI void cv_catch(const LAS NaiveCtx* Cp_, LAS unsigned char* lds, long layer, int wv_) {
    const int G = gridDim.x, c = opaque_bid(), need = CVT_L * (int)layer;
    const int done = __builtin_amdgcn_readfirstlane(*cv_counter(Cp_));
    if (done >= need) return;
    cv_range(Cp_, lds, done + c, need, G, wv_);
    __syncthreads();
    if (otid(wv_) == 0) *cv_counter(Cp_) = need;
}
#endif


struct NaiveWs { size_t total; };
static size_t naive_carve(NaiveCtx& C, char* base) {
    size_t off = 0;
    auto take = [&](size_t nfl) { size_t o = off; off += ((nfl * 4 + 255) / 256) * 256; return base ? (float*)(base + o) : (float*)nullptr; };
    const size_t NT = NT_, NS = NSLOT_;
    C.H = take(NT * D_MODEL); C.MOD = take((size_t)DEPTH * (BATCH + 1) * N_MOD * D_MODEL); C.YO = take(NT * D_MODEL);
#if defined(PERSISTENT)
    C.U = nullptr;
#else
    C.U = take(NT * D_MODEL);
#endif
    C.LOGIT = take(NT * N_EXPERTS); C.TOPG = take(NT * TOP_K);
    C.TOPI = (int*)take(NT * TOP_K); C.CNT = (int*)take(64 * DEPTH); C.CUR = (int*)take(64 * DEPTH); C.OFF = (int*)take(64); C.SLOT = (int*)take(NT * TOP_K); C.TOKOF = (int*)take(NS);
    C.TILE_E = (int*)take(NS / 64 + 64);
    C.WinE = (unsigned short*)take((size_t)N_EVEN * 4608 * D_MODEL / 2); C.WoutE = (unsigned short*)take((size_t)N_EVEN * D_MODEL * 1024 / 2); C.WinO = (unsigned short*)take((size_t)N_ODD * 512 * D_MODEL / 2);
    C.Wqb = (unsigned short*)take((size_t)N_ODD * 1536 * 256 / 2); C.Wkvb = (unsigned short*)take((size_t)N_ODD * 2048 * 256 / 2); C.WoutO = (unsigned short*)take((size_t)N_ODD * D_MODEL * 1024 / 2);
    C.Wgu = (unsigned short*)take((size_t)DEPTH * N_EXPERTS * 2 * EXPERT_DIM * D_MODEL / 2); C.Wdn = (unsigned short*)take((size_t)DEPTH * N_EXPERTS * D_MODEL * EXPERT_DIM / 2);
    C.ABF = (unsigned short*)take((size_t)NT * 1024 / 2); C.UB = (unsigned short*)take((size_t)NT * 1024 / 2);
    const size_t ubase = off; size_t umax = off;
    C.Z = take(NT * EVEN_IN); C.ZS = take(NT * RW_IN);
    C.R = take(NT * 512); C.V = take(NT * 512); C.KKR = take(NT * 512); C.NKK = take(NT * 512); C.G = take(NT * 512);
    C.DEC = take(2 * NT * 512); C.AG = take(2 * NT * 512); C.KD = take(2 * NT * 512); C.BB = take(2 * NT * 512); C.Y = take(2 * NT * 512);
    C.HQ = take(NT * 512); C.HF = take(2 * NT * 512); C.HK = take(2 * NT * 512); C.OP = take(4 * NT * 512);
    C.YCAT = take(NT * 1024);
    umax = off > umax ? off : umax; off = ubase;
    (void)take(NT * EVEN_IN);
    C.QN = take(NT * MLA_QR); C.KVN = take(NT * MLA_KVR); C.KPE = take(NT * MLA_ROPE); C.Q = take(NT * MLA_HEADS * MLA_QK); C.KV = take(NT * MLA_HEADS * 128);
    C.AO = take(NT * 1024);
    C.QB = (unsigned short*)take(NT * MLA_HEADS * 96 / 2); C.KB = (unsigned short*)take((size_t)BATCH * MLA_HEADS * TT_ * 96 / 2); C.VB = (unsigned short*)take((size_t)BATCH * MLA_HEADS * TT_ * 64 / 2);
    umax = off > umax ? off : umax; off = ubase;
    C.H1 = take(NS * 2 * EXPERT_DIM); C.ACT = take(NS * EXPERT_DIM); C.OUT2 = take(NS * D_MODEL);
    C.OUT2B = (unsigned short*)C.OUT2; C.XPB = (unsigned short*)C.H1; C.ACTB = (unsigned short*)(C.H1 ? C.H1 + NS * EXPERT_DIM / 2 + 64 : C.H1);
    umax = off > umax ? off : umax; off = umax;
    return off;
}


#if defined(PERSISTENT)
static size_t mega_carve(NaiveCtx& C, char* base) {
    size_t off = 0;
    auto takeb = [&](size_t nbytes) { size_t o = off; off += ((nbytes + 255) / 256) * 256; return base ? (void*)(base + o) : (void*)nullptr; };
    const size_t NT = NT_, NS = NSLOT_;
    C.HB = (unsigned short*)takeb(NT * D_MODEL * 2); C.H = nullptr; C.MOD = (float*)takeb((size_t)DEPTH * (BATCH + 1) * N_MOD * D_MODEL * 4); C.YOB = (unsigned short*)takeb(NT * D_MODEL * 2); C.YO = nullptr; C.UB = (unsigned short*)takeb(NT * D_MODEL * 2);
    C.TOPG = (float*)takeb(NT * TOP_K * 4); C.TOPI = (int*)takeb(NT * TOP_K * 4); C.SLOT = (int*)takeb(NT * TOP_K * 4); C.CNT = (int*)takeb(64 * DEPTH * 4); C.CUR = (int*)takeb(64 * DEPTH * 4); C.TOKOF = (int*)takeb(NS * 4);
    C.ROPE = (float*)takeb((size_t)SEQ * 32 * 4);
    C.WinE = (unsigned short*)takeb((size_t)N_EVEN * 4608 * D_MODEL * 2); C.WoutE = (unsigned short*)takeb((size_t)N_EVEN * D_MODEL * 1024 * 2); C.WinO = (unsigned short*)takeb((size_t)N_ODD * 512 * D_MODEL * 2);
    C.Wqb = (unsigned short*)takeb((size_t)N_ODD * 1536 * 256 * 2); C.Wkvb = (unsigned short*)takeb((size_t)N_ODD * 2048 * 256 * 2); C.WoutO = (unsigned short*)takeb((size_t)N_ODD * D_MODEL * 1024 * 2);
    C.Wlora = (unsigned short*)takeb((size_t)N_EVEN * 2560 * 384 * 2);
    C.Wgu = (unsigned short*)takeb((size_t)DEPTH * N_EXPERTS * 2 * EXPERT_DIM * D_MODEL * 2); C.Wdn = (unsigned short*)takeb((size_t)DEPTH * N_EXPERTS * D_MODEL * EXPERT_DIM * 2);
    const size_t ubase = off; size_t umax = off;
    C.ZB = (unsigned short*)takeb(NT * 4608 * 2); C.Z = (float*)C.ZB; C.TW = (unsigned short*)takeb(NT * 384 * 2); C.LOB = (unsigned short*)takeb(NT * 2560 * 2);
    C.RBh = (unsigned short*)takeb(NT * 512 * 2); C.VBh = (unsigned short*)takeb(NT * 512 * 2); C.NKh = (unsigned short*)takeb(NT * 512 * 2); C.GBh = (unsigned short*)takeb(NT * 512 * 2);
    C.KDh = (unsigned short*)takeb(2 * NT * 512 * 2); C.BBh = (unsigned short*)takeb(2 * NT * 512 * 2); C.DEC = (float*)takeb(2 * NT * 512 * 4); C.YBh = (unsigned short*)takeb(2 * NT * 512 * 2); C.Y = nullptr;
    C.OBh = (unsigned short*)takeb(2 * NT * 512 * 2); C.O = nullptr; C.BON = (float*)takeb(NT * 8 * 4); C.YCATB = (unsigned short*)takeb(NT * 1024 * 2);
    umax = off > umax ? off : umax; off = ubase;
    (void)takeb(NT * 512 * 4); C.QNB = (unsigned short*)takeb(NT * 256 * 2); C.KVNB = (unsigned short*)takeb(NT * 256 * 2);
    C.QB = (unsigned short*)takeb(NT * MLA_HEADS * 96 * 2); C.KVB = (unsigned short*)takeb(NT * MLA_HEADS * 128 * 2); C.KPEB = (unsigned short*)takeb(NT * 32 * 2);
    C.AOB = (unsigned short*)takeb(NT * 1024 * 2);
    umax = off > umax ? off : umax; off = ubase;
    C.XPB = (unsigned short*)takeb(NS * D_MODEL * 2); C.ACTB = (unsigned short*)takeb(NS * EXPERT_DIM * 2); C.OUT2B = (unsigned short*)takeb(NS * D_MODEL * 2);
    umax = off > umax ? off : umax; off = umax;
    return off;
}
#endif
#if defined(HOST_TEST)
#define FWD_QUAL static
#define FWD_SIG NaiveCtx C
#define FWD_ARGS C
#define NLAUNCH(n, ...) do { auto f_ = __VA_ARGS__; for (long i_ = 0; i_ < (long)(n); ++i_) f_(i_); } while (0)
#elif defined(PERSISTENT)
#define FWD_QUAL __device__ __forceinline__
#define FWD_SIG const LAS NaiveCtx* Cp_, const XcdBarrier& bar, LAS unsigned char* lds, int wv_
#define FWD_ARGS Cp_, bar, lds, wv_
#define PERSIST_C_MACRO 1
#define NLAUNCH(n, ...) do { auto f_ = __VA_ARGS__; const long n_ = (long)(n); int tz_ = otid(wv_); \
    for (long i_ = ((long)(tz_ >> 6) * gridDim.x + opaque_bid()) * 64 + (tz_ & 63); i_ < n_; i_ += (long)gridDim.x * PB_THREADS) f_(i_); \
    grid_sync(bar); } while (0)
#else
#define FWD_QUAL static
#define FWD_SIG NaiveCtx C
#define FWD_ARGS C
template <class F> __global__ void __launch_bounds__(256) k_run(long n, F f) { for (long i = (long)blockIdx.x * 256 + threadIdx.x; i < n; i += (long)gridDim.x * 256) f(i); }
template <class F> static void nlaunch_(long n, F f, hipStream_t st) { long nb = (n + 255) / 256; if (nb > 65536) nb = 65536; if (nb < 1) nb = 1; hipLaunchKernelGGL(k_run<F>, dim3((unsigned)nb), dim3(256), 0, st, n, f); }
#define NLAUNCH(n, ...) nlaunch_((long)(n), __VA_ARGS__, g_stream)
static hipStream_t g_stream;
#endif

#ifdef HOST_TEST
static void ngemm(const float* A, int lda, const int* arow, const float* B, long bstride, int ldb, const float* bias, long biasstride, float* Cm, int ldc, int M, int N, int K, const int* tile_e) {
    for (int m = 0; m < M; ++m) {
        int e = 0; if (tile_e) { e = tile_e[m / 64]; if (e < 0) continue; }
        int ar = arow ? arow[m] : m; if (ar < 0) continue;
        const float* Bp = B + (size_t)e * bstride;
        for (int n = 0; n < N; ++n) { double s = bias ? bias[(size_t)e * biasstride + n] : 0.0; for (int k = 0; k < K; ++k) s += (double)A[(size_t)ar * lda + k] * Bp[(size_t)k * ldb + n]; Cm[(size_t)m * ldc + n] = (float)s; }
    }
}
#elif defined(PERSISTENT)
__device__ __forceinline__ void pgemm_(const float* A, int lda, const int* arow, const float* B, long bstride, int ldb, const float* bias, long biasstride, float* Cm, int ldc, int M, int N, int K, const int* tile_e, int wv_) {
    constexpr int NH = PB_THREADS / 256;
    __shared__ float As[NH][16][68], Bs[NH][16][68];
    const int tz_ = otid(wv_);
    const int half = tz_ >> 8, tid = tz_ & 255, tx = tid & 15, ty = tid >> 4;
    const int ntn = (N + 63) / 64, ntm = (M + 63) / 64, ntiles = ntn * ntm;
    const int ar_l = tid >> 2, ak = (tid & 3) * 4, bk = tid >> 4, bn = (tid & 15) * 4;
    for (int t0 = opaque_bid() * NH; t0 < ntiles; t0 += gridDim.x * NH) {
        const int tile = t0 + half; bool active = tile < ntiles; const int rt = active ? tile / ntn : 0, ct = active ? tile % ntn : 0;
        int e = 0; if (tile_e && active) { e = tile_e[rt]; if (e < 0) { active = false; e = 0; } }
        const float* Bp = B + (size_t)e * bstride;
        const int m0 = rt * 64, n0 = ct * 64;
        float acc[4][4];
_Pragma("unroll")
        for (int i = 0; i < 4; ++i)
_Pragma("unroll")
            for (int j = 0; j < 4; ++j) acc[i][j] = 0.f;
        int am = m0 + ar_l; int arr = -1; if (active && am < M) arr = arow ? arow[am] : am;
        for (int k0 = 0; k0 < K; k0 += 16) {
            float4 av = make_float4(0, 0, 0, 0); if (arr >= 0) av = *(const float4*)(A + (size_t)arr * lda + k0 + ak);
            As[half][ak + 0][ar_l] = av.x; As[half][ak + 1][ar_l] = av.y; As[half][ak + 2][ar_l] = av.z; As[half][ak + 3][ar_l] = av.w;
_Pragma("unroll")
            for (int j = 0; j < 4; ++j) { int n = n0 + bn + j; Bs[half][bk][bn + j] = (active && n < N) ? Bp[(size_t)(k0 + bk) * ldb + n] : 0.f; }
            __syncthreads();
_Pragma("unroll")
            for (int k = 0; k < 16; ++k) {
                float a[4], b[4];
_Pragma("unroll")
                for (int i = 0; i < 4; ++i) { a[i] = As[half][k][ty * 4 + i]; b[i] = Bs[half][k][tx * 4 + i]; }
_Pragma("unroll")
                for (int i = 0; i < 4; ++i)
_Pragma("unroll")
                    for (int j = 0; j < 4; ++j) acc[i][j] += a[i] * b[j];
            }
            __syncthreads();
        }
        if (active) {
_Pragma("unroll")
            for (int i = 0; i < 4; ++i) { int m = m0 + ty * 4 + i; if (m >= M) continue;
_Pragma("unroll")
                for (int j = 0; j < 4; ++j) { int n = n0 + tx * 4 + j; if (n < N) Cm[(size_t)m * ldc + n] = acc[i][j] + (bias ? bias[(size_t)e * biasstride + n] : 0.f); } }
        }
    }
}
#define ngemm(...) do { pgemm_(__VA_ARGS__, wv_); grid_sync(bar); } while (0)
#else
__global__ void __launch_bounds__(256) k_ngemm(const float* A, const int* arow, const float* B, const float* bias, float* Cm, const int* tile_e, long bstride, long biasstride, int lda, int ldb, int ldc, int M, int N, int K) {
    __shared__ float As[16][68], Bs[16][68];
    const int rt = blockIdx.y, ct = blockIdx.x, tid = threadIdx.x, tx = tid & 15, ty = tid >> 4;
    int e = 0; if (tile_e) { e = tile_e[rt]; if (e < 0) return; }
    const float* Bp = B + (size_t)e * bstride;
    const int m0 = rt * 64, n0 = ct * 64;
    float acc[4][4] = {};
    const int ar_l = tid >> 2, ak = (tid & 3) * 4; int am = m0 + ar_l; int arr = -1; if (am < M) arr = arow ? arow[am] : am;
    const int bk = tid >> 4, bn = (tid & 15) * 4;
    for (int k0 = 0; k0 < K; k0 += 16) {
        float4 av = make_float4(0, 0, 0, 0); if (arr >= 0) av = *(const float4*)(A + (size_t)arr * lda + k0 + ak);
        As[ak + 0][ar_l] = av.x; As[ak + 1][ar_l] = av.y; As[ak + 2][ar_l] = av.z; As[ak + 3][ar_l] = av.w;
        float bv[4]; for (int j = 0; j < 4; ++j) { int n = n0 + bn + j; bv[j] = n < N ? Bp[(size_t)(k0 + bk) * ldb + n] : 0.f; }
        Bs[bk][bn + 0] = bv[0]; Bs[bk][bn + 1] = bv[1]; Bs[bk][bn + 2] = bv[2]; Bs[bk][bn + 3] = bv[3];
        __syncthreads();
_Pragma("unroll")
        for (int k = 0; k < 16; ++k) {
            float a[4], b[4];
_Pragma("unroll")
            for (int i = 0; i < 4; ++i) { a[i] = As[k][ty * 4 + i]; b[i] = Bs[k][tx * 4 + i]; }
_Pragma("unroll")
            for (int i = 0; i < 4; ++i)
_Pragma("unroll")
                for (int j = 0; j < 4; ++j) acc[i][j] += a[i] * b[j];
        }
        __syncthreads();
    }
_Pragma("unroll")
    for (int i = 0; i < 4; ++i) { int m = m0 + ty * 4 + i; if (m >= M) continue;
_Pragma("unroll")
        for (int j = 0; j < 4; ++j) { int n = n0 + tx * 4 + j; if (n < N) Cm[(size_t)m * ldc + n] = acc[i][j] + (bias ? bias[(size_t)e * biasstride + n] : 0.f); } }
}
static void ngemm(const float* A, int lda, const int* arow, const float* B, long bstride, int ldb, const float* bias, long biasstride, float* Cm, int ldc, int M, int N, int K, const int* tile_e) {
    dim3 grid((N + 63) / 64, (M + 63) / 64);
    hipLaunchKernelGGL(k_ngemm, grid, dim3(256), 0, g_stream, A, arow, B, bias, Cm, tile_e, bstride, biasstride, lda, ldb, ldc, M, N, K);
}
#endif


#ifndef ATT_REMAP
#define ATT_REMAP 1
#endif
namespace att {
typedef float f32x16 __attribute__((ext_vector_type(16)));
typedef short s16x4 __attribute__((ext_vector_type(4)));
typedef __bf16 bf16x2_t __attribute__((ext_vector_type(2)));
typedef float f32x2_t __attribute__((ext_vector_type(2)));
constexpr int KROWB = 208, KT_BYTES = 64 * KROWB, VT_BYTES = 8192, BUF = KT_BYTES + VT_BYTES;
DI unsigned pk2(float a, float b) { f32x2_t f = {a, b}; return __builtin_bit_cast(unsigned, __builtin_convertvector(f, bf16x2_t)); }
template <int S> DI bf16x8 pack8(const f32x16& x) { u32x4 p; p.x = pk2(x[8 * S], x[8 * S + 1]); p.y = pk2(x[8 * S + 2], x[8 * S + 3]); p.z = pk2(x[8 * S + 4], x[8 * S + 5]); p.w = pk2(x[8 * S + 6], x[8 * S + 7]); return __builtin_bit_cast(bf16x8, p); }
#ifndef ATT_SETPRIO
#define ATT_SETPRIO 1
#endif
#if ATT_SETPRIO
#define ATT_PRIO(p) __builtin_amdgcn_s_setprio(p)
#else
#define ATT_PRIO(p)
#endif
#define ATT_MFMA(a, b, c) __builtin_amdgcn_mfma_f32_32x32x16_bf16((a), (b), (c), 0, 0, 0)

template <bool BF16OUT, int KVSRC> DI void attn_phase(LAS unsigned char* lds, const bf16_t* __restrict__ Qb, const bf16_t* __restrict__ Kb, const bf16_t* __restrict__ Vb, float* __restrict__ AO, bf16_t* __restrict__ AOB, int with_ctx, int wv_, const float* __restrict__ rope_tab = nullptr) {
    const int tid = otid(wv_), lane = tid & 63, wid = tid >> 6, r = lane & 31, h2 = lane >> 5, g1 = (lane >> 4) & 1, i16 = lane & 15;
    const int nlat = BATCH * MLA_HEADS * (SEQ / 256), nctx = with_ctx ? BATCH * MLA_HEADS * (CTX_LEN / 256) : 0;
    const int kq0 = tid, kq1 = 512 + tid; const bool has_k1 = tid < 256;
    const int kr0 = kq0 / 12, kc0 = kq0 % 12, kr1 = kq1 / 12, kc1 = kq1 % 12, vr = tid >> 3, vc = tid & 7;
    const unsigned kl0 = kr0 * KROWB + kc0 * 16, kl1 = kr1 * KROWB + kc1 * 16, vl = KT_BYTES + (vc >> 2) * 4096 + vr * 64 + (vc & 3) * 16;
    for (int u0 = opaque_bid(); u0 < nlat + nctx; u0 += gridDim.x) {
        int u = u0;
#if ATT_REMAP
        if (gridDim.x == 256 && u0 < nlat && (SEQ / 256) == 8) { const int c = u0 & 255, x = c & 7, j = c >> 3; u = (u0 & ~255) + 8 * (4 * x + (j >> 3)) + (j & 7); }
#endif
        int b, h, qrow0, nkeys;
        if (u < nlat) { const int qb = u % (SEQ / 256), bh = u / (SEQ / 256); b = bh / MLA_HEADS; h = bh % MLA_HEADS; qrow0 = NC_ + b * SEQ + qb * 256; nkeys = TT_; }
        else { const int v = u - nlat; const int qb = v % (CTX_LEN / 256), bh = v / (CTX_LEN / 256); b = bh / MLA_HEADS; h = bh % MLA_HEADS; qrow0 = b * CTX_LEN + qb * 256; nkeys = CTX_LEN; }
        const int nt = nkeys / 64;
        const bf16_t* qp = Qb + (size_t)(qrow0 + wid * 32 + r) * (MLA_HEADS * 96) + h * 96 + 8 * h2;
        bf16x8 qf[6];
#pragma unroll
        for (int s = 0; s < 6; ++s) qf[s] = *(const GAS bf16x8*)(qp + 16 * s);
        const bf16_t* kbase = Kb + (size_t)(b * MLA_HEADS + h) * TT_ * 96;
        const bf16_t* vbase = Vb + (size_t)(b * MLA_HEADS + h) * TT_ * 64;
#define ATT_LOAD_TO(TI, sk0, sk1, sv) do { if (KVSRC == 0) { const size_t ko = (size_t)(TI) * 64; \
            sk0 = *(const GAS u32x4*)(kbase + (ko + kr0) * 96 + kc0 * 8); if (has_k1) sk1 = *(const GAS u32x4*)(kbase + (ko + kr1) * 96 + kc1 * 8); sv = *(const GAS u32x4*)(vbase + (ko + vr) * 64 + vc * 8); } \
          else { const int t0_ = (TI) * 64; const size_t rb = t0_ < CTX_LEN ? (size_t)b * CTX_LEN + t0_ : (size_t)NC_ + (size_t)b * SEQ + (t0_ - CTX_LEN); \
            sk0 = kc0 < 8 ? *(const GAS u32x4*)(Kb + (rb + kr0) * (MLA_HEADS * 128) + h * 128 + kc0 * 8) : *(const GAS u32x4*)(Vb + (rb + kr0) * 32 + (kc0 - 8) * 8); \
            if (has_k1) sk1 = kc1 < 8 ? *(const GAS u32x4*)(Kb + (rb + kr1) * (MLA_HEADS * 128) + h * 128 + kc1 * 8) : *(const GAS u32x4*)(Vb + (rb + kr1) * 32 + (kc1 - 8) * 8); \
            sv = *(const GAS u32x4*)(Kb + (rb + vr) * (MLA_HEADS * 128) + h * 128 + 64 + vc * 8); } } while (0)
#define ATT_LOAD(TI) ATT_LOAD_TO(TI, sk0, sk1, sv)
        const bool do_rope = rope_tab != nullptr && u < nlat;
        f32x4 rt[2][4];
        if (do_rope) { const int spos = (qrow0 - NC_ + wid * 32 + r) % SEQ; const float* tb = rope_tab + (size_t)spos * 32;
#pragma unroll
            for (int f = 0; f < 2; ++f)
#pragma unroll
                for (int c = 0; c < 4; ++c) rt[f][c] = *(const GAS f32x4*)(tb + 16 * f + 4 * c); }
        u32x4 sk0, sk1 = (u32x4){0u, 0u, 0u, 0u}, sv, tk0, tk1 = (u32x4){0u, 0u, 0u, 0u}, tv;
        ATT_LOAD(0);
        if (nt > 1) { ATT_LOAD_TO(1, tk0, tk1, tv); }
        if (do_rope) {
#pragma unroll
            for (int f = 0; f < 2; ++f) { const u32x4 own = __builtin_bit_cast(u32x4, qf[4 + f]); u32x4 oth;
                oth.x = __shfl_xor(own.x, 32); oth.y = __shfl_xor(own.y, 32); oth.z = __shfl_xor(own.z, 32); oth.w = __shfl_xor(own.w, 32);
                const f32x4 c0 = rt[f][0], c1 = rt[f][1], s0 = rt[f][2], s1 = rt[f][3];
                const float sgn = h2 ? 1.f : -1.f;
                const float x[8] = {bf_lo(own.x), bf_hi(own.x), bf_lo(own.y), bf_hi(own.y), bf_lo(own.z), bf_hi(own.z), bf_lo(own.w), bf_hi(own.w)};
                const float y[8] = {bf_lo(oth.x), bf_hi(oth.x), bf_lo(oth.y), bf_hi(oth.y), bf_lo(oth.z), bf_hi(oth.z), bf_lo(oth.w), bf_hi(oth.w)};
                const float cs[8] = {c0[0], c0[1], c0[2], c0[3], c1[0], c1[1], c1[2], c1[3]}, sn[8] = {s0[0], s0[1], s0[2], s0[3], s1[0], s1[1], s1[2], s1[3]};
                u32x4 w; w.x = pk2(x[0] * cs[0] + sgn * y[0] * sn[0], x[1] * cs[1] + sgn * y[1] * sn[1]); w.y = pk2(x[2] * cs[2] + sgn * y[2] * sn[2], x[3] * cs[3] + sgn * y[3] * sn[3]);
                w.z = pk2(x[4] * cs[4] + sgn * y[4] * sn[4], x[5] * cs[5] + sgn * y[5] * sn[5]); w.w = pk2(x[6] * cs[6] + sgn * y[6] * sn[6], x[7] * cs[7] + sgn * y[7] * sn[7]);
                qf[4 + f] = __builtin_bit_cast(bf16x8, w); } }
#define ATT_QK(S0, S1, BUFP) do { _Pragma("unroll") for (int i = 0; i < 16; ++i) { S0[i] = 0.f; S1[i] = 0.f; } \
            _Pragma("unroll") for (int s = 0; s < 6; ++s) { const bf16x8 k0 = *(const LAS bf16x8*)((BUFP) + r * KROWB + 32 * s + 16 * h2); const bf16x8 k1 = *(const LAS bf16x8*)((BUFP) + (32 + r) * KROWB + 32 * s + 16 * h2); \
                S0 = ATT_MFMA(k0, qf[s], S0); S1 = ATT_MFMA(k1, qf[s], S1); } } while (0)
#define ATT_STORE_STAGE(NB) do { *(LAS u32x4*)((NB) + kl0) = sk0; if (has_k1) *(LAS u32x4*)((NB) + kl1) = sk1; *(LAS u32x4*)((NB) + vl) = sv; } while (0)
        ATT_STORE_STAGE(lds);
        if (nt > 1) { *(LAS u32x4*)(lds + BUF + kl0) = tk0; if (has_k1) *(LAS u32x4*)(lds + BUF + kl1) = tk1; *(LAS u32x4*)(lds + BUF + vl) = tv; }
        __syncthreads();
        f32x16 o0, o1, s0, s1;
#pragma unroll
        for (int i = 0; i < 16; ++i) { o0[i] = 0.f; o1[i] = 0.f; }
        ATT_QK(s0, s1, lds);
        float m = -1e30f, l = 0.f;
        int st_cur = 0;
        for (int t = 0; t < nt; ++t) {
            const int st_nxt = st_cur == 2 ? 0 : st_cur + 1, st_nn = st_nxt == 2 ? 0 : st_nxt + 1;
            LAS unsigned char* buf = lds + st_cur * BUF;
            if (t + 2 < nt) { ATT_LOAD(t + 2); }
            f32x16 n0, n1;
            ATT_QK(n0, n1, lds + st_nxt * BUF);
            float mt = __builtin_fmaxf(s0[0], s1[0]);
#pragma unroll
            for (int i = 1; i < 16; ++i) mt = __builtin_fmaxf(__builtin_fmaxf(mt, s0[i]), s1[i]);
            { float ma = mt, mb = mt; asm volatile("s_nop 1\n\tv_permlane32_swap_b32 %0, %1" : "+v"(ma), "+v"(mb)); mt = fmaxf(ma, mb); }
            if (__any(mt > m + 8.f)) { const float mnew = fmaxf(m, mt), alpha = __builtin_amdgcn_exp2f(m - mnew); m = mnew; l *= alpha;
#pragma unroll
                for (int i = 0; i < 16; ++i) { o0[i] *= alpha; o1[i] *= alpha; } }
            float ls = 0.f;
#pragma unroll
            for (int i = 0; i < 16; ++i) { s0[i] = __builtin_amdgcn_exp2f(s0[i] - m); s1[i] = __builtin_amdgcn_exp2f(s1[i] - m); ls += s0[i] + s1[i]; }
            l += ls;
            LAS unsigned char* vb = buf + KT_BYTES + (4 * h2 + (i16 >> 2)) * 64 + 32 * g1 + 8 * (i16 & 3);
#define ATT_PV(PS, SB, S2) do { const bf16x8 pb = pack8<S2>(PS); \
            { const s16x4 lo = __builtin_amdgcn_ds_read_tr16_b64_v4i16((LAS s16x4*)(vb + (32 * SB + 16 * S2) * 64)), hi = __builtin_amdgcn_ds_read_tr16_b64_v4i16((LAS s16x4*)(vb + (32 * SB + 16 * S2 + 8) * 64)); \
              o0 = ATT_MFMA(__builtin_shufflevector(lo, hi, 0, 1, 2, 3, 4, 5, 6, 7), pb, o0); } \
            { const s16x4 lo = __builtin_amdgcn_ds_read_tr16_b64_v4i16((LAS s16x4*)(vb + 4096 + (32 * SB + 16 * S2) * 64)), hi = __builtin_amdgcn_ds_read_tr16_b64_v4i16((LAS s16x4*)(vb + 4096 + (32 * SB + 16 * S2 + 8) * 64)); \
              o1 = ATT_MFMA(__builtin_shufflevector(lo, hi, 0, 1, 2, 3, 4, 5, 6, 7), pb, o1); } } while (0)
            ATT_PRIO(1); ATT_PV(s0, 0, 0); ATT_PV(s0, 0, 1); ATT_PV(s1, 1, 0); ATT_PV(s1, 1, 1); ATT_PRIO(0);
#undef ATT_PV
            if (t + 2 < nt) ATT_STORE_STAGE(lds + st_nn * BUF);
            __syncthreads();
            s0 = n0; s1 = n1;
            st_cur = st_nxt;
        }
#undef ATT_QK
#undef ATT_STORE_STAGE
        l += __shfl_xor(l, 32);
        const float il = 1.f / l;
        if (BF16OUT) { bf16_t* op = AOB + (size_t)(qrow0 + wid * 32 + r) * 1024 + h * 64 + 4 * h2;
#pragma unroll
            for (int g = 0; g < 4; ++g) {
                *(GAS u32x2*)(op + 8 * g) = (u32x2){pk2(o0[4 * g] * il, o0[4 * g + 1] * il), pk2(o0[4 * g + 2] * il, o0[4 * g + 3] * il)};
                *(GAS u32x2*)(op + 32 + 8 * g) = (u32x2){pk2(o1[4 * g] * il, o1[4 * g + 1] * il), pk2(o1[4 * g + 2] * il, o1[4 * g + 3] * il)}; }
        } else { float* op = AO + (size_t)(qrow0 + wid * 32 + r) * 1024 + h * 64 + 4 * h2;
#pragma unroll
            for (int g = 0; g < 4; ++g) {
                *(GAS f32x4*)(op + 8 * g) = (f32x4){o0[4 * g] * il, o0[4 * g + 1] * il, o0[4 * g + 2] * il, o0[4 * g + 3] * il};
                *(GAS f32x4*)(op + 32 + 8 * g) = (f32x4){o1[4 * g] * il, o1[4 * g + 1] * il, o1[4 * g + 2] * il, o1[4 * g + 3] * il}; } }
    }
}
#undef ATT_LOAD
#undef ATT_LOAD_TO
}

namespace tl {
DI float wsum(float v) { v += __shfl_xor(v, 32); v += __shfl_xor(v, 16); v += __shfl_xor(v, 8); v += __shfl_xor(v, 4); v += __shfl_xor(v, 2); v += __shfl_xor(v, 1); return v; }
DI void ld16f(const float* p, int lane, float (&v)[16]) {
#pragma unroll
    for (int i = 0; i < 2; ++i) { const f32x4 a = *(const GAS f32x4*)(p + 512 * i + 8 * lane), b = *(const GAS f32x4*)(p + 512 * i + 8 * lane + 4);
        v[8 * i] = a[0]; v[8 * i + 1] = a[1]; v[8 * i + 2] = a[2]; v[8 * i + 3] = a[3]; v[8 * i + 4] = b[0]; v[8 * i + 5] = b[1]; v[8 * i + 6] = b[2]; v[8 * i + 7] = b[3]; } }
DI void st16f(float* p, int lane, const float (&v)[16]) {
#pragma unroll
    for (int i = 0; i < 2; ++i) { *(GAS f32x4*)(p + 512 * i + 8 * lane) = (f32x4){v[8 * i], v[8 * i + 1], v[8 * i + 2], v[8 * i + 3]}; *(GAS f32x4*)(p + 512 * i + 8 * lane + 4) = (f32x4){v[8 * i + 4], v[8 * i + 5], v[8 * i + 6], v[8 * i + 7]}; } }
DI void ld16b(const bf16_t* p, int lane, float (&v)[16]) {
#pragma unroll
    for (int i = 0; i < 2; ++i) { const u32x4 w = *(const GAS u32x4*)(p + 512 * i + 8 * lane);
        v[8 * i] = bf_lo(w.x); v[8 * i + 1] = bf_hi(w.x); v[8 * i + 2] = bf_lo(w.y); v[8 * i + 3] = bf_hi(w.y); v[8 * i + 4] = bf_lo(w.z); v[8 * i + 5] = bf_hi(w.z); v[8 * i + 6] = bf_lo(w.w); v[8 * i + 7] = bf_hi(w.w); } }
DI void st16b(bf16_t* p, int lane, const float (&v)[16]) {
#pragma unroll
    for (int i = 0; i < 2; ++i) { u32x4 w; w.x = att::pk2(v[8 * i], v[8 * i + 1]); w.y = att::pk2(v[8 * i + 2], v[8 * i + 3]); w.z = att::pk2(v[8 * i + 4], v[8 * i + 5]); w.w = att::pk2(v[8 * i + 6], v[8 * i + 7]);
        *(GAS u32x4*)(p + 512 * i + 8 * lane) = w; } }
typedef _Float16 f16x8 __attribute__((ext_vector_type(8)));
typedef float f32x8 __attribute__((ext_vector_type(8)));
DI void ld16h(const unsigned short* p, int lane, float (&v)[16]) {
#pragma unroll
    for (int i = 0; i < 2; ++i) { const f16x8 hv = *(const GAS f16x8*)(p + 512 * i + 8 * lane); const f32x8 f = __builtin_convertvector(hv, f32x8);
#pragma unroll
        for (int j = 0; j < 8; ++j) v[8 * i + j] = f[j]; } }
DI void st16h(unsigned short* p, int lane, const float (&v)[16]) {
#pragma unroll
    for (int i = 0; i < 2; ++i) { f32x8 f;
#pragma unroll
        for (int j = 0; j < 8; ++j) f[j] = v[8 * i + j];
        *(GAS f16x8*)(p + 512 * i + 8 * lane) = __builtin_convertvector(f, f16x8); } }
#define TL_ROWS(row, row_lo, nrows) const int rpw_ = ((nrows) + (int)gridDim.x - 1) / (int)gridDim.x, wg_ = opaque_bid(), tid_ = otid(wv_), lane = tid_ & 63, wid_ = tid_ >> 6; (void)lane; \
    for (int rr_ = wid_, row = (row_lo) + wg_ * rpw_ + wid_; rr_ < rpw_ && row < (row_lo) + (nrows); rr_ += 8, row += 8)

DI void init_h(const LAS NaiveCtx* Cp_, int wv_) {
    TL_ROWS(row, 0, NT_) { float h[16], m0[16], m1[16], u[16];
        ld16f(row < NC_ ? (*Cp_).ctx + (size_t)row * D_MODEL : (*Cp_).x + (size_t)(row - NC_) * D_MODEL, lane, h);
        const float* m = (*Cp_).MOD + (size_t)modrow(row) * N_MOD * D_MODEL; ld16f(m, lane, m0); ld16f(m + D_MODEL, lane, m1);
#pragma unroll
        for (int k = 0; k < 16; ++k) u[k] = h[k] * (1.f + m1[k]) + m0[k];
        st16h((*Cp_).HB + (size_t)row * D_MODEL, lane, h); st16b((*Cp_).UB + (size_t)row * D_MODEL, lane, u); }
}


DI void mod_phase(const LAS NaiveCtx* Cp_, LAS unsigned char* lds, int wv_) {
    constexpr int W = N_MOD * D_MODEL, NR = BATCH + 1, NCOLS = DEPTH * W;
    const int t = otid(wv_), wg = opaque_bid(), cpw = (NCOLS + (int)gridDim.x - 1) / (int)gridDim.x;
    LAS float* sl = (LAS float*)(lds + 72 * 1024);
    { constexpr int NV = NR * D_MODEL / PB_THREADS; float cv[NV]; const GAS float* cp = (const GAS float*)(*Cp_).c; const GAS float* cc = (const GAS float*)(*Cp_).c_ctx;
      static_assert(NR * D_MODEL % PB_THREADS == 0, "silu table");
#pragma unroll
      for (int j = 0; j < NV; ++j) { const int i = t + PB_THREADS * j, r = i / D_MODEL, k = i % D_MODEL; cv[j] = r < BATCH ? cp[(size_t)r * D_MODEL + k] : cc[k]; }
#pragma unroll
      for (int j = 0; j < NV; ++j) sl[t + PB_THREADS * j] = siluf_(cv[j]); }
    __syncthreads();
    const int col = wg * cpw + t;
    if (t < cpw && col < NCOLS) { const int l = col / W, j = col % W; const float* w = (*Cp_).mod_w + (size_t)l * D_MODEL * W + j;
        float acc[NR];
#pragma unroll
        for (int r = 0; r < NR; ++r) acc[r] = 0.f;
        for (int k = 0; k < D_MODEL; k += 4) { const GAS float* wg_ = (const GAS float*)w; const float w0 = wg_[(size_t)k * W], w1 = wg_[(size_t)(k + 1) * W], w2 = wg_[(size_t)(k + 2) * W], w3 = wg_[(size_t)(k + 3) * W];
#pragma unroll
            for (int r = 0; r < NR; ++r) { const f32x4 s = *(const LAS f32x4*)(sl + r * D_MODEL + k); acc[r] += s[0] * w0 + s[1] * w1 + s[2] * w2 + s[3] * w3; } }
        const float bj = (*Cp_).mod_b[(size_t)l * W + j];
#pragma unroll
        for (int r = 0; r < NR; ++r) (*Cp_).MOD[((size_t)l * NR + r) * W + j] = acc[r] + bj; }
    __syncthreads();
}

constexpr int WRT_STRIDE = 1028;
__shared__ int tl_lcnt[32], tl_wgbase[32], tl_offs[33], tl_tstart[33], tl_cnt[32];

DI void ln1_row_pre(const LAS NaiveCtx* Cp_, const float* MODp, const float (&g0)[16], const float (&b0)[16], int row, int lane, bool wr, float (&t)[16]) {
    const float* m = MODp + (size_t)modrow(row) * N_MOD * D_MODEL;
    float a[16], b[16];
    ld16h((*Cp_).HB + (size_t)row * D_MODEL, lane, t); ld16b((*Cp_).YOB + (size_t)row * D_MODEL, lane, a); ld16f(m + 2 * D_MODEL, lane, b);
    float s = 0.f;
#pragma unroll
    for (int k = 0; k < 16; ++k) { t[k] = ALPHA * t[k] + b[k] * a[k]; s += t[k]; }
    const float mean = wsum(s) * (1.f / D_MODEL); s = 0.f;
#pragma unroll
    for (int k = 0; k < 16; ++k) { t[k] -= mean; s += t[k] * t[k]; }
    const float rs = 1.f / sqrtf(wsum(s) * (1.f / D_MODEL) + 1e-5f);
    ld16f(m + 3 * D_MODEL, lane, a); ld16f(m + 4 * D_MODEL, lane, b);
#pragma unroll
    for (int k = 0; k < 16; ++k) t[k] = t[k] * rs * g0[k] + b0[k];
    if (wr) st16h((*Cp_).HB + (size_t)row * D_MODEL, lane, t);
#pragma unroll
    for (int k = 0; k < 16; ++k) t[k] = t[k] * (1.f + b[k]) + a[k];
    if (wr) st16b((*Cp_).UB + (size_t)row * D_MODEL, lane, t);
}
DI void ln1_row_post(const LAS NaiveCtx* Cp_, const float* brp, int row, int lane, bool wr, float (&p)[16]) {
#define TL_STAGE(N, BIT) { const bool up_ = (lane & BIT) != 0; _Pragma("unroll") for (int k = 0; k < N / 2; ++k) { const float send_ = up_ ? p[k] : p[k + N / 2], keep_ = up_ ? p[k + N / 2] : p[k]; p[k] = keep_ + __shfl_xor(send_, BIT); } }
        TL_STAGE(16, 16) TL_STAGE(8, 8) TL_STAGE(4, 4) TL_STAGE(2, 2)
#undef TL_STAGE
        const int e_me = (lane >> 1) & 31;
        const float lg = p[0] + __shfl_xor(p[0], 1) + brp[e_me];
        int rank = 0;
#pragma unroll
        for (int e2 = 0; e2 < 32; ++e2) { const float v = __builtin_bit_cast(float, __builtin_amdgcn_readlane(__builtin_bit_cast(int, lg), 2 * e2)); rank += (v > lg || (v == lg && e2 < e_me)) ? 1 : 0; }
        float vk[4]; int ek[4];
#pragma unroll
        for (int k = 0; k < 4; ++k) { const unsigned long long mk = __ballot(rank == k && (lane & 1) == 0); const int src = __builtin_amdgcn_readfirstlane((int)__builtin_ctzll(mk | (1ull << 63)));
            vk[k] = __builtin_bit_cast(float, __builtin_amdgcn_readlane(__builtin_bit_cast(int, lg), src)); ek[k] = src >> 1; }
        float wk[4], den = 0.f;
#pragma unroll
        for (int k = 0; k < 4; ++k) { wk[k] = expf(vk[k] - vk[0]); den += wk[k]; }
        if (wr && lane < 4) { const int e = lane == 0 ? ek[0] : lane == 1 ? ek[1] : lane == 2 ? ek[2] : ek[3]; const float g = (lane == 0 ? wk[0] : lane == 1 ? wk[1] : lane == 2 ? wk[2] : wk[3]) / den;
            const int r = atomicAdd(&tl_lcnt[e], 1);
            (*Cp_).TOPI[(size_t)row * TOP_K + lane] = e; (*Cp_).TOPG[(size_t)row * TOP_K + lane] = g; (*Cp_).SLOT[(size_t)row * TOP_K + lane] = r; }
}
DI void ln1_router(const LAS NaiveCtx* Cp_, LAS unsigned char* lds, long layer, int row_lo, int nrows, int wv_) {
    LAS float* wrt = (LAS float*)lds;
    { const int t = otid(wv_); const float* wrp = (*Cp_).moe_w_router + (size_t)layer * D_MODEL * N_EXPERTS;
      { const GAS f32x4* wrp4 = (const GAS f32x4*)wrp; constexpr int NV = D_MODEL * N_EXPERTS / 4 / PB_THREADS; f32x4 wv[NV];
#pragma unroll
        for (int j = 0; j < NV; ++j) wv[j] = wrp4[t + PB_THREADS * j];
#pragma unroll
        for (int j = 0; j < NV; ++j) { const int idx = 4 * (t + PB_THREADS * j);
#pragma unroll
            for (int c = 0; c < 4; ++c) wrt[((idx + c) & 31) * WRT_STRIDE + ((idx + c) >> 5)] = wv[j][c]; } }
      if (t < 32) tl_lcnt[t] = 0; }
    __syncthreads();
    const float* MODp = (*Cp_).MOD + (size_t)layer * (BATCH + 1) * N_MOD * D_MODEL;
    const float* lg0 = (*Cp_).ln_g + ((size_t)layer * 2) * D_MODEL; const float* lb0 = (*Cp_).ln_b + ((size_t)layer * 2) * D_MODEL;
    const float* brp = (*Cp_).moe_b_router + (size_t)layer * N_EXPERTS;
    { const int rpw_ = (nrows + (int)gridDim.x - 1) / (int)gridDim.x, wg_ = opaque_bid(), tid_ = otid(wv_), lane = tid_ & 63, wid_ = tid_ >> 6;
      float g0[16], b0[16]; ld16f(lg0, lane, g0); ld16f(lb0, lane, b0);
      for (int rr_ = wid_, row = row_lo + wg_ * rpw_ + wid_; rr_ < rpw_ && row < row_lo + nrows; rr_ += 16, row += 16) {
        const bool hasB = (rr_ + 8 < rpw_) && (row + 8 < row_lo + nrows); const int rowB = hasB ? row + 8 : row;
        float tA[16], tB[16];
        ln1_row_pre(Cp_, MODp, g0, b0, row, lane, true, tA); ln1_row_pre(Cp_, MODp, g0, b0, rowB, lane, hasB, tB);
        float pA[16], pB[16];
        const bool up5 = (lane & 32) != 0;
#pragma unroll
        for (int k = 0; k < 16; ++k) { float aA[2], aB[2];
#pragma unroll
            for (int hh = 0; hh < 2; ++hh) { const int e = k + 16 * hh; float accA = 0.f, accB = 0.f;
#pragma unroll
                for (int i = 0; i < 2; ++i) { const f32x4 w0 = *(const LAS f32x4*)(wrt + e * WRT_STRIDE + 512 * i + 8 * lane), w1 = *(const LAS f32x4*)(wrt + e * WRT_STRIDE + 512 * i + 8 * lane + 4);
                    accA += tA[8 * i] * w0[0] + tA[8 * i + 1] * w0[1] + tA[8 * i + 2] * w0[2] + tA[8 * i + 3] * w0[3] + tA[8 * i + 4] * w1[0] + tA[8 * i + 5] * w1[1] + tA[8 * i + 6] * w1[2] + tA[8 * i + 7] * w1[3];
                    accB += tB[8 * i] * w0[0] + tB[8 * i + 1] * w0[1] + tB[8 * i + 2] * w0[2] + tB[8 * i + 3] * w0[3] + tB[8 * i + 4] * w1[0] + tB[8 * i + 5] * w1[1] + tB[8 * i + 6] * w1[2] + tB[8 * i + 7] * w1[3]; }
                aA[hh] = accA; aB[hh] = accB; }
            { const float sendA = up5 ? aA[0] : aA[1], keepA = up5 ? aA[1] : aA[0]; pA[k] = keepA + __shfl_xor(sendA, 32);
              const float sendB = up5 ? aB[0] : aB[1], keepB = up5 ? aB[1] : aB[0]; pB[k] = keepB + __shfl_xor(sendB, 32); }
            __builtin_amdgcn_sched_barrier(0); }
        ln1_row_post(Cp_, brp, row, lane, true, pA); ln1_row_post(Cp_, brp, rowB, lane, hasB, pB);
      } }
    __syncthreads();
    { const int t = otid(wv_); if (t < 32) tl_wgbase[t] = atomicAdd((*Cp_).CNT + layer * 64 + t, tl_lcnt[t]); }
}

DI void slots_gather(const LAS NaiveCtx* Cp_, long layer, int row_lo, int nrows, int wv_) {
    { const int t = otid(wv_); if (t < N_EXPERTS) tl_cnt[t] = ld_cnt((*Cp_).CNT + layer * 64 + t); }
    __syncthreads();
    { const int t = otid(wv_); if (t == 0) { int off = 0; for (int e = 0; e < N_EXPERTS; ++e) { tl_offs[e] = off; tl_tstart[e] = off / MOE_PAD; off += (tl_cnt[e] + MOE_PAD - 1) / MOE_PAD * MOE_PAD; } tl_offs[N_EXPERTS] = off; tl_tstart[N_EXPERTS] = off / MOE_PAD; } }
    __syncthreads();
    { const int rpw_ = (nrows + (int)gridDim.x - 1) / (int)gridDim.x, base = row_lo + opaque_bid() * rpw_, hi = (base + rpw_ < row_lo + nrows) ? base + rpw_ : row_lo + nrows;
      const GAS int* topi = (const GAS int*)(*Cp_).TOPI; GAS int* slotp = (GAS int*)(*Cp_).SLOT; GAS int* tokof = (GAS int*)(*Cp_).TOKOF;
      for (int i = otid(wv_); i < (hi - base) * TOP_K; i += PB_THREADS) { const int row = base + i / TOP_K; const size_t idx = (size_t)base * TOP_K + i;
          const int e = topi[idx]; const int slot = tl_offs[e] + tl_wgbase[e] + slotp[idx]; slotp[idx] = slot;
          tokof[slot] = row; } }
    { const int wg = opaque_bid(), t = otid(wv_);
      if (wg < N_EXPERTS) { const int cnt = tl_cnt[wg], lo = tl_offs[wg] + cnt, hi = tl_offs[wg + 1]; for (int s = lo + t; s < hi; s += PB_THREADS) (*Cp_).TOKOF[s] = 0; } }
}

DI void cmb_issue(const LAS NaiveCtx* Cp_, int row, int lane, u32x4 (&o)[4][2], float (&g)[4], f16x8 (&h)[2]) {
    const GAS int* sp = (const GAS int*)((*Cp_).SLOT + (size_t)row * TOP_K); const GAS float* gp = (const GAS float*)((*Cp_).TOPG + (size_t)row * TOP_K);
    int sl[4];
#pragma unroll
    for (int q = 0; q < 4; ++q) { sl[q] = sp[q]; g[q] = gp[q]; }
#pragma unroll
    for (int q = 0; q < 4; ++q) { const GAS u32x4* p = (const GAS u32x4*)((*Cp_).OUT2B + (size_t)sl[q] * D_MODEL + 8 * lane); o[q][0] = p[0]; o[q][1] = p[64]; }
#pragma unroll
    for (int i = 0; i < 2; ++i) h[i] = *(const GAS f16x8*)((*Cp_).HB + (size_t)row * D_MODEL + 512 * i + 8 * lane);
}
DI void cmb_finish(const LAS NaiveCtx* Cp_, const float* MODp, const float (&g1)[16], const float (&b1)[16], bool last, int row, int lane, bool wr, const u32x4 (&o)[4][2], const float (&g)[4], const f16x8 (&h)[2]) {
    const float* m = MODp + (size_t)modrow(row) * N_MOD * D_MODEL;
    float f[16], t[16], a[16], b[16];
#pragma unroll
    for (int k = 0; k < 16; ++k) f[k] = 0.f;
#pragma unroll
    for (int q = 0; q < 4; ++q)
#pragma unroll
        for (int i = 0; i < 2; ++i) { const u32x4 w = o[q][i];
            f[8 * i] += g[q] * bf_lo(w.x); f[8 * i + 1] += g[q] * bf_hi(w.x); f[8 * i + 2] += g[q] * bf_lo(w.y); f[8 * i + 3] += g[q] * bf_hi(w.y);
            f[8 * i + 4] += g[q] * bf_lo(w.z); f[8 * i + 5] += g[q] * bf_hi(w.z); f[8 * i + 6] += g[q] * bf_lo(w.w); f[8 * i + 7] += g[q] * bf_hi(w.w); }
#pragma unroll
    for (int i = 0; i < 2; ++i) { const f32x8 hf = __builtin_convertvector(h[i], f32x8);
#pragma unroll
        for (int j = 0; j < 8; ++j) t[8 * i + j] = hf[j]; }
    ld16f(m + 5 * D_MODEL, lane, b);
    float s = 0.f;
#pragma unroll
    for (int k = 0; k < 16; ++k) { t[k] = ALPHA * t[k] + b[k] * f[k]; s += t[k]; }
    const float mean = wsum(s) * (1.f / D_MODEL); s = 0.f;
#pragma unroll
    for (int k = 0; k < 16; ++k) { t[k] -= mean; s += t[k] * t[k]; }
    const float rs = 1.f / sqrtf(wsum(s) * (1.f / D_MODEL) + 1e-5f);
#pragma unroll
    for (int k = 0; k < 16; ++k) t[k] = t[k] * rs * g1[k] + b1[k];
    if (!wr) return;
    if (last) { st16f((*Cp_).out + (size_t)(row - NC_) * D_MODEL, lane, t); }
    else { const float* mn = MODp + (size_t)(BATCH + 1) * N_MOD * D_MODEL + (size_t)modrow(row) * N_MOD * D_MODEL; ld16f(mn, lane, a); ld16f(mn + D_MODEL, lane, b);
        st16h((*Cp_).HB + (size_t)row * D_MODEL, lane, t);
#pragma unroll
        for (int k = 0; k < 16; ++k) t[k] = t[k] * (1.f + b[k]) + a[k];
        st16b((*Cp_).UB + (size_t)row * D_MODEL, lane, t); }
}
DI void combine_ln2(const LAS NaiveCtx* Cp_, long layer, int row_lo, int nrows, int wv_) {
    const float* MODp = (*Cp_).MOD + (size_t)layer * (BATCH + 1) * N_MOD * D_MODEL;
    const float* lg1 = (*Cp_).ln_g + ((size_t)layer * 2 + 1) * D_MODEL; const float* lb1 = (*Cp_).ln_b + ((size_t)layer * 2 + 1) * D_MODEL;
    const bool last = layer == DEPTH - 1;
    const int rpw_ = (nrows + (int)gridDim.x - 1) / (int)gridDim.x, wg_ = opaque_bid(), tid_ = otid(wv_), lane = tid_ & 63, wid_ = tid_ >> 6;
    float g1[16], b1[16]; ld16f(lg1, lane, g1); ld16f(lb1, lane, b1);
    for (int rr_ = wid_, row = row_lo + wg_ * rpw_ + wid_; rr_ < rpw_ && row < row_lo + nrows; rr_ += 16, row += 16) {
        const bool hasB = (rr_ + 8 < rpw_) && (row + 8 < row_lo + nrows); const int rowB = hasB ? row + 8 : row;
        u32x4 oA[4][2], oB[4][2]; float gA[4], gB[4]; f16x8 hA[2], hB[2];
        cmb_issue(Cp_, row, lane, oA, gA, hA); cmb_issue(Cp_, rowB, lane, oB, gB, hB);
        cmb_finish(Cp_, MODp, g1, b1, last, row, lane, true, oA, gA, hA); cmb_finish(Cp_, MODp, g1, b1, last, rowB, lane, hasB, oB, gB, hB);
    }
}
}

namespace tl {
DI u32x4 pack8f(const float (&v)[8]) { u32x4 w; w.x = att::pk2(v[0], v[1]); w.y = att::pk2(v[2], v[3]); w.z = att::pk2(v[4], v[5]); w.w = att::pk2(v[6], v[7]); return w; }
DI void ld8f(const float* p, float (&v)[8]) { const f32x4 a = *(const GAS f32x4*)p, b = *(const GAS f32x4*)(p + 4); v[0] = a[0]; v[1] = a[1]; v[2] = a[2]; v[3] = a[3]; v[4] = b[0]; v[5] = b[1]; v[6] = b[2]; v[7] = b[3]; }
DI void st8f(float* p, const float (&v)[8]) { *(GAS f32x4*)p = (f32x4){v[0], v[1], v[2], v[3]}; *(GAS f32x4*)(p + 4) = (f32x4){v[4], v[5], v[6], v[7]}; }
DI void up8b(const u32x4 w, float (&v)[8]) { v[0] = bf_lo(w.x); v[1] = bf_hi(w.x); v[2] = bf_lo(w.y); v[3] = bf_hi(w.y); v[4] = bf_lo(w.z); v[5] = bf_hi(w.z); v[6] = bf_lo(w.w); v[7] = bf_hi(w.w); }
DI void ld8b(const bf16_t* p, float (&v)[8]) { const u32x4 w = *(const GAS u32x4*)p; v[0] = bf_lo(w.x); v[1] = bf_hi(w.x); v[2] = bf_lo(w.y); v[3] = bf_hi(w.y); v[4] = bf_lo(w.z); v[5] = bf_hi(w.z); v[6] = bf_lo(w.w); v[7] = bf_hi(w.w); }
DI void shifted8(const float* Z, int ldz, int row, int c, bool has_p, bool has_n, const float* mu, float (&o)[8]) {
    float z[8], p[8], n[8], m[8]; ld8f(Z + (size_t)row * ldz + c, z); ld8f(mu + c, m);
    if (has_p) ld8f(Z + (size_t)(row - 1) * ldz + c, p); else {
#pragma unroll
        for (int j = 0; j < 8; ++j) p[j] = 0.f; }
    if (has_n) ld8f(Z + (size_t)(row + 1) * ldz + c, n); else {
#pragma unroll
        for (int j = 0; j < 8; ++j) n[j] = 0.f; }
#pragma unroll
    for (int j = 0; j < 8; ++j) o[j] = z[j] + m[j] * (0.5f * (p[j] + n[j]) - z[j]);
}
DI void shifted8b(const bf16_t* Z, int row, int c, bool has_p, bool has_n, const float* mu, float (&o)[8]) {
    float z[8], p[8], n[8], m[8]; ld8b(Z + (size_t)row * 4608 + c, z); ld8f(mu + c, m);
    if (has_p) ld8b(Z + (size_t)(row - 1) * 4608 + c, p); else {
#pragma unroll
        for (int j = 0; j < 8; ++j) p[j] = 0.f; }
    if (has_n) ld8b(Z + (size_t)(row + 1) * 4608 + c, n); else {
#pragma unroll
        for (int j = 0; j < 8; ++j) n[j] = 0.f; }
#pragma unroll
    for (int j = 0; j < 8; ++j) o[j] = z[j] + m[j] * (0.5f * (p[j] + n[j]) - z[j]);
}
#define TL_SEG(row, t, len) int t, len; if ((row) < NC_) { t = (row) % CTX_LEN; len = CTX_LEN; } else { t = ((row) - NC_) % SEQ; len = SEQ; }

DI void rw_tw(const LAS NaiveCtx* Cp_, long layer, int wv_) {
    const float* mu = (*Cp_).rw_mu + (size_t)(layer / 2) * RW_IN;
    TL_ROWS(row, 0, NT_) { if (lane < 48) { TL_SEG(row, t, len); float zs[8]; shifted8b((*Cp_).ZB, row, 1536 + 8 * lane, t > 0, t < len - 1, mu, zs);
#pragma unroll
            for (int j = 0; j < 8; ++j) zs[j] = lane < 16 ? ftanh(zs[j]) : (lane < 32 ? zs[j] : fsigmoid(zs[j]));
            *(GAS u32x4*)((*Cp_).TW + (size_t)row * 384 + 8 * lane) = pack8f(zs); } }
}

DI void rw_prep(const LAS NaiveCtx* Cp_, long layer, int wv_) {
    const long j2 = layer / 2;
    const float* mu = (*Cp_).rw_mu + (size_t)j2 * RW_IN;
    const float *w0 = (*Cp_).rw_w0 + (size_t)j2 * 1024, *a0 = (*Cp_).rw_a0 + (size_t)j2 * 1024, *kkp = (*Cp_).rw_k_k + (size_t)j2 * 512, *kap = (*Cp_).rw_k_a + (size_t)j2 * 512, *rkp = (*Cp_).rw_r_k + (size_t)j2 * 512;
    TL_ROWS(row, 0, NT_) { TL_SEG(row, t, len); const bool hp = t > 0, hn = t < len - 1; const int c0 = 8 * lane;
        float r[8], k[8], v[8], tmp[8], kk[8], g[8];
        const bf16_t* lo = (*Cp_).LOB + (size_t)row * 2560;
        const u32x4 lwl0 = *(const GAS u32x4*)(lo + c0), lwl1 = *(const GAS u32x4*)(lo + 512 + c0), lal0 = *(const GAS u32x4*)(lo + 1024 + c0), lal1 = *(const GAS u32x4*)(lo + 1536 + c0), lg = *(const GAS u32x4*)(lo + 2048 + c0);
        shifted8b((*Cp_).ZB, row, c0, hp, hn, mu, r); shifted8b((*Cp_).ZB, row, 512 + c0, hp, hn, mu, k); shifted8b((*Cp_).ZB, row, 1024 + c0, hp, hn, mu, v);
        ld8f(kkp + c0, tmp); float ss = 0.f;
#pragma unroll
        for (int j = 0; j < 8; ++j) { kk[j] = k[j] * tmp[j]; ss += kk[j] * kk[j]; }
        ss += __shfl_xor(ss, 1); ss += __shfl_xor(ss, 2); ss += __shfl_xor(ss, 4);
        const float inv = 1.f / sqrtf(fmaxf(ss, 1e-24f));
#pragma unroll
        for (int j = 0; j < 8; ++j) { kk[j] *= inv; tmp[j] = -kk[j]; }
        *(GAS u32x4*)((*Cp_).RBh + (size_t)row * 512 + c0) = pack8f(r); *(GAS u32x4*)((*Cp_).VBh + (size_t)row * 512 + c0) = pack8f(v); *(GAS u32x4*)((*Cp_).NKh + (size_t)row * 512 + c0) = pack8f(tmp);
        *(GAS u32x4*)((*Cp_).GBh + (size_t)row * 512 + c0) = lg; (void)g;
        float ka[8], rk[8], bon = 0.f; ld8f(kap + c0, ka); ld8f(rkp + c0, rk);
#pragma unroll
        for (int d = 0; d < 2; ++d) { float wl[8], al[8], wb[8], ab[8], dec[8], kd[8], bb[8];
            up8b(d ? lwl1 : lwl0, wl); up8b(d ? lal1 : lal0, al); ld8f(w0 + d * 512 + c0, wb); ld8f(a0 + d * 512 + c0, ab);
#pragma unroll
            for (int j = 0; j < 8; ++j) { const float wpre = wb[j] + wl[j]; dec[j] = -1.4426950408889634f * fexp(-fsoftplus(-wpre) - 0.5f);     const float a = fsigmoid(ab[j] + al[j]);
                kd[j] = k[j] * (1.f + (a - 1.f) * ka[j]); bb[j] = kk[j] * a; bon += r[j] * kd[j] * rk[j]; }
            const size_t o = ((size_t)d * NT_ + row) * 512 + c0; st8f((*Cp_).DEC + o, dec); *(GAS u32x4*)((*Cp_).KDh + o) = pack8f(kd); *(GAS u32x4*)((*Cp_).BBh + o) = pack8f(bb); }
        bon += __shfl_xor(bon, 1); bon += __shfl_xor(bon, 2); bon += __shfl_xor(bon, 4);
        if ((lane & 7) == 0) (*Cp_).BON[(size_t)row * 8 + (lane >> 3)] = bon;
    }
}

DI void even_post(const LAS NaiveCtx* Cp_, long layer, int wv_) {
    const long j2 = layer / 2;
    const float *gng = (*Cp_).rw_gn_g + (size_t)j2 * 512, *gnb = (*Cp_).rw_gn_b + (size_t)j2 * 512, *hgn = (*Cp_).hg_norm_g + (size_t)j2 * 512;
    TL_ROWS(row, 0, NT_) { const int c0 = 8 * lane;
        const u32x4 eo0 = *(const GAS u32x4*)((*Cp_).OBh + (size_t)row * 512 + c0), eo1 = *(const GAS u32x4*)((*Cp_).OBh + ((size_t)NT_ + row) * 512 + c0), egz = *(const GAS u32x4*)((*Cp_).ZB + (size_t)row * 4608 + RW_IN + 2048 + c0);
        { float y[8], y1[8], a[8], b[8], v[8], g[8], o[8];
          const u32x4 ry = *(const GAS u32x4*)((*Cp_).YBh + (size_t)row * 512 + c0), ry1 = *(const GAS u32x4*)((*Cp_).YBh + ((size_t)NT_ + row) * 512 + c0), rv = *(const GAS u32x4*)((*Cp_).VBh + (size_t)row * 512 + c0), rg = *(const GAS u32x4*)((*Cp_).GBh + (size_t)row * 512 + c0);
          const float bon = ((const GAS float*)(*Cp_).BON)[(size_t)row * 8 + (lane >> 3)]; ld8f(gng + c0, a); ld8f(gnb + c0, b);
          up8b(ry, y); up8b(ry1, y1);
          float s = 0.f;
#pragma unroll
          for (int j = 0; j < 8; ++j) { y[j] += y1[j]; s += y[j]; }
          s += __shfl_xor(s, 1); s += __shfl_xor(s, 2); s += __shfl_xor(s, 4); const float mean = s * (1.f / 64.f); s = 0.f;
#pragma unroll
          for (int j = 0; j < 8; ++j) { y[j] -= mean; s += y[j] * y[j]; }
          s += __shfl_xor(s, 1); s += __shfl_xor(s, 2); s += __shfl_xor(s, 4); const float rs = 1.f / sqrtf(s * (1.f / 64.f) + 64e-5f);
          up8b(rv, v); up8b(rg, g);
#pragma unroll
          for (int j = 0; j < 8; ++j) o[j] = (y[j] * rs * a[j] + b[j] + bon * v[j]) * g[j];
          *(GAS u32x4*)((*Cp_).YCATB + (size_t)row * 1024 + c0) = pack8f(o); }
        { float o[8], t0[8], a[8], gz[8]; up8b(eo0, o); up8b(eo1, t0);
#pragma unroll
          for (int j = 0; j < 8; ++j) o[j] += t0[j];
          float s = 0.f;
#pragma unroll
          for (int j = 0; j < 8; ++j) s += o[j] * o[j];
          s += __shfl_xor(s, 1); s += __shfl_xor(s, 2); s += __shfl_xor(s, 4); s += __shfl_xor(s, 8); const float rs = 1.f / sqrtf(s * (1.f / 128.f) + 1e-6f);
          ld8f(hgn + c0, a); up8b(egz, gz);
#pragma unroll
          for (int j = 0; j < 8; ++j) o[j] = o[j] * rs * a[j] * fsilu(gz[j]);
          *(GAS u32x4*)((*Cp_).YCATB + (size_t)row * 1024 + 512 + c0) = pack8f(o); }
    }
}

DI void mla_prep(const LAS NaiveCtx* Cp_, long layer, int wv_) {
    const long j2 = layer / 2; const float* qng = (*Cp_).mla_q_norm_g + (size_t)j2 * MLA_QR; const float* kvng = (*Cp_).mla_kv_norm_g + (size_t)j2 * MLA_KVR;
    TL_ROWS(row, 0, NT_) { const GAS bf16_t* z = (const GAS bf16_t*)(*Cp_).Z + (size_t)row * 512;
        const u32x2 qw = *(const GAS u32x2*)(z + 4 * lane); const f32x4 q = (f32x4){bf_lo(qw.x), bf_hi(qw.x), bf_lo(qw.y), bf_hi(qw.y)};
        const unsigned kvw = *(const GAS unsigned*)(z + 256 + 2 * lane); const float kv0 = bf_lo(kvw), kv1 = bf_hi(kvw); const float x = lane < 32 ? bf_lo((unsigned)z[384 + lane]) : 0.f;
        const float rsq = 1.f / sqrtf(wsum(q[0] * q[0] + q[1] * q[1] + q[2] * q[2] + q[3] * q[3]) * (1.f / MLA_QR) + 1e-6f);
        const f32x4 gq = *(const GAS f32x4*)(qng + 4 * lane);
        *(GAS u32x2*)((*Cp_).QNB + (size_t)row * 256 + 4 * lane) = (u32x2){att::pk2(q[0] * rsq * gq[0], q[1] * rsq * gq[1]), att::pk2(q[2] * rsq * gq[2], q[3] * rsq * gq[3])};
        const float rskv = 1.f / sqrtf(wsum(kv0 * kv0 + kv1 * kv1) * (1.f / MLA_KVR) + 1e-6f);
        *(GAS unsigned*)((*Cp_).KVNB + (size_t)row * 256 + 2 * lane) = att::pk2(kv0 * rskv * kvng[2 * lane], kv1 * rskv * kvng[2 * lane + 1]);
        *(GAS unsigned*)((*Cp_).KVNB + (size_t)row * 256 + 128 + 2 * lane) = 0u;
        const float partner = __shfl_xor(x, 8); float outv = x; int b, t;
        if (row >= NC_) { const int s = (row - NC_) % SEQ; b = (row - NC_) / SEQ; t = CTX_LEN + s; const float pos = (float)((lane & 16) ? (s % GRID_W) : (s / GRID_W));
            const float ang = pos * exp2f(-(float)(lane & 7) * 1.6609640474436812f); const float cs = cosf(ang), sn = sinf(ang); outv = (lane & 8) ? x * cs + partner * sn : x * cs - partner * sn; }
        else { b = row / CTX_LEN; t = row % CTX_LEN; }
        (void)b; (void)t; if (lane < 32) (*Cp_).KPEB[(size_t)row * 32 + lane] = f2bf(outv);
    }
}
DI void rope_table(const LAS NaiveCtx* Cp_, int wv_) {
    GRID_STRIDE_WAVES(i, (long)SEQ * 16) { const int s = (int)(i >> 4), q = (int)(i & 15); const float pos = (float)((q & 8) ? (s % GRID_W) : (s / GRID_W)); const float ang = pos * exp2f(-(float)(q & 7) * 1.6609640474436812f);
        (*Cp_).ROPE[(size_t)s * 32 + (q & 8) * 2 + (q & 7)] = cosf(ang); (*Cp_).ROPE[(size_t)s * 32 + (q & 8) * 2 + 8 + (q & 7)] = sinf(ang); }
}
DI void rope_q(const LAS NaiveCtx* Cp_, int wv_) {
    GRID_STRIDE_WAVES(i, (long)NL_ * MLA_HEADS) { const int h = (int)(i % MLA_HEADS); const long lr = i / MLA_HEADS; const int s = (int)(lr % SEQ);
        bf16_t* p = (*Cp_).QB + (size_t)(NC_ + lr) * (MLA_HEADS * 96) + h * 96 + 64; const float* tab = (*Cp_).ROPE + (size_t)s * 32;
        float r1[8], r2[8], c1[8], c2[8], cr[8], sr[8], cc[8], sc[8], o[8];
        ld8b(p, r1); ld8b(p + 8, r2); ld8b(p + 16, c1); ld8b(p + 24, c2); ld8f(tab, cr); ld8f(tab + 8, sr); ld8f(tab + 16, cc); ld8f(tab + 24, sc);
#pragma unroll
        for (int j = 0; j < 8; ++j) o[j] = r1[j] * cr[j] - r2[j] * sr[j];
        *(GAS u32x4*)p = pack8f(o);
#pragma unroll
        for (int j = 0; j < 8; ++j) o[j] = r2[j] * cr[j] + r1[j] * sr[j];
        *(GAS u32x4*)(p + 8) = pack8f(o);
#pragma unroll
        for (int j = 0; j < 8; ++j) o[j] = c1[j] * cc[j] - c2[j] * sc[j];
        *(GAS u32x4*)(p + 16) = pack8f(o);
#pragma unroll
        for (int j = 0; j < 8; ++j) o[j] = c2[j] * cc[j] + c1[j] * sc[j];
        *(GAS u32x4*)(p + 24) = pack8f(o); }
}
DI void lora_weights(const LAS NaiveCtx* Cp_, int wv_) {
    GRID_STRIDE_WAVES(i, (long)N_EVEN * 2560 * 384) { const int k = (int)(i % 384); const long t = i / 384; const int n = (int)(t % 2560), j = (int)(t / 2560); const int blk = n >> 9, c = n & 511; float v = 0.f;
        if (blk < 2) { if (k >= blk * 64 && k < blk * 64 + 64) v = (*Cp_).rw_w2[(((size_t)j * 2 + blk) * 64 + (k - blk * 64)) * 512 + c]; }
        else if (blk < 4) { const int d = blk - 2; if (k >= 128 + d * 64 && k < 128 + d * 64 + 64) v = (*Cp_).rw_a2[(((size_t)j * 2 + d) * 64 + (k - 128 - d * 64)) * 512 + c]; }
        else { if (k >= 256) v = (*Cp_).rw_g2[((size_t)j * 128 + (k - 256)) * 512 + c]; }
        (*Cp_).Wlora[i] = f2bf(v); }
}
}

namespace scan {
#ifndef SC_L32_PERM
#define SC_L32_PERM 1
#endif
#ifndef SC_L16_PERM
#define SC_L16_PERM 1
#endif
#ifndef SC_L8_DPP
#define SC_L8_DPP 1
#endif
#define SC_DPP(x, CTRL) __builtin_bit_cast(float, __builtin_amdgcn_update_dpp(0, __builtin_bit_cast(int, (x)), (CTRL), 0xF, 0xF, true))
DI float swap32_sum(float a, float b) { asm volatile("s_nop 1\n\tv_permlane32_swap_b32 %0, %1" : "+v"(a), "+v"(b)); return a + b; }
DI float swap16_sum(float a, float b) { asm volatile("s_nop 1\n\tv_permlane16_swap_b32 %0, %1" : "+v"(a), "+v"(b)); return a + b; }
DI float reduce8(const float (&x)[8], int lane) {
    float y0, y1, y2, y3, z0, z1, w;
#if SC_L32_PERM
    y0 = swap32_sum(x[0], x[4]); y1 = swap32_sum(x[1], x[5]); y2 = swap32_sum(x[2], x[6]); y3 = swap32_sum(x[3], x[7]);
#else
    { const bool up = (lane & 32) != 0;
      y0 = (up ? x[4] : x[0]) + __shfl_xor(up ? x[0] : x[4], 32); y1 = (up ? x[5] : x[1]) + __shfl_xor(up ? x[1] : x[5], 32);
      y2 = (up ? x[6] : x[2]) + __shfl_xor(up ? x[2] : x[6], 32); y3 = (up ? x[7] : x[3]) + __shfl_xor(up ? x[3] : x[7], 32); }
#endif
#if SC_L16_PERM
    z0 = swap16_sum(y0, y2); z1 = swap16_sum(y1, y3);
#else
    { const bool up = (lane & 16) != 0; z0 = (up ? y2 : y0) + __shfl_xor(up ? y0 : y2, 16); z1 = (up ? y3 : y1) + __shfl_xor(up ? y1 : y3, 16); }
#endif
    { const bool b3 = (lane & 8) != 0; const float keep = b3 ? z1 : z0, send = b3 ? z0 : z1;
#if SC_L8_DPP
      w = keep + SC_DPP(send, 0x128);
      w += SC_DPP(w, 0x141);
      w += SC_DPP(w, 0x4E);
      w += SC_DPP(w, 0xB1);
#else
      w = keep + __shfl_xor(send, 8); w += __shfl_xor(w, 4); w += __shfl_xor(w, 2); w += __shfl_xor(w, 1);
#endif
    }
    return w;
}
constexpr int TB = 32, STEP_F = 384, BUF_F = TB * STEP_F;

DI void rwkv_scan(const LAS NaiveCtx* Cp_, LAS unsigned char* lds, int wv_) {
    const int tid = otid(wv_), lane = tid & 63, wid = tid >> 6;
    LAS float* ldsf = (LAS float*)lds; LAS float* ybuf = ldsf + 2 * BUF_F;
    for (int chain = opaque_bid(); chain < 2 * BATCH * RW_HEADS; chain += gridDim.x) {
        const int d = chain / (BATCH * RW_HEADS), b = (chain / RW_HEADS) % BATCH, h = chain % RW_HEADS;
        const float* pA = (*Cp_).NKK + h * 64; const float* pW = (*Cp_).DEC + (size_t)d * NT_ * 512 + h * 64; const float* pB = (*Cp_).BB + (size_t)d * NT_ * 512 + h * 64;
        const float* pK = (*Cp_).KD + (size_t)d * NT_ * 512 + h * 64; const float* pR = (*Cp_).R + h * 64; const float* pV = (*Cp_).V + h * 64;
        float* pY = (*Cp_).Y + (size_t)d * NT_ * 512 + h * 64;
        float S[8];
#pragma unroll
        for (int j = 0; j < 8; ++j) S[j] = 0.f;
        f32x4 st[6];
#define SC_LOAD(T0) do { _Pragma("unroll") for (int q = 0; q < 6; ++q) { const int idx = tid + 512 * q, i = idx / 96, rem = idx % 96, arr = rem >> 4, part = rem & 15; \
            const size_t row = (size_t)tokrow(b, scan_pos(d, (T0) + i)); const float* src = arr == 0 ? pA : arr == 1 ? pW : arr == 2 ? pB : arr == 3 ? pK : arr == 4 ? pR : pV; \
            st[q] = *(const f32x4*)(src + row * 512 + part * 4); } } while (0)
#define SC_STORE(BUFI) do { _Pragma("unroll") for (int q = 0; q < 6; ++q) { const int idx = tid + 512 * q, i = idx / 96, rem = idx % 96; *(LAS f32x4*)(ldsf + (BUFI) * BUF_F + i * STEP_F + rem * 4) = st[q]; } } while (0)
        SC_LOAD(0); SC_STORE(0);
        __syncthreads();
        constexpr int NB = TT_ / TB;
        for (int blk = 0; blk < NB; ++blk) {
            if (blk + 1 < NB) SC_LOAD((blk + 1) * TB);
            const LAS float* buf = ldsf + (blk & 1) * BUF_F;
#pragma unroll 2
            for (int i = 0; i < TB; ++i) { const LAS float* sp = buf + i * STEP_F;
                const float a = sp[lane], w = sp[64 + lane], bb = sp[128 + lane], kd = sp[192 + lane], r = sp[256 + lane];
                const f32x4 v0 = *(const LAS f32x4*)(sp + 320 + 8 * wid), v1 = *(const LAS f32x4*)(sp + 324 + 8 * wid);
                float p[8];
#pragma unroll
                for (int j = 0; j < 8; ++j) p[j] = S[j] * a;
                const float wsa = reduce8(p, lane);
#pragma unroll
                for (int j = 0; j < 8; ++j) { const float sa = __builtin_bit_cast(float, __builtin_amdgcn_readlane(__builtin_bit_cast(int, wsa), 8 * j)); const float vv = j < 4 ? v0[j & 3] : v1[j & 3];
                    S[j] = S[j] * w + sa * bb + vv * kd; p[j] = S[j] * r; }
                const float wy = reduce8(p, lane);
                if ((lane & 7) == 0) ybuf[i * 64 + 8 * wid + (lane >> 3)] = wy; }
            __syncthreads();
            { const int i = tid >> 4, v4 = (tid & 15) * 4; const size_t row = (size_t)tokrow(b, scan_pos(d, blk * TB + i)); *(f32x4*)(pY + row * 512 + v4) = *(const LAS f32x4*)(ybuf + i * 64 + v4); }
            if (blk + 1 < NB) SC_STORE((blk + 1) & 1);
            __syncthreads();
        }
#undef SC_LOAD
#undef SC_STORE
    }
}
}

namespace hg {
typedef short s16x4 __attribute__((ext_vector_type(4)));
constexpr int RS = 272, RS2 = 40;
constexpr int OFF_QT = 0, OFF_KT = OFF_QT + 16 * RS, OFF_KH = OFF_KT + 16 * RS, OFF_VT = OFF_KH + 128 * RS2, OFF_ST = OFF_VT + 64 * RS2, OFF_P = OFF_ST + 2 * 64 * RS, OFF_GS = OFF_P + 512, OFF_SC = OFF_GS + 2048, OFF_V32 = OFF_SC + 4 * 16 * 80, HG_LDS = OFF_V32 + 64 * 80;
#define HG_MFMA16(a, b, c) __builtin_amdgcn_mfma_f32_16x16x16bf16_1k((a), (b), (c), 0, 0, 0)
#define HG_MFMA32(a, b, c) __builtin_amdgcn_mfma_f32_16x16x32_bf16((a), (b), (c), 0, 0, 0)
DI unsigned short bfr(float x) { return (unsigned short)(att::pk2(x, 0.f) & 0xffffu); }

DI void hgrn_scan(const LAS NaiveCtx* Cp_, LAS unsigned char* lds, long layer, int wv_) {
    const int tid = otid(wv_), lane = tid & 63, wid = tid >> 6, l15 = lane & 15, g = lane >> 4;
    const int k = tid & 127, tq = tid >> 7;
    LAS float* gsum = (LAS float*)(lds + OFF_GS); LAS float* p15 = (LAS float*)(lds + OFF_P);
    for (int unit = opaque_bid(); unit < 2 * BATCH * HG_HEADS * 2; unit += gridDim.x) {
        const int vh = unit & 1, h = (unit >> 1) % HG_HEADS, b = (unit / (2 * HG_HEADS)) % BATCH, d = unit / (2 * HG_HEADS * BATCH);
        const GAS bf16_t* pF = (const GAS bf16_t*)((*Cp_).ZB + RW_IN + 512 + d * 512 + h * 128 + k); const GAS bf16_t* pQ = (const GAS bf16_t*)((*Cp_).ZB + RW_IN + h * 128 + k);
        const GAS bf16_t* pV = (const GAS bf16_t*)((*Cp_).ZB + RW_IN + 1536 + h * 128 + vh * 64 + (tid & 15) * 4);
        float lower;
        { const long j2 = layer / 2; float mx = -1e30f;
#pragma unroll
          for (int qq = 0; qq < N_EVEN; ++qq) mx = fmaxf(mx, (*Cp_).hg_lb[((size_t)qq * 2 + d) * 512 + h * 128 + k]);
          float den = 0.f, num = 0.f;
#pragma unroll
          for (int qq = 0; qq < N_EVEN; ++qq) { const float e = fexp((*Cp_).hg_lb[((size_t)qq * 2 + d) * 512 + h * 128 + k] - mx); den += e; if (qq >= 1 && qq <= j2) num += e; }
          lower = num / den; }
        GAS bf16_t* pO = (GAS bf16_t*)((*Cp_).OBh + (size_t)d * NT_ * 512 + h * 128 + vh * 64);
        f32x4 acc[4];
#pragma unroll
        for (int n = 0; n < 4; ++n) acc[n] = (f32x4){0.f, 0.f, 0.f, 0.f};
        for (int i = tid; i < 64 * RS / 4; i += PB_THREADS) ((LAS unsigned*)(lds + OFF_ST))[i] = 0u;
        for (int i = tid; i < (4 * 16 * 80) / 4; i += PB_THREADS) ((LAS unsigned*)(lds + OFF_SC))[i] = 0u;
        unsigned fX[4][4], qX[4][4]; u32x2 vX[4];
        vX[0] = (u32x2){0u, 0u}; vX[1] = vX[0]; vX[2] = vX[0]; vX[3] = vX[0];
#define HG_ROWBASE(C0, rb) long rb; { const int i0_ = (C0) * 16; if (i0_ < CTX_LEN) rb = (long)b * CTX_LEN + (d ? CTX_LEN - 1 - i0_ : i0_); else rb = (long)NC_ + (long)b * SEQ + (d ? SEQ - 1 - (i0_ - CTX_LEN) : (i0_ - CTX_LEN)); }
#define HG_LOAD(C0, S) do { HG_ROWBASE(C0, rb_) const long sg_ = d ? -1 : 1; _Pragma("unroll") for (int i = 0; i < 4; ++i) { const long row = rb_ + sg_ * (4 * tq + i); fX[S][i] = pF[row * 4608]; qX[S][i] = pQ[row * 4608]; } \
            if (tid < 256) { const long row = rb_ + sg_ * (tid >> 4); vX[S] = *(const GAS u32x2*)(pV + row * 4608); } } while (0)
        HG_LOAD(0, 0); HG_LOAD(1, 1); HG_LOAD(2, 2); HG_LOAD(3, 3);
        constexpr int NCH = TT_ / 16;
        static_assert(NCH % 4 == 0, "chunks per trip");
        for (int c4 = 0; c4 < NCH; c4 += 4) {
            { const int c = c4 + 0;

            float f[4], kin[4], q[4], cum[4];
#pragma unroll
            for (int i = 0; i < 4; ++i) { const float sg = fsigmoid(bf_lo(fX[0][i])); f[i] = fmaxf(lower + (1.f - lower) * sg, 1e-30f); kin[i] = (1.f - lower) * (1.f - sg); q[i] = fsilu(bf_lo(qX[0][i])); }
            const f32x4 val = (f32x4){bf_lo(vX[0].x), bf_hi(vX[0].x), bf_lo(vX[0].y), bf_hi(vX[0].y)};
            cum[0] = flog2(f[0]); cum[1] = cum[0] + flog2(f[1]); cum[2] = cum[1] + flog2(f[2]); cum[3] = cum[2] + flog2(f[3]);
            gsum[tq * 128 + k] = cum[3];
            lds_barrier();
            { const float g0 = gsum[k], g1 = gsum[128 + k], g2 = gsum[256 + k], g3 = gsum[384 + k];
              const float base = tq == 0 ? 0.f : tq == 1 ? g0 : tq == 2 ? g0 + g1 : g0 + g1 + g2, tot = g0 + g1 + g2 + g3;
              float kh[4];
#pragma unroll
              for (int i = 0; i < 4; ++i) { const float cu = base + cum[i]; const int t = 4 * tq + i;
                  *(LAS unsigned short*)(lds + OFF_QT + t * RS + 2 * k) = bfr(q[i] * fexp2(cu));
                  *(LAS unsigned short*)(lds + OFF_KT + t * RS + 2 * k) = bfr(kin[i] * fexp2(fminf(-cu, 115.f)));
                  kh[i] = kin[i] * fexp2(tot - cu); }
              *(LAS u32x2*)(lds + OFF_KH + k * RS2 + 8 * tq) = (u32x2){att::pk2(kh[0], kh[1]), att::pk2(kh[2], kh[3])};
              if (tq == 0) p15[k] = fexp2(tot);
              if (tid < 256) { const int t = tid >> 4, v4 = (tid & 15) * 4;
#pragma unroll
                  for (int j = 0; j < 4; ++j) { const unsigned short hv = bfr(val[j]); *(LAS unsigned short*)(lds + OFF_VT + (v4 + j) * RS2 + 2 * t) = hv; } } }
            if (c + 4 < NCH) HG_LOAD(c + 4, 0);
            lds_barrier();
            const LAS unsigned char* stc = lds + OFF_ST + (c & 1) * 64 * RS; LAS unsigned char* stn = lds + OFF_ST + ((c + 1) & 1) * 64 * RS;
            if (wid < 4) {
                f32x4 sc = (f32x4){0.f, 0.f, 0.f, 0.f};
#pragma unroll
                for (int kk = 0; kk < 4; ++kk) { const bf16x8 a = *(const LAS bf16x8*)(lds + OFF_KT + l15 * RS + (32 * kk + 8 * g) * 2), bq = *(const LAS bf16x8*)(lds + OFF_QT + l15 * RS + (32 * kk + 8 * g) * 2); sc = HG_MFMA32(a, bq, sc); }
#pragma unroll
                for (int r = 0; r < 4; ++r) if (4 * g + r > l15) sc[r] = 0.f;
                const u32x2 pk = (u32x2){att::pk2(sc[0], sc[1]), att::pk2(sc[2], sc[3])};
                f32x4 o = (f32x4){0.f, 0.f, 0.f, 0.f};
                { LAS unsigned char* scw = lds + OFF_SC + wid * 16 * 80;
                  *(LAS u32x2*)(scw + l15 * 80 + 8 * g) = pk;
                  const bf16x8 sb = *(const LAS bf16x8*)(scw + l15 * 80 + 16 * g); bf16x8 va = (bf16x8){0, 0, 0, 0, 0, 0, 0, 0};
                  if (g < 2) { const LAS unsigned char* vp_ = lds + OFF_VT + (16 * wid + l15) * RS2 + 16 * g; const s16x4 lo_ = *(const LAS s16x4*)vp_, hi_ = *(const LAS s16x4*)(vp_ + 8); va = __builtin_shufflevector(lo_, hi_, 0, 1, 2, 3, 4, 5, 6, 7); }
                  o = HG_MFMA32(va, sb, o); }
#pragma unroll
                for (int kk = 0; kk < 4; ++kk) { const bf16x8 a = *(const LAS bf16x8*)(stc + (16 * wid + l15) * RS + (32 * kk + 8 * g) * 2), bq = *(const LAS bf16x8*)(lds + OFF_QT + l15 * RS + (32 * kk + 8 * g) * 2); o = HG_MFMA32(a, bq, o); }
                { HG_ROWBASE(c, rbo_) const long row = rbo_ + (d ? -l15 : l15); *(GAS u32x2*)(pO + row * 512 + 16 * wid + 4 * g) = (u32x2){att::pk2(o[0], o[1]), att::pk2(o[2], o[3])}; }
            }
            { const f32x4 pd = *(const LAS f32x4*)(p15 + 16 * wid + 4 * g); const s16x4 ka = *(const LAS s16x4*)(lds + OFF_KH + (16 * wid + l15) * RS2 + 8 * g);
#pragma unroll
              for (int n = 0; n < 4; ++n) { const s16x4 vb = *(const LAS s16x4*)(lds + OFF_VT + (16 * n + l15) * RS2 + 8 * g);
                  acc[n] = HG_MFMA16(ka, vb, acc[n] * pd);
                  *(LAS u32x2*)(stn + (16 * n + l15) * RS + (16 * wid + 4 * g) * 2) = (u32x2){att::pk2(acc[n][0], acc[n][1]), att::pk2(acc[n][2], acc[n][3])}; } }
                    }
            { const int c = c4 + 1;

            float f[4], kin[4], q[4], cum[4];
#pragma unroll
            for (int i = 0; i < 4; ++i) { const float sg = fsigmoid(bf_lo(fX[1][i])); f[i] = fmaxf(lower + (1.f - lower) * sg, 1e-30f); kin[i] = (1.f - lower) * (1.f - sg); q[i] = fsilu(bf_lo(qX[1][i])); }
            const f32x4 val = (f32x4){bf_lo(vX[1].x), bf_hi(vX[1].x), bf_lo(vX[1].y), bf_hi(vX[1].y)};
            cum[0] = flog2(f[0]); cum[1] = cum[0] + flog2(f[1]); cum[2] = cum[1] + flog2(f[2]); cum[3] = cum[2] + flog2(f[3]);
            gsum[tq * 128 + k] = cum[3];
            lds_barrier();
            { const float g0 = gsum[k], g1 = gsum[128 + k], g2 = gsum[256 + k], g3 = gsum[384 + k];
              const float base = tq == 0 ? 0.f : tq == 1 ? g0 : tq == 2 ? g0 + g1 : g0 + g1 + g2, tot = g0 + g1 + g2 + g3;
              float kh[4];
#pragma unroll
              for (int i = 0; i < 4; ++i) { const float cu = base + cum[i]; const int t = 4 * tq + i;
                  *(LAS unsigned short*)(lds + OFF_QT + t * RS + 2 * k) = bfr(q[i] * fexp2(cu));
                  *(LAS unsigned short*)(lds + OFF_KT + t * RS + 2 * k) = bfr(kin[i] * fexp2(fminf(-cu, 115.f)));
                  kh[i] = kin[i] * fexp2(tot - cu); }
              *(LAS u32x2*)(lds + OFF_KH + k * RS2 + 8 * tq) = (u32x2){att::pk2(kh[0], kh[1]), att::pk2(kh[2], kh[3])};
              if (tq == 0) p15[k] = fexp2(tot);
              if (tid < 256) { const int t = tid >> 4, v4 = (tid & 15) * 4;
#pragma unroll
                  for (int j = 0; j < 4; ++j) { const unsigned short hv = bfr(val[j]); *(LAS unsigned short*)(lds + OFF_VT + (v4 + j) * RS2 + 2 * t) = hv; } } }
            if (c + 4 < NCH) HG_LOAD(c + 4, 1);
            lds_barrier();
            const LAS unsigned char* stc = lds + OFF_ST + (c & 1) * 64 * RS; LAS unsigned char* stn = lds + OFF_ST + ((c + 1) & 1) * 64 * RS;
            if (wid < 4) {
                f32x4 sc = (f32x4){0.f, 0.f, 0.f, 0.f};
#pragma unroll
                for (int kk = 0; kk < 4; ++kk) { const bf16x8 a = *(const LAS bf16x8*)(lds + OFF_KT + l15 * RS + (32 * kk + 8 * g) * 2), bq = *(const LAS bf16x8*)(lds + OFF_QT + l15 * RS + (32 * kk + 8 * g) * 2); sc = HG_MFMA32(a, bq, sc); }
#pragma unroll
                for (int r = 0; r < 4; ++r) if (4 * g + r > l15) sc[r] = 0.f;
                const u32x2 pk = (u32x2){att::pk2(sc[0], sc[1]), att::pk2(sc[2], sc[3])};
                f32x4 o = (f32x4){0.f, 0.f, 0.f, 0.f};
                { LAS unsigned char* scw = lds + OFF_SC + wid * 16 * 80;
                  *(LAS u32x2*)(scw + l15 * 80 + 8 * g) = pk;
                  const bf16x8 sb = *(const LAS bf16x8*)(scw + l15 * 80 + 16 * g); bf16x8 va = (bf16x8){0, 0, 0, 0, 0, 0, 0, 0};
                  if (g < 2) { const LAS unsigned char* vp_ = lds + OFF_VT + (16 * wid + l15) * RS2 + 16 * g; const s16x4 lo_ = *(const LAS s16x4*)vp_, hi_ = *(const LAS s16x4*)(vp_ + 8); va = __builtin_shufflevector(lo_, hi_, 0, 1, 2, 3, 4, 5, 6, 7); }
                  o = HG_MFMA32(va, sb, o); }
#pragma unroll
                for (int kk = 0; kk < 4; ++kk) { const bf16x8 a = *(const LAS bf16x8*)(stc + (16 * wid + l15) * RS + (32 * kk + 8 * g) * 2), bq = *(const LAS bf16x8*)(lds + OFF_QT + l15 * RS + (32 * kk + 8 * g) * 2); o = HG_MFMA32(a, bq, o); }
                { HG_ROWBASE(c, rbo_) const long row = rbo_ + (d ? -l15 : l15); *(GAS u32x2*)(pO + row * 512 + 16 * wid + 4 * g) = (u32x2){att::pk2(o[0], o[1]), att::pk2(o[2], o[3])}; }
            }
            { const f32x4 pd = *(const LAS f32x4*)(p15 + 16 * wid + 4 * g); const s16x4 ka = *(const LAS s16x4*)(lds + OFF_KH + (16 * wid + l15) * RS2 + 8 * g);
#pragma unroll
              for (int n = 0; n < 4; ++n) { const s16x4 vb = *(const LAS s16x4*)(lds + OFF_VT + (16 * n + l15) * RS2 + 8 * g);
                  acc[n] = HG_MFMA16(ka, vb, acc[n] * pd);
                  *(LAS u32x2*)(stn + (16 * n + l15) * RS + (16 * wid + 4 * g) * 2) = (u32x2){att::pk2(acc[n][0], acc[n][1]), att::pk2(acc[n][2], acc[n][3])}; } }
                    }
            { const int c = c4 + 2;

            float f[4], kin[4], q[4], cum[4];
#pragma unroll
            for (int i = 0; i < 4; ++i) { const float sg = fsigmoid(bf_lo(fX[2][i])); f[i] = fmaxf(lower + (1.f - lower) * sg, 1e-30f); kin[i] = (1.f - lower) * (1.f - sg); q[i] = fsilu(bf_lo(qX[2][i])); }
            const f32x4 val = (f32x4){bf_lo(vX[2].x), bf_hi(vX[2].x), bf_lo(vX[2].y), bf_hi(vX[2].y)};
            cum[0] = flog2(f[0]); cum[1] = cum[0] + flog2(f[1]); cum[2] = cum[1] + flog2(f[2]); cum[3] = cum[2] + flog2(f[3]);
            gsum[tq * 128 + k] = cum[3];
            lds_barrier();
            { const float g0 = gsum[k], g1 = gsum[128 + k], g2 = gsum[256 + k], g3 = gsum[384 + k];
              const float base = tq == 0 ? 0.f : tq == 1 ? g0 : tq == 2 ? g0 + g1 : g0 + g1 + g2, tot = g0 + g1 + g2 + g3;
              float kh[4];
#pragma unroll
              for (int i = 0; i < 4; ++i) { const float cu = base + cum[i]; const int t = 4 * tq + i;
                  *(LAS unsigned short*)(lds + OFF_QT + t * RS + 2 * k) = bfr(q[i] * fexp2(cu));
                  *(LAS unsigned short*)(lds + OFF_KT + t * RS + 2 * k) = bfr(kin[i] * fexp2(fminf(-cu, 115.f)));
                  kh[i] = kin[i] * fexp2(tot - cu); }
              *(LAS u32x2*)(lds + OFF_KH + k * RS2 + 8 * tq) = (u32x2){att::pk2(kh[0], kh[1]), att::pk2(kh[2], kh[3])};
              if (tq == 0) p15[k] = fexp2(tot);
              if (tid < 256) { const int t = tid >> 4, v4 = (tid & 15) * 4;
#pragma unroll
                  for (int j = 0; j < 4; ++j) { const unsigned short hv = bfr(val[j]); *(LAS unsigned short*)(lds + OFF_VT + (v4 + j) * RS2 + 2 * t) = hv; } } }
            if (c + 4 < NCH) HG_LOAD(c + 4, 2);
            lds_barrier();
            const LAS unsigned char* stc = lds + OFF_ST + (c & 1) * 64 * RS; LAS unsigned char* stn = lds + OFF_ST + ((c + 1) & 1) * 64 * RS;
            if (wid < 4) {
                f32x4 sc = (f32x4){0.f, 0.f, 0.f, 0.f};
#pragma unroll
                for (int kk = 0; kk < 4; ++kk) { const bf16x8 a = *(const LAS bf16x8*)(lds + OFF_KT + l15 * RS + (32 * kk + 8 * g) * 2), bq = *(const LAS bf16x8*)(lds + OFF_QT + l15 * RS + (32 * kk + 8 * g) * 2); sc = HG_MFMA32(a, bq, sc); }
#pragma unroll
                for (int r = 0; r < 4; ++r) if (4 * g + r > l15) sc[r] = 0.f;
                const u32x2 pk = (u32x2){att::pk2(sc[0], sc[1]), att::pk2(sc[2], sc[3])};
                f32x4 o = (f32x4){0.f, 0.f, 0.f, 0.f};
                { LAS unsigned char* scw = lds + OFF_SC + wid * 16 * 80;
                  *(LAS u32x2*)(scw + l15 * 80 + 8 * g) = pk;
                  const bf16x8 sb = *(const LAS bf16x8*)(scw + l15 * 80 + 16 * g); bf16x8 va = (bf16x8){0, 0, 0, 0, 0, 0, 0, 0};
                  if (g < 2) { const LAS unsigned char* vp_ = lds + OFF_VT + (16 * wid + l15) * RS2 + 16 * g; const s16x4 lo_ = *(const LAS s16x4*)vp_, hi_ = *(const LAS s16x4*)(vp_ + 8); va = __builtin_shufflevector(lo_, hi_, 0, 1, 2, 3, 4, 5, 6, 7); }
                  o = HG_MFMA32(va, sb, o); }
#pragma unroll
                for (int kk = 0; kk < 4; ++kk) { const bf16x8 a = *(const LAS bf16x8*)(stc + (16 * wid + l15) * RS + (32 * kk + 8 * g) * 2), bq = *(const LAS bf16x8*)(lds + OFF_QT + l15 * RS + (32 * kk + 8 * g) * 2); o = HG_MFMA32(a, bq, o); }
                { HG_ROWBASE(c, rbo_) const long row = rbo_ + (d ? -l15 : l15); *(GAS u32x2*)(pO + row * 512 + 16 * wid + 4 * g) = (u32x2){att::pk2(o[0], o[1]), att::pk2(o[2], o[3])}; }
            }
            { const f32x4 pd = *(const LAS f32x4*)(p15 + 16 * wid + 4 * g); const s16x4 ka = *(const LAS s16x4*)(lds + OFF_KH + (16 * wid + l15) * RS2 + 8 * g);
#pragma unroll
              for (int n = 0; n < 4; ++n) { const s16x4 vb = *(const LAS s16x4*)(lds + OFF_VT + (16 * n + l15) * RS2 + 8 * g);
                  acc[n] = HG_MFMA16(ka, vb, acc[n] * pd);
                  *(LAS u32x2*)(stn + (16 * n + l15) * RS + (16 * wid + 4 * g) * 2) = (u32x2){att::pk2(acc[n][0], acc[n][1]), att::pk2(acc[n][2], acc[n][3])}; } }
                    }
            { const int c = c4 + 3;

            float f[4], kin[4], q[4], cum[4];
#pragma unroll
            for (int i = 0; i < 4; ++i) { const float sg = fsigmoid(bf_lo(fX[3][i])); f[i] = fmaxf(lower + (1.f - lower) * sg, 1e-30f); kin[i] = (1.f - lower) * (1.f - sg); q[i] = fsilu(bf_lo(qX[3][i])); }
            const f32x4 val = (f32x4){bf_lo(vX[3].x), bf_hi(vX[3].x), bf_lo(vX[3].y), bf_hi(vX[3].y)};
            cum[0] = flog2(f[0]); cum[1] = cum[0] + flog2(f[1]); cum[2] = cum[1] + flog2(f[2]); cum[3] = cum[2] + flog2(f[3]);
            gsum[tq * 128 + k] = cum[3];
            lds_barrier();
            { const float g0 = gsum[k], g1 = gsum[128 + k], g2 = gsum[256 + k], g3 = gsum[384 + k];
              const float base = tq == 0 ? 0.f : tq == 1 ? g0 : tq == 2 ? g0 + g1 : g0 + g1 + g2, tot = g0 + g1 + g2 + g3;
              float kh[4];
#pragma unroll
              for (int i = 0; i < 4; ++i) { const float cu = base + cum[i]; const int t = 4 * tq + i;
                  *(LAS unsigned short*)(lds + OFF_QT + t * RS + 2 * k) = bfr(q[i] * fexp2(cu));
                  *(LAS unsigned short*)(lds + OFF_KT + t * RS + 2 * k) = bfr(kin[i] * fexp2(fminf(-cu, 115.f)));
                  kh[i] = kin[i] * fexp2(tot - cu); }
              *(LAS u32x2*)(lds + OFF_KH + k * RS2 + 8 * tq) = (u32x2){att::pk2(kh[0], kh[1]), att::pk2(kh[2], kh[3])};
              if (tq == 0) p15[k] = fexp2(tot);
              if (tid < 256) { const int t = tid >> 4, v4 = (tid & 15) * 4;
#pragma unroll
                  for (int j = 0; j < 4; ++j) { const unsigned short hv = bfr(val[j]); *(LAS unsigned short*)(lds + OFF_VT + (v4 + j) * RS2 + 2 * t) = hv; } } }
            if (c + 4 < NCH) HG_LOAD(c + 4, 3);
            lds_barrier();
            const LAS unsigned char* stc = lds + OFF_ST + (c & 1) * 64 * RS; LAS unsigned char* stn = lds + OFF_ST + ((c + 1) & 1) * 64 * RS;
            if (wid < 4) {
                f32x4 sc = (f32x4){0.f, 0.f, 0.f, 0.f};
#pragma unroll
                for (int kk = 0; kk < 4; ++kk) { const bf16x8 a = *(const LAS bf16x8*)(lds + OFF_KT + l15 * RS + (32 * kk + 8 * g) * 2), bq = *(const LAS bf16x8*)(lds + OFF_QT + l15 * RS + (32 * kk + 8 * g) * 2); sc = HG_MFMA32(a, bq, sc); }
#pragma unroll
                for (int r = 0; r < 4; ++r) if (4 * g + r > l15) sc[r] = 0.f;
                const u32x2 pk = (u32x2){att::pk2(sc[0], sc[1]), att::pk2(sc[2], sc[3])};
                f32x4 o = (f32x4){0.f, 0.f, 0.f, 0.f};
                { LAS unsigned char* scw = lds + OFF_SC + wid * 16 * 80;
                  *(LAS u32x2*)(scw + l15 * 80 + 8 * g) = pk;
                  const bf16x8 sb = *(const LAS bf16x8*)(scw + l15 * 80 + 16 * g); bf16x8 va = (bf16x8){0, 0, 0, 0, 0, 0, 0, 0};
                  if (g < 2) { const LAS unsigned char* vp_ = lds + OFF_VT + (16 * wid + l15) * RS2 + 16 * g; const s16x4 lo_ = *(const LAS s16x4*)vp_, hi_ = *(const LAS s16x4*)(vp_ + 8); va = __builtin_shufflevector(lo_, hi_, 0, 1, 2, 3, 4, 5, 6, 7); }
                  o = HG_MFMA32(va, sb, o); }
#pragma unroll
                for (int kk = 0; kk < 4; ++kk) { const bf16x8 a = *(const LAS bf16x8*)(stc + (16 * wid + l15) * RS + (32 * kk + 8 * g) * 2), bq = *(const LAS bf16x8*)(lds + OFF_QT + l15 * RS + (32 * kk + 8 * g) * 2); o = HG_MFMA32(a, bq, o); }
                { HG_ROWBASE(c, rbo_) const long row = rbo_ + (d ? -l15 : l15); *(GAS u32x2*)(pO + row * 512 + 16 * wid + 4 * g) = (u32x2){att::pk2(o[0], o[1]), att::pk2(o[2], o[3])}; }
            }
            { const f32x4 pd = *(const LAS f32x4*)(p15 + 16 * wid + 4 * g); const s16x4 ka = *(const LAS s16x4*)(lds + OFF_KH + (16 * wid + l15) * RS2 + 8 * g);
#pragma unroll
              for (int n = 0; n < 4; ++n) { const s16x4 vb = *(const LAS s16x4*)(lds + OFF_VT + (16 * n + l15) * RS2 + 8 * g);
                  acc[n] = HG_MFMA16(ka, vb, acc[n] * pd);
                  *(LAS u32x2*)(stn + (16 * n + l15) * RS + (16 * wid + 4 * g) * 2) = (u32x2){att::pk2(acc[n][0], acc[n][1]), att::pk2(acc[n][2], acc[n][3])}; } }
                    }
        }
        lds_barrier();
#undef HG_LOAD
    }
}
}

namespace rwc {
constexpr int RS = 144, RS40 = 80;
constexpr int O_AT = 0, O_RT = 2304, O_BT = 4608, O_KT = 6912, O_BH = 9216, O_KH = 14336, O_VT = 19456, O_UT = 24576, O_HT = 29696, O_GAK = 48128, O_GRB = 49408, O_GRK = 50688,
              O_GAB = 51968, O_XS = 52992, O_P15 = 57088, O_GS = 57344, RW_LDS = 59392;
#define RW_MFMA(a, b, c) __builtin_amdgcn_mfma_f32_16x16x32_bf16((a), (b), (c), 0, 0, 0)
#define RW_FRAG(img, row, RSB, byteoff) (*(const LAS bf16x8*)(lds + (img) + (row) * (RSB) + (byteoff)))
DI unsigned short bfr(float x) { return (unsigned short)(att::pk2(x, 0.f) & 0xffffu); }

DI void rwkv_chunk_scan(const LAS NaiveCtx* Cp_, LAS unsigned char* lds, int wv_) {
    const int tid = otid(wv_), lane = tid & 63, wid = tid >> 6, l15 = lane & 15, g = lane >> 4;
    const int k = tid & 63, tq = tid >> 6;
    LAS float* gsum = (LAS float*)(lds + O_GS); LAS float* p15 = (LAS float*)(lds + O_P15); LAS float* gab = (LAS float*)(lds + O_GAB); LAS float* xs = (LAS float*)(lds + O_XS);
    for (int chain = opaque_bid(); chain < 2 * BATCH * RW_HEADS; chain += gridDim.x) {
        const int d = chain / (BATCH * RW_HEADS), b = (chain / RW_HEADS) % BATCH, h = chain % RW_HEADS;
        const GAS bf16_t* pA = (const GAS bf16_t*)((*Cp_).NKh + h * 64 + k); const GAS float* pW = (const GAS float*)((*Cp_).DEC + (size_t)d * NT_ * 512 + h * 64 + k); const GAS bf16_t* pB = (const GAS bf16_t*)((*Cp_).BBh + (size_t)d * NT_ * 512 + h * 64 + k);
        const GAS bf16_t* pK = (const GAS bf16_t*)((*Cp_).KDh + (size_t)d * NT_ * 512 + h * 64 + k); const GAS bf16_t* pR = (const GAS bf16_t*)((*Cp_).RBh + h * 64 + k); const GAS bf16_t* pV = (const GAS bf16_t*)((*Cp_).VBh + h * 64 + (tid & 31) * 2);
        GAS bf16_t* pY = (GAS bf16_t*)((*Cp_).YBh + (size_t)d * NT_ * 512 + h * 64);
        for (int i = tid; i < RW_LDS / 4; i += PB_THREADS) ((LAS unsigned*)lds)[i] = 0u;
        f32x4 acc[2];
        acc[0] = (f32x4){0.f, 0.f, 0.f, 0.f}; acc[1] = acc[0];
        float lwX[4][2]; unsigned aX[4][2], bX[4][2], kX[4][2], rX[4][2], vX[4];
#define RW_ROWBASE(C0, rb) long rb; { const int i0_ = (C0) * 16; if (i0_ < CTX_LEN) rb = (long)b * CTX_LEN + (d ? CTX_LEN - 1 - i0_ : i0_); else rb = (long)NC_ + (long)b * SEQ + (d ? SEQ - 1 - (i0_ - CTX_LEN) : (i0_ - CTX_LEN)); }
#define RW_LOAD(C0, S) do { RW_ROWBASE(C0, rb_) const long sg_ = d ? -1 : 1; _Pragma("unroll") for (int i = 0; i < 2; ++i) { const long row = rb_ + sg_ * (2 * tq + i); lwX[S][i] = pW[row * 512]; aX[S][i] = pA[row * 512]; bX[S][i] = pB[row * 512]; kX[S][i] = pK[row * 512]; rX[S][i] = pR[row * 512]; } \
            { const long row = rb_ + sg_ * (tid >> 5); vX[S] = *(const GAS unsigned*)(pV + row * 512); } } while (0)
        RW_LOAD(0, 0); RW_LOAD(1, 1); RW_LOAD(2, 2); RW_LOAD(3, 3);
        lds_barrier();
        constexpr int NCH = TT_ / 16;
        static_assert(NCH % 4 == 0, "chunks per trip");
        for (int c4 = 0; c4 < NCH; c4 += 4) {
            { const int c = c4 + 0;

            float lw[2], a[2], bb[2], kd[2], r[2];
#pragma unroll
            for (int i = 0; i < 2; ++i) { lw[i] = lwX[0][i]; a[i] = bf_lo(aX[0][i]); bb[i] = bf_lo(bX[0][i]); kd[i] = bf_lo(kX[0][i]); r[i] = bf_lo(rX[0][i]); }
            const float v0 = bf_lo(vX[0]), v1 = bf_hi(vX[0]);
            const float c0 = lw[0], c1 = lw[0] + lw[1];
            gsum[tq * 64 + k] = c1;
            lds_barrier();
            { float base = 0.f, tot = 0.f;
#pragma unroll
              for (int q = 0; q < 8; ++q) { const float gq = gsum[q * 64 + k]; tot += gq; base += q < tq ? gq : 0.f; }
              float bh[2], kh[2];
#pragma unroll
              for (int i = 0; i < 2; ++i) { const float cu = base + (i ? c1 : c0); const int t = 2 * tq + i; const float ep = fexp2(cu), em = fexp2(-cu), eh = fexp2(tot - cu);
                  *(LAS unsigned short*)(lds + O_AT + t * RS + 2 * k) = bfr(a[i] * fexp2(cu - lw[i]));
                  *(LAS unsigned short*)(lds + O_RT + t * RS + 2 * k) = bfr(r[i] * ep);
                  *(LAS unsigned short*)(lds + O_BT + t * RS + 2 * k) = bfr(bb[i] * em);
                  *(LAS unsigned short*)(lds + O_KT + t * RS + 2 * k) = bfr(kd[i] * em);
                  bh[i] = bb[i] * eh; kh[i] = kd[i] * eh; }
              *(LAS unsigned*)(lds + O_BH + k * RS40 + 4 * tq) = att::pk2(bh[0], bh[1]);
              *(LAS unsigned*)(lds + O_KH + k * RS40 + 4 * tq) = att::pk2(kh[0], kh[1]);
              if (tq == 0) p15[k] = fexp2(tot);
              { const int t = tid >> 5, v2 = (tid & 31) * 2; *(LAS unsigned short*)(lds + O_VT + v2 * RS40 + 2 * t) = bfr(v0); *(LAS unsigned short*)(lds + O_VT + (v2 + 1) * RS40 + 2 * t) = bfr(v1); } }
            if (c + 4 < NCH) RW_LOAD(c + 4, 0);
            lds_barrier();
            const int htc = O_HT + (c & 1) * 64 * RS, htn = O_HT + ((c + 1) & 1) * 64 * RS;
            if (wid < 4) { const int ia = wid < 2 ? O_AT : O_RT, ib = (wid & 1) ? O_KT : O_BT;
                f32x4 gm = (f32x4){0.f, 0.f, 0.f, 0.f};
#pragma unroll
                for (int kk = 0; kk < 2; ++kk) gm = RW_MFMA(RW_FRAG(ia, l15, RS, 64 * kk + 16 * g), RW_FRAG(ib, l15, RS, 64 * kk + 16 * g), gm);
#pragma unroll
                for (int rr = 0; rr < 4; ++rr) { const int t = 4 * g + rr; const bool keep = wid < 2 ? (l15 < t) : (l15 <= t); const float val = keep ? gm[rr] : 0.f;
                    if (wid == 0) gab[l15 * 16 + t] = val;
                    else *(LAS unsigned short*)(lds + (wid == 1 ? O_GAK : wid == 2 ? O_GRB : O_GRK) + t * RS40 + 2 * l15) = bfr(val); } }
            lds_barrier();
            if (wid < 4) { f32x4 x = (f32x4){0.f, 0.f, 0.f, 0.f};
#pragma unroll
                for (int kk = 0; kk < 2; ++kk) x = RW_MFMA(RW_FRAG(O_AT, l15, RS, 64 * kk + 16 * g), RW_FRAG(htc, 16 * wid + l15, RS, 64 * kk + 16 * g), x);
                x = RW_MFMA(RW_FRAG(O_GAK, l15, RS40, 16 * g), RW_FRAG(O_VT, 16 * wid + l15, RS40, 16 * g), x);
#pragma unroll
                for (int rr = 0; rr < 4; ++rr) xs[(4 * g + rr) * 64 + 16 * wid + l15] = x[rr]; }
            lds_barrier();
            if (wid == 0) { float u[16];
#pragma unroll
                for (int t = 0; t < 16; ++t) u[t] = xs[t * 64 + lane];
#pragma unroll
                for (int s = 0; s < 15; ++s) {
#pragma unroll
                    for (int q4 = (s + 1) / 4; q4 < 4; ++q4) { const f32x4 gc = *(const LAS f32x4*)(gab + s * 16 + 4 * q4);
#pragma unroll
                        for (int j = 0; j < 4; ++j) if (4 * q4 + j > s) u[4 * q4 + j] += gc[j] * u[s]; } }
                u32x4 w0, w1; w0.x = att::pk2(u[0], u[1]); w0.y = att::pk2(u[2], u[3]); w0.z = att::pk2(u[4], u[5]); w0.w = att::pk2(u[6], u[7]);
                w1.x = att::pk2(u[8], u[9]); w1.y = att::pk2(u[10], u[11]); w1.z = att::pk2(u[12], u[13]); w1.w = att::pk2(u[14], u[15]);
                *(LAS u32x4*)(lds + O_UT + lane * RS40) = w0; *(LAS u32x4*)(lds + O_UT + lane * RS40 + 16) = w1; }
            lds_barrier();
            if (wid < 4) { f32x4 y = (f32x4){0.f, 0.f, 0.f, 0.f};
#pragma unroll
                for (int kk = 0; kk < 2; ++kk) y = RW_MFMA(RW_FRAG(O_RT, l15, RS, 64 * kk + 16 * g), RW_FRAG(htc, 16 * wid + l15, RS, 64 * kk + 16 * g), y);
                y = RW_MFMA(RW_FRAG(O_GRB, l15, RS40, 16 * g), RW_FRAG(O_UT, 16 * wid + l15, RS40, 16 * g), y);
                y = RW_MFMA(RW_FRAG(O_GRK, l15, RS40, 16 * g), RW_FRAG(O_VT, 16 * wid + l15, RS40, 16 * g), y);
                { RW_ROWBASE(c, rby_) const long sgy_ = d ? -1 : 1;
#pragma unroll
                for (int rr = 0; rr < 4; ++rr) { const long row = rby_ + sgy_ * (4 * g + rr); pY[row * 512 + 16 * wid + l15] = bfr(y[rr]); } } }
            { const int kt = wid >> 1; const f32x4 pd = *(const LAS f32x4*)(p15 + 16 * kt + 4 * g);
              const bf16x8 fb = RW_FRAG(O_BH, 16 * kt + l15, RS40, 16 * g), fk = RW_FRAG(O_KH, 16 * kt + l15, RS40, 16 * g);
#pragma unroll
              for (int j = 0; j < 2; ++j) { const int vt = 2 * (wid & 1) + j;
                  acc[j] = RW_MFMA(fb, RW_FRAG(O_UT, 16 * vt + l15, RS40, 16 * g), acc[j] * pd);
                  acc[j] = RW_MFMA(fk, RW_FRAG(O_VT, 16 * vt + l15, RS40, 16 * g), acc[j]);
                  *(LAS u32x2*)(lds + htn + (16 * vt + l15) * RS + (16 * kt + 4 * g) * 2) = (u32x2){att::pk2(acc[j][0], acc[j][1]), att::pk2(acc[j][2], acc[j][3])}; } }
                    }
            { const int c = c4 + 1;

            float lw[2], a[2], bb[2], kd[2], r[2];
#pragma unroll
            for (int i = 0; i < 2; ++i) { lw[i] = lwX[1][i]; a[i] = bf_lo(aX[1][i]); bb[i] = bf_lo(bX[1][i]); kd[i] = bf_lo(kX[1][i]); r[i] = bf_lo(rX[1][i]); }
            const float v0 = bf_lo(vX[1]), v1 = bf_hi(vX[1]);
            const float c0 = lw[0], c1 = lw[0] + lw[1];
            gsum[tq * 64 + k] = c1;
            lds_barrier();
            { float base = 0.f, tot = 0.f;
#pragma unroll
              for (int q = 0; q < 8; ++q) { const float gq = gsum[q * 64 + k]; tot += gq; base += q < tq ? gq : 0.f; }
              float bh[2], kh[2];
#pragma unroll
              for (int i = 0; i < 2; ++i) { const float cu = base + (i ? c1 : c0); const int t = 2 * tq + i; const float ep = fexp2(cu), em = fexp2(-cu), eh = fexp2(tot - cu);
                  *(LAS unsigned short*)(lds + O_AT + t * RS + 2 * k) = bfr(a[i] * fexp2(cu - lw[i]));
                  *(LAS unsigned short*)(lds + O_RT + t * RS + 2 * k) = bfr(r[i] * ep);
                  *(LAS unsigned short*)(lds + O_BT + t * RS + 2 * k) = bfr(bb[i] * em);
                  *(LAS unsigned short*)(lds + O_KT + t * RS + 2 * k) = bfr(kd[i] * em);
                  bh[i] = bb[i] * eh; kh[i] = kd[i] * eh; }
              *(LAS unsigned*)(lds + O_BH + k * RS40 + 4 * tq) = att::pk2(bh[0], bh[1]);
              *(LAS unsigned*)(lds + O_KH + k * RS40 + 4 * tq) = att::pk2(kh[0], kh[1]);
              if (tq == 0) p15[k] = fexp2(tot);
              { const int t = tid >> 5, v2 = (tid & 31) * 2; *(LAS unsigned short*)(lds + O_VT + v2 * RS40 + 2 * t) = bfr(v0); *(LAS unsigned short*)(lds + O_VT + (v2 + 1) * RS40 + 2 * t) = bfr(v1); } }
            if (c + 4 < NCH) RW_LOAD(c + 4, 1);
            lds_barrier();
            const int htc = O_HT + (c & 1) * 64 * RS, htn = O_HT + ((c + 1) & 1) * 64 * RS;
            if (wid < 4) { const int ia = wid < 2 ? O_AT : O_RT, ib = (wid & 1) ? O_KT : O_BT;
                f32x4 gm = (f32x4){0.f, 0.f, 0.f, 0.f};
#pragma unroll
                for (int kk = 0; kk < 2; ++kk) gm = RW_MFMA(RW_FRAG(ia, l15, RS, 64 * kk + 16 * g), RW_FRAG(ib, l15, RS, 64 * kk + 16 * g), gm);
#pragma unroll
                for (int rr = 0; rr < 4; ++rr) { const int t = 4 * g + rr; const bool keep = wid < 2 ? (l15 < t) : (l15 <= t); const float val = keep ? gm[rr] : 0.f;
                    if (wid == 0) gab[l15 * 16 + t] = val;
                    else *(LAS unsigned short*)(lds + (wid == 1 ? O_GAK : wid == 2 ? O_GRB : O_GRK) + t * RS40 + 2 * l15) = bfr(val); } }
            lds_barrier();
            if (wid < 4) { f32x4 x = (f32x4){0.f, 0.f, 0.f, 0.f};
#pragma unroll
                for (int kk = 0; kk < 2; ++kk) x = RW_MFMA(RW_FRAG(O_AT, l15, RS, 64 * kk + 16 * g), RW_FRAG(htc, 16 * wid + l15, RS, 64 * kk + 16 * g), x);
                x = RW_MFMA(RW_FRAG(O_GAK, l15, RS40, 16 * g), RW_FRAG(O_VT, 16 * wid + l15, RS40, 16 * g), x);
#pragma unroll
                for (int rr = 0; rr < 4; ++rr) xs[(4 * g + rr) * 64 + 16 * wid + l15] = x[rr]; }
            lds_barrier();
            if (wid == 0) { float u[16];
#pragma unroll
                for (int t = 0; t < 16; ++t) u[t] = xs[t * 64 + lane];
#pragma unroll
                for (int s = 0; s < 15; ++s) {
#pragma unroll
                    for (int q4 = (s + 1) / 4; q4 < 4; ++q4) { const f32x4 gc = *(const LAS f32x4*)(gab + s * 16 + 4 * q4);
#pragma unroll
                        for (int j = 0; j < 4; ++j) if (4 * q4 + j > s) u[4 * q4 + j] += gc[j] * u[s]; } }
                u32x4 w0, w1; w0.x = att::pk2(u[0], u[1]); w0.y = att::pk2(u[2], u[3]); w0.z = att::pk2(u[4], u[5]); w0.w = att::pk2(u[6], u[7]);
                w1.x = att::pk2(u[8], u[9]); w1.y = att::pk2(u[10], u[11]); w1.z = att::pk2(u[12], u[13]); w1.w = att::pk2(u[14], u[15]);
                *(LAS u32x4*)(lds + O_UT + lane * RS40) = w0; *(LAS u32x4*)(lds + O_UT + lane * RS40 + 16) = w1; }
            lds_barrier();
            if (wid < 4) { f32x4 y = (f32x4){0.f, 0.f, 0.f, 0.f};
#pragma unroll
                for (int kk = 0; kk < 2; ++kk) y = RW_MFMA(RW_FRAG(O_RT, l15, RS, 64 * kk + 16 * g), RW_FRAG(htc, 16 * wid + l15, RS, 64 * kk + 16 * g), y);
                y = RW_MFMA(RW_FRAG(O_GRB, l15, RS40, 16 * g), RW_FRAG(O_UT, 16 * wid + l15, RS40, 16 * g), y);
                y = RW_MFMA(RW_FRAG(O_GRK, l15, RS40, 16 * g), RW_FRAG(O_VT, 16 * wid + l15, RS40, 16 * g), y);
                { RW_ROWBASE(c, rby_) const long sgy_ = d ? -1 : 1;
#pragma unroll
                for (int rr = 0; rr < 4; ++rr) { const long row = rby_ + sgy_ * (4 * g + rr); pY[row * 512 + 16 * wid + l15] = bfr(y[rr]); } } }
            { const int kt = wid >> 1; const f32x4 pd = *(const LAS f32x4*)(p15 + 16 * kt + 4 * g);
              const bf16x8 fb = RW_FRAG(O_BH, 16 * kt + l15, RS40, 16 * g), fk = RW_FRAG(O_KH, 16 * kt + l15, RS40, 16 * g);
#pragma unroll
              for (int j = 0; j < 2; ++j) { const int vt = 2 * (wid & 1) + j;
                  acc[j] = RW_MFMA(fb, RW_FRAG(O_UT, 16 * vt + l15, RS40, 16 * g), acc[j] * pd);
                  acc[j] = RW_MFMA(fk, RW_FRAG(O_VT, 16 * vt + l15, RS40, 16 * g), acc[j]);
                  *(LAS u32x2*)(lds + htn + (16 * vt + l15) * RS + (16 * kt + 4 * g) * 2) = (u32x2){att::pk2(acc[j][0], acc[j][1]), att::pk2(acc[j][2], acc[j][3])}; } }
                    }
            { const int c = c4 + 2;

            float lw[2], a[2], bb[2], kd[2], r[2];
#pragma unroll
            for (int i = 0; i < 2; ++i) { lw[i] = lwX[2][i]; a[i] = bf_lo(aX[2][i]); bb[i] = bf_lo(bX[2][i]); kd[i] = bf_lo(kX[2][i]); r[i] = bf_lo(rX[2][i]); }
            const float v0 = bf_lo(vX[2]), v1 = bf_hi(vX[2]);
            const float c0 = lw[0], c1 = lw[0] + lw[1];
            gsum[tq * 64 + k] = c1;
            lds_barrier();
            { float base = 0.f, tot = 0.f;
#pragma unroll
              for (int q = 0; q < 8; ++q) { const float gq = gsum[q * 64 + k]; tot += gq; base += q < tq ? gq : 0.f; }
              float bh[2], kh[2];
#pragma unroll
              for (int i = 0; i < 2; ++i) { const float cu = base + (i ? c1 : c0); const int t = 2 * tq + i; const float ep = fexp2(cu), em = fexp2(-cu), eh = fexp2(tot - cu);
                  *(LAS unsigned short*)(lds + O_AT + t * RS + 2 * k) = bfr(a[i] * fexp2(cu - lw[i]));
                  *(LAS unsigned short*)(lds + O_RT + t * RS + 2 * k) = bfr(r[i] * ep);
                  *(LAS unsigned short*)(lds + O_BT + t * RS + 2 * k) = bfr(bb[i] * em);
                  *(LAS unsigned short*)(lds + O_KT + t * RS + 2 * k) = bfr(kd[i] * em);
                  bh[i] = bb[i] * eh; kh[i] = kd[i] * eh; }
              *(LAS unsigned*)(lds + O_BH + k * RS40 + 4 * tq) = att::pk2(bh[0], bh[1]);
              *(LAS unsigned*)(lds + O_KH + k * RS40 + 4 * tq) = att::pk2(kh[0], kh[1]);
              if (tq == 0) p15[k] = fexp2(tot);
              { const int t = tid >> 5, v2 = (tid & 31) * 2; *(LAS unsigned short*)(lds + O_VT + v2 * RS40 + 2 * t) = bfr(v0); *(LAS unsigned short*)(lds + O_VT + (v2 + 1) * RS40 + 2 * t) = bfr(v1); } }
            if (c + 4 < NCH) RW_LOAD(c + 4, 2);
            lds_barrier();
            const int htc = O_HT + (c & 1) * 64 * RS, htn = O_HT + ((c + 1) & 1) * 64 * RS;
            if (wid < 4) { const int ia = wid < 2 ? O_AT : O_RT, ib = (wid & 1) ? O_KT : O_BT;
                f32x4 gm = (f32x4){0.f, 0.f, 0.f, 0.f};
#pragma unroll
                for (int kk = 0; kk < 2; ++kk) gm = RW_MFMA(RW_FRAG(ia, l15, RS, 64 * kk + 16 * g), RW_FRAG(ib, l15, RS, 64 * kk + 16 * g), gm);
#pragma unroll
                for (int rr = 0; rr < 4; ++rr) { const int t = 4 * g + rr; const bool keep = wid < 2 ? (l15 < t) : (l15 <= t); const float val = keep ? gm[rr] : 0.f;
                    if (wid == 0) gab[l15 * 16 + t] = val;
                    else *(LAS unsigned short*)(lds + (wid == 1 ? O_GAK : wid == 2 ? O_GRB : O_GRK) + t * RS40 + 2 * l15) = bfr(val); } }
            lds_barrier();
            if (wid < 4) { f32x4 x = (f32x4){0.f, 0.f, 0.f, 0.f};
#pragma unroll
                for (int kk = 0; kk < 2; ++kk) x = RW_MFMA(RW_FRAG(O_AT, l15, RS, 64 * kk + 16 * g), RW_FRAG(htc, 16 * wid + l15, RS, 64 * kk + 16 * g), x);
                x = RW_MFMA(RW_FRAG(O_GAK, l15, RS40, 16 * g), RW_FRAG(O_VT, 16 * wid + l15, RS40, 16 * g), x);
#pragma unroll
                for (int rr = 0; rr < 4; ++rr) xs[(4 * g + rr) * 64 + 16 * wid + l15] = x[rr]; }
            lds_barrier();
            if (wid == 0) { float u[16];
#pragma unroll
                for (int t = 0; t < 16; ++t) u[t] = xs[t * 64 + lane];
#pragma unroll
                for (int s = 0; s < 15; ++s) {
#pragma unroll
                    for (int q4 = (s + 1) / 4; q4 < 4; ++q4) { const f32x4 gc = *(const LAS f32x4*)(gab + s * 16 + 4 * q4);
#pragma unroll
                        for (int j = 0; j < 4; ++j) if (4 * q4 + j > s) u[4 * q4 + j] += gc[j] * u[s]; } }
                u32x4 w0, w1; w0.x = att::pk2(u[0], u[1]); w0.y = att::pk2(u[2], u[3]); w0.z = att::pk2(u[4], u[5]); w0.w = att::pk2(u[6], u[7]);
                w1.x = att::pk2(u[8], u[9]); w1.y = att::pk2(u[10], u[11]); w1.z = att::pk2(u[12], u[13]); w1.w = att::pk2(u[14], u[15]);
                *(LAS u32x4*)(lds + O_UT + lane * RS40) = w0; *(LAS u32x4*)(lds + O_UT + lane * RS40 + 16) = w1; }
            lds_barrier();
            if (wid < 4) { f32x4 y = (f32x4){0.f, 0.f, 0.f, 0.f};
#pragma unroll
                for (int kk = 0; kk < 2; ++kk) y = RW_MFMA(RW_FRAG(O_RT, l15, RS, 64 * kk + 16 * g), RW_FRAG(htc, 16 * wid + l15, RS, 64 * kk + 16 * g), y);
                y = RW_MFMA(RW_FRAG(O_GRB, l15, RS40, 16 * g), RW_FRAG(O_UT, 16 * wid + l15, RS40, 16 * g), y);
                y = RW_MFMA(RW_FRAG(O_GRK, l15, RS40, 16 * g), RW_FRAG(O_VT, 16 * wid + l15, RS40, 16 * g), y);
                { RW_ROWBASE(c, rby_) const long sgy_ = d ? -1 : 1;
#pragma unroll
                for (int rr = 0; rr < 4; ++rr) { const long row = rby_ + sgy_ * (4 * g + rr); pY[row * 512 + 16 * wid + l15] = bfr(y[rr]); } } }
            { const int kt = wid >> 1; const f32x4 pd = *(const LAS f32x4*)(p15 + 16 * kt + 4 * g);
              const bf16x8 fb = RW_FRAG(O_BH, 16 * kt + l15, RS40, 16 * g), fk = RW_FRAG(O_KH, 16 * kt + l15, RS40, 16 * g);
#pragma unroll
              for (int j = 0; j < 2; ++j) { const int vt = 2 * (wid & 1) + j;
                  acc[j] = RW_MFMA(fb, RW_FRAG(O_UT, 16 * vt + l15, RS40, 16 * g), acc[j] * pd);
                  acc[j] = RW_MFMA(fk, RW_FRAG(O_VT, 16 * vt + l15, RS40, 16 * g), acc[j]);
                  *(LAS u32x2*)(lds + htn + (16 * vt + l15) * RS + (16 * kt + 4 * g) * 2) = (u32x2){att::pk2(acc[j][0], acc[j][1]), att::pk2(acc[j][2], acc[j][3])}; } }
                    }
            { const int c = c4 + 3;

            float lw[2], a[2], bb[2], kd[2], r[2];
#pragma unroll
            for (int i = 0; i < 2; ++i) { lw[i] = lwX[3][i]; a[i] = bf_lo(aX[3][i]); bb[i] = bf_lo(bX[3][i]); kd[i] = bf_lo(kX[3][i]); r[i] = bf_lo(rX[3][i]); }
            const float v0 = bf_lo(vX[3]), v1 = bf_hi(vX[3]);
            const float c0 = lw[0], c1 = lw[0] + lw[1];
            gsum[tq * 64 + k] = c1;
            lds_barrier();
            { float base = 0.f, tot = 0.f;
#pragma unroll
              for (int q = 0; q < 8; ++q) { const float gq = gsum[q * 64 + k]; tot += gq; base += q < tq ? gq : 0.f; }
              float bh[2], kh[2];
#pragma unroll
              for (int i = 0; i < 2; ++i) { const float cu = base + (i ? c1 : c0); const int t = 2 * tq + i; const float ep = fexp2(cu), em = fexp2(-cu), eh = fexp2(tot - cu);
                  *(LAS unsigned short*)(lds + O_AT + t * RS + 2 * k) = bfr(a[i] * fexp2(cu - lw[i]));
                  *(LAS unsigned short*)(lds + O_RT + t * RS + 2 * k) = bfr(r[i] * ep);
                  *(LAS unsigned short*)(lds + O_BT + t * RS + 2 * k) = bfr(bb[i] * em);
                  *(LAS unsigned short*)(lds + O_KT + t * RS + 2 * k) = bfr(kd[i] * em);
                  bh[i] = bb[i] * eh; kh[i] = kd[i] * eh; }
              *(LAS unsigned*)(lds + O_BH + k * RS40 + 4 * tq) = att::pk2(bh[0], bh[1]);
              *(LAS unsigned*)(lds + O_KH + k * RS40 + 4 * tq) = att::pk2(kh[0], kh[1]);
              if (tq == 0) p15[k] = fexp2(tot);
              { const int t = tid >> 5, v2 = (tid & 31) * 2; *(LAS unsigned short*)(lds + O_VT + v2 * RS40 + 2 * t) = bfr(v0); *(LAS unsigned short*)(lds + O_VT + (v2 + 1) * RS40 + 2 * t) = bfr(v1); } }
            if (c + 4 < NCH) RW_LOAD(c + 4, 3);
            lds_barrier();
            const int htc = O_HT + (c & 1) * 64 * RS, htn = O_HT + ((c + 1) & 1) * 64 * RS;
            if (wid < 4) { const int ia = wid < 2 ? O_AT : O_RT, ib = (wid & 1) ? O_KT : O_BT;
                f32x4 gm = (f32x4){0.f, 0.f, 0.f, 0.f};
#pragma unroll
                for (int kk = 0; kk < 2; ++kk) gm = RW_MFMA(RW_FRAG(ia, l15, RS, 64 * kk + 16 * g), RW_FRAG(ib, l15, RS, 64 * kk + 16 * g), gm);
#pragma unroll
                for (int rr = 0; rr < 4; ++rr) { const int t = 4 * g + rr; const bool keep = wid < 2 ? (l15 < t) : (l15 <= t); const float val = keep ? gm[rr] : 0.f;
                    if (wid == 0) gab[l15 * 16 + t] = val;
                    else *(LAS unsigned short*)(lds + (wid == 1 ? O_GAK : wid == 2 ? O_GRB : O_GRK) + t * RS40 + 2 * l15) = bfr(val); } }
            lds_barrier();
            if (wid < 4) { f32x4 x = (f32x4){0.f, 0.f, 0.f, 0.f};
#pragma unroll
                for (int kk = 0; kk < 2; ++kk) x = RW_MFMA(RW_FRAG(O_AT, l15, RS, 64 * kk + 16 * g), RW_FRAG(htc, 16 * wid + l15, RS, 64 * kk + 16 * g), x);
                x = RW_MFMA(RW_FRAG(O_GAK, l15, RS40, 16 * g), RW_FRAG(O_VT, 16 * wid + l15, RS40, 16 * g), x);
#pragma unroll
                for (int rr = 0; rr < 4; ++rr) xs[(4 * g + rr) * 64 + 16 * wid + l15] = x[rr]; }
            lds_barrier();
            if (wid == 0) { float u[16];
#pragma unroll
                for (int t = 0; t < 16; ++t) u[t] = xs[t * 64 + lane];
#pragma unroll
                for (int s = 0; s < 15; ++s) {
#pragma unroll
                    for (int q4 = (s + 1) / 4; q4 < 4; ++q4) { const f32x4 gc = *(const LAS f32x4*)(gab + s * 16 + 4 * q4);
#pragma unroll
                        for (int j = 0; j < 4; ++j) if (4 * q4 + j > s) u[4 * q4 + j] += gc[j] * u[s]; } }
                u32x4 w0, w1; w0.x = att::pk2(u[0], u[1]); w0.y = att::pk2(u[2], u[3]); w0.z = att::pk2(u[4], u[5]); w0.w = att::pk2(u[6], u[7]);
                w1.x = att::pk2(u[8], u[9]); w1.y = att::pk2(u[10], u[11]); w1.z = att::pk2(u[12], u[13]); w1.w = att::pk2(u[14], u[15]);
                *(LAS u32x4*)(lds + O_UT + lane * RS40) = w0; *(LAS u32x4*)(lds + O_UT + lane * RS40 + 16) = w1; }
            lds_barrier();
            if (wid < 4) { f32x4 y = (f32x4){0.f, 0.f, 0.f, 0.f};
#pragma unroll
                for (int kk = 0; kk < 2; ++kk) y = RW_MFMA(RW_FRAG(O_RT, l15, RS, 64 * kk + 16 * g), RW_FRAG(htc, 16 * wid + l15, RS, 64 * kk + 16 * g), y);
                y = RW_MFMA(RW_FRAG(O_GRB, l15, RS40, 16 * g), RW_FRAG(O_UT, 16 * wid + l15, RS40, 16 * g), y);
                y = RW_MFMA(RW_FRAG(O_GRK, l15, RS40, 16 * g), RW_FRAG(O_VT, 16 * wid + l15, RS40, 16 * g), y);
                { RW_ROWBASE(c, rby_) const long sgy_ = d ? -1 : 1;
#pragma unroll
                for (int rr = 0; rr < 4; ++rr) { const long row = rby_ + sgy_ * (4 * g + rr); pY[row * 512 + 16 * wid + l15] = bfr(y[rr]); } } }
            { const int kt = wid >> 1; const f32x4 pd = *(const LAS f32x4*)(p15 + 16 * kt + 4 * g);
              const bf16x8 fb = RW_FRAG(O_BH, 16 * kt + l15, RS40, 16 * g), fk = RW_FRAG(O_KH, 16 * kt + l15, RS40, 16 * g);
#pragma unroll
              for (int j = 0; j < 2; ++j) { const int vt = 2 * (wid & 1) + j;
                  acc[j] = RW_MFMA(fb, RW_FRAG(O_UT, 16 * vt + l15, RS40, 16 * g), acc[j] * pd);
                  acc[j] = RW_MFMA(fk, RW_FRAG(O_VT, 16 * vt + l15, RS40, 16 * g), acc[j]);
                  *(LAS u32x2*)(lds + htn + (16 * vt + l15) * RS + (16 * kt + 4 * g) * 2) = (u32x2){att::pk2(acc[j][0], acc[j][1]), att::pk2(acc[j][2], acc[j][3])}; } }
                    }
        }
        lds_barrier();
#undef RW_LOAD
    }
}
}

#if defined(PERSISTENT)
#define DENSE_GEMM(Af, lda, Kreal, KP, WT, Wf, ldb, Cout, ldc, Mrows, Nvalid, NP) do { \
    conv_act((Af), (lda), (Kreal), C.ABF, (KP), (Mrows), wv_); grid_sync(bar); \
    { g8::DenseSched S_; S_.init(C.ABF, (WT), (Mrows), (NP), (KP), gridDim.x, opaque_bid()); g8::EpiF32 E_{(Cout), (ldc), (Nvalid)}; g8::gemm_phase<(KP), g8::EpiF32, g8::DenseSched>(lds, S_, E_, wv_); } \
    grid_sync(bar); } while (0)
#define DENSE_GEMM_UB(Af, lda, Kreal, KP, WT, Wf, ldb, Cout, ldc, Mrows, Nvalid, NP) do { \
    { g8::DenseSched S_; S_.init(C.UB, (WT), (Mrows), (NP), (KP), gridDim.x, opaque_bid()); g8::EpiF32 E_{(Cout), (ldc), (Nvalid)}; g8::gemm_phase<(KP), g8::EpiF32, g8::DenseSched>(lds, S_, E_, wv_); } \
    grid_sync(bar); } while (0)
#else
#define DENSE_GEMM_UB DENSE_GEMM
#define DENSE_GEMM(Af, lda, Kreal, KP, WT, Wf, ldb, Cout, ldc, Mrows, Nvalid, NP) ngemm((Af), (lda), nullptr, (Wf), 0, (ldb), nullptr, 0, (Cout), (ldc), (Mrows), (Nvalid), (Kreal), nullptr)
#endif
#ifdef PERSIST_C_MACRO
#define C (*Cp_)
#endif
#define MODL (C.MOD + (size_t)layer * (BATCH + 1) * N_MOD * D_MODEL)
FWD_QUAL void naive_prologue(FWD_SIG) {
    const int D = D_MODEL, NT = NT_, NC = NC_;
#if defined(PERSISTENT)
    tl::mod_phase(Cp_, lds, wv_);
    tl::rope_table(Cp_, wv_); tl::lora_weights(Cp_, wv_);
    conv_weight_b(lds, C.moe_w_gu, (size_t)D_MODEL * 2 * EXPERT_DIM, C.Wgu, (size_t)2 * EXPERT_DIM * D_MODEL, CV_PRO_LAYERS * N_EXPERTS, D_MODEL, 2 * EXPERT_DIM, 2 * EXPERT_DIM, D_MODEL, 2 * EXPERT_DIM, 1, wv_);
    conv_weight_b(lds, C.moe_w_down, (size_t)EXPERT_DIM * D_MODEL, C.Wdn, (size_t)D_MODEL * EXPERT_DIM, CV_PRO_LAYERS * N_EXPERTS, EXPERT_DIM, D_MODEL, D_MODEL, EXPERT_DIM, D_MODEL, 0, wv_);
    conv_weight_b(lds, C.ev_w_in, (size_t)D_MODEL * EVEN_IN, C.WinE, (size_t)4608 * 1024, N_EVEN, D_MODEL, EVEN_IN, EVEN_IN, 1024, 4608, 0, wv_);
    conv_weight_b(lds, C.ev_w_out, (size_t)1024 * D_MODEL, C.WoutE, (size_t)1024 * 1024, N_EVEN, 1024, D_MODEL, D_MODEL, 1024, 1024, 0, wv_);
    conv_weight_b(lds, C.od_w_in, (size_t)D_MODEL * MLA_IN, C.WinO, (size_t)512 * 1024, N_ODD, D_MODEL, MLA_IN, MLA_IN, 1024, 512, 0, wv_);
    conv_weight_b(lds, C.mla_w_qb, (size_t)MLA_QR * 1536, C.Wqb, (size_t)1536 * 256, N_ODD, MLA_QR, 1536, 1536, 256, 1536, 0, wv_);
    conv_weight_b(lds, C.mla_w_kvb, (size_t)MLA_KVR * 2048, C.Wkvb, (size_t)2048 * 256, N_ODD, MLA_KVR, 2048, 2048, 256, 2048, 0, wv_);
    conv_weight_b(lds, C.od_w_out, (size_t)1024 * D_MODEL, C.WoutO, (size_t)1024 * 1024, N_ODD, 1024, D_MODEL, D_MODEL, 1024, 1024, 0, wv_);
    grid_sync(bar);
#endif
#if !defined(PERSISTENT)
    NLAUNCH((long)NT * D, [=] HD(long i) { long row = i / D_MODEL; int d = (int)(i % D_MODEL); C.H[i] = row < NC_ ? C.ctx[row * D_MODEL + d] : C.x[(row - NC_) * D_MODEL + d]; });
#endif
#if !defined(PERSISTENT)
    NLAUNCH((long)DEPTH * (BATCH + 1) * N_MOD * D, [=] HD(long i) {
        const int W = N_MOD * D_MODEL; int j = (int)(i % W); long t = i / W; int r = (int)(t % (BATCH + 1)); int l = (int)(t / (BATCH + 1));
        const float* cv = r < BATCH ? C.c + (size_t)r * D_MODEL : C.c_ctx; const float* w = C.mod_w + (size_t)l * D_MODEL * W;
        float s = 0.f; for (int k = 0; k < D_MODEL; ++k) s += siluf_(cv[k]) * w[(size_t)k * W + j];
        C.MOD[i] = s + C.mod_b[(size_t)l * W + j]; });
#endif
#if defined(PERSISTENT)
    tl::init_h(Cp_, wv_); grid_sync(bar);
#endif
}
FWD_QUAL void naive_modu(FWD_SIG, long layer) {
#if !defined(PERSISTENT)
    const int D = D_MODEL, NT = NT_, NC = NC_; (void)D; (void)NT; (void)NC;
    const bool need_ctx = layer < DEPTH - 1; const long j2 = layer / 2; (void)need_ctx; (void)j2;
        NLAUNCH((long)NT * D, [=] HD(long i) { long row = i / D_MODEL; int d = (int)(i % D_MODEL); const float* m = MODL + (size_t)modrow((int)row) * N_MOD * D_MODEL; C.U[i] = C.H[i] * (1.f + m[D_MODEL + d]) + m[d]; });
#endif
}
FWD_QUAL void naive_even(FWD_SIG, long layer) {
    const int D = D_MODEL, NT = NT_, NC = NC_; (void)D; (void)NT; (void)NC;
    const bool need_ctx = layer < DEPTH - 1; const long j2 = layer / 2; (void)need_ctx; (void)j2;
            DENSE_GEMM_UB(C.U, D_MODEL, D_MODEL, 1024, C.WinE + (size_t)j2 * 4608 * 1024, C.ev_w_in + (size_t)j2 * D * EVEN_IN, EVEN_IN, C.Z, EVEN_IN, NT_, EVEN_IN, 4608);
#define mu (C.rw_mu + (size_t)j2 * RW_IN)
            NLAUNCH((long)NT * RW_IN, [=] HD(long i) { int row = (int)(i / RW_IN), c = (int)(i % RW_IN);
                int t, len; if (row < NC_) { t = row % CTX_LEN; len = CTX_LEN; } else { t = (row - NC_) % SEQ; len = SEQ; }
                float z = C.Z[(size_t)row * EVEN_IN + c]; float p = t > 0 ? C.Z[(size_t)(row - 1) * EVEN_IN + c] : 0.f; float n = t < len - 1 ? C.Z[(size_t)(row + 1) * EVEN_IN + c] : 0.f;
                C.ZS[i] = z + mu[c] * (0.5f * (p + n) - z); });
#define w0 (C.rw_w0 + (size_t)j2 * 2 * 512)
#define w2 (C.rw_w2 + (size_t)j2 * 2 * 64 * 512)
#define a0 (C.rw_a0 + (size_t)j2 * 2 * 512)
#define a2 (C.rw_a2 + (size_t)j2 * 2 * 64 * 512)
#define g2 (C.rw_g2 + (size_t)j2 * 128 * 512)
#define k_k (C.rw_k_k + (size_t)j2 * 512)
#define k_a (C.rw_k_a + (size_t)j2 * 512)
#define r_k (C.rw_r_k + (size_t)j2 * 512)
#define gn_g (C.rw_gn_g + (size_t)j2 * 512)
#define gn_b (C.rw_gn_b + (size_t)j2 * 512)
            NLAUNCH((long)NT * 512, [=] HD(long i) { int row = (int)(i / 512), c = (int)(i % 512); const float* zs = C.ZS + (size_t)row * RW_IN;
                float r = zs[c], k = zs[512 + c], v = zs[1024 + c];
                C.R[i] = r; C.V[i] = v; C.KKR[i] = k * k_k[c];
                float g = 0.f; for (int q = 0; q < 128; ++q) g += sigmoidf_(zs[1792 + q]) * g2[(size_t)q * 512 + c];
                C.G[i] = g;
                for (int d = 0; d < 2; ++d) {
                    float wl = 0.f, al = 0.f;
                    for (int q = 0; q < 64; ++q) { wl += tanhf(zs[1536 + d * 64 + q]) * w2[((size_t)d * 64 + q) * 512 + c]; al += zs[1664 + d * 64 + q] * a2[((size_t)d * 64 + q) * 512 + c]; }
                    float wpre = w0[d * 512 + c] + wl; float dec = expf(-expf(-softplusf_(-wpre) - 0.5f)); float a = sigmoidf_(a0[d * 512 + c] + al);
                    size_t o = ((size_t)d * NT_ + row) * 512 + c;
                    C.DEC[o] = dec; C.AG[o] = a; C.KD[o] = k * (1.f + (a - 1.f) * k_a[c]);
                } });
            NLAUNCH((long)NT * RW_HEADS, [=] HD(long i) { int row = (int)(i / RW_HEADS), h = (int)(i % RW_HEADS); size_t b0 = (size_t)row * 512 + h * 64;
                float ss = 0.f; for (int n = 0; n < 64; ++n) ss += C.KKR[b0 + n] * C.KKR[b0 + n];
                float inv = 1.f / sqrtf(fmaxf(ss, 1e-24f));
                for (int n = 0; n < 64; ++n) { float kk = C.KKR[b0 + n] * inv; C.NKK[b0 + n] = -kk; for (int d = 0; d < 2; ++d) { size_t o = ((size_t)d * NT_ + row) * 512 + h * 64 + n; C.BB[o] = kk * C.AG[o]; } } });
            NLAUNCH((long)2 * BATCH * RW_HEADS * 64, [=] HD(long i) { int v = (int)(i % 64); long t = i / 64; int h = (int)(t % RW_HEADS); t /= RW_HEADS; int b = (int)(t % BATCH); int d = (int)(t / BATCH);
                float S[64];
_Pragma("unroll")
                for (int k = 0; k < 64; ++k) S[k] = 0.f;
                for (int st = 0; st < TT_; ++st) { int row = tokrow(b, scan_pos(d, st)); size_t s0 = (size_t)row * 512 + h * 64, s1 = ((size_t)d * NT_ + row) * 512 + h * 64;
                    float sa = 0.f;
_Pragma("unroll")
                    for (int k = 0; k < 64; ++k) { sa += S[k] * C.NKK[s0 + k]; MEMFENCE_EVERY(k, 16); }
                    float vv = C.V[s0 + v], y = 0.f;
_Pragma("unroll")
                    for (int k = 0; k < 64; ++k) { S[k] = S[k] * C.DEC[s1 + k] + sa * C.BB[s1 + k] + vv * C.KD[s1 + k]; y += S[k] * C.R[s0 + k]; MEMFENCE_EVERY(k, 8); }
                    C.Y[s1 + v] = y; } });
#define lbp (C.hg_lb)
#define hgn (C.hg_norm_g + (size_t)j2 * 512)
            NLAUNCH((long)NT * 512, [=] HD(long i) { int row = (int)(i / 512), c = (int)(i % 512); const float* zb = C.Z + (size_t)row * EVEN_IN + RW_IN;
                C.HQ[i] = siluf_(zb[c]);
                for (int d = 0; d < 2; ++d) {
                    float mx = -1e30f; for (int q = 0; q < N_EVEN; ++q) mx = fmaxf(mx, lbp[((size_t)q * 2 + d) * 512 + c]);
                    float den = 0.f, num = 0.f; for (int q = 0; q < N_EVEN; ++q) { float e = expf(lbp[((size_t)q * 2 + d) * 512 + c] - mx); den += e; if (q >= 1 && q <= j2) num += e; }
                    float lower = num / den;
                    float sig = sigmoidf_(zb[512 + d * 512 + c]); float f = lower + (1.f - lower) * sig; f = fmaxf(f, 1e-30f);
                    size_t o = ((size_t)d * NT_ + row) * 512 + c; C.HF[o] = f; C.HK[o] = (1.f - lower) * (1.f - sig);
                } });
            NLAUNCH((long)2 * BATCH * HG_HEADS * 128 * 2, [=] HD(long i) { int kh = (int)(i & 1); int v = (int)((i >> 1) % 128); long t = (i >> 1) / 128; int h = (int)(t % HG_HEADS); t /= HG_HEADS; int b = (int)(t % BATCH); int d = (int)(t / BATCH);
                float S[64];
_Pragma("unroll")
                for (int k = 0; k < 64; ++k) S[k] = 0.f;
                for (int st = 0; st < TT_; ++st) { int row = tokrow(b, scan_pos(d, st)); size_t s0 = (size_t)row * 512 + h * 128 + kh * 64, s1 = ((size_t)d * NT_ + row) * 512 + h * 128 + kh * 64;
                    float val = C.Z[(size_t)row * EVEN_IN + RW_IN + 1536 + h * 128 + v], o = 0.f;
_Pragma("unroll")
                    for (int k = 0; k < 64; ++k) { S[k] = C.HF[s1 + k] * S[k] + C.HK[s1 + k] * val; o += S[k] * C.HQ[s0 + k]; MEMFENCE_EVERY(k, 16); }
                    C.OP[(((size_t)d * NT_ + row) * 512 + h * 128 + v) * 2 + kh] = o; } });
            NLAUNCH((long)NT * RW_HEADS, [=] HD(long i) { int row = (int)(i / RW_HEADS), h = (int)(i % RW_HEADS); size_t b0 = (size_t)row * 512 + h * 64, b1 = ((size_t)NT_ + row) * 512 + h * 64;
                float mu_ = 0.f; for (int n = 0; n < 64; ++n) mu_ += C.Y[b0 + n] + C.Y[b1 + n]; mu_ /= 64.f;
                float var = 0.f; for (int n = 0; n < 64; ++n) { float y = C.Y[b0 + n] + C.Y[b1 + n] - mu_; var += y * y; } var /= 64.f;
                float rs = 1.f / sqrtf(var + 64e-5f);
                float bon = 0.f; for (int n = 0; n < 64; ++n) bon += C.R[b0 + n] * (C.KD[b0 + n] + C.KD[b1 + n]) * r_k[h * 64 + n];
                for (int n = 0; n < 64; ++n) { int c = h * 64 + n; float y = (C.Y[b0 + n] + C.Y[b1 + n] - mu_) * rs * gn_g[c] + gn_b[c]; C.YCAT[(size_t)row * 1024 + c] = (y + bon * C.V[b0 + n]) * C.G[b0 + n]; } });
            NLAUNCH((long)NT * HG_HEADS, [=] HD(long i) { int row = (int)(i / HG_HEADS), h = (int)(i % HG_HEADS); size_t b0 = (size_t)row * 512 + h * 128, b1 = ((size_t)NT_ + row) * 512 + h * 128;
                float ss = 0.f; for (int n = 0; n < 128; ++n) { float o = C.OP[(b0 + n) * 2] + C.OP[(b0 + n) * 2 + 1] + C.OP[(b1 + n) * 2] + C.OP[(b1 + n) * 2 + 1]; ss += o * o; }
                float rs = 1.f / sqrtf(ss / 128.f + 1e-6f);
                for (int n = 0; n < 128; ++n) { int c = h * 128 + n; float o = (C.OP[(b0 + n) * 2] + C.OP[(b0 + n) * 2 + 1] + C.OP[(b1 + n) * 2] + C.OP[(b1 + n) * 2 + 1]) * rs * hgn[c]; C.YCAT[(size_t)row * 1024 + 512 + c] = o * siluf_(C.Z[(size_t)row * EVEN_IN + RW_IN + 2048 + c]); } });
            DENSE_GEMM(C.YCAT, 1024, 1024, 1024, C.WoutE + (size_t)j2 * 1024 * 1024, C.ev_w_out + (size_t)j2 * 1024 * D, D_MODEL, C.YO, D_MODEL, NT_, D_MODEL, 1024);
}
FWD_QUAL void naive_scans(FWD_SIG, long layer) {
    const long j2 = layer / 2; (void)j2;
            NLAUNCH((long)2 * BATCH * RW_HEADS * 64, [=] HD(long i) { int v = (int)(i % 64); long t = i / 64; int h = (int)(t % RW_HEADS); t /= RW_HEADS; int b = (int)(t % BATCH); int d = (int)(t / BATCH);
                float S[64];
_Pragma("unroll")
                for (int k = 0; k < 64; ++k) S[k] = 0.f;
                for (int st = 0; st < TT_; ++st) { int row = tokrow(b, scan_pos(d, st)); size_t s0 = (size_t)row * 512 + h * 64, s1 = ((size_t)d * NT_ + row) * 512 + h * 64;
                    float sa = 0.f;
_Pragma("unroll")
                    for (int k = 0; k < 64; ++k) { sa += S[k] * C.NKK[s0 + k]; MEMFENCE_EVERY(k, 16); }
                    float vv = C.V[s0 + v], y = 0.f;
_Pragma("unroll")
                    for (int k = 0; k < 64; ++k) { S[k] = S[k] * C.DEC[s1 + k] + sa * C.BB[s1 + k] + vv * C.KD[s1 + k]; y += S[k] * C.R[s0 + k]; MEMFENCE_EVERY(k, 8); }
                    C.Y[s1 + v] = y; } });
            NLAUNCH((long)2 * BATCH * HG_HEADS * 128 * 2, [=] HD(long i) { int kh = (int)(i & 1); int v = (int)((i >> 1) % 128); long t = (i >> 1) / 128; int h = (int)(t % HG_HEADS); t /= HG_HEADS; int b = (int)(t % BATCH); int d = (int)(t / BATCH);
                float S[64];
_Pragma("unroll")
                for (int k = 0; k < 64; ++k) S[k] = 0.f;
                for (int st = 0; st < TT_; ++st) { int row = tokrow(b, scan_pos(d, st)); size_t s0 = (size_t)row * 512 + h * 128 + kh * 64, s1 = ((size_t)d * NT_ + row) * 512 + h * 128 + kh * 64;
                    float val = C.Z[(size_t)row * EVEN_IN + RW_IN + 1536 + h * 128 + v], o = 0.f;
_Pragma("unroll")
                    for (int k = 0; k < 64; ++k) { S[k] = C.HF[s1 + k] * S[k] + C.HK[s1 + k] * val; o += S[k] * C.HQ[s0 + k]; MEMFENCE_EVERY(k, 16); }
                    C.OP[(((size_t)d * NT_ + row) * 512 + h * 128 + v) * 2 + kh] = o; } });
}
FWD_QUAL void naive_scan_hgrn(FWD_SIG, long layer) {
    const long j2 = layer / 2; (void)j2;
            NLAUNCH((long)2 * BATCH * HG_HEADS * 128 * 2, [=] HD(long i) { int kh = (int)(i & 1); int v = (int)((i >> 1) % 128); long t = (i >> 1) / 128; int h = (int)(t % HG_HEADS); t /= HG_HEADS; int b = (int)(t % BATCH); int d = (int)(t / BATCH);
                float S[64];
_Pragma("unroll")
                for (int k = 0; k < 64; ++k) S[k] = 0.f;
                for (int st = 0; st < TT_; ++st) { int row = tokrow(b, scan_pos(d, st)); size_t s0 = (size_t)row * 512 + h * 128 + kh * 64, s1 = ((size_t)d * NT_ + row) * 512 + h * 128 + kh * 64;
                    float val = C.Z[(size_t)row * EVEN_IN + RW_IN + 1536 + h * 128 + v], o = 0.f;
_Pragma("unroll")
                    for (int k = 0; k < 64; ++k) { S[k] = C.HF[s1 + k] * S[k] + C.HK[s1 + k] * val; o += S[k] * C.HQ[s0 + k]; MEMFENCE_EVERY(k, 16); }
                    C.OP[(((size_t)d * NT_ + row) * 512 + h * 128 + v) * 2 + kh] = o; } });
}
FWD_QUAL void naive_odd(FWD_SIG, long layer) {
    const int D = D_MODEL, NT = NT_, NC = NC_; (void)D; (void)NT; (void)NC;
    const bool need_ctx = layer < DEPTH - 1; const long j2 = layer / 2; (void)need_ctx; (void)j2;
            DENSE_GEMM_UB(C.U, D_MODEL, D_MODEL, 1024, C.WinO + (size_t)j2 * 512 * 1024, C.od_w_in + (size_t)j2 * D * MLA_IN, MLA_IN, C.Z, EVEN_IN, NT_, MLA_IN, 512);
#define qng (C.mla_q_norm_g + (size_t)j2 * MLA_QR)
#define kvng (C.mla_kv_norm_g + (size_t)j2 * MLA_KVR)
            NLAUNCH((long)NT, [=] HD(long i) { int row = (int)i; const float* z = C.Z + (size_t)row * EVEN_IN;
                float ss = 0.f; for (int k = 0; k < MLA_QR; ++k) ss += z[k] * z[k]; float rs = 1.f / sqrtf(ss / MLA_QR + 1e-6f);
                for (int k = 0; k < MLA_QR; ++k) C.QN[(size_t)row * MLA_QR + k] = z[k] * rs * qng[k];
                ss = 0.f; for (int k = 0; k < MLA_KVR; ++k) ss += z[MLA_QR + k] * z[MLA_QR + k]; rs = 1.f / sqrtf(ss / MLA_KVR + 1e-6f);
                for (int k = 0; k < MLA_KVR; ++k) C.KVN[(size_t)row * MLA_KVR + k] = z[MLA_QR + k] * rs * kvng[k];
                const float* kp = z + MLA_QR + MLA_KVR; float* o = C.KPE + (size_t)row * 32;
                if (row < NC_) { for (int k = 0; k < 32; ++k) o[k] = kp[k]; }
                else { int s = (row - NC_) % SEQ; float fr = (float)(s / GRID_W), fc = (float)(s % GRID_W);
                    for (int q = 0; q < 8; ++q) { float inv = powf(10000.f, -(float)(2 * q) / 16.f); float ar = fr * inv, ac = fc * inv; float cr = cosf(ar), sr = sinf(ar), cc = cosf(ac), sc = sinf(ac);
                        o[q] = kp[q] * cr - kp[8 + q] * sr; o[8 + q] = kp[8 + q] * cr + kp[q] * sr; o[16 + q] = kp[16 + q] * cc - kp[24 + q] * sc; o[24 + q] = kp[24 + q] * cc + kp[16 + q] * sc; } } });
            DENSE_GEMM(C.QN, MLA_QR, MLA_QR, 256, C.Wqb + (size_t)j2 * 1536 * 256, C.mla_w_qb + (size_t)j2 * MLA_QR * 1536, 1536, C.Q, 1536, NT_, 1536, 1536);
            DENSE_GEMM(C.KVN, MLA_KVR, MLA_KVR, 256, C.Wkvb + (size_t)j2 * 2048 * 256, C.mla_w_kvb + (size_t)j2 * MLA_KVR * 2048, 2048, C.KV, 2048, NT_, 2048, 2048);
            NLAUNCH((long)NL_ * MLA_HEADS * 8, [=] HD(long i) { int q = (int)(i % 8); long t = i / 8; int h = (int)(t % MLA_HEADS); int lr = (int)(t / MLA_HEADS); int s = lr % SEQ;
                float* p = C.Q + (size_t)(NC_ + lr) * 1536 + h * 96 + 64; float fr = (float)(s / GRID_W), fc = (float)(s % GRID_W);
                float inv = powf(10000.f, -(float)(2 * q) / 16.f); float ar = fr * inv, ac = fc * inv; float cr = cosf(ar), sr = sinf(ar), cc = cosf(ac), sc = sinf(ac);
                float r1 = p[q], r2 = p[8 + q], c1 = p[16 + q], c2 = p[24 + q];
                p[q] = r1 * cr - r2 * sr; p[8 + q] = r2 * cr + r1 * sr; p[16 + q] = c1 * cc - c2 * sc; p[24 + q] = c2 * cc + c1 * sc; });
#if defined(PERSISTENT)
            GRID_STRIDE_WAVES(i, (long)NT_ * (MLA_HEADS * 96 / 8)) { const long row = i / (MLA_HEADS * 96 / 8); const int c8 = (int)(i % (MLA_HEADS * 96 / 8)) * 8; const float* q = C.Q + row * 1536 + c8; const float sc = 0.14724445136f;
                u32x4 w; w.x = att::pk2(q[0] * sc, q[1] * sc); w.y = att::pk2(q[2] * sc, q[3] * sc); w.z = att::pk2(q[4] * sc, q[5] * sc); w.w = att::pk2(q[6] * sc, q[7] * sc); *(u32x4*)(C.QB + row * 1536 + c8) = w; }
            GRID_STRIDE_WAVES(i, (long)NT_ * MLA_HEADS * 20) { const int c8 = (int)(i % 20); const long rh = i / 20; const int h = (int)(rh % MLA_HEADS); const int row = (int)(rh / MLA_HEADS);
                int b, t; if (row < NC_) { b = row / CTX_LEN; t = row % CTX_LEN; } else { b = (row - NC_) / SEQ; t = CTX_LEN + (row - NC_) % SEQ; }
                const size_t kvrow = (size_t)(b * MLA_HEADS + h) * TT_ + t;
                const float* src = c8 < 8 ? C.KV + (size_t)row * 2048 + h * 128 + c8 * 8 : (c8 < 12 ? C.KPE + (size_t)row * 32 + (c8 - 8) * 8 : C.KV + (size_t)row * 2048 + h * 128 + 64 + (c8 - 12) * 8);
                u32x4 w; w.x = att::pk2(src[0], src[1]); w.y = att::pk2(src[2], src[3]); w.z = att::pk2(src[4], src[5]); w.w = att::pk2(src[6], src[7]);
                if (c8 < 12) *(u32x4*)(C.KB + kvrow * 96 + c8 * 8) = w; else *(u32x4*)(C.VB + kvrow * 64 + (c8 - 12) * 8) = w; }
            grid_sync(bar);
            att::attn_phase<false, 0>(lds, C.QB, C.KB, C.VB, C.AO, nullptr, need_ctx ? 1 : 0, wv_);
            grid_sync(bar);
#else
            const long row_lo = need_ctx ? 0 : NC;
            NLAUNCH((long)(NT - row_lo) * MLA_HEADS * 2, [=] HD(long i) { const int nrows_ = NT_ - (int)row_lo; int hv = (int)(i / nrows_); int row = (int)row_lo + (int)(i % nrows_); const int h = hv >> 1, vh = hv & 1;
                int b, nkeys; if (row < NC_) { b = row / CTX_LEN; nkeys = CTX_LEN; } else { b = (row - NC_) / SEQ; nkeys = TT_; }
                float q[96];
_Pragma("unroll")
                for (int k = 0; k < 96; ++k) q[k] = C.Q[(size_t)row * 1536 + h * 96 + k];
                float o[32];
_Pragma("unroll")
                for (int k = 0; k < 32; ++k) o[k] = 0.f;
                float m = -1e30f, l = 0.f; const float scale = 0.10206207261596577f;
                for (int t = 0; t < nkeys; ++t) { int kr = tokrow(b, t); const float* kn = C.KV + (size_t)kr * 2048 + h * 128; const float* kp = C.KPE + (size_t)kr * 32;
                    float s = 0.f;
_Pragma("unroll")
                    for (int k = 0; k < 64; ++k) { s += q[k] * kn[k]; MEMFENCE_EVERY(k, 16); }
_Pragma("unroll")
                    for (int k = 0; k < 32; ++k) { s += q[64 + k] * kp[k]; MEMFENCE_EVERY(k, 16); }
                    s *= scale; float mn = fmaxf(m, s); float corr = expf(m - mn), p = expf(s - mn); l = l * corr + p;
_Pragma("unroll")
                    for (int k = 0; k < 32; ++k) { o[k] = o[k] * corr + p * kn[64 + vh * 32 + k]; MEMFENCE_EVERY(k, 16); }
                    m = mn; }
                float il = 1.f / l;
_Pragma("unroll")
                for (int k = 0; k < 32; ++k) C.AO[(size_t)row * 1024 + h * 64 + vh * 32 + k] = o[k] * il; });
#endif
            DENSE_GEMM(C.AO, 1024, 1024, 1024, C.WoutO + (size_t)j2 * 1024 * 1024, C.od_w_out + (size_t)j2 * 1024 * D, D_MODEL, C.YO, D_MODEL, NT_, D_MODEL, 1024);
}
FWD_QUAL void naive_common(FWD_SIG, long layer) {
#if defined(PERSISTENT)
    {
        const int row_lo = layer < DEPTH - 1 ? 0 : NC_, nrows = NT_ - row_lo;
#if CV_BACKGROUND
        if (layer > 0) cv_catchup(Cp_, layer, wv_);
#endif
#if CV_TAIL && !CV_BACKGROUND
        if (layer > 0) cv_catch(Cp_, lds, layer, wv_);
#endif
        tl::ln1_router(Cp_, lds, layer, row_lo, nrows, wv_); grid_sync(bar);
        tl::slots_gather(Cp_, layer, row_lo, nrows, wv_); grid_sync(bar);
        RP(REP_MOE,
        { g8::MoeSched S_; S_.init(C.UB, C.Wgu + (size_t)layer * N_EXPERTS * 2 * EXPERT_DIM * D_MODEL, D_MODEL, 2 * EXPERT_DIM, N_EXPERTS, (const LAS int*)tl::tl_tstart, gridDim.x, moe_remap(opaque_bid(), gridDim.x, 2 * EXPERT_DIM / 256)); S_.gather = true; MOE_SET_CHUNK
          LAS int* gtab = (LAS int*)(lds + 131072);
          { const int t_ = otid(wv_); const GAS int* tok_ = (const GAS int*)C.TOKOF; int gv_[20];
            _Pragma("unroll") for (int i_ = 0; i_ < 20; ++i_) { const long L_ = S_.unit(i_); const int rt_ = (int)((L_ < 0 ? 0 : L_) / S_.NCT); gv_[i_] = (L_ >= 0 && t_ < 256) ? tok_[(size_t)rt_ * 256 + t_] : 0; }
            _Pragma("unroll") for (int i_ = 0; i_ < 20; ++i_) { const long L_ = S_.unit(i_); if (L_ >= 0 && t_ < 256) gtab[i_ * 256 + t_] = gv_[i_]; } }
          __syncthreads();
          g8::EpiSwiGLU E_{C.ACTB, C.moe_b_gu + (size_t)layer * N_EXPERTS * 2 * EXPERT_DIM, EXPERT_DIM}; g8::gemm_phase<D_MODEL, g8::EpiSwiGLU, g8::MoeSched, true>(lds, S_, E_, wv_, gtab, CV_CTX);
#if CV_TAIL && !CV_BACKGROUND
          if (layer < DEPTH - 1) cv_tail(Cp_, lds, S_, wv_);
#endif
          }
        grid_sync(bar);
        { g8::MoeSched S_; S_.init(C.ACTB, C.Wdn + (size_t)layer * N_EXPERTS * D_MODEL * EXPERT_DIM, EXPERT_DIM, D_MODEL, N_EXPERTS, (const LAS int*)tl::tl_tstart, gridDim.x, moe_remap(opaque_bid(), gridDim.x, D_MODEL / 256)); MOE_SET_CHUNK
          g8::EpiDownBf16 E_{C.OUT2B, D_MODEL, C.moe_b_down + (size_t)layer * N_EXPERTS * D_MODEL}; g8::gemm_phase<EXPERT_DIM, g8::EpiDownBf16, g8::MoeSched>(lds, S_, E_, wv_, nullptr, CV_CTX);
#if CV_TAIL && !CV_BACKGROUND
          if (layer < DEPTH - 1) cv_tail(Cp_, lds, S_, wv_);
#endif
          }
        grid_sync(bar);
        )
        tl::combine_ln2(Cp_, layer, row_lo, nrows, wv_); if (layer < DEPTH - 1) grid_sync(bar);
    }
#else

    const int D = D_MODEL, NT = NT_, NC = NC_; (void)D; (void)NT; (void)NC;
    const bool need_ctx = layer < DEPTH - 1; const long j2 = layer / 2; (void)need_ctx; (void)j2;
#define lng0 (C.ln_g + ((size_t)layer * 2 + 0) * D_MODEL)
#define lnb0 (C.ln_b + ((size_t)layer * 2 + 0) * D_MODEL)
#define lng1 (C.ln_g + ((size_t)layer * 2 + 1) * D_MODEL)
#define lnb1 (C.ln_b + ((size_t)layer * 2 + 1) * D_MODEL)
        const long row_lo = need_ctx ? 0 : NC;
        NLAUNCH((long)(NT - row_lo), [=] HD(long i) { int row = (int)row_lo + (int)i; const float* m = MODL + (size_t)modrow(row) * N_MOD * D_MODEL; float* h = C.H + (size_t)row * D_MODEL; const float* yo = C.YO + (size_t)row * D_MODEL;
            float mu_ = 0.f; for (int d = 0; d < D_MODEL; ++d) mu_ += ALPHA * h[d] + m[2 * D_MODEL + d] * yo[d]; mu_ /= D_MODEL;
            float var = 0.f; for (int d = 0; d < D_MODEL; ++d) { float t = ALPHA * h[d] + m[2 * D_MODEL + d] * yo[d] - mu_; var += t * t; } var /= D_MODEL;
            float rs = 1.f / sqrtf(var + 1e-5f);
            for (int d = 0; d < D_MODEL; ++d) { float t = (ALPHA * h[d] + m[2 * D_MODEL + d] * yo[d] - mu_) * rs * lng0[d] + lnb0[d]; h[d] = t; C.U[(size_t)row * D_MODEL + d] = t * (1.f + m[4 * D_MODEL + d]) + m[3 * D_MODEL + d]; } });
#define wr (C.moe_w_router + (size_t)layer * D_MODEL * N_EXPERTS)
#define br (C.moe_b_router + (size_t)layer * N_EXPERTS)
        NLAUNCH((long)(NT - row_lo) * N_EXPERTS, [=] HD(long i) { int e = (int)(i % N_EXPERTS); int row = (int)row_lo + (int)(i / N_EXPERTS); const float* u = C.U + (size_t)row * D_MODEL;
            float s = 0.f; for (int k = 0; k < D_MODEL; ++k) s += u[k] * wr[(size_t)k * N_EXPERTS + e]; C.LOGIT[(size_t)row * N_EXPERTS + e] = s + br[e]; });
#define CNTL (C.CNT + layer * 64)
#define CURL (C.CUR + layer * 64)
        NLAUNCH((long)(NT - row_lo), [=] HD(long i) { int row = (int)row_lo + (int)i; const float* lg = C.LOGIT + (size_t)row * N_EXPERTS; int idx[TOP_K]; float val[TOP_K];
            for (int k = 0; k < TOP_K; ++k) { int best = -1; float bv = -3.4e38f; for (int e = 0; e < N_EXPERTS; ++e) { bool used = false; for (int q = 0; q < k; ++q) used |= (idx[q] == e); if (!used && lg[e] > bv) { bv = lg[e]; best = e; } } idx[k] = best; val[k] = bv; }
            float den = 0.f; for (int k = 0; k < TOP_K; ++k) den += expf(val[k] - val[0]);
            for (int k = 0; k < TOP_K; ++k) { C.TOPI[(size_t)row * TOP_K + k] = idx[k]; C.TOPG[(size_t)row * TOP_K + k] = expf(val[k] - val[0]) / den;
#ifdef HOST_TEST
                CNTL[idx[k]]++;
#else
                atomicAdd(&CNTL[idx[k]], 1);
#endif
            } });
        NLAUNCH(1, [=] HD(long) { int off = 0; for (int e = 0; e < N_EXPERTS; ++e) { C.OFF[e] = off; const int cnt = ld_cnt(CNTL + e); int nt = (cnt + MOE_PAD - 1) / MOE_PAD * MOE_PAD; for (int t = 0; t < nt / 64; ++t) C.TILE_E[off / 64 + t] = (t * 64 < cnt) ? e : -1; off += nt; }
            for (int t = off / 64; t < NSLOT_ / 64; ++t) C.TILE_E[t] = -1; });
        NLAUNCH((long)NSLOT_, [=] HD(long i) { C.TOKOF[i] = -1; });
        NLAUNCH((long)(NT - row_lo) * TOP_K, [=] HD(long i) { int row = (int)row_lo + (int)(i / TOP_K); int k = (int)(i % TOP_K); int e = C.TOPI[(size_t)row * TOP_K + k];
#ifdef HOST_TEST
            int r = CURL[e]++;
#else
            int r = atomicAdd(&CURL[e], 1);
#endif
            int s = C.OFF[e] + r; C.SLOT[(size_t)row * TOP_K + k] = s; C.TOKOF[s] = row; });
#if defined(PERSISTENT)
        {
            __shared__ int tstart_s[40];
            if (otid(wv_) == 0) { int acc_t = 0; for (int e = 0; e < N_EXPERTS; ++e) { tstart_s[e] = acc_t; acc_t += (ld_cnt(CNTL + e) + MOE_PAD - 1) / MOE_PAD; } tstart_s[N_EXPERTS] = acc_t; }
            GRID_STRIDE_WAVES(i, (long)NSLOT_ * (D_MODEL / 8)) { const long sl = i / (D_MODEL / 8); const int c8 = (int)(i % (D_MODEL / 8)) * 8; const int tk = C.TOKOF[sl]; u32x4 w = (u32x4){0u, 0u, 0u, 0u};
                if (tk >= 0) { const float4 a = *(const float4*)(C.U + (size_t)tk * D_MODEL + c8), b = *(const float4*)(C.U + (size_t)tk * D_MODEL + c8 + 4);
                    w.x = cvt_pk_bf16(a.x, a.y); w.y = cvt_pk_bf16(a.z, a.w); w.z = cvt_pk_bf16(b.x, b.y); w.w = cvt_pk_bf16(b.z, b.w); }
                *(u32x4*)(C.XPB + sl * D_MODEL + c8) = w; }
            grid_sync(bar);
            { g8::MoeSched S_; S_.init(C.XPB, C.Wgu + (size_t)layer * N_EXPERTS * 2 * EXPERT_DIM * D_MODEL, D_MODEL, 2 * EXPERT_DIM, N_EXPERTS, (const LAS int*)tstart_s, gridDim.x, opaque_bid());
              g8::EpiSwiGLU E_{C.ACTB, C.moe_b_gu + (size_t)layer * N_EXPERTS * 2 * EXPERT_DIM, EXPERT_DIM}; g8::gemm_phase<D_MODEL, g8::EpiSwiGLU, g8::MoeSched>(lds, S_, E_, wv_); }
            grid_sync(bar);
            { g8::MoeSched S_; S_.init(C.ACTB, C.Wdn + (size_t)layer * N_EXPERTS * D_MODEL * EXPERT_DIM, EXPERT_DIM, D_MODEL, N_EXPERTS, (const LAS int*)tstart_s, gridDim.x, opaque_bid());
              g8::EpiDownF32 E_{C.OUT2, D_MODEL, C.moe_b_down + (size_t)layer * N_EXPERTS * D_MODEL}; g8::gemm_phase<EXPERT_DIM, g8::EpiDownF32, g8::MoeSched>(lds, S_, E_, wv_); }
            grid_sync(bar);
        }
#else
        const int F = EXPERT_DIM;
        ngemm(C.U, D, C.TOKOF, C.moe_w_gu + (size_t)layer * N_EXPERTS * D * 2 * F, (long)D * 2 * F, 2 * F, C.moe_b_gu + (size_t)layer * N_EXPERTS * 2 * F, 2 * F, C.H1, 2 * F, NSLOT_, 2 * F, D, C.TILE_E);
        NLAUNCH((long)NSLOT_ * F, [=] HD(long i) { long s = i / EXPERT_DIM; int j = (int)(i % EXPERT_DIM); if (C.TOKOF[s] < 0) { C.ACT[i] = 0.f; return; }
            float glu = fminf(C.H1[s * 2 * EXPERT_DIM + j], 7.f), lin = fminf(fmaxf(C.H1[s * 2 * EXPERT_DIM + EXPERT_DIM + j], -7.f), 7.f);
            C.ACT[i] = glu * sigmoidf_(1.702f * glu) * (lin + 1.f); });
        ngemm(C.ACT, F, nullptr, C.moe_w_down + (size_t)layer * N_EXPERTS * F * D, (long)F * D, D, C.moe_b_down + (size_t)layer * N_EXPERTS * D, D, C.OUT2, D, NSLOT_, D, F, C.TILE_E);
#endif
#define outp (C.out)
        const long last = (layer == DEPTH - 1);
        NLAUNCH((long)(NT - row_lo), [=] HD(long i) { int row = (int)row_lo + (int)i; const float* m = MODL + (size_t)modrow(row) * N_MOD * D_MODEL; float* h = C.H + (size_t)row * D_MODEL;
            const int* sl = C.SLOT + (size_t)row * TOP_K; const float* tg = C.TOPG + (size_t)row * TOP_K;
            float mu_ = 0.f; for (int d = 0; d < D_MODEL; ++d) { float f = 0.f; for (int k = 0; k < TOP_K; ++k) f += tg[k] * C.OUT2[(size_t)sl[k] * D_MODEL + d]; mu_ += ALPHA * h[d] + m[5 * D_MODEL + d] * f; } mu_ /= D_MODEL;
            float var = 0.f; for (int d = 0; d < D_MODEL; ++d) { float f = 0.f; for (int k = 0; k < TOP_K; ++k) f += tg[k] * C.OUT2[(size_t)sl[k] * D_MODEL + d]; float t = ALPHA * h[d] + m[5 * D_MODEL + d] * f - mu_; var += t * t; } var /= D_MODEL;
            float rs = 1.f / sqrtf(var + 1e-5f);
            for (int d = 0; d < D_MODEL; ++d) { float f = 0.f; for (int k = 0; k < TOP_K; ++k) f += tg[k] * C.OUT2[(size_t)sl[k] * D_MODEL + d]; float t = (ALPHA * h[d] + m[5 * D_MODEL + d] * f - mu_) * rs * lng1[d] + lnb1[d]; h[d] = t; if (last) outp[(size_t)(row - NC_) * D_MODEL + d] = t; } });
#endif
}


#if defined(PERSISTENT)
#define MG_DENSE(KP, EPI, Aptr, Wptr, Mrows, NP, ...) do { g8::DenseSched S_; S_.init((Aptr), (Wptr), (Mrows), (NP), (KP), gridDim.x, opaque_bid()); g8::EPI E_{__VA_ARGS__}; g8::gemm_phase<(KP), g8::EPI, g8::DenseSched>(lds, S_, E_, wv_, nullptr, CV_CTX); } while (0)
FWD_QUAL void mega_even(FWD_SIG, long layer) {
    const long j2 = layer / 2;
    RP(REP_DEN, MG_DENSE(1024, EpiBf16, C.UB, C.WinE + (size_t)j2 * 4608 * 1024, NT_, 4608, C.ZB, 4608, 1.f); grid_sync(bar);)
    RP(REP_TLE, tl::rw_tw(Cp_, layer, wv_); grid_sync(bar);)
    RP(REP_DEN, { g8::LoraSched S_; S_.init(C.TW, C.Wlora + (size_t)j2 * 2560 * 384, NT_, 2560, 384, gridDim.x, opaque_bid()); g8::EpiBf16 E_{C.LOB, 2560, 1.f}; g8::gemm_phase<256, g8::EpiBf16, g8::LoraSched, false, 384>(lds, S_, E_, wv_, nullptr, CV_CTX); } grid_sync(bar);)
    RP(REP_TLE, tl::rw_prep(Cp_, layer, wv_); grid_sync(bar);)
    RP(REP_RWS, rwc::rwkv_chunk_scan(Cp_, lds, wv_);)
    RP(REP_HGS, hg::hgrn_scan(Cp_, lds, layer, wv_); grid_sync(bar);)
    RP(REP_TLE, tl::even_post(Cp_, layer, wv_); grid_sync(bar);)
    RP(REP_DEN, MG_DENSE(1024, EpiBf16, C.YCATB, C.WoutE + (size_t)j2 * 1024 * 1024, NT_, 1024, C.YOB, D_MODEL, 1.f); grid_sync(bar);)
}
FWD_QUAL void mega_odd(FWD_SIG, long layer) {
    const long j2 = layer / 2; const bool need_ctx = layer < DEPTH - 1;
    RP(REP_DEN, MG_DENSE(1024, EpiBf16, C.UB, C.WinO + (size_t)j2 * 512 * 1024, NT_, 512, (bf16_t*)C.Z, 512, 1.f); grid_sync(bar);)
    RP(REP_TLE, tl::mla_prep(Cp_, layer, wv_); grid_sync(bar);)
    const size_t r0 = need_ctx ? 0 : (size_t)NC_; const int mq = need_ctx ? NT_ : NT_ - NC_;
    RP(REP_DEN, MG_DENSE(256, EpiBf16, C.QNB + r0 * 256, C.Wqb + (size_t)j2 * 1536 * 256, mq, 1536, C.QB + r0 * 1536, 1536, 0.14724445136f);)
    RP(REP_DEN, MG_DENSE(256, EpiBf16, C.KVNB, C.Wkvb + (size_t)j2 * 2048 * 256, NT_, 2048, C.KVB, 2048, 1.f); grid_sync(bar);)
    RP(REP_ATT, att::attn_phase<true, 1>(lds, C.QB, C.KVB, C.KPEB, nullptr, C.AOB, need_ctx ? 1 : 0, wv_, C.ROPE); grid_sync(bar);)
    RP(REP_DEN, MG_DENSE(1024, EpiBf16, C.AOB + r0 * 1024, C.WoutO + (size_t)j2 * 1024 * 1024, mq, 1024, C.YOB + r0 * D_MODEL, D_MODEL, 1.f); grid_sync(bar);)
}
#endif
FWD_QUAL void naive_forward(FWD_SIG) {
#if defined(PERSISTENT)
    RP(REP_PRO, naive_prologue(FWD_ARGS);)
#else
    naive_prologue(FWD_ARGS);
#endif
#if defined(PERSISTENT)
    mega_even(FWD_ARGS, 0); naive_common(FWD_ARGS, 0);
    mega_odd(FWD_ARGS, 1); naive_common(FWD_ARGS, 1);
    mega_even(FWD_ARGS, 2); naive_common(FWD_ARGS, 2);
    mega_odd(FWD_ARGS, 3); naive_common(FWD_ARGS, 3);
#else
    for (long p = 0; p < DEPTH / 2; ++p) {
        naive_modu(FWD_ARGS, 2 * p); naive_even(FWD_ARGS, 2 * p); naive_common(FWD_ARGS, 2 * p);
        naive_modu(FWD_ARGS, 2 * p + 1); naive_odd(FWD_ARGS, 2 * p + 1); naive_common(FWD_ARGS, 2 * p + 1);
    }
#endif
}

#undef MODL
#undef mu
#undef w0
#undef w2
#undef a0
#undef a2
#undef g2
#undef k_k
#undef k_a
#undef r_k
#undef gn_g
#undef gn_b
#undef lbp
#undef hgn
#undef qng
#undef kvng
#undef lng0
#undef lnb0
#undef lng1
#undef lnb1
#undef wr
#undef br
#undef CNTL
#undef CURL
#undef outp

#ifdef PERSIST_C_MACRO
#undef C
#endif
struct Params { NaiveCtx C; unsigned* bar; };
__global__ void __launch_bounds__(PB_THREADS, 2) mega_fwd(Params p) {
    extern __shared__ __attribute__((aligned(16))) unsigned char dyn_lds[];
    __shared__ NaiveCtx sC;
    __shared__ uint4 xb_words;
    typedef unsigned long long u64;
    const __attribute__((address_space(4))) u64* ka = (const __attribute__((address_space(4))) u64*)__builtin_amdgcn_kernarg_segment_ptr();
    constexpr int NW = (int)(sizeof(NaiveCtx) / 8);
    if (threadIdx.x < NW) ((LAS u64*)&sC)[threadIdx.x] = ka[threadIdx.x];
    if (threadIdx.x == 0) xb_words = make_uint4(0u, 0u, 0u, 0u);
    __syncthreads();
    unsigned* barp = (unsigned*)ka[NW];
    XcdBarrier bar = xcd_barrier_post(barp, (volatile LAS unsigned*)&xb_words);
    naive_forward((const LAS NaiveCtx*)&sC, bar, (LAS unsigned char*)dyn_lds, __builtin_amdgcn_readfirstlane(threadIdx.x >> 6));
}
extern "C" void kernel_launch(void* const* d_in, const int* in_sizes, int n_in, void* d_out, int out_size, void* d_ws, size_t ws_size, hipStream_t stream) {
    static int grid = 0;
    constexpr size_t kDynLds = 152 * 1024;
    if (grid == 0) {
        int dev = 0, cus = 0, per_cu = 0;
        hipGetDevice(&dev); hipDeviceGetAttribute(&cus, hipDeviceAttributeMultiprocessorCount, dev);
        hipFuncSetAttribute((const void*)mega_fwd, hipFuncAttributeMaxDynamicSharedMemorySize, (int)kDynLds);
        hipOccupancyMaxActiveBlocksPerMultiprocessor(&per_cu, (const void*)mega_fwd, PB_THREADS, kDynLds);
        if (per_cu < 1) { fprintf(stderr, "kernel_launch: occupancy query says %d blocks per CU\n", per_cu); grid = -1; return; }
        grid = cus;
    }
    if (grid < 0) return;
    Params p; memset(&p, 0, sizeof(p));
    const float** ip = (const float**)&p.C.x; for (int i = 0; i < 35; ++i) ip[i] = (const float*)d_in[i];
    p.C.out = (float*)d_out;
    const size_t ctl_bytes = 64 * 1024;
    p.bar = (unsigned*)d_ws;
    size_t need = ctl_bytes + mega_carve(p.C, (char*)d_ws + ctl_bytes);
    if (n_in != 35 || need > ws_size) { fprintf(stderr, "kernel_launch: n_in %d ws need %zu have %zu\n", n_in, need, ws_size); return; }
    hipMemsetAsync(d_ws, 0, ctl_bytes, stream);
    hipMemsetAsync(p.C.CNT, 0, 64 * DEPTH * 4 * 2 + 512, stream);
    hipLaunchKernelGGL(mega_fwd, dim3(grid), dim3(PB_THREADS), kDynLds, stream, p);
}
```
